# Optimizing an MI355X kernel written in HIP

```python
import jax, jax.numpy as jnp
from jax import lax
import numpy as np

D_MODEL = 1024
BATCH = 8
SEQ = 4096
DEPTH = 2

CHUNK = 64
HEAD_DIM = 64
N_BRANCH = 4
A_HEADS = 4
A_LEFT_CHUNKS = 8
A_BAND = (A_LEFT_CHUNKS + 1) * CHUNK
REL_CLIP = 128
A_BIAS_SIZE = CHUNK + REL_CLIP
B_HEADS = 4
B_DK = 64
B_DV = 64
C_HEADS = 4
IDX_HEADS = 8
IDX_DIM = 64
TOPK_MAX = 256
Q_BLOCK = 128
D_HEADS = 4
W_LORA = 64
A_LORA = 64

ROPE_THETA = 10000.0
EPS = 1e-6
GN_EPS = 64e-5

WA = A_HEADS * HEAD_DIM
WB = B_HEADS * B_DV
WC = C_HEADS * HEAD_DIM
WD = D_HEADS * HEAD_DIM
BRANCH_W = WA

A_COLS = [WA, WA, WA, WA]
B_COLS = [B_HEADS * B_DK, B_HEADS * B_DK, WB, WB]
C_COLS = [WC, WC, WC, WC, IDX_HEADS * IDX_DIM, IDX_DIM, IDX_HEADS]
D_SHIFT_COLS = [WD, WD, WD, W_LORA, A_LORA]
COARSE_COLS = [sum(A_COLS), sum(B_COLS), sum(C_COLS), sum(D_SHIFT_COLS), WD, N_BRANCH * D_MODEL]
IN_COLS = sum(COARSE_COLS)


def _cuts(sizes):
    return [int(c) for c in np.cumsum(sizes)[:-1]]


kernel_name = 'hybrid_chunk_causal_gated_merge'


def _rmsnorm(x, g):
    xf = x.astype(jnp.float32)
    inv = lax.rsqrt(jnp.mean(xf * xf, axis=-1, keepdims=True) + EPS)
    return (xf * inv).astype(x.dtype) * g


def _heads(t, h):
    return t.reshape(t.shape[0], t.shape[1], h, -1)


def _rope(t, pos):
    half = t.shape[-1] // 2
    freqs = ROPE_THETA ** (-jnp.arange(half, dtype=jnp.float32) / half)
    ang = pos.astype(jnp.float32)[:, None] * freqs[None, :]
    cos = jnp.cos(ang)[None, :, None, :].astype(t.dtype)
    sin = jnp.sin(ang)[None, :, None, :].astype(t.dtype)
    t1, t2 = t[..., :half], t[..., half:]
    return jnp.concatenate([t1 * cos - t2 * sin, t2 * cos + t1 * sin], axis=-1)


def _chunk_band_attention(q, k, v, rel_bias):
    b_, s_, h_, dh = q.shape
    n = s_ // CHUNK
    pad = A_LEFT_CHUNKS * CHUNK
    qc = q.reshape(b_, n, CHUNK, h_, dh)
    kp = jnp.pad(k, ((0, 0), (pad, 0), (0, 0), (0, 0))).reshape(b_, n + A_LEFT_CHUNKS, CHUNK, h_, dh)
    vp = jnp.pad(v, ((0, 0), (pad, 0), (0, 0), (0, 0))).reshape(b_, n + A_LEFT_CHUNKS, CHUNK, h_, dh)
    kb = jnp.concatenate([kp[:, j:j + n] for j in range(A_LEFT_CHUNKS + 1)], axis=2)
    vb = jnp.concatenate([vp[:, j:j + n] for j in range(A_LEFT_CHUNKS + 1)], axis=2)
    s = jnp.einsum('bnqhd,bnkhd->bnhqk', qc, kb).astype(jnp.float32) * (dh ** -0.5)
    qi = jnp.arange(CHUNK)
    kj = jnp.arange(A_BAND)
    rel = jnp.clip(pad + qi[:, None] - kj[None, :], -(CHUNK - 1), REL_CLIP) + (CHUNK - 1)
    bias = rel_bias[:, rel].astype(jnp.float32)
    valid = (jnp.arange(n)[:, None] * CHUNK - pad + kj[None, :]) >= 0
    s = jnp.where(valid[None, :, None, None, :], s + bias[None, None], -jnp.inf)
    p = jax.nn.softmax(s, axis=-1).astype(v.dtype)
    o = jnp.einsum('bnhqk,bnkhd->bnqhd', p, vb)
    return o.reshape(b_, s_, h_ * dh)


def _hgrn2(q, f_logit, i, lb, norm_g):
    out_dtype = i.dtype
    b_, s_, h_, dk = q.shape
    dv = i.shape[-1]
    n = s_ // CHUNK
    lb = lb.astype(jnp.float32).reshape(h_, dk)
    fl = f_logit.astype(jnp.float32)
    log_f = jnp.logaddexp(jnp.log(lb), jnp.log1p(-lb) + jax.nn.log_sigmoid(fl))
    key = (1.0 - lb) * jax.nn.sigmoid(-fl)
    qf = jax.nn.silu(q.astype(jnp.float32))
    vf = i.astype(jnp.float32)

    def to_chunks(t):
        return t.reshape(b_, n, CHUNK, h_, t.shape[-1]).transpose(1, 0, 3, 2, 4)

    causal = jnp.tril(jnp.ones((CHUNK, CHUNK), dtype=bool))

    def step(state, xs):
        qb, kb, vb, gb = xs
        bcum = jnp.cumsum(gb, axis=2)
        diff = bcum[:, :, :, None, :] - bcum[:, :, None, :, :]
        decay = jnp.exp(jnp.where(causal[None, None, :, :, None], diff, -jnp.inf))
        att = jnp.sum(qb[:, :, :, None, :] * kb[:, :, None, :, :] * decay, axis=-1)
        o = jnp.einsum('bhts,bhsv->bhtv', att, vb) + jnp.einsum('bhtd,bhdv->bhtv', qb * jnp.exp(bcum), state)
        b_last = bcum[:, :, -1:, :]
        state = jnp.exp(b_last[:, :, 0, :])[..., None] * state + jnp.einsum('bhsd,bhsv->bhdv', kb * jnp.exp(b_last - bcum), vb)
        return state, o

    s0 = jnp.zeros((b_, h_, dk, dv), jnp.float32)
    _, o = lax.scan(step, s0, (to_chunks(qf), to_chunks(key), to_chunks(vf), to_chunks(log_f)))
    o = o.transpose(1, 0, 3, 2, 4).reshape(b_, s_, h_, dv)
    o = o * lax.rsqrt(jnp.mean(o * o, axis=-1, keepdims=True) + EPS) * norm_g.astype(jnp.float32)
    return o.reshape(b_, s_, h_ * dv).astype(out_dtype)


def _dsa(q, k, v, qi, ki, wi):
    b_, s_, h_, dh = q.shape
    topk = min(TOPK_MAX, s_ // 4)
    nb = s_ // Q_BLOCK
    key_chunk = jnp.arange(s_) // CHUNK

    def blk(xs):
        qb, qib, wib, start = xs
        qchunk = (start + jnp.arange(Q_BLOCK)) // CHUNK
        admissible = key_chunk[None, :] <= qchunk[:, None]
        sc = jax.nn.relu(jnp.einsum('bqhd,bsd->bqhs', qib, ki) * (IDX_DIM ** -0.5))
        iscore = jnp.einsum('bqhs,bqh->bqs', sc, wib * (IDX_HEADS ** -0.5)).astype(jnp.float32)
        iscore = jnp.where(admissible[None], iscore, -jnp.inf)
        _, sel = lax.top_k(iscore, topk)
        ksel = jax.vmap(lambda kk, ii: kk[ii])(k, sel)
        vsel = jax.vmap(lambda vv, ii: vv[ii])(v, sel)
        sel_ok = (sel // CHUNK) <= qchunk[None, :, None]
        s = jnp.einsum('bqhd,bqkhd->bhqk', qb, ksel).astype(jnp.float32) * (dh ** -0.5)
        s = jnp.where(sel_ok[:, None], s, -jnp.inf)
        p = jax.nn.softmax(s, axis=-1).astype(v.dtype)
        return jnp.einsum('bhqk,bqkhd->bqhd', p, vsel)

    def to_blocks(t):
        return t.reshape(b_, nb, Q_BLOCK, *t.shape[2:]).swapaxes(0, 1)

    starts = jnp.arange(nb, dtype=jnp.int32) * Q_BLOCK
    o = lax.map(blk, (to_blocks(q), to_blocks(qi), to_blocks(wi), starts))
    return o.swapaxes(0, 1).reshape(b_, s_, h_ * dh)


def _token_shift(p, mu):
    prev = jnp.pad(p, ((0, 0), (1, 0), (0, 0)))[:, :-1]
    return p + mu * (prev - p)


def _rwkv7(r, k, v, wd, ad, w0, w_up, a0, a_up, k_k, k_a, r_k, gn_g, gn_b):
    out_dtype = v.dtype
    b_, s_, _ = r.shape
    h_, n_ = D_HEADS, HEAD_DIM
    wlog = -jax.nn.softplus(-(w0 + jnp.tanh(wd) @ w_up)) - 0.5
    decay = jnp.exp(-jnp.exp(wlog.astype(jnp.float32)))
    a = jax.nn.sigmoid((a0 + ad @ a_up).astype(jnp.float32))
    kf = k.astype(jnp.float32)
    kk = (kf * k_k).reshape(b_, s_, h_, n_)
    kk = kk / jnp.maximum(jnp.sqrt(jnp.sum(kk * kk, axis=-1, keepdims=True)), 1e-12)
    kf = kf * (1.0 + (a - 1.0) * k_a)
    r4 = r.astype(jnp.float32).reshape(b_, s_, h_, n_)
    k4 = kf.reshape(b_, s_, h_, n_)
    v4 = v.astype(jnp.float32).reshape(b_, s_, h_, n_)
    w4 = decay.reshape(b_, s_, h_, n_)
    a4 = a.reshape(b_, s_, h_, n_)

    def step(state, xs):
        rt, wt, kt, vt, kkt, at = xs
        sa = jnp.einsum('bhvk,bhk->bhv', state, -kkt)
        state = state * wt[:, :, None, :] + sa[..., None] * (kkt * at)[:, :, None, :] + vt[..., None] * kt[:, :, None, :]
        return state, jnp.einsum('bhvk,bhk->bhv', state, rt)

    tm = lambda t: t.transpose(1, 0, 2, 3)
    s0 = jnp.zeros((b_, h_, n_, n_), jnp.float32)
    _, o = lax.scan(step, s0, (tm(r4), tm(w4), tm(k4), tm(v4), tm(kk), tm(a4)))
    o = tm(o)
    mean = jnp.mean(o, axis=-1, keepdims=True)
    var = jnp.mean(jnp.square(o - mean), axis=-1, keepdims=True)
    o = ((o - mean) * lax.rsqrt(var + GN_EPS)).reshape(b_, s_, h_ * n_) * gn_g + gn_b
    bonus = jnp.sum(r4 * k4 * r_k.astype(jnp.float32), axis=-1, keepdims=True) * v4
    o = o + bonus.reshape(b_, s_, h_ * n_)
    return o.astype(out_dtype)


def setup_inputs(seed: int = 0) -> dict:
    key = jax.random.key(seed)
    ks = jax.random.split(key, 24)
    f32 = jnp.float32
    nrm = lambda i, shape, scale: jax.random.normal(ks[i], shape, f32) * scale
    return {
        'x': nrm(0, (BATCH, SEQ, D_MODEL), 1.0),
        'norm_g': 1.0 + nrm(1, (DEPTH, D_MODEL), 0.02),
        'w_in': nrm(2, (DEPTH, D_MODEL, IN_COLS), D_MODEL ** -0.5),
        'a_rel_bias': nrm(3, (DEPTH, A_HEADS, A_BIAS_SIZE), 0.3),
        'b_lb_logits': nrm(4, (DEPTH, B_HEADS * B_DK), 1.0),
        'b_norm_g': 1.0 + nrm(5, (DEPTH, B_DV), 0.02),
        'd_mu': jax.random.uniform(ks[6], (DEPTH, sum(D_SHIFT_COLS)), f32),
        'd_w0': nrm(7, (DEPTH, WD), 0.5),
        'd_w_up': nrm(8, (DEPTH, W_LORA, WD), 0.5 * W_LORA ** -0.5),
        'd_a0': nrm(9, (DEPTH, WD), 0.1),
        'd_a_up': nrm(10, (DEPTH, A_LORA, WD), 0.5 * A_LORA ** -0.5),
        'd_k_k': 0.85 + nrm(11, (DEPTH, WD), 0.02),
        'd_k_a': 1.0 + nrm(12, (DEPTH, WD), 0.02),
        'd_r_k': nrm(13, (DEPTH, D_HEADS, HEAD_DIM), 0.1),
        'd_gn_g': 1.0 + nrm(14, (DEPTH, WD), 0.02),
        'd_gn_b': nrm(15, (DEPTH, WD), 0.01),
        'w_branch': nrm(16, (DEPTH, N_BRANCH, BRANCH_W, D_MODEL), BRANCH_W ** -0.5),
        'w_out': nrm(17, (DEPTH, D_MODEL, D_MODEL), D_MODEL ** -0.5),
        'final_g': 1.0 + nrm(18, (D_MODEL,), 0.02),
    }


def reference(x, norm_g, w_in, a_rel_bias, b_lb_logits, b_norm_g, d_mu, d_w0, d_w_up, d_a0, d_a_up,
              d_k_k, d_k_a, d_r_k, d_gn_g, d_gn_b, w_branch, w_out, final_g):
    pos = jnp.arange(x.shape[1], dtype=jnp.int32)
    lb_all = jnp.cumsum(jax.nn.softmax(b_lb_logits.astype(jnp.float32), axis=0), axis=0)
    lb_all = lb_all - lb_all[0:1]
    for l in range(DEPTH):
        h = _rmsnorm(x, norm_g[l])
        p = h @ w_in[l]
        pa, pb, pc, pd, dz, pg = jnp.split(p, _cuts(COARSE_COLS), axis=-1)
        aq, ak, av, az = jnp.split(pa, _cuts(A_COLS), axis=-1)
        oa = _chunk_band_attention(_heads(aq, A_HEADS), _heads(ak, A_HEADS), _heads(av, A_HEADS), a_rel_bias[l]) * jax.nn.silu(az)
        bq, bf, bi, bz = jnp.split(pb, _cuts(B_COLS), axis=-1)
        ob = _hgrn2(_heads(bq, B_HEADS), _heads(bf, B_HEADS), _heads(bi, B_HEADS), lb_all[l], b_norm_g[l]) * jax.nn.silu(bz)
        cq, ck, cv, cz, cqi, cki, cwi = jnp.split(pc, _cuts(C_COLS), axis=-1)
        oc = _dsa(_rope(_heads(cq, C_HEADS), pos), _rope(_heads(ck, C_HEADS), pos), _heads(cv, C_HEADS),
                  _rope(_heads(cqi, IDX_HEADS), pos), _rope(cki[:, :, None, :], pos)[:, :, 0, :], cwi) * jax.nn.silu(cz)
        dr, dk, dv, dwd, dad = jnp.split(_token_shift(pd, d_mu[l]), _cuts(D_SHIFT_COLS), axis=-1)
        od = _rwkv7(dr, dk, dv, dwd, dad, d_w0[l], d_w_up[l], d_a0[l], d_a_up[l], d_k_k[l], d_k_a[l],
                    d_r_k[l], d_gn_g[l], d_gn_b[l]) * jax.nn.silu(dz)
        ga, gb, gc, gd = jnp.split(pg, N_BRANCH, axis=-1)
        y = (jax.nn.sigmoid(ga) * (oa @ w_branch[l, 0]) + jax.nn.sigmoid(gb) * (ob @ w_branch[l, 1])
             + jax.nn.sigmoid(gc) * (oc @ w_branch[l, 2]) + jax.nn.sigmoid(gd) * (od @ w_branch[l, 3]))
        x = x + y @ w_out[l]
    return _rmsnorm(x, final_g)
```

```cpp
#include <hip/hip_runtime.h>
#include <math.h>
#include <stdint.h>

#define DM 1024
#define SEQ 4096
#define NBATCH 8
#define INC 8904
#define C_AQ 0
#define C_AK 256
#define C_AV 512
#define C_AZ 768
#define C_BQ 1024
#define C_BF 1280
#define C_BI 1536
#define C_BZ 1792
#define C_CQ 2048
#define C_CK 2304
#define C_CV 2560
#define C_CZ 2816
#define C_CQI 3072
#define C_CKI 3584
#define C_CWI 3648
#define C_PD 3656
#define C_DR 3656
#define C_DK 3912
#define C_DV 4168
#define C_DWD 4424
#define C_DAD 4488
#define C_DZ 4552
#define C_PG 4808

__device__ __forceinline__ float sigmoidf_(float x) { return 1.f / (1.f + expf(-x)); }
__device__ __forceinline__ float siluf_(float x) { return x / (1.f + expf(-x)); }

__global__ void k_setup(float* tcos, float* tsin, const float* lb_logits, float* lb) {
    int i = blockIdx.x * blockDim.x + threadIdx.x;
    if (i < SEQ * 32) {
        int pos = i / 32, j = i % 32;
        float freq = (float)pow(10000.0, -(double)j / 32.0);
        float ang = (float)pos * freq;
        tcos[i] = (float)cos((double)ang);
        tsin[i] = (float)sin((double)ang);
    }
    if (i < 256) {
        float l0 = lb_logits[i], l1 = lb_logits[256 + i];
        lb[i] = 0.f;
        lb[256 + i] = 1.f / (1.f + expf(l0 - l1));
    }
}

__global__ __launch_bounds__(256) void k_rmsnorm(const float* __restrict__ x, const float* __restrict__ g, float* __restrict__ y) {
    __shared__ float red[4];
    size_t row = blockIdx.x;
    const float4 v = ((const float4*)(x + row * DM))[threadIdx.x];
    float s = v.x * v.x + v.y * v.y + v.z * v.z + v.w * v.w;
    for (int o = 32; o > 0; o >>= 1) s += __shfl_xor(s, o);
    if ((threadIdx.x & 63) == 0) red[threadIdx.x >> 6] = s;
    __syncthreads();
    float tot = red[0] + red[1] + red[2] + red[3];
    float inv = rsqrtf(tot * (1.f / DM) + 1e-6f);
    const float4 gg = ((const float4*)g)[threadIdx.x];
    float4 o4 = make_float4(v.x * inv * gg.x, v.y * inv * gg.y, v.z * inv * gg.z, v.w * inv * gg.w);
    ((float4*)(y + row * DM))[threadIdx.x] = o4;
}

__global__ __launch_bounds__(256) void k_gemm(const float* __restrict__ A, int lda, const float* __restrict__ B, int ldb,
                                              float* __restrict__ C, int ldc, int M, int N, int K,
                                              const float* __restrict__ R, int ldr) {
    __shared__ float As[16][68];
    __shared__ float Bs[16][68];
    const int tx = threadIdx.x & 15, ty = threadIdx.x >> 4;
    const int m0 = blockIdx.y * 64, n0 = blockIdx.x * 64;
    float acc[4][4];
#pragma unroll
    for (int i = 0; i < 4; i++)
#pragma unroll
        for (int j = 0; j < 4; j++) acc[i][j] = 0.f;
    for (int k0 = 0; k0 < K; k0 += 16) {
#pragma unroll
        for (int r = 0; r < 4; r++) {
            int i = threadIdx.x + r * 256;
            int m = i >> 4, k = i & 15;
            As[k][m] = A[(size_t)(m0 + m) * lda + k0 + k];
        }
#pragma unroll
        for (int r = 0; r < 4; r++) {
            int i = threadIdx.x + r * 256;
            int k = i >> 6, n = i & 63;
            Bs[k][n] = (n0 + n < N) ? B[(size_t)(k0 + k) * ldb + n0 + n] : 0.f;
        }
        __syncthreads();
#pragma unroll
        for (int k = 0; k < 16; k++) {
            float a[4], b[4];
#pragma unroll
            for (int i = 0; i < 4; i++) a[i] = As[k][ty * 4 + i];
#pragma unroll
            for (int j = 0; j < 4; j++) b[j] = Bs[k][tx * 4 + j];
#pragma unroll
            for (int i = 0; i < 4; i++)
#pragma unroll
                for (int j = 0; j < 4; j++) acc[i][j] = fmaf(a[i], b[j], acc[i][j]);
        }
        __syncthreads();
    }
#pragma unroll
    for (int i = 0; i < 4; i++) {
        int m = m0 + ty * 4 + i;
#pragma unroll
        for (int j = 0; j < 4; j++) {
            int n = n0 + tx * 4 + j;
            if (n < N) {
                float v = acc[i][j];
                if (R) v += R[(size_t)m * ldr + n];
                C[(size_t)m * ldc + n] = v;
            }
        }
    }
}

__global__ void k_rope(float* __restrict__ p, const float* __restrict__ tcos, const float* __restrict__ tsin) {
    int idx = blockIdx.x * blockDim.x + threadIdx.x;
    if (idx >= SEQ * 17 * 32) return;
    int i = idx & 31; int u = (idx >> 5) % 17; int t = idx / (17 * 32);
    int base;
    if (u < 4) base = C_CQ + u * 64;
    else if (u < 8) base = C_CK + (u - 4) * 64;
    else if (u < 16) base = C_CQI + (u - 8) * 64;
    else base = C_CKI;
    float* row = p + (size_t)t * INC + base;
    float c = tcos[t * 32 + i], s = tsin[t * 32 + i];
    float t1 = row[i], t2 = row[32 + i];
    row[i] = t1 * c - t2 * s;
    row[32 + i] = t2 * c + t1 * s;
}

__global__ __launch_bounds__(64) void k_attnA(const float* __restrict__ p, const float* __restrict__ bias, float* __restrict__ ocat) {
    const int c = blockIdx.x, h = blockIdx.y, qi = threadIdx.x;
    const int t = c * 64 + qi;
    float q[64], o[64];
    const float* qrow = p + (size_t)t * INC + C_AQ + h * 64;
#pragma unroll
    for (int d = 0; d < 64; d++) { q[d] = qrow[d]; o[d] = 0.f; }
    float m = -INFINITY, l = 0.f;
    const float* bh = bias + h * 192;
    for (int kj = 0; kj < 576; kj++) {
        int kp = c * 64 - 512 + kj;
        if (kp < 0) continue;
        const float* krow = p + (size_t)kp * INC + C_AK + h * 64;
        const float* vrow = p + (size_t)kp * INC + C_AV + h * 64;
        float s = 0.f;
#pragma unroll
        for (int d = 0; d < 64; d++) s = fmaf(q[d], krow[d], s);
        int rel = qi + 512 - kj;
        rel = rel < -63 ? -63 : (rel > 128 ? 128 : rel);
        s = s * 0.125f + bh[rel + 63];
        float mn = fmaxf(m, s);
        float al = expf(m - mn);
        float pe = expf(s - mn);
        l = l * al + pe;
#pragma unroll
        for (int d = 0; d < 64; d++) o[d] = fmaf(pe, vrow[d], o[d] * al);
        m = mn;
    }
    float invl = 1.f / l;
    const float* zrow = p + (size_t)t * INC + C_AZ + h * 64;
    float* orow = ocat + (size_t)t * 1024 + 0 + h * 64;
#pragma unroll
    for (int d = 0; d < 64; d++) orow[d] = o[d] * invl * siluf_(zrow[d]);
}

__global__ void k_bprep(const float* __restrict__ p, const float* __restrict__ lb, float* __restrict__ bq, float* __restrict__ bf, float* __restrict__ bk) {
    int idx = blockIdx.x * blockDim.x + threadIdx.x;
    if (idx >= SEQ * 256) return;
    int t = idx >> 8, j = idx & 255;
    float fl = p[(size_t)t * INC + C_BF + j];
    float key = (1.f - lb[j]) * sigmoidf_(-fl);
    bk[idx] = key;
    bf[idx] = 1.f - key;
    bq[idx] = siluf_(p[(size_t)t * INC + C_BQ + j]);
}
__global__ __launch_bounds__(64) void k_hgrn(const float* __restrict__ p, const float* __restrict__ bq, const float* __restrict__ bf, const float* __restrict__ bk,
                                             const float* __restrict__ normg, float* __restrict__ ocat) {
    const int h = blockIdx.x, v = threadIdx.x;
    float S[64];
#pragma unroll
    for (int d = 0; d < 64; d++) S[d] = 0.f;
    const float g = normg[v];
    for (int t = 0; t < SEQ; t++) {
        const float* qr = bq + (size_t)t * 256 + h * 64;
        const float* fr = bf + (size_t)t * 256 + h * 64;
        const float* kr = bk + (size_t)t * 256 + h * 64;
        float iv = p[(size_t)t * INC + C_BI + h * 64 + v];
        float o = 0.f;
#pragma unroll
        for (int d = 0; d < 64; d++) {
            S[d] = fmaf(fr[d], S[d], kr[d] * iv);
            o = fmaf(qr[d], S[d], o);
        }
        float ss = o * o;
        for (int off = 32; off > 0; off >>= 1) ss += __shfl_xor(ss, off);
        float r = rsqrtf(ss * (1.f / 64.f) + 1e-6f);
        float z = p[(size_t)t * INC + C_BZ + h * 64 + v];
        ocat[(size_t)t * 1024 + 256 + h * 64 + v] = o * r * g * siluf_(z);
    }
}

__global__ __launch_bounds__(256) void k_iscore(const float* __restrict__ p, float* __restrict__ isc) {
    const int t0 = blockIdx.y * 16, s0 = blockIdx.x * 64;
    const int nmax = ((t0 + 15) / 64 + 1) * 64;
    if (s0 >= nmax) return;
    __shared__ float qs[16][512];
    __shared__ float ks[64][65];
    __shared__ float ws[16][8];
    for (int i = threadIdx.x; i < 16 * 512; i += 256) { int t = i >> 9, c = i & 511; qs[t][c] = p[(size_t)(t0 + t) * INC + C_CQI + c]; }
    for (int i = threadIdx.x; i < 64 * 64; i += 256) { int s = i >> 6, c = i & 63; ks[s][c] = p[(size_t)(s0 + s) * INC + C_CKI + c]; }
    if (threadIdx.x < 128) { int t = threadIdx.x >> 3, hh = threadIdx.x & 7; ws[t][hh] = p[(size_t)(t0 + t) * INC + C_CWI + hh] * 0.35355339059327373f; }
    __syncthreads();
    const int s = threadIdx.x & 63, tq = threadIdx.x >> 6;
    for (int tt = 0; tt < 4; tt++) {
        int t = tq * 4 + tt;
        float acc = 0.f;
        for (int hh = 0; hh < 8; hh++) {
            float d = 0.f;
#pragma unroll
            for (int c = 0; c < 64; c++) d = fmaf(qs[t][hh * 64 + c], ks[s][c], d);
            d = fmaxf(d * 0.125f, 0.f);
            acc = fmaf(d, ws[t][hh], acc);
        }
        isc[(size_t)(t0 + t) * SEQ + s0 + s] = acc;
    }
}

__global__ __launch_bounds__(256) void k_topk(const float* __restrict__ isc, int* __restrict__ sel, int* __restrict__ cnt) {
    const int t = blockIdx.x, tid = threadIdx.x;
    const int n = (t / 64 + 1) * 64;
    int* srow = sel + (size_t)t * 256;
    if (n <= 256) {
        if (tid < n) srow[tid] = tid;
        if (tid == 0) cnt[t] = n;
        return;
    }
    __shared__ unsigned hist[256];
    __shared__ unsigned s_prefix, s_k, s_eqcnt, s_pos;
    __shared__ int s_cut;
    unsigned key[16];
    const float* row = isc + (size_t)t * SEQ;
#pragma unroll
    for (int j = 0; j < 16; j++) {
        int idx = tid + 256 * j;
        unsigned kk = 0u;
        if (idx < n) {
            unsigned u = __float_as_uint(row[idx]);
            kk = (u & 0x80000000u) ? ~u : (u | 0x80000000u);
        }
        key[j] = kk;
    }
    if (tid == 0) { s_prefix = 0u; s_k = 256u; s_pos = 0u; }
    unsigned mask = 0u;
    for (int pass = 3; pass >= 0; pass--) {
        const int shift = pass * 8;
        hist[tid] = 0u;
        __syncthreads();
        const unsigned prefix = s_prefix;
#pragma unroll
        for (int j = 0; j < 16; j++) {
            int idx = tid + 256 * j;
            if (idx < n && (key[j] & mask) == prefix) atomicAdd(&hist[(key[j] >> shift) & 255u], 1u);
        }
        __syncthreads();
        if (tid == 0) {
            unsigned k = s_k, c = 0u; int b = 255;
            for (; b > 0; b--) { if (c + hist[b] >= k) break; c += hist[b]; }
            s_k = k - c; s_prefix = prefix | ((unsigned)b << shift); s_eqcnt = hist[b];
        }
        mask |= (0xFFu << shift);
        __syncthreads();
    }
    const unsigned thr = s_prefix, need = s_k, eqc = s_eqcnt;
    if (tid == 0) {
        int cut = SEQ;
        if (eqc != need) {
            unsigned c = 0u;
            for (int i = 0; i < n; i++) {
                unsigned u = __float_as_uint(row[i]);
                unsigned kk = (u & 0x80000000u) ? ~u : (u | 0x80000000u);
                if (kk == thr) { c++; if (c == need) { cut = i; break; } }
            }
        }
        s_cut = cut;
    }
    __syncthreads();
    const int cut = s_cut;
#pragma unroll
    for (int j = 0; j < 16; j++) {
        int idx = tid + 256 * j;
        if (idx < n && (key[j] > thr || (key[j] == thr && idx <= cut))) {
            unsigned pos = atomicAdd(&s_pos, 1u);
            if (pos < 256u) srow[pos] = idx;
        }
    }
    if (tid == 0) cnt[t] = 256;
}

__global__ __launch_bounds__(256) void k_attnC(const float* __restrict__ p, const int* __restrict__ sel, const int* __restrict__ cnt, float* __restrict__ ocat) {
    const int t = blockIdx.x, tid = threadIdx.x;
    __shared__ float qs[256];
    __shared__ float ps[4][256];
    __shared__ int ss[256];
    __shared__ float red[4][4];
    const int n = cnt[t];
    qs[tid] = p[(size_t)t * INC + C_CQ + tid];
    ss[tid] = (tid < n) ? sel[(size_t)t * 256 + tid] : 0;
    __syncthreads();
    float sc[4];
    if (tid < n) {
        const float* krow = p + (size_t)ss[tid] * INC + C_CK;
#pragma unroll
        for (int h = 0; h < 4; h++) {
            float d = 0.f;
            for (int c = 0; c < 64; c++) d = fmaf(qs[h * 64 + c], krow[h * 64 + c], d);
            sc[h] = d * 0.125f;
        }
    } else {
#pragma unroll
        for (int h = 0; h < 4; h++) sc[h] = -INFINITY;
    }
    float mx[4];
#pragma unroll
    for (int h = 0; h < 4; h++) {
        float v = sc[h];
        for (int o = 32; o > 0; o >>= 1) v = fmaxf(v, __shfl_xor(v, o));
        if ((tid & 63) == 0) red[h][tid >> 6] = v;
    }
    __syncthreads();
#pragma unroll
    for (int h = 0; h < 4; h++) mx[h] = fmaxf(fmaxf(red[h][0], red[h][1]), fmaxf(red[h][2], red[h][3]));
    __syncthreads();
    float sm[4];
#pragma unroll
    for (int h = 0; h < 4; h++) {
        float e = (tid < n) ? expf(sc[h] - mx[h]) : 0.f;
        ps[h][tid] = e;
        float v = e;
        for (int o = 32; o > 0; o >>= 1) v += __shfl_xor(v, o);
        if ((tid & 63) == 0) red[h][tid >> 6] = v;
    }
    __syncthreads();
#pragma unroll
    for (int h = 0; h < 4; h++) sm[h] = red[h][0] + red[h][1] + red[h][2] + red[h][3];
    const int h = tid >> 6;
    float o = 0.f;
    for (int j = 0; j < n; j++) o = fmaf(ps[h][j], p[(size_t)ss[j] * INC + C_CV + tid], o);
    float l = (h == 0) ? sm[0] : (h == 1) ? sm[1] : (h == 2) ? sm[2] : sm[3];
    float z = p[(size_t)t * INC + C_CZ + tid];
    ocat[(size_t)t * 1024 + 512 + tid] = o / l * siluf_(z);
}

__global__ __launch_bounds__(256) void k_dprep(const float* __restrict__ p, const float* __restrict__ mu, const float* __restrict__ w0, const float* __restrict__ w_up,
                                               const float* __restrict__ a0, const float* __restrict__ a_up, const float* __restrict__ k_k, const float* __restrict__ k_a,
                                               const float* __restrict__ r_k,
                                               float* __restrict__ R, float* __restrict__ W, float* __restrict__ KF, float* __restrict__ V, float* __restrict__ KK, float* __restrict__ BB,
                                               float* __restrict__ BON) {
    const int t = blockIdx.x, j = threadIdx.x;
    __shared__ float wd[64], ad[64];
    const float* cur = p + (size_t)t * INC;
    const float* prv = p + (size_t)(t - 1) * INC;
    const bool first = (t == 0);
    auto sh = [&](int col) -> float {
        float c = cur[col];
        float pv = first ? 0.f : prv[col];
        return c + mu[col - C_PD] * (pv - c);
    };
    float r = sh(C_DR + j), kx = sh(C_DK + j), v = sh(C_DV + j);
    if (j < 64) wd[j] = tanhf(sh(C_DWD + j));
    else if (j < 128) ad[j - 64] = sh(C_DAD + j - 64);
    __syncthreads();
    float wl = w0[j], al = a0[j];
    for (int i = 0; i < 64; i++) { wl = fmaf(wd[i], w_up[i * 256 + j], wl); al = fmaf(ad[i], a_up[i * 256 + j], al); }
    float x = -wl;
    float sp = fmaxf(x, 0.f) + log1pf(expf(-fabsf(x)));
    float wlog = -sp - 0.5f;
    float decay = expf(-expf(wlog));
    float a = sigmoidf_(al);
    float kkr = kx * k_k[j];
    float ssq = kkr * kkr;
    for (int o = 32; o > 0; o >>= 1) ssq += __shfl_xor(ssq, o);
    float kk = kkr / fmaxf(sqrtf(ssq), 1e-12f);
    float kf = kx * (1.f + (a - 1.f) * k_a[j]);
    float bon = r * kf * r_k[j];
    for (int o = 32; o > 0; o >>= 1) bon += __shfl_xor(bon, o);
    size_t o_ = (size_t)t * 256 + j;
    R[o_] = r; W[o_] = decay; KF[o_] = kf; V[o_] = v; KK[o_] = kk; BB[o_] = kk * a;
    if ((j & 63) == 0) BON[t * 4 + (j >> 6)] = bon;
}
__global__ __launch_bounds__(256) void k_drec(const float* __restrict__ R, const float* __restrict__ W, const float* __restrict__ KF, const float* __restrict__ V,
                                              const float* __restrict__ KK, const float* __restrict__ BB, float* __restrict__ ORAW) {
    const int h = blockIdx.x, v = threadIdx.x >> 2, q4 = threadIdx.x & 3;
    float S[16];
#pragma unroll
    for (int i = 0; i < 16; i++) S[i] = 0.f;
    const int cb = h * 64 + q4 * 16;
    for (int t = 0; t < SEQ; t++) {
        const size_t ro = (size_t)t * 256;
        float4 kk4[4], w4[4], bb4[4], kf4[4], r4[4];
#pragma unroll
        for (int i = 0; i < 4; i++) {
            kk4[i] = *(const float4*)(KK + ro + cb + i * 4);
            w4[i] = *(const float4*)(W + ro + cb + i * 4);
            bb4[i] = *(const float4*)(BB + ro + cb + i * 4);
            kf4[i] = *(const float4*)(KF + ro + cb + i * 4);
            r4[i] = *(const float4*)(R + ro + cb + i * 4);
        }
        float vv = V[ro + h * 64 + v];
        float sa = 0.f;
#pragma unroll
        for (int i = 0; i < 4; i++) {
            sa = fmaf(S[i * 4 + 0], kk4[i].x, sa); sa = fmaf(S[i * 4 + 1], kk4[i].y, sa);
            sa = fmaf(S[i * 4 + 2], kk4[i].z, sa); sa = fmaf(S[i * 4 + 3], kk4[i].w, sa);
        }
        sa += __shfl_xor(sa, 1);
        sa += __shfl_xor(sa, 2);
        sa = -sa;
        float o = 0.f;
#define DSTEP(e, c) S[e] = fmaf(S[e], w4[i].c, fmaf(sa, bb4[i].c, vv * kf4[i].c)); o = fmaf(S[e], r4[i].c, o);
#pragma unroll
        for (int i = 0; i < 4; i++) { DSTEP(i * 4 + 0, x) DSTEP(i * 4 + 1, y) DSTEP(i * 4 + 2, z) DSTEP(i * 4 + 3, w) }
#undef DSTEP
        o += __shfl_xor(o, 1);
        o += __shfl_xor(o, 2);
        if (q4 == 0) ORAW[ro + h * 64 + v] = o;
    }
}
__global__ __launch_bounds__(256) void k_dpost(const float* __restrict__ p, const float* __restrict__ ORAW, const float* __restrict__ V, const float* __restrict__ BON,
                                               const float* __restrict__ gn_g, const float* __restrict__ gn_b, float* __restrict__ ocat) {
    const int t = blockIdx.x, j = threadIdx.x;
    float o = ORAW[(size_t)t * 256 + j];
    float s = o;
    for (int off = 32; off > 0; off >>= 1) s += __shfl_xor(s, off);
    float mean = s * (1.f / 64.f);
    float d = o - mean;
    float s2 = d * d;
    for (int off = 32; off > 0; off >>= 1) s2 += __shfl_xor(s2, off);
    float var = s2 * (1.f / 64.f);
    float y = d * rsqrtf(var + 64e-5f) * gn_g[j] + gn_b[j];
    y += BON[t * 4 + (j >> 6)] * V[(size_t)t * 256 + j];
    float z = p[(size_t)t * INC + C_DZ + j];
    ocat[(size_t)t * 1024 + 768 + j] = y * siluf_(z);
}

__global__ void k_combine(const float* __restrict__ p, const float* __restrict__ bp, float* __restrict__ y) {
    int idx = blockIdx.x * blockDim.x + threadIdx.x;
    if (idx >= SEQ * 1024) return;
    int t = idx >> 10, n = idx & 1023;
    float acc = 0.f;
#pragma unroll
    for (int b = 0; b < 4; b++) acc += sigmoidf_(p[(size_t)t * INC + C_PG + b * 1024 + n]) * bp[(size_t)b * SEQ * 1024 + idx];
    y[idx] = acc;
}

extern "C" void kernel_launch(void* const* d_in, const int* in_sizes, int n_in, void* d_out, int out_size, void* d_ws, size_t ws_size, hipStream_t stream) {
    const float* x_in = (const float*)d_in[0];
    const float* norm_g = (const float*)d_in[1];
    const float* w_in = (const float*)d_in[2];
    const float* a_rel_bias = (const float*)d_in[3];
    const float* b_lb_logits = (const float*)d_in[4];
    const float* b_norm_g = (const float*)d_in[5];
    const float* d_mu = (const float*)d_in[6];
    const float* d_w0 = (const float*)d_in[7];
    const float* d_w_up = (const float*)d_in[8];
    const float* d_a0 = (const float*)d_in[9];
    const float* d_a_up = (const float*)d_in[10];
    const float* d_k_k = (const float*)d_in[11];
    const float* d_k_a = (const float*)d_in[12];
    const float* d_r_k = (const float*)d_in[13];
    const float* d_gn_g = (const float*)d_in[14];
    const float* d_gn_b = (const float*)d_in[15];
    const float* w_branch = (const float*)d_in[16];
    const float* w_out = (const float*)d_in[17];
    const float* final_g = (const float*)d_in[18];
    float* out = (float*)d_out;

    float* ws = (float*)d_ws;
    size_t off = 0;
    auto take = [&](size_t n) { float* r = ws + off; off += (n + 63) & ~(size_t)63; return r; };
    float* tcos = take(SEQ * 32);
    float* tsin = take(SEQ * 32);
    float* lb = take(512);
    float* hb = take((size_t)SEQ * 1024);
    float* pb = take((size_t)SEQ * INC);
    float* isc = take((size_t)SEQ * SEQ);
    int* sel = (int*)take((size_t)SEQ * 256);
    int* cnt = (int*)take(SEQ);
    float* ocat = take((size_t)SEQ * 1024);
    float* bp = take((size_t)4 * SEQ * 1024);
    float* yb = take((size_t)SEQ * 1024);
    float* dR = take((size_t)SEQ * 256);
    float* dW = take((size_t)SEQ * 256);
    float* dKF = take((size_t)SEQ * 256);
    float* dV = take((size_t)SEQ * 256);
    float* dKK = take((size_t)SEQ * 256);
    float* dBB = take((size_t)SEQ * 256);
    float* dORAW = take((size_t)SEQ * 256);
    float* dBON = take((size_t)SEQ * 4);
    float* bq = take((size_t)SEQ * 256);
    float* bf = take((size_t)SEQ * 256);
    float* bk = take((size_t)SEQ * 256);
    float* x2 = take((size_t)SEQ * 1024);
    if (off * 4 > ws_size) return;

    k_setup<<<(SEQ * 32 + 255) / 256, 256, 0, stream>>>(tcos, tsin, b_lb_logits, lb);

    for (int l = 0; l < 2; l++) {
        for (int b = 0; b < NBATCH; b++) {
            const float* xb = (l == 0 ? x_in : out) + (size_t)b * SEQ * 1024;
            k_rmsnorm<<<SEQ, 256, 0, stream>>>(xb, norm_g + l * 1024, hb);
            k_gemm<<<dim3((INC + 63) / 64, SEQ / 64), 256, 0, stream>>>(hb, 1024, w_in + (size_t)l * 1024 * INC, INC, pb, INC, SEQ, INC, 1024, nullptr, 0);
            k_rope<<<(SEQ * 17 * 32 + 255) / 256, 256, 0, stream>>>(pb, tcos, tsin);
            k_attnA<<<dim3(64, 4), 64, 0, stream>>>(pb, a_rel_bias + l * 4 * 192, ocat);
            k_bprep<<<(SEQ * 256 + 255) / 256, 256, 0, stream>>>(pb, lb + l * 256, bq, bf, bk);
            k_hgrn<<<4, 64, 0, stream>>>(pb, bq, bf, bk, b_norm_g + l * 64, ocat);
            k_iscore<<<dim3(SEQ / 64, SEQ / 16), 256, 0, stream>>>(pb, isc);
            k_topk<<<SEQ, 256, 0, stream>>>(isc, sel, cnt);
            k_attnC<<<SEQ, 256, 0, stream>>>(pb, sel, cnt, ocat);
            k_dprep<<<SEQ, 256, 0, stream>>>(pb, d_mu + l * 896, d_w0 + l * 256, d_w_up + l * 64 * 256, d_a0 + l * 256, d_a_up + l * 64 * 256,
                                            d_k_k + l * 256, d_k_a + l * 256, d_r_k + l * 256, dR, dW, dKF, dV, dKK, dBB, dBON);
            k_drec<<<4, 256, 0, stream>>>(dR, dW, dKF, dV, dKK, dBB, dORAW);
            k_dpost<<<SEQ, 256, 0, stream>>>(pb, dORAW, dV, dBON, d_gn_g + l * 256, d_gn_b + l * 256, ocat);
            for (int br = 0; br < 4; br++)
                k_gemm<<<dim3(1024 / 64, SEQ / 64), 256, 0, stream>>>(ocat + br * 256, 1024, w_branch + ((size_t)l * 4 + br) * 256 * 1024, 1024,
                                                                      bp + (size_t)br * SEQ * 1024, 1024, SEQ, 1024, 256, nullptr, 0);
            k_combine<<<(SEQ * 1024 + 255) / 256, 256, 0, stream>>>(pb, bp, yb);
            if (l == 0) {
                k_gemm<<<dim3(1024 / 64, SEQ / 64), 256, 0, stream>>>(yb, 1024, w_out + (size_t)l * 1024 * 1024, 1024, out + (size_t)b * SEQ * 1024, 1024, SEQ, 1024, 1024, xb, 1024);
            } else {
                k_gemm<<<dim3(1024 / 64, SEQ / 64), 256, 0, stream>>>(yb, 1024, w_out + (size_t)l * 1024 * 1024, 1024, x2, 1024, SEQ, 1024, 1024, xb, 1024);
                k_rmsnorm<<<SEQ, 256, 0, stream>>>(x2, final_g, out + (size_t)b * SEQ * 1024);
            }
        }
    }
}
```

```cpp
#include <hip/hip_runtime.h>
#include <cstdio>
#include <cstdint>
#include <math.h>

#define DM 1024
#define SEQ 4096
#define NBATCH 8
#define NTOK (NBATCH * SEQ)
#define INC 8904
#define C_AQ 0
#define C_AK 256
#define C_AV 512
#define C_AZ 768
#define C_BQ 1024
#define C_BF 1280
#define C_BI 1536
#define C_BZ 1792
#define C_CQ 2048
#define C_CK 2304
#define C_CV 2560
#define C_CZ 2816
#define C_CQI 3072
#define C_CKI 3584
#define C_CWI 3648
#define C_PD 3656
#define C_DR 3656
#define C_DK 3912
#define C_DV 4168
#define C_DWD 4424
#define C_DAD 4488
#define C_DZ 4552
#define C_PG 4808
#define NG1 4864

namespace pg8 {
#define PG8_LAS __attribute__((address_space(3)))
typedef unsigned short bf16_t;
typedef short bf16x8 __attribute__((ext_vector_type(8)));
typedef float f32x4 __attribute__((ext_vector_type(4)));
typedef unsigned u32x4 __attribute__((ext_vector_type(4)));
constexpr int BM = 256, BK = 64, HALF = 128, HTB = HALF * BK * 2  , STAGE_BYTES = 8 * HTB, NXCD = 8, WGM = 8;

__host__ __device__ __forceinline__ int lds_byte(int r, int c) { const int st = (r >> 4) * 2 + (c >> 5), rr = r & 15, cc = c & 31, ob = rr * 64 + cc * 2; return st * 1024 + (ob ^ (((ob >> 9) & 1) << 5)); }
__host__ __device__ __forceinline__ void stage_rc(int b, int& R, int& C) { const int st = b / 1024, sb = b % 1024, swz = sb ^ (((sb >> 9) & 1) << 5); R = (st >> 1) * 16 + swz / 64; C = (st & 1) * 32 + (swz % 64) / 2; }
__host__ __device__ __forceinline__ int perm32(int rho) { const int n = rho >> 4, i = rho & 15; return 8 * (i >> 2) + 4 * n + (i & 3); }

struct Unit { int pm, pn; };
struct Gemm { const bf16_t* A; const bf16_t* Bt; int M, N, K; };

struct StaticOrder {
    int nM, nN, nwg, G, c;
    __host__ __device__ void init(int M, int N, int G_, int c_) { nM = M / BM; nN = N / BM; nwg = nM * nN; G = G_; c = c_; }
    __host__ __device__ bool next(int i, Unit& u) const {
        const long L = (long)i * G + c; if (L >= nwg) return false;
        int wgid = (int)L; { const int q = nwg / NXCD, r = nwg % NXCD, xcd = wgid % NXCD, off = wgid / NXCD; wgid = (xcd < r ? xcd * (q + 1) : r * (q + 1) + (xcd - r) * q) + off; }
        const int nig = WGM * nN, gid = wgid / nig, fm = gid * WGM, gsz = (nM - fm) < WGM ? (nM - fm) : WGM;
        u.pm = fm + ((wgid % nig) % gsz); u.pn = (wgid % nig) / gsz; return true;
    }
    __device__ __forceinline__ void a_ready(const Unit&) const {}
    __device__ __forceinline__ void done(const Unit&) const {}
};

__device__ __forceinline__ unsigned cvt_pk_bf16(float lo, float hi) { unsigned r; asm volatile("v_cvt_pk_bf16_f32 %0, %1, %2" : "=v"(r) : "v"(lo), "v"(hi)); return r; }
template <class Epi, class Sched, bool ALIGN_EPI = false, bool SP2 = false>
__device__ __forceinline__ void gemm_phase(PG8_LAS unsigned char* lds, const Gemm g, const Sched& S, const Epi& E, const int wave_in) {
    int lane_; asm volatile("v_mbcnt_lo_u32_b32 %0, -1, 0\n\tv_mbcnt_hi_u32_b32 %0, -1, %0" : "=v"(lane_));
    const int wid = wave_in, lane = lane_, tid = wid * 64 + lane, wr = wid >> 2, wc = wid & 3, fr = lane & 15, fq = lane >> 4;
    const int K = g.K, nt = K / BK;
    unsigned voffA[2], voffB[2];
#pragma unroll
    for (int i = 0; i < 2; ++i) { int R, C; stage_rc(tid * 16 + i * 8192, R, C); const int Rb = Epi::PERM ? ((R & ~31) + perm32(R & 31)) : R;
        voffA[i] = (unsigned)(R * K + C) * 2u; voffB[i] = (unsigned)(Rb * K + C) * 2u; }
    const size_t kstep = (size_t)(BK * 2);
    const size_t hstep = (size_t)HALF * K * 2;
    const size_t tstep = 2 * hstep;
    const unsigned ldsw = (unsigned)wid * 1024u;
    const int aoff = lds_byte(wr * 64 + fr, fq * 8), boff = lds_byte(wc * 32 + fr, fq * 8);
#define PG8_SA(b, h) (((b) * 2 + (h)) * HTB)
#define PG8_SB(b, h) ((4 + (b) * 2 + (h)) * HTB)
#define PG8_STAGE(bufoff, gbase, voff) do { _Pragma("unroll") for (int _i = 0; _i < 2; ++_i) \
        __builtin_amdgcn_global_load_lds((const unsigned*)((const char*)(gbase) + (voff)[_i]), (PG8_LAS unsigned*)(lds + (bufoff) + ldsw + _i * 8192), 16, 0, 0); } while (0)
#define PG8_LDA(dst, b, h) do { _Pragma("unroll") for (int m = 0; m < 4; ++m) _Pragma("unroll") for (int k = 0; k < 2; ++k) dst[m][k] = *(const PG8_LAS bf16x8*)(lds + PG8_SA(b, h) + aoff + m * 2048 + k * 1024); } while (0)
#define PG8_LDB(dst, b, h) do { _Pragma("unroll") for (int n = 0; n < 2; ++n) _Pragma("unroll") for (int k = 0; k < 2; ++k) dst[n][k] = *(const PG8_LAS bf16x8*)(lds + PG8_SB(b, h) + boff + n * 2048 + k * 1024); } while (0)
#define PG8_MMA(ai, bj, At, Bt) do { __builtin_amdgcn_s_setprio(1); _Pragma("unroll") for (int m = 0; m < 4; ++m) _Pragma("unroll") for (int n = 0; n < 2; ++n) _Pragma("unroll") for (int k = 0; k < 2; ++k) \
        acc[ai][bj][m][n] = __builtin_amdgcn_mfma_f32_16x16x32_bf16(Bt[n][k], At[m][k], acc[ai][bj][m][n], 0, 0, 0); __builtin_amdgcn_s_setprio(0); } while (0)
#define PG8_WAIT_V(n) asm volatile("s_waitcnt vmcnt(" #n ")" ::: "memory")
#define PG8_WAIT_L(n) asm volatile("s_waitcnt lgkmcnt(" #n ")" ::: "memory")
#define PG8_BAR __builtin_amdgcn_s_barrier()
#define PG8_SCHED __builtin_amdgcn_sched_barrier(0)
    Unit cur, nxt; int ui = 0;
    if (!S.next(0, cur)) return;
    f32x4 acc[2][2][4][2];
#pragma unroll
    for (int a = 0; a < 2; ++a)
#pragma unroll
        for (int b = 0; b < 2; ++b)
#pragma unroll
            for (int m = 0; m < 4; ++m)
#pragma unroll
                for (int n = 0; n < 2; ++n) acc[a][b][m][n] = (f32x4){0.f, 0.f, 0.f, 0.f};
    bf16x8 At[4][2], B0[2][2], B1[2][2];
    const char* cA = (const char*)g.A + (size_t)cur.pm * tstep; const char* cB = (const char*)g.Bt + (size_t)cur.pn * tstep;
    S.a_ready(cur);
    if constexpr (SP2) {
        PG8_STAGE(PG8_SB(0, 0), cB, voffB); PG8_STAGE(PG8_SB(0, 1), cB + hstep, voffB); PG8_STAGE(PG8_SA(0, 0), cA, voffA); PG8_STAGE(PG8_SA(0, 1), cA + hstep, voffA);
        if (wr == 1) PG8_BAR;
        PG8_WAIT_V(2); PG8_BAR;
        PG8_STAGE(PG8_SB(1, 0), cB + kstep, voffB); PG8_STAGE(PG8_SA(1, 0), cA + kstep, voffA); PG8_STAGE(PG8_SB(1, 1), cB + hstep + kstep, voffB);
        PG8_WAIT_V(6); PG8_BAR;
    } else {
        PG8_STAGE(PG8_SB(0, 0), cB, voffB); PG8_STAGE(PG8_SA(0, 0), cA, voffA); PG8_STAGE(PG8_SB(0, 1), cB + hstep, voffB); PG8_STAGE(PG8_SA(0, 1), cA + hstep, voffA);
        if (wr == 1) PG8_BAR;
        PG8_WAIT_V(4); PG8_BAR;
        PG8_STAGE(PG8_SB(1, 0), cB + kstep, voffB); PG8_STAGE(PG8_SA(1, 0), cA + kstep, voffA); PG8_STAGE(PG8_SB(1, 1), cB + hstep + kstep, voffB);
        PG8_WAIT_V(6); PG8_BAR;
    }
    for (;;) {
        const bool has_next = S.next(ui + 1, nxt);
        const char* nA = has_next ? (const char*)g.A + (size_t)nxt.pm * tstep : cA; const char* nB = has_next ? (const char*)g.Bt + (size_t)nxt.pn * tstep : cB;
        for (int t = 0; t < nt; t += 2) {
            const bool last = (t == nt - 2);
            const char* a1 = cA + (size_t)(t + 1) * kstep;
            const char* a2 = last ? nA : cA + (size_t)(t + 2) * kstep; const char* b2 = last ? nB : cB + (size_t)(t + 2) * kstep;
            const char* a3 = a2 + kstep; const char* b3 = b2 + kstep;
            if (last && has_next) S.a_ready(nxt);
            if constexpr (SP2) {
            PG8_LDB(B0, 0, 0); PG8_LDB(B1, 0, 1); PG8_SCHED; PG8_LDA(At, 0, 0); PG8_STAGE(PG8_SA(1, 1), a1 + hstep, voffA);
            PG8_WAIT_V(8); PG8_WAIT_L(0); PG8_BAR; PG8_MMA(0, 0, At, B0); PG8_MMA(0, 1, At, B1); PG8_BAR; PG8_SCHED;
            PG8_LDA(At, 0, 1); PG8_STAGE(PG8_SB(0, 0), b2, voffB); PG8_STAGE(PG8_SB(0, 1), b2 + hstep, voffB); PG8_STAGE(PG8_SA(0, 0), a2, voffA);
            PG8_WAIT_V(8); PG8_WAIT_L(0); PG8_BAR; PG8_MMA(1, 0, At, B0); PG8_MMA(1, 1, At, B1); PG8_BAR; PG8_SCHED;
            PG8_LDB(B0, 1, 0); PG8_LDB(B1, 1, 1); PG8_SCHED; PG8_LDA(At, 1, 0); PG8_STAGE(PG8_SA(0, 1), a2 + hstep, voffA);
            PG8_WAIT_V(8); PG8_WAIT_L(0); PG8_BAR; PG8_MMA(0, 0, At, B0); PG8_MMA(0, 1, At, B1); PG8_BAR; PG8_SCHED;
            PG8_LDA(At, 1, 1); PG8_STAGE(PG8_SB(1, 0), b3, voffB); PG8_STAGE(PG8_SB(1, 1), b3 + hstep, voffB); PG8_STAGE(PG8_SA(1, 0), a3, voffA);
            PG8_WAIT_V(8); PG8_WAIT_L(0); PG8_BAR; PG8_MMA(1, 0, At, B0); PG8_MMA(1, 1, At, B1); PG8_BAR; PG8_SCHED;
            } else {
            PG8_LDB(B0, 0, 0); PG8_SCHED; PG8_LDA(At, 0, 0); PG8_STAGE(PG8_SA(1, 1), a1 + hstep, voffA);
            PG8_WAIT_L(8); PG8_BAR; PG8_WAIT_L(0); PG8_MMA(0, 0, At, B0); PG8_BAR; PG8_SCHED;
            PG8_LDB(B1, 0, 1); PG8_STAGE(PG8_SB(0, 0), b2, voffB);
            PG8_BAR; PG8_WAIT_L(0); PG8_MMA(0, 1, At, B1); PG8_BAR;
            PG8_LDA(At, 0, 1); PG8_STAGE(PG8_SA(0, 0), a2, voffA);
            PG8_BAR; PG8_WAIT_L(0); PG8_MMA(1, 0, At, B0); PG8_BAR; PG8_SCHED;
            PG8_STAGE(PG8_SB(0, 1), b2 + hstep, voffB);
            PG8_WAIT_V(6); PG8_BAR; PG8_MMA(1, 1, At, B1); PG8_BAR;
            PG8_LDB(B0, 1, 0); PG8_SCHED; PG8_LDA(At, 1, 0); PG8_STAGE(PG8_SA(0, 1), a2 + hstep, voffA);
            PG8_WAIT_L(8); PG8_BAR; PG8_WAIT_L(0); PG8_MMA(0, 0, At, B0); PG8_BAR; PG8_SCHED;
            PG8_LDB(B1, 1, 1); PG8_STAGE(PG8_SB(1, 0), b3, voffB);
            PG8_BAR; PG8_WAIT_L(0); PG8_MMA(0, 1, At, B1); PG8_BAR;
            PG8_LDA(At, 1, 1); PG8_STAGE(PG8_SA(1, 0), a3, voffA);
            PG8_BAR; PG8_WAIT_L(0); PG8_MMA(1, 0, At, B0); PG8_BAR; PG8_SCHED;
            PG8_STAGE(PG8_SB(1, 1), b3 + hstep, voffB);
            PG8_WAIT_V(6); PG8_BAR; PG8_MMA(1, 1, At, B1); PG8_BAR;
            }
        }
        if constexpr (ALIGN_EPI) { if (wr == 0) PG8_BAR; }
        if constexpr (!Epi::AFTER_DRAIN) { E(acc, cur, wr, wc, fr, fq); S.done(cur); }
        if (!has_next) break;
#pragma unroll
        for (int a = 0; a < 2; ++a)
#pragma unroll
            for (int b = 0; b < 2; ++b)
#pragma unroll
                for (int m = 0; m < 4; ++m)
#pragma unroll
                    for (int n = 0; n < 2; ++n) acc[a][b][m][n] = (f32x4){0.f, 0.f, 0.f, 0.f};
        cur = nxt; cA = nA; cB = nB; ++ui;
        if constexpr (ALIGN_EPI) { if (wr == 1) PG8_BAR; }
    }
    PG8_WAIT_V(0);
    if constexpr (!ALIGN_EPI) { if (wr == 0) PG8_BAR; }
    PG8_BAR;
    if constexpr (Epi::AFTER_DRAIN) { E.fused(acc, cur, wr, wc, fr, fq, lds, wid, lane); S.done(cur); }
#undef PG8_SA
#undef PG8_SB
#undef PG8_STAGE
#undef PG8_LDA
#undef PG8_LDB
#undef PG8_MMA
#undef PG8_WAIT_V
#undef PG8_WAIT_L
#undef PG8_BAR
#undef PG8_SCHED
}
}

#define GAS __attribute__((address_space(1)))
#define LAS __attribute__((address_space(3)))
typedef unsigned short bf16;
typedef unsigned v4u __attribute__((ext_vector_type(4)));
typedef unsigned v2u __attribute__((ext_vector_type(2)));
typedef float f32x4 __attribute__((ext_vector_type(4)));
typedef GAS unsigned gu32;
#define RLX_AGENT __ATOMIC_RELAXED, __HIP_MEMORY_SCOPE_AGENT
#define LDS_WAIT() asm volatile("s_waitcnt lgkmcnt(0)" ::: "memory")
#define VM_WAIT() asm volatile("s_waitcnt vmcnt(0)" ::: "memory")
__device__ __forceinline__ unsigned f2bf(float f) { unsigned u = __builtin_bit_cast(unsigned, f); return (u + 0x7fffu + ((u >> 16) & 1u)) >> 16; }
__device__ __forceinline__ unsigned pk2(float lo, float hi) { return f2bf(lo) | (f2bf(hi) << 16); }
__device__ __forceinline__ float bf2f(unsigned short b) { return __builtin_bit_cast(float, (unsigned)b << 16); }
__device__ __forceinline__ float bflo(unsigned w) { return __builtin_bit_cast(float, w << 16); }
__device__ __forceinline__ float bfhi(unsigned w) { return __builtin_bit_cast(float, w & 0xffff0000u); }
__device__ __forceinline__ float sigmoidf_(float x) { return 1.f / (1.f + expf(-x)); }
__device__ __forceinline__ float fsig(float x) { return __builtin_amdgcn_rcpf(1.f + __builtin_amdgcn_exp2f(-1.4426950408889634f * x)); }
__device__ __forceinline__ float siluf_(float x) { return x / (1.f + expf(-x)); }
__device__ __forceinline__ float wave_sum(float v) {
#pragma unroll
    for (int o = 1; o < 64; o <<= 1) v += __shfl_xor(v, o);
    return v;
}
__device__ __forceinline__ float wave_max(float v) {
#pragma unroll
    for (int o = 1; o < 64; o <<= 1) v = fmaxf(v, __shfl_xor(v, o));
    return v;
}

constexpr size_t MiB = 1u << 20;
constexpr size_t WS_CTL = 0, CTL_ZERO_BYTES = 1 * MiB;
constexpr size_t WS_COS = 1 * MiB, WS_SIN = 1 * MiB + 512 * 1024;
constexpr size_t WS_LB = 2 * MiB;
constexpr size_t WS_W1T = 16 * MiB;
constexpr size_t W1T_LAYER = (size_t)NG1 * 1024 * 2;
constexpr size_t WS_WGT = 36 * MiB;
constexpr size_t WGT_LAYER = (size_t)4096 * 1024 * 2;
constexpr size_t WS_WBT = 52 * MiB;
constexpr size_t WBT_LAYER = (size_t)4 * 1024 * 256 * 2;
constexpr size_t WS_WOT = 56 * MiB;
constexpr size_t WOT_LAYER = (size_t)1024 * 1024 * 2;
constexpr size_t WS_H = 64 * MiB;
constexpr size_t WS_PL = 128 * MiB;
constexpr size_t PLANE = 16 * MiB;
constexpr size_t WS_BF = WS_PL + 17 * PLANE;
constexpr size_t WS_MISC = WS_BF + 32 * MiB;
constexpr size_t WS_END = WS_MISC + 32 * MiB;
constexpr size_t WS_Y = WS_PL;
constexpr size_t WS_PB = WS_PL + 4 * PLANE;
static_assert(WS_PB + (size_t)4 * NTOK * 1024 * 2 <= WS_END, "P_b overlay");
enum { PL_AQ = 0, PL_BQ = 1, PL_CQ = 2, PL_DR = 3, PL_AK = 4, PL_AV = 5, PL_AZ = 6, PL_BI = 7, PL_BZ = 8, PL_CK = 9, PL_CV = 10, PL_CZ = 11, PL_CQI0 = 12, PL_CQI1 = 13, PL_DK = 14, PL_DV = 15, PL_DZ = 16 };
#define PLP(ws, i) ((bf16*)((ws) + WS_PL + (size_t)(i) * PLANE))
constexpr int CW_BAR = 4096;

constexpr int RING_BYTES = 131072;
constexpr int LDSCTL_OFF = RING_BYTES, MISC_OFF = LDSCTL_OFF + 320;
constexpr int LDS_BYTES = 147456;

__device__ __forceinline__ int rope_j(int head, int dim) {
    const int bj = head >> 1, wc = ((head & 1) << 1) | ((dim >> 4) & 1), n = dim >> 5, fq = (dim >> 2) & 3, i = dim & 3;
    return 128 * bj + 32 * wc + 16 * n + 4 * fq + i;
}
__device__ __forceinline__ int win_dst_row(int c, int& which) {
    which = 0;
    if (c < 2048) return c;
    if (c < 2304) { const int l = c - 2048; return 8 * 256 + rope_j(l >> 6, l & 63); }
    if (c < 2560) { const int l = c - 2304; return 9 * 256 + rope_j(l >> 6, l & 63); }
    if (c < 3072) return c;
    if (c < 3584) { const int l = c - 3072; return (12 + (l >> 8)) * 256 + rope_j((l >> 6) & 3, l & 63); }
    if (c < 3648) return 14 * 256 + rope_j(0, c - 3584);
    if (c < 3656) return 14 * 256 + 64 + (c - 3648);
    if (c < 3912) return 15 * 256 + (c - 3656);
    if (c < 4168) return 16 * 256 + (c - 3912);
    if (c < 4424) return 17 * 256 + (c - 4168);
    if (c < 4488) return 14 * 256 + 72 + (c - 4424);
    if (c < 4552) return 14 * 256 + 136 + (c - 4488);
    if (c < 4808) return 18 * 256 + (c - 4552);
    which = 1;
    { const int g = c - 4808, br = g >> 10, y = g & 1023, pn = y >> 6, wc = (y >> 4) & 3, fq = (y >> 2) & 3, i = y & 3;
      return 256 * pn + 128 * (br >> 1) + 32 * wc + 16 * (br & 1) + 4 * fq + i; }
}

struct EpiG1 {
    static constexpr bool PERM = false, AFTER_DRAIN = false;
    unsigned char* ws; const float* lbl;
    __device__ __forceinline__ void operator()(const f32x4 (&acc)[2][2][4][2], const pg8::Unit& u, int wr, int wc, int fr, int fq) const {
        const int pn = u.pn;
        const int rbase = u.pm * 256 + wr * 64 + fr;
        const int cq = wc * 32 + 4 * fq;
        if (pn == 5) {
            float* BF = (float*)(ws + WS_BF);
#pragma unroll
            for (int bj = 0; bj < 2; ++bj)
#pragma unroll
                for (int n = 0; n < 2; ++n) {
                    const int col = cq + bj * 128 + n * 16;
                    const f32x4 l4 = *(const f32x4*)(lbl + col);
#pragma unroll
                    for (int ai = 0; ai < 2; ++ai)
#pragma unroll
                        for (int m = 0; m < 4; ++m) {
                            const f32x4 x = acc[ai][bj][m][n]; f32x4 o;
#pragma unroll
                            for (int i = 0; i < 4; ++i) o[i] = 1.f - (1.f - l4[i]) * fsig(-x[i]);
                            *(f32x4*)(BF + (size_t)(rbase + ai * 128 + m * 16) * 256 + col) = o;
                            asm volatile("" ::: "memory");
                        }
                }
        } else if (pn == 14) {
            float* MS = (float*)(ws + WS_MISC);
            const float* tcos = (const float*)(ws + WS_COS); const float* tsin = (const float*)(ws + WS_SIN);
#pragma unroll
            for (int bj = 0; bj < 2; ++bj) {
                if (bj == 0 && wc < 2) {
                    const int d0 = 16 * (wc & 1) + 4 * fq;
#pragma unroll
                    for (int ai = 0; ai < 2; ++ai)
#pragma unroll
                        for (int m = 0; m < 4; ++m) {
                            const int row = rbase + ai * 128 + m * 16, pos = row & (SEQ - 1);
                            const f32x4 c4 = *(const f32x4*)(tcos + pos * 32 + d0), s4 = *(const f32x4*)(tsin + pos * 32 + d0);
                            const f32x4 x1 = acc[ai][0][m][0], x2 = acc[ai][0][m][1];
                            *(f32x4*)(MS + (size_t)row * 256 + d0) = x1 * c4 - x2 * s4;
                            *(f32x4*)(MS + (size_t)row * 256 + 32 + d0) = x2 * c4 + x1 * s4;
                            asm volatile("" ::: "memory");
                        }
                } else {
#pragma unroll
                    for (int n = 0; n < 2; ++n)
#pragma unroll
                        for (int ai = 0; ai < 2; ++ai)
#pragma unroll
                            for (int m = 0; m < 4; ++m)
                                *(f32x4*)(MS + (size_t)(rbase + ai * 128 + m * 16) * 256 + cq + bj * 128 + n * 16) = acc[ai][bj][m][n];
                }
            }
        } else {
            const unsigned long long lo = 0ull | (0ull << 0) | (4ull << 5) | (5ull << 10) | (6ull << 15) | (1ull << 20) | (0ull << 25) | (7ull << 30) | (8ull << 35) | (2ull << 40) | (9ull << 45) | (10ull << 50) | (11ull << 55);
            const unsigned long long hi = (12ull << 0) | (13ull << 5) | (0ull << 10) | (3ull << 15) | (14ull << 20) | (15ull << 25) | (16ull << 30);
            const int plane = (int)((pn < 12 ? (lo >> (5 * pn)) : (hi >> (5 * (pn - 12)))) & 31ull);
            bf16* PLN = PLP(ws, plane);
            if (pn == 8 || pn == 9 || pn == 12 || pn == 13) {
                const float* tcos = (const float*)(ws + WS_COS); const float* tsin = (const float*)(ws + WS_SIN);
                const int d0 = 16 * (wc & 1) + 4 * fq;
#pragma unroll
                for (int ai = 0; ai < 2; ++ai)
#pragma unroll
                    for (int m = 0; m < 4; ++m) {
                        const int row = rbase + ai * 128 + m * 16, pos = row & (SEQ - 1);
                        const f32x4 c4 = *(const f32x4*)(tcos + pos * 32 + d0), s4 = *(const f32x4*)(tsin + pos * 32 + d0);
#pragma unroll
                        for (int bj = 0; bj < 2; ++bj) {
                            const int head = 2 * bj + (wc >> 1);
                            const f32x4 x1 = acc[ai][bj][m][0], x2 = acc[ai][bj][m][1];
                            const f32x4 y1 = x1 * c4 - x2 * s4, y2 = x2 * c4 + x1 * s4;
                            v2u w1, w2; w1.x = pk2(y1[0], y1[1]); w1.y = pk2(y1[2], y1[3]); w2.x = pk2(y2[0], y2[1]); w2.y = pk2(y2[2], y2[3]);
                            *(v2u*)(PLN + (size_t)row * 256 + head * 64 + d0) = w1;
                            *(v2u*)(PLN + (size_t)row * 256 + head * 64 + 32 + d0) = w2;
                        }
                        asm volatile("" ::: "memory");
                    }
            } else {
                const bool do_silu = (pn == 4);
#pragma unroll
                for (int ai = 0; ai < 2; ++ai)
#pragma unroll
                    for (int m = 0; m < 4; ++m) {
                        bf16* rowp = PLN + (size_t)(rbase + ai * 128 + m * 16) * 256 + cq;
#pragma unroll
                        for (int bj = 0; bj < 2; ++bj)
#pragma unroll
                            for (int n = 0; n < 2; ++n) {
                                f32x4 x = acc[ai][bj][m][n];
                                if (do_silu) {
#pragma unroll
                                    for (int i = 0; i < 4; ++i) x[i] = x[i] * fsig(x[i]);
                                }
                                v2u w; w.x = pk2(x[0], x[1]); w.y = pk2(x[2], x[3]);
                                *(v2u*)(rowp + bj * 128 + n * 16) = w;
                            }
                        asm volatile("" ::: "memory");
                    }
            }
        }
    }
};
struct EpiBf {
    static constexpr bool PERM = false, AFTER_DRAIN = false;
    bf16* O; int ldc;
    __device__ __forceinline__ void operator()(const f32x4 (&acc)[2][2][4][2], const pg8::Unit& u, int wr, int wc, int fr, int fq) const {
        const int rbase = u.pm * 256 + wr * 64 + fr, cb = u.pn * 256 + wc * 32 + 4 * fq;
#pragma unroll
        for (int ai = 0; ai < 2; ++ai)
#pragma unroll
            for (int m = 0; m < 4; ++m) {
                bf16* rowp = O + (size_t)(rbase + ai * 128 + m * 16) * ldc + cb;
#pragma unroll
                for (int bj = 0; bj < 2; ++bj)
#pragma unroll
                    for (int n = 0; n < 2; ++n) { const f32x4 x = acc[ai][bj][m][n]; v2u w; w.x = pk2(x[0], x[1]); w.y = pk2(x[2], x[3]); *(v2u*)(rowp + bj * 128 + n * 16) = w; }
            }
    }
};
struct EpiGate {
    static constexpr bool PERM = false, AFTER_DRAIN = false;
    const bf16* PB; bf16* Y;
    __device__ __forceinline__ void operator()(const f32x4 (&acc)[2][2][4][2], const pg8::Unit& u, int wr, int wc, int fr, int fq) const {
        const int rbase = u.pm * 256 + wr * 64 + fr, yc = u.pn * 64 + wc * 16 + 4 * fq;
#pragma unroll
        for (int ai = 0; ai < 2; ++ai)
#pragma unroll
            for (int m = 0; m < 4; ++m) {
                const size_t row = (size_t)(rbase + ai * 128 + m * 16);
                f32x4 y = (f32x4){0.f, 0.f, 0.f, 0.f};
#pragma unroll
                for (int br = 0; br < 4; ++br) {
                    const v2u pw = *(const v2u*)(PB + ((size_t)br * NTOK + row) * 1024 + yc);
                    const f32x4 g = acc[ai][br >> 1][m][br & 1];
                    y[0] += bflo(pw.x) * fsig(g[0]); y[1] += bfhi(pw.x) * fsig(g[1]);
                    y[2] += bflo(pw.y) * fsig(g[2]); y[3] += bfhi(pw.y) * fsig(g[3]);
                }
                v2u w; w.x = pk2(y[0], y[1]); w.y = pk2(y[2], y[3]);
                *(v2u*)(Y + row * 1024 + yc) = w;
                asm volatile("" ::: "memory");
            }
    }
};
struct EpiRes {
    static constexpr bool PERM = false, AFTER_DRAIN = false;
    const float* R; float* O;
    __device__ __forceinline__ void operator()(const f32x4 (&acc)[2][2][4][2], const pg8::Unit& u, int wr, int wc, int fr, int fq) const {
        const int rbase = u.pm * 256 + wr * 64 + fr, cb = u.pn * 256 + wc * 32 + 4 * fq;
#pragma unroll
        for (int ai = 0; ai < 2; ++ai)
#pragma unroll
            for (int m = 0; m < 4; ++m) {
                const size_t off = (size_t)(rbase + ai * 128 + m * 16) * 1024 + cb;
#pragma unroll
                for (int bj = 0; bj < 2; ++bj)
#pragma unroll
                    for (int n = 0; n < 2; ++n) { const f32x4 r = *(const f32x4*)(R + off + bj * 128 + n * 16); *(f32x4*)(O + off + bj * 128 + n * 16) = r + acc[ai][bj][m][n]; }
            }
    }
};
#define XB_TMO      128
#define XB_XCNT(j)  (256  + 64 * (j))
#define XB_XSUB(j)  (1280 + 64 * (j))
#define XB_XGEN(j)  (2304 + 64 * (j))
#define XB_TOP      3328
#define XB_TOPGEN   3392
#define XCD_BAR_WORDS 3456
#define XB_SPIN_CAP (1u << 18)

__device__ __forceinline__ unsigned xb_ld(unsigned* p)              { return __hip_atomic_load(p, __ATOMIC_RELAXED, __HIP_MEMORY_SCOPE_AGENT); }
__device__ __forceinline__ unsigned xb_add(unsigned* p, unsigned v) { return __hip_atomic_fetch_add(p, v, __ATOMIC_RELAXED, __HIP_MEMORY_SCOPE_AGENT); }
__device__ __forceinline__ unsigned xb_xcc_id() { return (unsigned)__builtin_amdgcn_s_getreg((3 << 11) | 20) & 0xFu; }
#define XB_SPIN(cond, bar) do { unsigned _sp = 0; while (cond) { __builtin_amdgcn_s_sleep(1); \
    if ((++_sp & 255u) == 0u) { if (xb_ld(&(bar)[XB_TMO])) break; if (_sp > XB_SPIN_CAP) { atomicAdd(&(bar)[XB_TMO], 1u); break; } } } } while (0)

struct XcdBarrier {
    unsigned* bar; unsigned x;
    volatile LAS unsigned* st;
};

__device__ __forceinline__ XcdBarrier xcd_barrier_post(unsigned* bar, volatile LAS unsigned* st) {
    XcdBarrier b; b.bar = bar; b.x = xb_xcc_id(); b.st = st;
    if (threadIdx.x == 0) (void)xb_add(&bar[XB_XCNT(b.x)], 1u);
    return b;
}
__device__ __forceinline__ void xcd_barrier_complete(unsigned* bar, unsigned x, unsigned& nloc, unsigned& nx) {
    const unsigned G = gridDim.x * gridDim.y * gridDim.z;
    unsigned sum, cnt, mine, sp = 0u;
    for (;;) {
        sum = 0u; cnt = 0u; mine = 0u;
#pragma unroll
        for (unsigned j = 0; j < 16; ++j) { const unsigned c = xb_ld(&bar[XB_XCNT(j)]); sum += c; cnt += (c > 0u) ? 1u : 0u; mine = (j == x) ? c : mine; }
        if (sum == G) break;
        __builtin_amdgcn_s_sleep(1);
        if ((++sp & 255u) == 0u) { if (xb_ld(&bar[XB_TMO])) break; if (sp > XB_SPIN_CAP) { atomicAdd(&bar[XB_TMO], 1u); break; } }
    }
    nloc = mine > 0u ? mine : 1u; nx = cnt > 0u ? cnt : 1u;
}

__device__ __forceinline__ void xcd_barrier(const XcdBarrier& b_in, const bool t0) {
    XcdBarrier b = b_in; asm volatile("" : "+s"(b.bar), "+s"(b.x));
    asm volatile("s_waitcnt vmcnt(0)" ::: "memory");
    __syncthreads();
    if (t0) {
        unsigned* bar = b.bar;
        __builtin_amdgcn_s_waitcnt(0);
        unsigned nloc = b.st[0], nx = b.st[1];
        if (nloc == 0u) { xcd_barrier_complete(bar, b.x, nloc, nx); b.st[0] = nloc; b.st[1] = nx; }
        const unsigned old = xb_add(&bar[XB_XSUB(b.x)], 1u);
        const unsigned gen = old / nloc;
        if (old + 1u == (gen + 1u) * nloc) {
            __builtin_amdgcn_fence(__ATOMIC_RELEASE, "agent");
            asm volatile("s_waitcnt vmcnt(0)" ::: "memory");
            const unsigned og = xb_add(&bar[XB_TOP], 1u);
            const unsigned tg = og / nx;
            if (og + 1u == (tg + 1u) * nx) xb_add(&bar[XB_TOPGEN], 1u);
            else XB_SPIN(xb_ld(&bar[XB_TOPGEN]) == tg, bar);
            __builtin_amdgcn_fence(__ATOMIC_ACQUIRE, "agent");
            xb_add(&bar[XB_XGEN(b.x)], 1u);
            asm volatile("s_waitcnt vmcnt(0)" ::: "memory");
        } else {
            XB_SPIN(xb_ld(&bar[XB_XGEN(b.x)]) == gen, bar);
            __builtin_amdgcn_fence(__ATOMIC_ACQUIRE, "agent");
            asm volatile("s_waitcnt vmcnt(0)" ::: "memory");
        }
    }
    __syncthreads();
}

struct Params { const float* in[19]; float* out; unsigned char* ws; };
struct Ctx {
    LAS unsigned char* lds; int tid, lane, wave, G, bid;
};
__device__ __forceinline__ int lane_id_fresh() { int l; asm volatile("v_mbcnt_lo_u32_b32 %0, -1, 0\n\tv_mbcnt_hi_u32_b32 %0, -1, %0" : "=v"(l)); return l; }
#define OPQ(C) do { (C).lane = lane_id_fresh(); (C).tid = (C).wave * 64 + (C).lane; } while (0)

template <class MapFn>
__device__ __forceinline__ void transpose_item(const float* W, int K, int N, LAS float* scr, int item, int lane, MapFn map) {
    const int nblk = (N + 31) / 32, kb = item / nblk, nb = item % nblk, k0 = 64 * kb, n0 = 32 * nb;
    const int ncol = n0 + (lane & 31);
#pragma unroll 8
    for (int i = 0; i < 32; ++i) { const int kk = 2 * i + (lane >> 5); scr[kk * 33 + (lane & 31)] = (ncol < N) ? W[(size_t)(k0 + kk) * N + ncol] : 0.f; }
    LDS_WAIT(); asm volatile("" ::: "memory");
    const int c = lane & 7;
#pragma unroll
    for (int j = 0; j < 4; ++j) {
        const int n = (lane >> 3) + 8 * j; const LAS float* s = scr + (8 * c) * 33 + n;
        v4u o; o.x = pk2(s[0 * 33], s[1 * 33]); o.y = pk2(s[2 * 33], s[3 * 33]); o.z = pk2(s[4 * 33], s[5 * 33]); o.w = pk2(s[6 * 33], s[7 * 33]);
        if (n0 + n < N) { bf16* dst = map(n0 + n); *(v4u*)(dst + k0 + 8 * c) = o; }
    }
    LDS_WAIT(); asm volatile("" ::: "memory");
}
__device__ __forceinline__ void convert_weights(Ctx C, const Params& P, int l) {
    OPQ(C);
    LAS float* scr = (LAS float*)(C.lds + C.wave * 16384);
    const int gw = C.bid * 8 + C.wave, NGW = C.G * 8;
    unsigned char* ws = P.ws;
    bf16* W1t = (bf16*)(ws + WS_W1T + (size_t)l * W1T_LAYER); bf16* Wgt = (bf16*)(ws + WS_WGT + (size_t)l * WGT_LAYER);
    bf16* Wbt = (bf16*)(ws + WS_WBT + (size_t)l * WBT_LAYER); bf16* Wot = (bf16*)(ws + WS_WOT + (size_t)l * WOT_LAYER);
    const float* w_in = P.in[2] + (size_t)l * 1024 * INC; const float* w_br = P.in[16] + (size_t)l * 4 * 256 * 1024; const float* w_out = P.in[17] + (size_t)l * 1024 * 1024;
    constexpr int I_IN = 16 * ((INC + 31) / 32), I_BR = 4 * 32, I_OUT = 16 * 32;
    constexpr int NITEMS = I_IN + 4 * I_BR + I_OUT;
    for (int it = gw; it < NITEMS; it += NGW) {
        int r = it;
        if (r < I_IN) { transpose_item(w_in, 1024, INC, scr, r, C.lane, [&](int c) -> bf16* { int which; const int row = win_dst_row(c, which); return (which ? Wgt : W1t) + (size_t)row * 1024; }); continue; }
        r -= I_IN;
        if (r < 4 * I_BR) { const int br = r / I_BR, ri = r % I_BR; transpose_item(w_br + (size_t)br * 256 * 1024, 256, 1024, scr, ri, C.lane, [&](int c) -> bf16* { return Wbt + ((size_t)br * 1024 + c) * 256; }); continue; }
        r -= 4 * I_BR;
        transpose_item(w_out, 1024, 1024, scr, r, C.lane, [&](int c) -> bf16* { return Wot + (size_t)c * 1024; });
    }
    for (int i = C.bid * 512 + C.tid; i < 56 * 1024 / 8; i += C.G * 512) *(v4u*)(W1t + (size_t)(14 * 256 + 200) * 1024 + (size_t)i * 8) = (v4u){0u, 0u, 0u, 0u};
}
__device__ __forceinline__ void rms_row(const float* xrow, const float* g, bf16* obf, float* of32, int lane) {
    const f32x4* xr = (const f32x4*)xrow + lane;
    f32x4 v[4]; float s = 0.f;
#pragma unroll
    for (int j = 0; j < 4; ++j) { v[j] = xr[64 * j]; s += (v[j].x * v[j].x + v[j].y * v[j].y) + (v[j].z * v[j].z + v[j].w * v[j].w); }
    const float inv = rsqrtf(wave_sum(s) * (1.f / 1024.f) + 1e-6f);
#pragma unroll
    for (int j = 0; j < 4; ++j) {
        const f32x4 gg = ((const f32x4*)g)[lane + 64 * j];
        const f32x4 o = v[j] * inv * gg;
        if (obf) { v2u w; w.x = pk2(o.x, o.y); w.y = pk2(o.z, o.w); ((v2u*)obf)[lane + 64 * j] = w; }
        else ((f32x4*)of32)[lane + 64 * j] = o;
    }
}
__device__ __forceinline__ void norm_rows_bf16(Ctx C, const float* x, const float* g, bf16* h) {
    OPQ(C);
    const int gw = C.bid * 8 + C.wave, NGW = C.G * 8;
    for (int m = gw; m < NTOK; m += NGW) rms_row(x + (size_t)m * 1024, g, h + (size_t)m * 1024, nullptr, C.lane);
}
__device__ __forceinline__ void setup_tables(Ctx C, const Params& P) {
    OPQ(C);
    float* tcos = (float*)(P.ws + WS_COS); float* tsin = (float*)(P.ws + WS_SIN); float* lb = (float*)(P.ws + WS_LB);
    for (int i = C.bid * 512 + C.tid; i < SEQ * 32; i += C.G * 512) {
        const int pos = i >> 5, j = i & 31;
        const float freq = (float)pow(10000.0, -(double)j / 32.0);
        const float ang = (float)pos * freq;
        tcos[i] = (float)cos((double)ang); tsin[i] = (float)sin((double)ang);
    }
    if (C.bid == 0 && C.tid < 256) {
        const float l0 = P.in[4][C.tid], l1 = P.in[4][256 + C.tid];
        lb[C.tid] = 0.f; lb[256 + C.tid] = 1.f / (1.f + expf(l0 - l1));
    }
}

__device__ __forceinline__ void mixA_simple(Ctx C, unsigned char* ws, const float* bias) {
    OPQ(C);
    bf16* AQ = PLP(ws, PL_AQ); const bf16* AK = PLP(ws, PL_AK); const bf16* AV = PLP(ws, PL_AV); const bf16* AZ = PLP(ws, PL_AZ);
    for (int it = C.bid * 512 + C.tid; it < 4 * NTOK; it += C.G * 512) {
        const int h = it / NTOK, m = it % NTOK, b = m >> 12, t = m & 4095, c = t >> 6, qi = t & 63;
        float q[64], o[64];
        {
            const v4u* qp = (const v4u*)(AQ + (size_t)m * 256 + h * 64);
#pragma unroll
            for (int j = 0; j < 8; ++j) { const v4u w = qp[j]; q[8 * j] = bflo(w.x); q[8 * j + 1] = bfhi(w.x); q[8 * j + 2] = bflo(w.y); q[8 * j + 3] = bfhi(w.y); q[8 * j + 4] = bflo(w.z); q[8 * j + 5] = bfhi(w.z); q[8 * j + 6] = bflo(w.w); q[8 * j + 7] = bfhi(w.w); }
        }
#pragma unroll
        for (int d = 0; d < 64; ++d) o[d] = 0.f;
        float mx = -INFINITY, l = 0.f;
        const float* bh = bias + h * 192;
        for (int kj = 0; kj < 576; ++kj) {
            const int kp = c * 64 - 512 + kj;
            if (kp < 0) continue;
            const size_t mk = ((size_t)b << 12) + kp;
            const v4u* kr = (const v4u*)(AK + mk * 256 + h * 64); const v4u* vr = (const v4u*)(AV + mk * 256 + h * 64);
            float s = 0.f;
#pragma unroll
            for (int j = 0; j < 8; ++j) { const v4u w = kr[j];
                s = fmaf(q[8 * j], bflo(w.x), s); s = fmaf(q[8 * j + 1], bfhi(w.x), s); s = fmaf(q[8 * j + 2], bflo(w.y), s); s = fmaf(q[8 * j + 3], bfhi(w.y), s);
                s = fmaf(q[8 * j + 4], bflo(w.z), s); s = fmaf(q[8 * j + 5], bfhi(w.z), s); s = fmaf(q[8 * j + 6], bflo(w.w), s); s = fmaf(q[8 * j + 7], bfhi(w.w), s); }
            int rel = qi + 512 - kj; rel = rel < -63 ? -63 : (rel > 128 ? 128 : rel);
            s = s * 0.125f + bh[rel + 63];
            const float mn = fmaxf(mx, s), al = expf(mx - mn), pe = expf(s - mn);
            l = l * al + pe; mx = mn;
#pragma unroll
            for (int j = 0; j < 8; ++j) { const v4u w = vr[j];
                o[8 * j] = fmaf(pe, bflo(w.x), o[8 * j] * al); o[8 * j + 1] = fmaf(pe, bfhi(w.x), o[8 * j + 1] * al); o[8 * j + 2] = fmaf(pe, bflo(w.y), o[8 * j + 2] * al); o[8 * j + 3] = fmaf(pe, bfhi(w.y), o[8 * j + 3] * al);
                o[8 * j + 4] = fmaf(pe, bflo(w.z), o[8 * j + 4] * al); o[8 * j + 5] = fmaf(pe, bfhi(w.z), o[8 * j + 5] * al); o[8 * j + 6] = fmaf(pe, bflo(w.w), o[8 * j + 6] * al); o[8 * j + 7] = fmaf(pe, bfhi(w.w), o[8 * j + 7] * al); }
        }
        const float invl = 1.f / l;
        const v4u* zp = (const v4u*)(AZ + (size_t)m * 256 + h * 64); v4u* op = (v4u*)(AQ + (size_t)m * 256 + h * 64);
#pragma unroll
        for (int j = 0; j < 8; ++j) { const v4u z = zp[j]; v4u w;
            w.x = pk2(o[8 * j] * invl * siluf_(bflo(z.x)), o[8 * j + 1] * invl * siluf_(bfhi(z.x))); w.y = pk2(o[8 * j + 2] * invl * siluf_(bflo(z.y)), o[8 * j + 3] * invl * siluf_(bfhi(z.y)));
            w.z = pk2(o[8 * j + 4] * invl * siluf_(bflo(z.z)), o[8 * j + 5] * invl * siluf_(bfhi(z.z))); w.w = pk2(o[8 * j + 6] * invl * siluf_(bflo(z.w)), o[8 * j + 7] * invl * siluf_(bfhi(z.w)));
            op[j] = w; }
    }
}
__device__ __forceinline__ void mixB_simple(Ctx C, unsigned char* ws, const float* normg) {
    OPQ(C);
    if (C.bid < 32 || C.bid >= 36) return;
    const int gw = (C.bid - 32) * 8 + C.wave;
    const int b = gw >> 2, h = gw & 3, v = C.lane;
    bf16* BQ = PLP(ws, PL_BQ); const bf16* BI = PLP(ws, PL_BI); const bf16* BZ = PLP(ws, PL_BZ); const float* BF = (const float*)(ws + WS_BF);
    float S[64];
#pragma unroll
    for (int d = 0; d < 64; ++d) S[d] = 0.f;
    const float g = normg[v];
    for (int t = 0; t < SEQ; ++t) {
        const size_t m = ((size_t)b << 12) + t;
        const float* fr = BF + m * 256 + h * 64; const bf16* qr = BQ + m * 256 + h * 64;
        const float iv = bf2f(BI[m * 256 + h * 64 + v]); const float z = bf2f(BZ[m * 256 + h * 64 + v]);
        float o = 0.f;
#pragma unroll
        for (int d = 0; d < 64; ++d) { S[d] = fmaf(fr[d], S[d] - iv, iv); o = fmaf(bf2f(qr[d]), S[d], o); }
        const float r = rsqrtf(wave_sum(o * o) * (1.f / 64.f) + 1e-6f);
        asm volatile("" ::: "memory");
        BQ[m * 256 + h * 64 + v] = (bf16)f2bf(o * r * g * siluf_(z));
    }
}
__device__ __forceinline__ void mixD_simple(Ctx C, unsigned char* ws, const Params& P, int l) {
    OPQ(C);
    if (C.bid >= 32) return;
    const int b = C.bid >> 2, h = C.bid & 3, tid = C.tid;
    bf16* DR = PLP(ws, PL_DR); const bf16* DK = PLP(ws, PL_DK); const bf16* DV = PLP(ws, PL_DV); const bf16* DZ = PLP(ws, PL_DZ); const float* MS = (const float*)(ws + WS_MISC);
    const float* mu = P.in[6] + l * 896; const float* w0 = P.in[7] + l * 256; const float* w_up = P.in[8] + (size_t)l * 64 * 256; const float* a0 = P.in[9] + l * 256;
    const float* a_up = P.in[10] + (size_t)l * 64 * 256; const float* k_k = P.in[11] + l * 256; const float* k_a = P.in[12] + l * 256; const float* r_k = P.in[13] + l * 256;
    const float* gn_g = P.in[14] + l * 256; const float* gn_b = P.in[15] + l * 256;
    LAS float* L = (LAS float*)C.lds;
    LAS float* twd = L; LAS float* ads = L + 64; LAS float* rs = L + 128; LAS float* kr = L + 192; LAS float* vs = L + 256;
    LAS float* wv = L + 320; LAS float* av = L + 384; LAS float* kkv = L + 448; LAS float* kfv = L + 512; LAS float* bv = L + 576; LAS float* ob = L + 640; LAS float* bon = L + 704;
    const int v = tid >> 3, ks = tid & 7;
    float S[8];
#pragma unroll
    for (int i = 0; i < 8; ++i) S[i] = 0.f;
    const int grp = tid >> 6, cc = tid & 63;
    float prev = 0.f, mucol = 0.f;
    if (grp == 0) mucol = mu[768 + cc]; else if (grp == 1) mucol = mu[832 + cc]; else if (grp == 2) mucol = mu[h * 64 + cc]; else if (grp == 3) mucol = mu[256 + h * 64 + cc]; else if (grp == 4) mucol = mu[512 + h * 64 + cc];
    for (int t = 0; t < SEQ; ++t) {
        const size_t m = ((size_t)b << 12) + t;
        if (grp < 5) {
            float cur;
            if (grp == 0) cur = MS[m * 256 + 72 + cc]; else if (grp == 1) cur = MS[m * 256 + 136 + cc];
            else if (grp == 2) cur = bf2f(DR[m * 256 + h * 64 + cc]); else if (grp == 3) cur = bf2f(DK[m * 256 + h * 64 + cc]); else cur = bf2f(DV[m * 256 + h * 64 + cc]);
            const float sh = cur + mucol * (prev - cur); prev = cur;
            if (grp == 0) twd[cc] = tanhf(sh); else if (grp == 1) ads[cc] = sh; else if (grp == 2) rs[cc] = sh; else if (grp == 3) kr[cc] = sh; else vs[cc] = sh;
        }
        __syncthreads();
        if (tid < 128) {
            const int c = tid & 63, hc = h * 64 + c;
            if (tid < 64) { float wl = w0[hc];
_Pragma("nounroll")
                for (int i = 0; i < 64; ++i) wl = fmaf(twd[i], w_up[i * 256 + hc], wl);
                const float x = -wl; const float sp = fmaxf(x, 0.f) + log1pf(expf(-fabsf(x))); wv[c] = expf(-expf(-sp - 0.5f)); }
            else { float al = a0[hc];
_Pragma("nounroll")
                for (int i = 0; i < 64; ++i) al = fmaf(ads[i], a_up[i * 256 + hc], al); av[c] = sigmoidf_(al); }
        }
        __syncthreads();
        if (tid < 64) {
            const int hc = h * 64 + tid; const float kx = kr[tid], a = av[tid];
            const float kkr = kx * k_k[hc]; const float nrm = sqrtf(wave_sum(kkr * kkr)); const float kk = kkr / fmaxf(nrm, 1e-12f);
            const float kf = kx * (1.f + (a - 1.f) * k_a[hc]);
            kkv[tid] = kk; kfv[tid] = kf; bv[tid] = kk * a;
            const float bsum = wave_sum(rs[tid] * kf * r_k[hc]); if (tid == 0) bon[0] = bsum;
        }
        __syncthreads();
        {
            float sa = 0.f;
#pragma unroll
            for (int i = 0; i < 8; ++i) sa = fmaf(S[i], kkv[8 * ks + i], sa);
            sa += __shfl_xor(sa, 1); sa += __shfl_xor(sa, 2); sa += __shfl_xor(sa, 4); sa = -sa;
            const float vv = vs[v]; float o = 0.f;
#pragma unroll
            for (int i = 0; i < 8; ++i) { S[i] = fmaf(S[i], wv[8 * ks + i], fmaf(sa, bv[8 * ks + i], vv * kfv[8 * ks + i])); o = fmaf(S[i], rs[8 * ks + i], o); }
            o += __shfl_xor(o, 1); o += __shfl_xor(o, 2); o += __shfl_xor(o, 4);
            if (ks == 0) ob[v] = o;
        }
        __syncthreads();
        if (tid < 64) {
            const int hc = h * 64 + tid; const float o = ob[tid];
            const float mean = wave_sum(o) * (1.f / 64.f); const float d = o - mean; const float var = wave_sum(d * d) * (1.f / 64.f);
            float y = d * rsqrtf(var + 64e-5f) * gn_g[hc] + gn_b[hc];
            y += bon[0] * vs[tid];
            const float z = bf2f(DZ[m * 256 + hc]);
            DR[m * 256 + hc] = (bf16)f2bf(y * siluf_(z));
        }
        __syncthreads();
    }
}
__device__ __forceinline__ void mixC_simple(Ctx C, unsigned char* ws) {
    OPQ(C);
    bf16* CQ = PLP(ws, PL_CQ); const bf16* CK = PLP(ws, PL_CK); const bf16* CV = PLP(ws, PL_CV); const bf16* CZ = PLP(ws, PL_CZ);
    const bf16* QI0 = PLP(ws, PL_CQI0); const bf16* QI1 = PLP(ws, PL_CQI1); const float* MS = (const float*)(ws + WS_MISC);
    LAS float* L = (LAS float*)C.lds;
    LAS float* qs = L;
    LAS float* q4 = L + 512;
    LAS float* wq = L + 768;
    LAS float* sc = L + 1024;
    LAS float* ps = L + 5120;
    LAS int* sel = (LAS int*)(L + 6144);
    LAS unsigned* hist = (LAS unsigned*)(L + 6400);
    LAS float* red = L + 6656;
    LAS unsigned* sw = (LAS unsigned*)(L + 6672);
    const int tid = C.tid;
    for (int m = C.bid; m < NTOK; m += C.G) {
        const int b = m >> 12, t = m & 4095, n = ((t >> 6) + 1) * 64;
        qs[tid] = bf2f(tid < 256 ? QI0[(size_t)m * 256 + tid] : QI1[(size_t)m * 256 + tid - 256]);
        if (tid < 256) q4[tid] = bf2f(CQ[(size_t)m * 256 + tid]);
        if (tid < 8) wq[tid] = MS[(size_t)m * 256 + 64 + tid] * 0.35355339059327373f;
        __syncthreads();
        for (int s = tid; s < n; s += 512) {
            const f32x4* kp = (const f32x4*)(MS + (((size_t)b << 12) + s) * 256);
            float kv[64];
#pragma unroll
            for (int j = 0; j < 16; ++j) { const f32x4 w = kp[j]; kv[4 * j] = w.x; kv[4 * j + 1] = w.y; kv[4 * j + 2] = w.z; kv[4 * j + 3] = w.w; }
            float acc = 0.f;
            for (int hh = 0; hh < 8; ++hh) {
                float d = 0.f;
#pragma unroll
                for (int c = 0; c < 64; ++c) d = fmaf(qs[hh * 64 + c], kv[c], d);
                d = fmaxf(d * 0.125f, 0.f);
                acc = fmaf(d, wq[hh], acc);
            }
            sc[s] = acc;
        }
        __syncthreads();
        int cnt;
        if (n <= 256) { if (tid < n) sel[tid] = tid; cnt = n; }
        else {
            unsigned key[8];
#pragma unroll
            for (int j = 0; j < 8; ++j) { const int idx = tid + 512 * j; unsigned kk = 0u; if (idx < n) { const unsigned u = __float_as_uint(sc[idx]); kk = (u & 0x80000000u) ? ~u : (u | 0x80000000u); } key[j] = kk; }
            if (tid == 0) { sw[0] = 0u; sw[1] = 256u; sw[3] = 0u; }
            unsigned mask = 0u;
            for (int pass = 3; pass >= 0; --pass) {
                const int shift = pass * 8;
                if (tid < 256) hist[tid] = 0u;
                __syncthreads();
                const unsigned prefix = sw[0];
#pragma unroll
                for (int j = 0; j < 8; ++j) { const int idx = tid + 512 * j; if (idx < n && (key[j] & mask) == prefix) atomicAdd((unsigned*)&hist[(key[j] >> shift) & 255u], 1u); }
                __syncthreads();
                if (tid == 0) { const unsigned k = sw[1]; unsigned c = 0u; int bb = 255; for (; bb > 0; --bb) { if (c + hist[bb] >= k) break; c += hist[bb]; }
                    sw[1] = k - c; sw[0] = prefix | ((unsigned)bb << shift); sw[2] = hist[bb]; }
                mask |= (0xFFu << shift);
                __syncthreads();
            }
            const unsigned thr = sw[0], need = sw[1], eqc = sw[2];
            if (tid == 0) { int cut = SEQ;
                if (eqc != need) { unsigned c = 0u; for (int i = 0; i < n; ++i) { const unsigned u = __float_as_uint(sc[i]); const unsigned kk = (u & 0x80000000u) ? ~u : (u | 0x80000000u); if (kk == thr) { ++c; if (c == need) { cut = i; break; } } } }
                sw[4] = (unsigned)cut; }
            __syncthreads();
            const int cut = (int)sw[4];
#pragma unroll
            for (int j = 0; j < 8; ++j) { const int idx = tid + 512 * j; if (idx < n && (key[j] > thr || (key[j] == thr && idx <= cut))) { const unsigned pos = atomicAdd((unsigned*)&sw[3], 1u); if (pos < 256u) sel[pos] = idx; } }
            cnt = 256;
        }
        __syncthreads();
        float s4[4] = {-INFINITY, -INFINITY, -INFINITY, -INFINITY};
        if (tid < cnt) {
            const v4u* kr = (const v4u*)(CK + (((size_t)b << 12) + sel[tid]) * 256);
#pragma unroll
            for (int hh = 0; hh < 4; ++hh) { float d = 0.f;
#pragma unroll
                for (int j = 0; j < 8; ++j) { const v4u w = kr[hh * 8 + j]; const LAS float* qq = q4 + hh * 64 + 8 * j;
                    d = fmaf(qq[0], bflo(w.x), d); d = fmaf(qq[1], bfhi(w.x), d); d = fmaf(qq[2], bflo(w.y), d); d = fmaf(qq[3], bfhi(w.y), d);
                    d = fmaf(qq[4], bflo(w.z), d); d = fmaf(qq[5], bfhi(w.z), d); d = fmaf(qq[6], bflo(w.w), d); d = fmaf(qq[7], bfhi(w.w), d); }
                s4[hh] = d * 0.125f; }
        }
        if (tid < 256) {
#pragma unroll
            for (int hh = 0; hh < 4; ++hh) { const float v = wave_max(s4[hh]); if (C.lane == 0) red[hh * 4 + C.wave] = v; }
        }
        __syncthreads();
        float mx[4];
#pragma unroll
        for (int hh = 0; hh < 4; ++hh) mx[hh] = fmaxf(fmaxf(red[hh * 4], red[hh * 4 + 1]), fmaxf(red[hh * 4 + 2], red[hh * 4 + 3]));
        __syncthreads();
        if (tid < 256) {
#pragma unroll
            for (int hh = 0; hh < 4; ++hh) { const float e = (tid < cnt) ? expf(s4[hh] - mx[hh]) : 0.f; ps[hh * 256 + tid] = e; const float v = wave_sum(e); if (C.lane == 0) red[hh * 4 + C.wave] = v; }
        }
        __syncthreads();
        if (tid < 256) {
            const int hh = tid >> 6;
            const float lsum = red[hh * 4] + red[hh * 4 + 1] + red[hh * 4 + 2] + red[hh * 4 + 3];
            float o = 0.f;
            for (int j = 0; j < cnt; ++j) o = fmaf(ps[hh * 256 + j], bf2f(CV[(((size_t)b << 12) + sel[j]) * 256 + tid]), o);
            const float z = bf2f(CZ[(size_t)m * 256 + tid]);
            CQ[(size_t)m * 256 + tid] = (bf16)f2bf(o / lsum * siluf_(z));
        }
        __syncthreads();
    }
}

#define GRID_BAR() do { xcd_barrier(bar, C.wave == 0 && lane_id_fresh() == 0); } while (0)
template <int l>
__device__ __forceinline__ void layer_body(Ctx C, const Params& P, const XcdBarrier& bar) {
    unsigned char* ws = P.ws;
    const float* xin = (l == 0) ? P.in[0] : P.out;
    {
        pg8::Gemm g{(const pg8::bf16_t*)(ws + WS_H), (const pg8::bf16_t*)(ws + WS_W1T + (size_t)l * W1T_LAYER), NTOK, NG1, 1024};
        pg8::StaticOrder S; S.init(NTOK, NG1, C.G, C.bid);
        EpiG1 E{ws, (const float*)(ws + WS_LB) + l * 256};
        pg8::gemm_phase<EpiG1, pg8::StaticOrder, true, true>(C.lds, g, S, E, C.wave);
    }
    GRID_BAR();
    mixD_simple(C, ws, P, l);
    mixB_simple(C, ws, P.in[5] + l * 64);
    mixA_simple(C, ws, P.in[3] + l * 4 * 192);
    __syncthreads();
    mixC_simple(C, ws);
    GRID_BAR();
#pragma nounroll
    for (int br = 0; br < 4; ++br) {
        pg8::Gemm g{(const pg8::bf16_t*)PLP(ws, br), (const pg8::bf16_t*)(ws + WS_WBT + (size_t)l * WBT_LAYER + (size_t)br * 1024 * 256 * 2), NTOK, 1024, 256};
        pg8::StaticOrder S; S.init(NTOK, 1024, C.G, C.bid);
        EpiBf E{(bf16*)(ws + WS_PB) + (size_t)br * NTOK * 1024, 1024};
        pg8::gemm_phase<EpiBf, pg8::StaticOrder, true, true>(C.lds, g, S, E, C.wave);
    }
    GRID_BAR();
    {
        pg8::Gemm g{(const pg8::bf16_t*)(ws + WS_H), (const pg8::bf16_t*)(ws + WS_WGT + (size_t)l * WGT_LAYER), NTOK, 4096, 1024};
        pg8::StaticOrder S; S.init(NTOK, 4096, C.G, C.bid);
        EpiGate E{(const bf16*)(ws + WS_PB), (bf16*)(ws + WS_Y)};
        pg8::gemm_phase<EpiGate, pg8::StaticOrder, true, true>(C.lds, g, S, E, C.wave);
    }
    GRID_BAR();
    {
        pg8::Gemm g{(const pg8::bf16_t*)(ws + WS_Y), (const pg8::bf16_t*)(ws + WS_WOT + (size_t)l * WOT_LAYER), NTOK, 1024, 1024};
        pg8::StaticOrder S; S.init(NTOK, 1024, C.G, C.bid);
        EpiRes E{xin, P.out};
        pg8::gemm_phase<EpiRes, pg8::StaticOrder, true, true>(C.lds, g, S, E, C.wave);
    }
    GRID_BAR();
    if (l == 0) { norm_rows_bf16(C, P.out, P.in[1] + 1024, (bf16*)(ws + WS_H)); GRID_BAR(); }
    else {
        OPQ(C); const int gw = C.bid * 8 + C.wave, NGW = C.G * 8;
        for (int m = gw; m < NTOK; m += NGW) rms_row(P.out + (size_t)m * 1024, P.in[18], nullptr, P.out + (size_t)m * 1024, C.lane);
    }
}
__global__ void __launch_bounds__(512, 2) mega_fwd(Params P) {
    extern __shared__ __attribute__((aligned(16))) unsigned char lds_raw[];
    Ctx C; C.lds = (LAS unsigned char*)lds_raw; C.wave = __builtin_amdgcn_readfirstlane((int)threadIdx.x >> 6); C.G = gridDim.x; C.bid = blockIdx.x; OPQ(C);
    unsigned char* ws = P.ws;
    for (int u = C.tid; u < (LDS_BYTES - LDSCTL_OFF) / 4; u += 512) ((LAS unsigned*)(C.lds + LDSCTL_OFF))[u] = 0u;
    __syncthreads();
    volatile LAS unsigned* MISCW = (volatile LAS unsigned*)(C.lds + MISC_OFF);
    XcdBarrier bar = xcd_barrier_post((unsigned*)(ws + WS_CTL) + CW_BAR, MISCW + 8);
    setup_tables(C, P);
    convert_weights(C, P, 0);
    convert_weights(C, P, 1);
    norm_rows_bf16(C, P.in[0], P.in[1], (bf16*)(ws + WS_H));
    GRID_BAR();
    layer_body<0>(C, P, bar);
    layer_body<1>(C, P, bar);
}

extern "C" void kernel_launch(void* const* d_in, const int* in_sizes, int n_in, void* d_out, int out_size, void* d_ws, size_t ws_size, hipStream_t stream) {
    static int grid = 0;
    if (grid == 0) {
        if (n_in != 19 || ws_size < WS_END) { fprintf(stderr, "kernel_launch: need 19 inputs and %zu bytes of workspace (got %d, %zu)\n", (size_t)WS_END, n_in, ws_size); grid = -1; return; }
        int dev = 0, cus = 0, per_cu = 0;
        if (hipGetDevice(&dev) != hipSuccess || hipDeviceGetAttribute(&cus, hipDeviceAttributeMultiprocessorCount, dev) != hipSuccess) { grid = -1; return; }
        if (hipFuncSetAttribute((const void*)mega_fwd, hipFuncAttributeMaxDynamicSharedMemorySize, LDS_BYTES) != hipSuccess) { grid = -1; return; }
        (void)hipOccupancyMaxActiveBlocksPerMultiprocessor(&per_cu, (const void*)mega_fwd, 512, LDS_BYTES);
        (void)hipGetLastError();
        grid = cus;
    }
    if (grid < 0) return;
    if (hipMemsetAsync((char*)d_ws + WS_CTL, 0, CTL_ZERO_BYTES, stream) != hipSuccess) return;
    Params p{};
    for (int i = 0; i < 19; ++i) p.in[i] = (const float*)d_in[i];
    p.out = (float*)d_out; p.ws = (unsigned char*)d_ws;
    hipLaunchKernelGGL(mega_fwd, dim3(grid), dim3(512), LDS_BYTES, stream, p);
}
```

```cpp
#include <hip/hip_runtime.h>
#include <cstdio>
#include <cstdint>
#include <math.h>

#define DM 1024
#define SEQ 4096
#define NBATCH 8
#define NTOK (NBATCH * SEQ)
#define INC 8904
#define C_AQ 0
#define C_AK 256
#define C_AV 512
#define C_AZ 768
#define C_BQ 1024
#define C_BF 1280
#define C_BI 1536
#define C_BZ 1792
#define C_CQ 2048
#define C_CK 2304
#define C_CV 2560
#define C_CZ 2816
#define C_CQI 3072
#define C_CKI 3584
#define C_CWI 3648
#define C_PD 3656
#define C_DR 3656
#define C_DK 3912
#define C_DV 4168
#define C_DWD 4424
#define C_DAD 4488
#define C_DZ 4552
#define C_PG 4808
#define NG1 4864

namespace pg8 {
#define PG8_LAS __attribute__((address_space(3)))
typedef unsigned short bf16_t;
typedef short bf16x8 __attribute__((ext_vector_type(8)));
typedef float f32x4 __attribute__((ext_vector_type(4)));
typedef unsigned u32x4 __attribute__((ext_vector_type(4)));
constexpr int BM = 256, BK = 64, HALF = 128, HTB = HALF * BK * 2  , STAGE_BYTES = 8 * HTB, NXCD = 8, WGM = 8;

__host__ __device__ __forceinline__ int lds_byte(int r, int c) { const int st = (r >> 4) * 2 + (c >> 5), rr = r & 15, cc = c & 31, ob = rr * 64 + cc * 2; return st * 1024 + (ob ^ (((ob >> 9) & 1) << 5)); }
__host__ __device__ __forceinline__ void stage_rc(int b, int& R, int& C) { const int st = b / 1024, sb = b % 1024, swz = sb ^ (((sb >> 9) & 1) << 5); R = (st >> 1) * 16 + swz / 64; C = (st & 1) * 32 + (swz % 64) / 2; }
__host__ __device__ __forceinline__ int perm32(int rho) { const int n = rho >> 4, i = rho & 15; return 8 * (i >> 2) + 4 * n + (i & 3); }

struct Unit { int pm, pn; };
struct Gemm { const bf16_t* A; const bf16_t* Bt; int M, N, K; };

struct StaticOrder {
    int nM, nN, nwg, G, c;
    __host__ __device__ void init(int M, int N, int G_, int c_) { nM = M / BM; nN = N / BM; nwg = nM * nN; G = G_; c = c_; }
    __host__ __device__ bool next(int i, Unit& u) const {
        const long L = (long)i * G + c; if (L >= nwg) return false;
        int wgid = (int)L; { const int q = nwg / NXCD, r = nwg % NXCD, xcd = wgid % NXCD, off = wgid / NXCD; wgid = (xcd < r ? xcd * (q + 1) : r * (q + 1) + (xcd - r) * q) + off; }
        const int nig = WGM * nN, gid = wgid / nig, fm = gid * WGM, gsz = (nM - fm) < WGM ? (nM - fm) : WGM;
        u.pm = fm + ((wgid % nig) % gsz); u.pn = (wgid % nig) / gsz; return true;
    }
    __device__ __forceinline__ void a_ready(const Unit&) const {}
    __device__ __forceinline__ void done(const Unit&) const {}
};

__device__ __forceinline__ unsigned cvt_pk_bf16(float lo, float hi) { unsigned r; asm volatile("v_cvt_pk_bf16_f32 %0, %1, %2" : "=v"(r) : "v"(lo), "v"(hi)); return r; }
template <class Epi, class Sched, bool ALIGN_EPI = false, bool SP2 = false>
__device__ __forceinline__ void gemm_phase(PG8_LAS unsigned char* lds, const Gemm g, const Sched& S, const Epi& E, const int wave_in) {
    int lane_; asm volatile("v_mbcnt_lo_u32_b32 %0, -1, 0\n\tv_mbcnt_hi_u32_b32 %0, -1, %0" : "=v"(lane_));
    const int wid = wave_in, lane = lane_, tid = wid * 64 + lane, wr = wid >> 2, wc = wid & 3, fr = lane & 15, fq = lane >> 4;
    const int K = g.K, nt = K / BK;
    unsigned voffA[2], voffB[2];
#pragma unroll
    for (int i = 0; i < 2; ++i) { int R, C; stage_rc(tid * 16 + i * 8192, R, C); const int Rb = Epi::PERM ? ((R & ~31) + perm32(R & 31)) : R;
        voffA[i] = (unsigned)(R * K + C) * 2u; voffB[i] = (unsigned)(Rb * K + C) * 2u; }
    const size_t kstep = (size_t)(BK * 2);
    const size_t hstep = (size_t)HALF * K * 2;
    const size_t tstep = 2 * hstep;
    const unsigned ldsw = (unsigned)wid * 1024u;
    const int aoff = lds_byte(wr * 64 + fr, fq * 8), boff = lds_byte(wc * 32 + fr, fq * 8);
#define PG8_SA(b, h) (((b) * 2 + (h)) * HTB)
#define PG8_SB(b, h) ((4 + (b) * 2 + (h)) * HTB)
#define PG8_STAGE(bufoff, gbase, voff) do { _Pragma("unroll") for (int _i = 0; _i < 2; ++_i) \
        __builtin_amdgcn_global_load_lds((const unsigned*)((const char*)(gbase) + (voff)[_i]), (PG8_LAS unsigned*)(lds + (bufoff) + ldsw + _i * 8192), 16, 0, 0); } while (0)
#define PG8_LDA(dst, b, h) do { _Pragma("unroll") for (int m = 0; m < 4; ++m) _Pragma("unroll") for (int k = 0; k < 2; ++k) dst[m][k] = *(const PG8_LAS bf16x8*)(lds + PG8_SA(b, h) + aoff + m * 2048 + k * 1024); } while (0)
#define PG8_LDB(dst, b, h) do { _Pragma("unroll") for (int n = 0; n < 2; ++n) _Pragma("unroll") for (int k = 0; k < 2; ++k) dst[n][k] = *(const PG8_LAS bf16x8*)(lds + PG8_SB(b, h) + boff + n * 2048 + k * 1024); } while (0)
#define PG8_MMA(ai, bj, At, Bt) do { __builtin_amdgcn_s_setprio(1); _Pragma("unroll") for (int m = 0; m < 4; ++m) _Pragma("unroll") for (int n = 0; n < 2; ++n) _Pragma("unroll") for (int k = 0; k < 2; ++k) \
        acc[ai][bj][m][n] = __builtin_amdgcn_mfma_f32_16x16x32_bf16(Bt[n][k], At[m][k], acc[ai][bj][m][n], 0, 0, 0); __builtin_amdgcn_s_setprio(0); } while (0)
#define PG8_WAIT_V(n) asm volatile("s_waitcnt vmcnt(" #n ")" ::: "memory")
#define PG8_WAIT_L(n) asm volatile("s_waitcnt lgkmcnt(" #n ")" ::: "memory")
#define PG8_BAR __builtin_amdgcn_s_barrier()
#define PG8_SCHED __builtin_amdgcn_sched_barrier(0)
    Unit cur, nxt; int ui = 0;
    if (!S.next(0, cur)) return;
    f32x4 acc[2][2][4][2];
#pragma unroll
    for (int a = 0; a < 2; ++a)
#pragma unroll
        for (int b = 0; b < 2; ++b)
#pragma unroll
            for (int m = 0; m < 4; ++m)
#pragma unroll
                for (int n = 0; n < 2; ++n) acc[a][b][m][n] = (f32x4){0.f, 0.f, 0.f, 0.f};
    bf16x8 At[4][2], B0[2][2], B1[2][2];
    const char* cA = (const char*)g.A + (size_t)cur.pm * tstep; const char* cB = (const char*)g.Bt + (size_t)cur.pn * tstep;
    S.a_ready(cur);
    if constexpr (SP2) {
        PG8_STAGE(PG8_SB(0, 0), cB, voffB); PG8_STAGE(PG8_SB(0, 1), cB + hstep, voffB); PG8_STAGE(PG8_SA(0, 0), cA, voffA); PG8_STAGE(PG8_SA(0, 1), cA + hstep, voffA);
        if (wr == 1) PG8_BAR;
        PG8_WAIT_V(2); PG8_BAR;
        PG8_STAGE(PG8_SB(1, 0), cB + kstep, voffB); PG8_STAGE(PG8_SA(1, 0), cA + kstep, voffA); PG8_STAGE(PG8_SB(1, 1), cB + hstep + kstep, voffB);
        PG8_WAIT_V(6); PG8_BAR;
    } else {
        PG8_STAGE(PG8_SB(0, 0), cB, voffB); PG8_STAGE(PG8_SA(0, 0), cA, voffA); PG8_STAGE(PG8_SB(0, 1), cB + hstep, voffB); PG8_STAGE(PG8_SA(0, 1), cA + hstep, voffA);
        if (wr == 1) PG8_BAR;
        PG8_WAIT_V(4); PG8_BAR;
        PG8_STAGE(PG8_SB(1, 0), cB + kstep, voffB); PG8_STAGE(PG8_SA(1, 0), cA + kstep, voffA); PG8_STAGE(PG8_SB(1, 1), cB + hstep + kstep, voffB);
        PG8_WAIT_V(6); PG8_BAR;
    }
    for (;;) {
        const bool has_next = S.next(ui + 1, nxt);
        const char* nA = has_next ? (const char*)g.A + (size_t)nxt.pm * tstep : cA; const char* nB = has_next ? (const char*)g.Bt + (size_t)nxt.pn * tstep : cB;
        for (int t = 0; t < nt; t += 2) {
            const bool last = (t == nt - 2);
            const char* a1 = cA + (size_t)(t + 1) * kstep;
            const char* a2 = last ? nA : cA + (size_t)(t + 2) * kstep; const char* b2 = last ? nB : cB + (size_t)(t + 2) * kstep;
            const char* a3 = a2 + kstep; const char* b3 = b2 + kstep;
            if (last && has_next) S.a_ready(nxt);
            if constexpr (SP2) {
            PG8_LDB(B0, 0, 0); PG8_LDB(B1, 0, 1); PG8_SCHED; PG8_LDA(At, 0, 0); PG8_STAGE(PG8_SA(1, 1), a1 + hstep, voffA);
            PG8_WAIT_V(8); PG8_WAIT_L(0); PG8_BAR; PG8_MMA(0, 0, At, B0); PG8_MMA(0, 1, At, B1); PG8_BAR; PG8_SCHED;
            PG8_LDA(At, 0, 1); PG8_STAGE(PG8_SB(0, 0), b2, voffB); PG8_STAGE(PG8_SB(0, 1), b2 + hstep, voffB); PG8_STAGE(PG8_SA(0, 0), a2, voffA);
            PG8_WAIT_V(8); PG8_WAIT_L(0); PG8_BAR; PG8_MMA(1, 0, At, B0); PG8_MMA(1, 1, At, B1); PG8_BAR; PG8_SCHED;
            PG8_LDB(B0, 1, 0); PG8_LDB(B1, 1, 1); PG8_SCHED; PG8_LDA(At, 1, 0); PG8_STAGE(PG8_SA(0, 1), a2 + hstep, voffA);
            PG8_WAIT_V(8); PG8_WAIT_L(0); PG8_BAR; PG8_MMA(0, 0, At, B0); PG8_MMA(0, 1, At, B1); PG8_BAR; PG8_SCHED;
            PG8_LDA(At, 1, 1); PG8_STAGE(PG8_SB(1, 0), b3, voffB); PG8_STAGE(PG8_SB(1, 1), b3 + hstep, voffB); PG8_STAGE(PG8_SA(1, 0), a3, voffA);
            PG8_WAIT_V(8); PG8_WAIT_L(0); PG8_BAR; PG8_MMA(1, 0, At, B0); PG8_MMA(1, 1, At, B1); PG8_BAR; PG8_SCHED;
            } else {
            PG8_LDB(B0, 0, 0); PG8_SCHED; PG8_LDA(At, 0, 0); PG8_STAGE(PG8_SA(1, 1), a1 + hstep, voffA);
            PG8_WAIT_L(8); PG8_BAR; PG8_WAIT_L(0); PG8_MMA(0, 0, At, B0); PG8_BAR; PG8_SCHED;
            PG8_LDB(B1, 0, 1); PG8_STAGE(PG8_SB(0, 0), b2, voffB);
            PG8_BAR; PG8_WAIT_L(0); PG8_MMA(0, 1, At, B1); PG8_BAR;
            PG8_LDA(At, 0, 1); PG8_STAGE(PG8_SA(0, 0), a2, voffA);
            PG8_BAR; PG8_WAIT_L(0); PG8_MMA(1, 0, At, B0); PG8_BAR; PG8_SCHED;
            PG8_STAGE(PG8_SB(0, 1), b2 + hstep, voffB);
            PG8_WAIT_V(6); PG8_BAR; PG8_MMA(1, 1, At, B1); PG8_BAR;
            PG8_LDB(B0, 1, 0); PG8_SCHED; PG8_LDA(At, 1, 0); PG8_STAGE(PG8_SA(0, 1), a2 + hstep, voffA);
            PG8_WAIT_L(8); PG8_BAR; PG8_WAIT_L(0); PG8_MMA(0, 0, At, B0); PG8_BAR; PG8_SCHED;
            PG8_LDB(B1, 1, 1); PG8_STAGE(PG8_SB(1, 0), b3, voffB);
            PG8_BAR; PG8_WAIT_L(0); PG8_MMA(0, 1, At, B1); PG8_BAR;
            PG8_LDA(At, 1, 1); PG8_STAGE(PG8_SA(1, 0), a3, voffA);
            PG8_BAR; PG8_WAIT_L(0); PG8_MMA(1, 0, At, B0); PG8_BAR; PG8_SCHED;
            PG8_STAGE(PG8_SB(1, 1), b3 + hstep, voffB);
            PG8_WAIT_V(6); PG8_BAR; PG8_MMA(1, 1, At, B1); PG8_BAR;
            }
        }
        if constexpr (ALIGN_EPI) { if (wr == 0) PG8_BAR; }
        if constexpr (!Epi::AFTER_DRAIN) { E(acc, cur, wr, wc, fr, fq); S.done(cur); }
        if (!has_next) break;
#pragma unroll
        for (int a = 0; a < 2; ++a)
#pragma unroll
            for (int b = 0; b < 2; ++b)
#pragma unroll
                for (int m = 0; m < 4; ++m)
#pragma unroll
                    for (int n = 0; n < 2; ++n) acc[a][b][m][n] = (f32x4){0.f, 0.f, 0.f, 0.f};
        cur = nxt; cA = nA; cB = nB; ++ui;
        if constexpr (ALIGN_EPI) { if (wr == 1) PG8_BAR; }
    }
    PG8_WAIT_V(0);
    if constexpr (!ALIGN_EPI) { if (wr == 0) PG8_BAR; }
    PG8_BAR;
    if constexpr (Epi::AFTER_DRAIN) { E.fused(acc, cur, wr, wc, fr, fq, lds, wid, lane); S.done(cur); }
#undef PG8_SA
#undef PG8_SB
#undef PG8_STAGE
#undef PG8_LDA
#undef PG8_LDB
#undef PG8_MMA
#undef PG8_WAIT_V
#undef PG8_WAIT_L
#undef PG8_BAR
#undef PG8_SCHED
}
}

#define GAS __attribute__((address_space(1)))
#define LAS __attribute__((address_space(3)))
typedef unsigned short bf16;
typedef unsigned v4u __attribute__((ext_vector_type(4)));
typedef unsigned v2u __attribute__((ext_vector_type(2)));
typedef float f32x4 __attribute__((ext_vector_type(4)));
typedef GAS unsigned gu32;
#define RLX_AGENT __ATOMIC_RELAXED, __HIP_MEMORY_SCOPE_AGENT
#define LDS_WAIT() asm volatile("s_waitcnt lgkmcnt(0)" ::: "memory")
#define VM_WAIT() asm volatile("s_waitcnt vmcnt(0)" ::: "memory")
__device__ __forceinline__ unsigned f2bf(float f) { unsigned u = __builtin_bit_cast(unsigned, f); return (u + 0x7fffu + ((u >> 16) & 1u)) >> 16; }
__device__ __forceinline__ unsigned pk2(float lo, float hi) { return f2bf(lo) | (f2bf(hi) << 16); }
__device__ __forceinline__ float bf2f(unsigned short b) { return __builtin_bit_cast(float, (unsigned)b << 16); }
__device__ __forceinline__ float bflo(unsigned w) { return __builtin_bit_cast(float, w << 16); }
__device__ __forceinline__ float bfhi(unsigned w) { return __builtin_bit_cast(float, w & 0xffff0000u); }
__device__ __forceinline__ float sigmoidf_(float x) { return 1.f / (1.f + expf(-x)); }
__device__ __forceinline__ float fsig(float x) { return __builtin_amdgcn_rcpf(1.f + __builtin_amdgcn_exp2f(-1.4426950408889634f * x)); }
__device__ __forceinline__ float siluf_(float x) { return x / (1.f + expf(-x)); }
__device__ __forceinline__ float dppf(float x, const int sel) {
    const int xi = __builtin_bit_cast(int, x); int r;
    if (sel == 0) r = __builtin_amdgcn_update_dpp(xi, xi, 0xB1, 0xF, 0xF, false);
    else if (sel == 1) r = __builtin_amdgcn_update_dpp(xi, xi, 0x4E, 0xF, 0xF, false);
    else if (sel == 2) r = __builtin_amdgcn_update_dpp(xi, xi, 0x141, 0xF, 0xF, false);
    else if (sel == 3) r = __builtin_amdgcn_update_dpp(xi, xi, 0x140, 0xF, 0xF, false);
    else r = __builtin_amdgcn_update_dpp(xi, xi, 0x128, 0xF, 0xF, false);
    return __builtin_bit_cast(float, r);
}
__device__ __forceinline__ float swz16f(float x) { return __builtin_bit_cast(float, __builtin_amdgcn_ds_swizzle(__builtin_bit_cast(int, x), 0x401F)); }
__device__ __forceinline__ float xh_sum(float x) { auto rr = __builtin_amdgcn_permlane32_swap(__float_as_uint(x), __float_as_uint(x), false, false); return __uint_as_float(rr[0]) + __uint_as_float(rr[1]); }
__device__ __forceinline__ float xh_max(float x) { auto rr = __builtin_amdgcn_permlane32_swap(__float_as_uint(x), __float_as_uint(x), false, false); return fmaxf(__uint_as_float(rr[0]), __uint_as_float(rr[1])); }
__device__ __forceinline__ unsigned xh_or(unsigned x) { auto rr = __builtin_amdgcn_permlane32_swap(x, x, false, false); return rr[0] | rr[1]; }
__device__ __forceinline__ float wave_sum(float v) {
    v += dppf(v, 0); v += dppf(v, 1); v += dppf(v, 2); v += dppf(v, 3); v += swz16f(v); return xh_sum(v);
}
__device__ __forceinline__ float wave_max(float v) {
    v = fmaxf(v, dppf(v, 0)); v = fmaxf(v, dppf(v, 1)); v = fmaxf(v, dppf(v, 2)); v = fmaxf(v, dppf(v, 3)); v = fmaxf(v, swz16f(v)); return xh_max(v);
}

constexpr size_t MiB = 1u << 20;
constexpr size_t WS_CTL = 0, CTL_ZERO_BYTES = 1 * MiB;
constexpr size_t WS_COS = 1 * MiB, WS_SIN = 1 * MiB + 512 * 1024;
constexpr size_t WS_LB = 2 * MiB;
constexpr size_t WS_DBON = 3 * MiB;
constexpr size_t WS_DAB = 4 * MiB;
constexpr size_t WS_DSS = 12 * MiB;
constexpr size_t WS_W1T = 16 * MiB;
constexpr size_t WS_WGT = 26 * MiB;
constexpr size_t WS_WBT = 34 * MiB;
constexpr size_t WS_WOT = 36 * MiB;
constexpr size_t WS_KI = 38 * MiB;
constexpr size_t WS_H = 42 * MiB;
constexpr size_t WS_PL = 106 * MiB;
constexpr size_t PLANE = 16 * MiB;
constexpr size_t WS_BF = WS_PL + 17 * PLANE;
constexpr size_t WS_MISC = WS_BF + 32 * MiB;
constexpr size_t WS_OL = WS_MISC + 32 * MiB;
constexpr size_t WS_CC = WS_OL + 16 * MiB;
constexpr size_t WS_BS = WS_CC + 16 * MiB;
constexpr size_t WS_BG = WS_BS + 32 * MiB;
constexpr size_t WS_END = WS_BG + 1 * MiB;
constexpr size_t WS_Y = WS_PL;
constexpr size_t WS_PB = WS_PL + 4 * PLANE;
static_assert(WS_PB + (size_t)4 * NTOK * 1024 * 2 <= WS_OL, "P_b overlay");
enum { PL_AQ = 0, PL_BQ = 1, PL_CQ = 2, PL_DR = 3, PL_AK = 4, PL_AV = 5, PL_AZ = 6, PL_BI = 7, PL_BZ = 8, PL_CK = 9, PL_CV = 10, PL_CZ = 11, PL_CQI0 = 12, PL_CQI1 = 13, PL_DK = 14, PL_DV = 15, PL_DZ = 16 };
#define PLP(ws, i) ((bf16*)((ws) + WS_PL + (size_t)(i) * PLANE))
constexpr int CW_BAR = 4096;

constexpr int RING_BYTES = 131072;
constexpr int LDSCTL_OFF = RING_BYTES, MISC_OFF = LDSCTL_OFF + 320;
constexpr int LDS_BYTES = 147456;

__device__ __forceinline__ int rope_j(int head, int dim) {
    const int bj = head >> 1, wc = ((head & 1) << 1) | ((dim >> 4) & 1), n = dim >> 5, fq = (dim >> 2) & 3, i = dim & 3;
    return 128 * bj + 32 * wc + 16 * n + 4 * fq + i;
}
__device__ __forceinline__ int win_dst_row(int c, int& which) {
    which = 0;
    if (c < 2048) return c;
    if (c < 2304) { const int l = c - 2048; return 8 * 256 + rope_j(l >> 6, l & 63); }
    if (c < 2560) { const int l = c - 2304; return 9 * 256 + rope_j(l >> 6, l & 63); }
    if (c < 3072) return c;
    if (c < 3584) { const int l = c - 3072; return (12 + (l >> 8)) * 256 + rope_j((l >> 6) & 3, l & 63); }
    if (c < 3648) return 14 * 256 + rope_j(0, c - 3584);
    if (c < 3656) return 14 * 256 + 64 + (c - 3648);
    if (c < 3912) return 15 * 256 + (c - 3656);
    if (c < 4168) return 16 * 256 + (c - 3912);
    if (c < 4424) return 17 * 256 + (c - 4168);
    if (c < 4488) return 14 * 256 + 72 + (c - 4424);
    if (c < 4552) return 14 * 256 + 136 + (c - 4488);
    if (c < 4808) return 18 * 256 + (c - 4552);
    which = 1;
    { const int g = c - 4808, br = g >> 10, y = g & 1023, pn = y >> 6, wc = (y >> 4) & 3, fq = (y >> 2) & 3, i = y & 3;
      return 256 * pn + 128 * (br >> 1) + 32 * wc + 16 * (br & 1) + 4 * fq + i; }
}

struct EpiG1 {
    static constexpr bool PERM = false, AFTER_DRAIN = false;
    unsigned char* ws; const float* lbl;
    __device__ __forceinline__ void operator()(const f32x4 (&acc)[2][2][4][2], const pg8::Unit& u, int wr, int wc, int fr, int fq) const {
        asm volatile("" : "+v"(fr), "+v"(fq));
        const int pn = u.pn;
        const int rbase = u.pm * 256 + wr * 64 + fr;
        const int cq = wc * 32 + 4 * fq;
        if (pn == 5) {
            float* BF = (float*)(ws + WS_BF);
#pragma unroll
            for (int bj = 0; bj < 2; ++bj)
#pragma unroll
                for (int n = 0; n < 2; ++n) {
                    const int col = cq + bj * 128 + n * 16;
                    const f32x4 l4 = *(const f32x4*)(lbl + col);
#pragma unroll
                    for (int ai = 0; ai < 2; ++ai)
#pragma unroll
                        for (int m = 0; m < 4; ++m) {
                            const f32x4 x = acc[ai][bj][m][n]; f32x4 o;
#pragma unroll
                            for (int i = 0; i < 4; ++i) o[i] = 1.f - (1.f - l4[i]) * fsig(-x[i]);
                            *(f32x4*)(BF + (size_t)(rbase + ai * 128 + m * 16) * 256 + col) = o;
                            asm volatile("" ::: "memory");
                        }
                }
        } else if (pn == 14) {
            float* MS = (float*)(ws + WS_MISC);
            const float* tcos = (const float*)(ws + WS_COS); const float* tsin = (const float*)(ws + WS_SIN);
#pragma unroll
            for (int bj = 0; bj < 2; ++bj) {
                if (bj == 0 && wc < 2) {
                    const int d0 = 16 * (wc & 1) + 4 * fq;
#pragma unroll
                    for (int ai = 0; ai < 2; ++ai)
#pragma unroll
                        for (int m = 0; m < 4; ++m) {
                            const int row = rbase + ai * 128 + m * 16, pos = row & (SEQ - 1);
                            const f32x4 c4 = *(const f32x4*)(tcos + pos * 32 + d0), s4 = *(const f32x4*)(tsin + pos * 32 + d0);
                            const f32x4 x1 = acc[ai][0][m][0], x2 = acc[ai][0][m][1];
                            const f32x4 y1 = x1 * c4 - x2 * s4, y2 = x2 * c4 + x1 * s4;
                            *(f32x4*)(MS + (size_t)row * 256 + d0) = y1;
                            *(f32x4*)(MS + (size_t)row * 256 + 32 + d0) = y2;
                            bf16* KIp = (bf16*)(ws + WS_KI) + (size_t)row * 64;
                            v2u w1, w2; w1.x = pk2(y1[0], y1[1]); w1.y = pk2(y1[2], y1[3]); w2.x = pk2(y2[0], y2[1]); w2.y = pk2(y2[2], y2[3]);
                            *(v2u*)(KIp + d0) = w1; *(v2u*)(KIp + 32 + d0) = w2;
                            asm volatile("" ::: "memory");
                        }
                } else {
#pragma unroll
                    for (int n = 0; n < 2; ++n)
#pragma unroll
                        for (int ai = 0; ai < 2; ++ai)
#pragma unroll
                            for (int m = 0; m < 4; ++m)
                                *(f32x4*)(MS + (size_t)(rbase + ai * 128 + m * 16) * 256 + cq + bj * 128 + n * 16) = acc[ai][bj][m][n];
                }
            }
        } else {
            const unsigned long long lo = 0ull | (0ull << 0) | (4ull << 5) | (5ull << 10) | (6ull << 15) | (1ull << 20) | (0ull << 25) | (7ull << 30) | (8ull << 35) | (2ull << 40) | (9ull << 45) | (10ull << 50) | (11ull << 55);
            const unsigned long long hi = (12ull << 0) | (13ull << 5) | (0ull << 10) | (3ull << 15) | (14ull << 20) | (15ull << 25) | (16ull << 30);
            const int plane = (int)((pn < 12 ? (lo >> (5 * pn)) : (hi >> (5 * (pn - 12)))) & 31ull);
            bf16* PLN = PLP(ws, plane);
            if (pn == 8 || pn == 9 || pn == 12 || pn == 13) {
                const float* tcos = (const float*)(ws + WS_COS); const float* tsin = (const float*)(ws + WS_SIN);
                const int d0 = 16 * (wc & 1) + 4 * fq;
#pragma unroll
                for (int ai = 0; ai < 2; ++ai)
#pragma unroll
                    for (int m = 0; m < 4; ++m) {
                        const int row = rbase + ai * 128 + m * 16, pos = row & (SEQ - 1);
                        const f32x4 c4 = *(const f32x4*)(tcos + pos * 32 + d0), s4 = *(const f32x4*)(tsin + pos * 32 + d0);
#pragma unroll
                        for (int bj = 0; bj < 2; ++bj) {
                            const int head = 2 * bj + (wc >> 1);
                            const f32x4 x1 = acc[ai][bj][m][0], x2 = acc[ai][bj][m][1];
                            const f32x4 y1 = x1 * c4 - x2 * s4, y2 = x2 * c4 + x1 * s4;
                            v2u w1, w2; w1.x = pk2(y1[0], y1[1]); w1.y = pk2(y1[2], y1[3]); w2.x = pk2(y2[0], y2[1]); w2.y = pk2(y2[2], y2[3]);
                            *(v2u*)(PLN + (size_t)row * 256 + head * 64 + d0) = w1;
                            *(v2u*)(PLN + (size_t)row * 256 + head * 64 + 32 + d0) = w2;
                        }
                        asm volatile("" ::: "memory");
                    }
            } else if (pn == 2 || pn == 10) {
#pragma unroll
                for (int ai = 0; ai < 2; ++ai)
#pragma unroll
                    for (int m = 0; m < 4; ++m) {
                        const int row = rbase + ai * 128 + m * 16, bb = row >> 12, tq = row & (SEQ - 1);
#pragma unroll
                        for (int bj = 0; bj < 2; ++bj)
#pragma unroll
                            for (int n = 0; n < 2; ++n) {
                                const f32x4 x = acc[ai][bj][m][n]; const int col = cq + bj * 128 + n * 16;
                                bf16* p = PLN + ((size_t)(bb * 256 + col) << 12) + tq;
#pragma unroll
                                for (int i = 0; i < 4; ++i) { *p = (bf16)f2bf(x[i]); p += 4096; asm volatile("" : "+v"(p)); }
                            }
                        asm volatile("" ::: "memory");
                    }
            } else if (pn == 4) {
#pragma unroll
                for (int ai = 0; ai < 2; ++ai)
#pragma unroll
                    for (int m = 0; m < 4; ++m) {
                        bf16* rowp = PLN + (size_t)(rbase + ai * 128 + m * 16) * 256 + cq;
#pragma unroll
                        for (int bj = 0; bj < 2; ++bj)
#pragma unroll
                            for (int n = 0; n < 2; ++n) {
                                f32x4 x = acc[ai][bj][m][n];
#pragma unroll
                                for (int i = 0; i < 4; ++i) x[i] = x[i] * fsig(x[i]);
                                v2u w; w.x = pk2(x[0], x[1]); w.y = pk2(x[2], x[3]);
                                *(v2u*)(rowp + bj * 128 + n * 16) = w;
                            }
                        asm volatile("" ::: "memory");
                    }
            } else {
#pragma unroll
                for (int ai = 0; ai < 2; ++ai)
#pragma unroll
                    for (int m = 0; m < 4; ++m) {
                        bf16* rowp = PLN + (size_t)(rbase + ai * 128 + m * 16) * 256 + cq;
#pragma unroll
                        for (int bj = 0; bj < 2; ++bj)
#pragma unroll
                            for (int n = 0; n < 2; ++n) {
                                const f32x4 x = acc[ai][bj][m][n];
                                v2u w; w.x = pk2(x[0], x[1]); w.y = pk2(x[2], x[3]);
                                *(v2u*)(rowp + bj * 128 + n * 16) = w;
                            }
                        asm volatile("" ::: "memory");
                    }
            }
        }
    }
};
struct EpiBf {
    static constexpr bool PERM = false, AFTER_DRAIN = false;
    bf16* O; int ldc;
    __device__ __forceinline__ void operator()(const f32x4 (&acc)[2][2][4][2], const pg8::Unit& u, int wr, int wc, int fr, int fq) const {
        asm volatile("" : "+v"(fr), "+v"(fq));
        const int rbase = u.pm * 256 + wr * 64 + fr, cb = u.pn * 256 + wc * 32 + 4 * fq;
#pragma unroll
        for (int ai = 0; ai < 2; ++ai)
#pragma unroll
            for (int m = 0; m < 4; ++m) {
                bf16* rowp = O + (size_t)(rbase + ai * 128 + m * 16) * ldc + cb;
#pragma unroll
                for (int bj = 0; bj < 2; ++bj)
#pragma unroll
                    for (int n = 0; n < 2; ++n) { const f32x4 x = acc[ai][bj][m][n]; v2u w; w.x = pk2(x[0], x[1]); w.y = pk2(x[2], x[3]); *(v2u*)(rowp + bj * 128 + n * 16) = w; }
            }
    }
};
struct EpiGate {
    static constexpr bool PERM = false, AFTER_DRAIN = false;
    const bf16* PB; bf16* Y;
    __device__ __forceinline__ void operator()(const f32x4 (&acc)[2][2][4][2], const pg8::Unit& u, int wr, int wc, int fr, int fq) const {
        asm volatile("" : "+v"(fr), "+v"(fq));
        const int rbase = u.pm * 256 + wr * 64 + fr, yc = u.pn * 64 + wc * 16 + 4 * fq;
#pragma unroll
        for (int ai = 0; ai < 2; ++ai)
#pragma unroll
            for (int m = 0; m < 4; ++m) {
                const size_t row = (size_t)(rbase + ai * 128 + m * 16);
                f32x4 y = (f32x4){0.f, 0.f, 0.f, 0.f};
#pragma unroll
                for (int br = 0; br < 4; ++br) {
                    const v2u pw = *(const v2u*)(PB + ((size_t)br * NTOK + row) * 1024 + yc);
                    const f32x4 g = acc[ai][br >> 1][m][br & 1];
                    y[0] += bflo(pw.x) * fsig(g[0]); y[1] += bfhi(pw.x) * fsig(g[1]);
                    y[2] += bflo(pw.y) * fsig(g[2]); y[3] += bfhi(pw.y) * fsig(g[3]);
                }
                v2u w; w.x = pk2(y[0], y[1]); w.y = pk2(y[2], y[3]);
                *(v2u*)(Y + row * 1024 + yc) = w;
                asm volatile("" ::: "memory");
            }
    }
};
struct EpiRes {
    static constexpr bool PERM = false, AFTER_DRAIN = false;
    const float* R; float* O;
    __device__ __forceinline__ void operator()(const f32x4 (&acc)[2][2][4][2], const pg8::Unit& u, int wr, int wc, int fr, int fq) const {
        asm volatile("" : "+v"(fr), "+v"(fq));
        const int rbase = u.pm * 256 + wr * 64 + fr, cb = u.pn * 256 + wc * 32 + 4 * fq;
#pragma unroll
        for (int ai = 0; ai < 2; ++ai)
#pragma unroll
            for (int m = 0; m < 4; ++m) {
                const size_t off = (size_t)(rbase + ai * 128 + m * 16) * 1024 + cb;
#pragma unroll
                for (int bj = 0; bj < 2; ++bj)
#pragma unroll
                    for (int n = 0; n < 2; ++n) { const f32x4 r = *(const f32x4*)(R + off + bj * 128 + n * 16); *(f32x4*)(O + off + bj * 128 + n * 16) = r + acc[ai][bj][m][n]; }
            }
    }
};
#define XB_TMO      128
#define XB_XCNT(j)  (256  + 64 * (j))
#define XB_XSUB(j)  (1280 + 64 * (j))
#define XB_XGEN(j)  (2304 + 64 * (j))
#define XB_TOP      3328
#define XB_TOPGEN   3392
#define XCD_BAR_WORDS 3456
#define XB_SPIN_CAP (1u << 18)

__device__ __forceinline__ unsigned xb_ld(unsigned* p)              { return __hip_atomic_load(p, __ATOMIC_RELAXED, __HIP_MEMORY_SCOPE_AGENT); }
__device__ __forceinline__ unsigned xb_add(unsigned* p, unsigned v) { return __hip_atomic_fetch_add(p, v, __ATOMIC_RELAXED, __HIP_MEMORY_SCOPE_AGENT); }
__device__ __forceinline__ unsigned xb_xcc_id() { return (unsigned)__builtin_amdgcn_s_getreg((3 << 11) | 20) & 0xFu; }
#define XB_SPIN(cond, bar) do { unsigned _sp = 0; while (cond) { __builtin_amdgcn_s_sleep(1); \
    if ((++_sp & 255u) == 0u) { if (xb_ld(&(bar)[XB_TMO])) break; if (_sp > XB_SPIN_CAP) { atomicAdd(&(bar)[XB_TMO], 1u); break; } } } } while (0)

struct XcdBarrier {
    unsigned* bar; unsigned x;
    volatile LAS unsigned* st;
};

__device__ __forceinline__ XcdBarrier xcd_barrier_post(unsigned* bar, volatile LAS unsigned* st) {
    XcdBarrier b; b.bar = bar; b.x = xb_xcc_id(); b.st = st;
    if (threadIdx.x == 0) (void)xb_add(&bar[XB_XCNT(b.x)], 1u);
    return b;
}
__device__ __forceinline__ void xcd_barrier_complete(unsigned* bar, unsigned x, unsigned& nloc, unsigned& nx) {
    const unsigned G = gridDim.x * gridDim.y * gridDim.z;
    unsigned sum, cnt, mine, sp = 0u;
    for (;;) {
        sum = 0u; cnt = 0u; mine = 0u;
#pragma unroll
        for (unsigned j = 0; j < 16; ++j) { const unsigned c = xb_ld(&bar[XB_XCNT(j)]); sum += c; cnt += (c > 0u) ? 1u : 0u; mine = (j == x) ? c : mine; }
        if (sum == G) break;
        __builtin_amdgcn_s_sleep(1);
        if ((++sp & 255u) == 0u) { if (xb_ld(&bar[XB_TMO])) break; if (sp > XB_SPIN_CAP) { atomicAdd(&bar[XB_TMO], 1u); break; } }
    }
    nloc = mine > 0u ? mine : 1u; nx = cnt > 0u ? cnt : 1u;
}

__device__ __forceinline__ void xcd_barrier(const XcdBarrier& b_in, const bool t0) {
    XcdBarrier b = b_in; asm volatile("" : "+s"(b.bar), "+s"(b.x));
    asm volatile("s_waitcnt vmcnt(0)" ::: "memory");
    __syncthreads();
    if (t0) {
        unsigned* bar = b.bar;
        __builtin_amdgcn_s_waitcnt(0);
        unsigned nloc = b.st[0], nx = b.st[1];
        if (nloc == 0u) { xcd_barrier_complete(bar, b.x, nloc, nx); b.st[0] = nloc; b.st[1] = nx; }
        const unsigned old = xb_add(&bar[XB_XSUB(b.x)], 1u);
        const unsigned gen = old / nloc;
        if (old + 1u == (gen + 1u) * nloc) {
            __builtin_amdgcn_fence(__ATOMIC_RELEASE, "agent");
            asm volatile("s_waitcnt vmcnt(0)" ::: "memory");
            const unsigned og = xb_add(&bar[XB_TOP], 1u);
            const unsigned tg = og / nx;
            if (og + 1u == (tg + 1u) * nx) xb_add(&bar[XB_TOPGEN], 1u);
            else XB_SPIN(xb_ld(&bar[XB_TOPGEN]) == tg, bar);
            __builtin_amdgcn_fence(__ATOMIC_ACQUIRE, "agent");
            xb_add(&bar[XB_XGEN(b.x)], 1u);
            asm volatile("s_waitcnt vmcnt(0)" ::: "memory");
        } else {
            XB_SPIN(xb_ld(&bar[XB_XGEN(b.x)]) == gen, bar);
            __builtin_amdgcn_fence(__ATOMIC_ACQUIRE, "agent");
            asm volatile("s_waitcnt vmcnt(0)" ::: "memory");
        }
    }
    __syncthreads();
}

struct Params { const float* in[19]; float* out; unsigned char* ws; };
struct Ctx {
    LAS unsigned char* lds; int tid, lane, wave, G, bid;
};
__device__ __forceinline__ int lane_id_fresh() { int l; asm volatile("v_mbcnt_lo_u32_b32 %0, -1, 0\n\tv_mbcnt_hi_u32_b32 %0, -1, %0" : "=v"(l)); return l; }
#define OPQ(C) do { (C).lane = lane_id_fresh(); (C).tid = (C).wave * 64 + (C).lane; } while (0)

template <class MapFn>
__device__ __forceinline__ void transpose_item(const float* W, int K, int N, LAS float* scr, int item, int lane, MapFn map) {
    const int nblk = (N + 31) / 32, kb = item / nblk, nb = item % nblk, k0 = 64 * kb, n0 = 32 * nb;
    const int ncol = n0 + (lane & 31);
#pragma unroll 8
    for (int i = 0; i < 32; ++i) { const int kk = 2 * i + (lane >> 5); scr[kk * 33 + (lane & 31)] = (ncol < N) ? W[(size_t)(k0 + kk) * N + ncol] : 0.f; }
    LDS_WAIT(); asm volatile("" ::: "memory");
    const int c = lane & 7;
#pragma unroll
    for (int j = 0; j < 4; ++j) {
        const int n = (lane >> 3) + 8 * j; const LAS float* s = scr + (8 * c) * 33 + n;
        v4u o; o.x = pk2(s[0 * 33], s[1 * 33]); o.y = pk2(s[2 * 33], s[3 * 33]); o.z = pk2(s[4 * 33], s[5 * 33]); o.w = pk2(s[6 * 33], s[7 * 33]);
        if (n0 + n < N) { bf16* dst = map(n0 + n); *(v4u*)(dst + k0 + 8 * c) = o; }
    }
    LDS_WAIT(); asm volatile("" ::: "memory");
}
__device__ __forceinline__ void convert_weights(Ctx C, const Params& P, int l) {
    OPQ(C);
    LAS float* scr = (LAS float*)(C.lds + C.wave * 16384);
    const int gw = C.bid * 8 + C.wave, NGW = C.G * 8;
    unsigned char* ws = P.ws;
    bf16* W1t = (bf16*)(ws + WS_W1T); bf16* Wgt = (bf16*)(ws + WS_WGT);
    bf16* Wbt = (bf16*)(ws + WS_WBT); bf16* Wot = (bf16*)(ws + WS_WOT);
    const float* w_in = P.in[2] + (size_t)l * 1024 * INC; const float* w_br = P.in[16] + (size_t)l * 4 * 256 * 1024; const float* w_out = P.in[17] + (size_t)l * 1024 * 1024;
    constexpr int I_IN = 16 * ((INC + 31) / 32), I_BR = 4 * 32, I_OUT = 16 * 32;
    constexpr int NITEMS = I_IN + 4 * I_BR + I_OUT;
    for (int it = gw; it < NITEMS; it += NGW) {
        int r = it;
        if (r < I_IN) { transpose_item(w_in, 1024, INC, scr, r, C.lane, [&](int c) -> bf16* { int which; const int row = win_dst_row(c, which); return (which ? Wgt : W1t) + (size_t)row * 1024; }); continue; }
        r -= I_IN;
        if (r < 4 * I_BR) { const int br = r / I_BR, ri = r % I_BR; transpose_item(w_br + (size_t)br * 256 * 1024, 256, 1024, scr, ri, C.lane, [&](int c) -> bf16* { return Wbt + ((size_t)br * 1024 + c) * 256; }); continue; }
        r -= 4 * I_BR;
        transpose_item(w_out, 1024, 1024, scr, r, C.lane, [&](int c) -> bf16* { return Wot + (size_t)c * 1024; });
    }
    for (int i = C.bid * 512 + C.tid; i < 56 * 1024 / 8; i += C.G * 512) *(v4u*)(W1t + (size_t)(14 * 256 + 200) * 1024 + (size_t)i * 8) = (v4u){0u, 0u, 0u, 0u};
}
__device__ __forceinline__ void rms_row(const float* xrow, const float* g, bf16* obf, float* of32, int lane) {
    const f32x4* xr = (const f32x4*)xrow + lane;
    f32x4 v[4]; float s = 0.f;
#pragma unroll
    for (int j = 0; j < 4; ++j) { v[j] = xr[64 * j]; s += (v[j].x * v[j].x + v[j].y * v[j].y) + (v[j].z * v[j].z + v[j].w * v[j].w); }
    const float inv = rsqrtf(wave_sum(s) * (1.f / 1024.f) + 1e-6f);
#pragma unroll
    for (int j = 0; j < 4; ++j) {
        const f32x4 gg = ((const f32x4*)g)[lane + 64 * j];
        const f32x4 o = v[j] * inv * gg;
        if (obf) { v2u w; w.x = pk2(o.x, o.y); w.y = pk2(o.z, o.w); ((v2u*)obf)[lane + 64 * j] = w; }
        else ((f32x4*)of32)[lane + 64 * j] = o;
    }
}
__device__ __forceinline__ void norm_rows_bf16(Ctx C, const float* x, const float* g, bf16* h) {
    OPQ(C);
    const int gw = C.bid * 8 + C.wave, NGW = C.G * 8;
    for (int m = gw; m < NTOK; m += NGW) rms_row(x + (size_t)m * 1024, g, h + (size_t)m * 1024, nullptr, C.lane);
}
__device__ __forceinline__ void setup_tables(Ctx C, const Params& P) {
    OPQ(C);
    float* tcos = (float*)(P.ws + WS_COS); float* tsin = (float*)(P.ws + WS_SIN); float* lb = (float*)(P.ws + WS_LB);
    for (int i = C.bid * 512 + C.tid; i < SEQ * 32; i += C.G * 512) {
        const int pos = i >> 5, j = i & 31;
        const float freq = (float)pow(10000.0, -(double)j / 32.0);
        const float ang = (float)pos * freq;
        tcos[i] = (float)cos((double)ang); tsin[i] = (float)sin((double)ang);
    }
    if (C.bid == 0 && C.tid < 256) {
        const float l0 = P.in[4][C.tid], l1 = P.in[4][256 + C.tid];
        lb[C.tid] = 0.f; lb[256 + C.tid] = 1.f / (1.f + expf(l0 - l1));
    }
}

__device__ __forceinline__ void mixA_simple(Ctx C, unsigned char* ws, const float* bias) {
    OPQ(C);
    bf16* AQ = PLP(ws, PL_AQ); const bf16* AK = PLP(ws, PL_AK); const bf16* AV = PLP(ws, PL_AV); const bf16* AZ = PLP(ws, PL_AZ);
    for (int it = C.bid * 512 + C.tid; it < 4 * NTOK; it += C.G * 512) {
        const int h = it / NTOK, m = it % NTOK, b = m >> 12, t = m & 4095, c = t >> 6, qi = t & 63;
        float q[64], o[64];
        {
            const v4u* qp = (const v4u*)(AQ + (size_t)m * 256 + h * 64);
#pragma unroll
            for (int j = 0; j < 8; ++j) { const v4u w = qp[j]; q[8 * j] = bflo(w.x); q[8 * j + 1] = bfhi(w.x); q[8 * j + 2] = bflo(w.y); q[8 * j + 3] = bfhi(w.y); q[8 * j + 4] = bflo(w.z); q[8 * j + 5] = bfhi(w.z); q[8 * j + 6] = bflo(w.w); q[8 * j + 7] = bfhi(w.w); }
        }
#pragma unroll
        for (int d = 0; d < 64; ++d) o[d] = 0.f;
        float mx = -INFINITY, l = 0.f;
        const float* bh = bias + h * 192;
        for (int kj = 0; kj < 576; ++kj) {
            const int kp = c * 64 - 512 + kj;
            if (kp < 0) continue;
            const size_t mk = ((size_t)b << 12) + kp;
            const v4u* kr = (const v4u*)(AK + mk * 256 + h * 64); const v4u* vr = (const v4u*)(AV + mk * 256 + h * 64);
            float s = 0.f;
#pragma unroll
            for (int j = 0; j < 8; ++j) { const v4u w = kr[j];
                s = fmaf(q[8 * j], bflo(w.x), s); s = fmaf(q[8 * j + 1], bfhi(w.x), s); s = fmaf(q[8 * j + 2], bflo(w.y), s); s = fmaf(q[8 * j + 3], bfhi(w.y), s);
                s = fmaf(q[8 * j + 4], bflo(w.z), s); s = fmaf(q[8 * j + 5], bfhi(w.z), s); s = fmaf(q[8 * j + 6], bflo(w.w), s); s = fmaf(q[8 * j + 7], bfhi(w.w), s); }
            int rel = qi + 512 - kj; rel = rel < -63 ? -63 : (rel > 128 ? 128 : rel);
            s = s * 0.125f + bh[rel + 63];
            const float mn = fmaxf(mx, s), al = expf(mx - mn), pe = expf(s - mn);
            l = l * al + pe; mx = mn;
#pragma unroll
            for (int j = 0; j < 8; ++j) { const v4u w = vr[j];
                o[8 * j] = fmaf(pe, bflo(w.x), o[8 * j] * al); o[8 * j + 1] = fmaf(pe, bfhi(w.x), o[8 * j + 1] * al); o[8 * j + 2] = fmaf(pe, bflo(w.y), o[8 * j + 2] * al); o[8 * j + 3] = fmaf(pe, bfhi(w.y), o[8 * j + 3] * al);
                o[8 * j + 4] = fmaf(pe, bflo(w.z), o[8 * j + 4] * al); o[8 * j + 5] = fmaf(pe, bfhi(w.z), o[8 * j + 5] * al); o[8 * j + 6] = fmaf(pe, bflo(w.w), o[8 * j + 6] * al); o[8 * j + 7] = fmaf(pe, bfhi(w.w), o[8 * j + 7] * al); }
        }
        const float invl = 1.f / l;
        const v4u* zp = (const v4u*)(AZ + (size_t)m * 256 + h * 64); v4u* op = (v4u*)(AQ + (size_t)m * 256 + h * 64);
#pragma unroll
        for (int j = 0; j < 8; ++j) { const v4u z = zp[j]; v4u w;
            w.x = pk2(o[8 * j] * invl * siluf_(bflo(z.x)), o[8 * j + 1] * invl * siluf_(bfhi(z.x))); w.y = pk2(o[8 * j + 2] * invl * siluf_(bflo(z.y)), o[8 * j + 3] * invl * siluf_(bfhi(z.y)));
            w.z = pk2(o[8 * j + 4] * invl * siluf_(bflo(z.z)), o[8 * j + 5] * invl * siluf_(bfhi(z.z))); w.w = pk2(o[8 * j + 6] * invl * siluf_(bflo(z.w)), o[8 * j + 7] * invl * siluf_(bfhi(z.w)));
            op[j] = w; }
    }
}
__device__ __forceinline__ void mixB_simple(Ctx C, unsigned char* ws, const float* normg) {
    OPQ(C);
    if (C.bid < 32 || C.bid >= 36) return;
    const int gw = (C.bid - 32) * 8 + C.wave;
    const int b = gw >> 2, h = gw & 3, v = C.lane;
    bf16* BQ = PLP(ws, PL_BQ); const bf16* BI = PLP(ws, PL_BI); const bf16* BZ = PLP(ws, PL_BZ); const float* BF = (const float*)(ws + WS_BF);
    float S[64];
#pragma unroll
    for (int d = 0; d < 64; ++d) S[d] = 0.f;
    const float g = normg[v];
    for (int t = 0; t < SEQ; ++t) {
        const size_t m = ((size_t)b << 12) + t;
        const float* fr = BF + m * 256 + h * 64; const bf16* qr = BQ + m * 256 + h * 64;
        const float iv = bf2f(BI[m * 256 + h * 64 + v]); const float z = bf2f(BZ[m * 256 + h * 64 + v]);
        float o = 0.f;
#pragma unroll
        for (int d = 0; d < 64; ++d) { S[d] = fmaf(fr[d], S[d] - iv, iv); o = fmaf(bf2f(qr[d]), S[d], o); }
        const float r = rsqrtf(wave_sum(o * o) * (1.f / 64.f) + 1e-6f);
        asm volatile("" ::: "memory");
        BQ[m * 256 + h * 64 + v] = (bf16)f2bf(o * r * g * siluf_(z));
    }
}
__device__ __forceinline__ void mixD_simple(Ctx C, unsigned char* ws, const Params& P, int l) {
    OPQ(C);
    if (C.bid >= 32) return;
    const int b = C.bid >> 2, h = C.bid & 3, tid = C.tid;
    bf16* DR = PLP(ws, PL_DR); const bf16* DK = PLP(ws, PL_DK); const bf16* DV = PLP(ws, PL_DV); const bf16* DZ = PLP(ws, PL_DZ); const float* MS = (const float*)(ws + WS_MISC);
    const float* mu = P.in[6] + l * 896; const float* w0 = P.in[7] + l * 256; const float* w_up = P.in[8] + (size_t)l * 64 * 256; const float* a0 = P.in[9] + l * 256;
    const float* a_up = P.in[10] + (size_t)l * 64 * 256; const float* k_k = P.in[11] + l * 256; const float* k_a = P.in[12] + l * 256; const float* r_k = P.in[13] + l * 256;
    const float* gn_g = P.in[14] + l * 256; const float* gn_b = P.in[15] + l * 256;
    LAS float* L = (LAS float*)C.lds;
    LAS float* twd = L; LAS float* ads = L + 64; LAS float* rs = L + 128; LAS float* kr = L + 192; LAS float* vs = L + 256;
    LAS float* wv = L + 320; LAS float* av = L + 384; LAS float* kkv = L + 448; LAS float* kfv = L + 512; LAS float* bv = L + 576; LAS float* ob = L + 640; LAS float* bon = L + 704;
    const int v = tid >> 3, ks = tid & 7;
    float S[8];
#pragma unroll
    for (int i = 0; i < 8; ++i) S[i] = 0.f;
    const int grp = tid >> 6, cc = tid & 63;
    float prev = 0.f, mucol = 0.f;
    if (grp == 0) mucol = mu[768 + cc]; else if (grp == 1) mucol = mu[832 + cc]; else if (grp == 2) mucol = mu[h * 64 + cc]; else if (grp == 3) mucol = mu[256 + h * 64 + cc]; else if (grp == 4) mucol = mu[512 + h * 64 + cc];
    for (int t = 0; t < SEQ; ++t) {
        const size_t m = ((size_t)b << 12) + t;
        if (grp < 5) {
            float cur;
            if (grp == 0) cur = MS[m * 256 + 72 + cc]; else if (grp == 1) cur = MS[m * 256 + 136 + cc];
            else if (grp == 2) cur = bf2f(DR[m * 256 + h * 64 + cc]); else if (grp == 3) cur = bf2f(DK[m * 256 + h * 64 + cc]); else cur = bf2f(DV[m * 256 + h * 64 + cc]);
            const float sh = cur + mucol * (prev - cur); prev = cur;
            if (grp == 0) twd[cc] = tanhf(sh); else if (grp == 1) ads[cc] = sh; else if (grp == 2) rs[cc] = sh; else if (grp == 3) kr[cc] = sh; else vs[cc] = sh;
        }
        __syncthreads();
        if (tid < 128) {
            const int c = tid & 63, hc = h * 64 + c;
            if (tid < 64) { float wl = w0[hc];
_Pragma("nounroll")
                for (int i = 0; i < 64; ++i) wl = fmaf(twd[i], w_up[i * 256 + hc], wl);
                const float x = -wl; const float sp = fmaxf(x, 0.f) + log1pf(expf(-fabsf(x))); wv[c] = expf(-expf(-sp - 0.5f)); }
            else { float al = a0[hc];
_Pragma("nounroll")
                for (int i = 0; i < 64; ++i) al = fmaf(ads[i], a_up[i * 256 + hc], al); av[c] = sigmoidf_(al); }
        }
        __syncthreads();
        if (tid < 64) {
            const int hc = h * 64 + tid; const float kx = kr[tid], a = av[tid];
            const float kkr = kx * k_k[hc]; const float nrm = sqrtf(wave_sum(kkr * kkr)); const float kk = kkr / fmaxf(nrm, 1e-12f);
            const float kf = kx * (1.f + (a - 1.f) * k_a[hc]);
            kkv[tid] = kk; kfv[tid] = kf; bv[tid] = kk * a;
            const float bsum = wave_sum(rs[tid] * kf * r_k[hc]); if (tid == 0) bon[0] = bsum;
        }
        __syncthreads();
        {
            float sa = 0.f;
#pragma unroll
            for (int i = 0; i < 8; ++i) sa = fmaf(S[i], kkv[8 * ks + i], sa);
            sa += __shfl_xor(sa, 1); sa += __shfl_xor(sa, 2); sa += __shfl_xor(sa, 4); sa = -sa;
            const float vv = vs[v]; float o = 0.f;
#pragma unroll
            for (int i = 0; i < 8; ++i) { S[i] = fmaf(S[i], wv[8 * ks + i], fmaf(sa, bv[8 * ks + i], vv * kfv[8 * ks + i])); o = fmaf(S[i], rs[8 * ks + i], o); }
            o += __shfl_xor(o, 1); o += __shfl_xor(o, 2); o += __shfl_xor(o, 4);
            if (ks == 0) ob[v] = o;
        }
        __syncthreads();
        if (tid < 64) {
            const int hc = h * 64 + tid; const float o = ob[tid];
            const float mean = wave_sum(o) * (1.f / 64.f); const float d = o - mean; const float var = wave_sum(d * d) * (1.f / 64.f);
            float y = d * rsqrtf(var + 64e-5f) * gn_g[hc] + gn_b[hc];
            y += bon[0] * vs[tid];
            const float z = bf2f(DZ[m * 256 + hc]);
            DR[m * 256 + hc] = (bf16)f2bf(y * siluf_(z));
        }
        __syncthreads();
    }
}
__device__ __forceinline__ void mixC_simple(Ctx C, unsigned char* ws) {
    OPQ(C);
    bf16* CQ = PLP(ws, PL_CQ); const bf16* CK = PLP(ws, PL_CK); const bf16* CV = PLP(ws, PL_CV); const bf16* CZ = PLP(ws, PL_CZ);
    const bf16* QI0 = PLP(ws, PL_CQI0); const bf16* QI1 = PLP(ws, PL_CQI1); const float* MS = (const float*)(ws + WS_MISC);
    LAS float* L = (LAS float*)C.lds;
    LAS float* qs = L;
    LAS float* q4 = L + 512;
    LAS float* wq = L + 768;
    LAS float* sc = L + 1024;
    LAS float* ps = L + 5120;
    LAS int* sel = (LAS int*)(L + 6144);
    LAS unsigned* hist = (LAS unsigned*)(L + 6400);
    LAS float* red = L + 6656;
    LAS unsigned* sw = (LAS unsigned*)(L + 6672);
    const int tid = C.tid;
    for (int m = C.bid; m < NTOK; m += C.G) {
        const int b = m >> 12, t = m & 4095, n = ((t >> 6) + 1) * 64;
        qs[tid] = bf2f(tid < 256 ? QI0[(size_t)m * 256 + tid] : QI1[(size_t)m * 256 + tid - 256]);
        if (tid < 256) q4[tid] = bf2f(CQ[(size_t)m * 256 + tid]);
        if (tid < 8) wq[tid] = MS[(size_t)m * 256 + 64 + tid] * 0.35355339059327373f;
        __syncthreads();
        for (int s = tid; s < n; s += 512) {
            const f32x4* kp = (const f32x4*)(MS + (((size_t)b << 12) + s) * 256);
            float kv[64];
#pragma unroll
            for (int j = 0; j < 16; ++j) { const f32x4 w = kp[j]; kv[4 * j] = w.x; kv[4 * j + 1] = w.y; kv[4 * j + 2] = w.z; kv[4 * j + 3] = w.w; }
            float acc = 0.f;
            for (int hh = 0; hh < 8; ++hh) {
                float d = 0.f;
#pragma unroll
                for (int c = 0; c < 64; ++c) d = fmaf(qs[hh * 64 + c], kv[c], d);
                d = fmaxf(d * 0.125f, 0.f);
                acc = fmaf(d, wq[hh], acc);
            }
            sc[s] = acc;
        }
        __syncthreads();
        int cnt;
        if (n <= 256) { if (tid < n) sel[tid] = tid; cnt = n; }
        else {
            unsigned key[8];
#pragma unroll
            for (int j = 0; j < 8; ++j) { const int idx = tid + 512 * j; unsigned kk = 0u; if (idx < n) { const unsigned u = __float_as_uint(sc[idx]); kk = (u & 0x80000000u) ? ~u : (u | 0x80000000u); } key[j] = kk; }
            if (tid == 0) { sw[0] = 0u; sw[1] = 256u; sw[3] = 0u; }
            unsigned mask = 0u;
            for (int pass = 3; pass >= 0; --pass) {
                const int shift = pass * 8;
                if (tid < 256) hist[tid] = 0u;
                __syncthreads();
                const unsigned prefix = sw[0];
#pragma unroll
                for (int j = 0; j < 8; ++j) { const int idx = tid + 512 * j; if (idx < n && (key[j] & mask) == prefix) atomicAdd((unsigned*)&hist[(key[j] >> shift) & 255u], 1u); }
                __syncthreads();
                if (tid == 0) { const unsigned k = sw[1]; unsigned c = 0u; int bb = 255; for (; bb > 0; --bb) { if (c + hist[bb] >= k) break; c += hist[bb]; }
                    sw[1] = k - c; sw[0] = prefix | ((unsigned)bb << shift); sw[2] = hist[bb]; }
                mask |= (0xFFu << shift);
                __syncthreads();
            }
            const unsigned thr = sw[0], need = sw[1], eqc = sw[2];
            if (tid == 0) { int cut = SEQ;
                if (eqc != need) { unsigned c = 0u; for (int i = 0; i < n; ++i) { const unsigned u = __float_as_uint(sc[i]); const unsigned kk = (u & 0x80000000u) ? ~u : (u | 0x80000000u); if (kk == thr) { ++c; if (c == need) { cut = i; break; } } } }
                sw[4] = (unsigned)cut; }
            __syncthreads();
            const int cut = (int)sw[4];
#pragma unroll
            for (int j = 0; j < 8; ++j) { const int idx = tid + 512 * j; if (idx < n && (key[j] > thr || (key[j] == thr && idx <= cut))) { const unsigned pos = atomicAdd((unsigned*)&sw[3], 1u); if (pos < 256u) sel[pos] = idx; } }
            cnt = 256;
        }
        __syncthreads();
        float s4[4] = {-INFINITY, -INFINITY, -INFINITY, -INFINITY};
        if (tid < cnt) {
            const v4u* kr = (const v4u*)(CK + (((size_t)b << 12) + sel[tid]) * 256);
#pragma unroll
            for (int hh = 0; hh < 4; ++hh) { float d = 0.f;
#pragma unroll
                for (int j = 0; j < 8; ++j) { const v4u w = kr[hh * 8 + j]; const LAS float* qq = q4 + hh * 64 + 8 * j;
                    d = fmaf(qq[0], bflo(w.x), d); d = fmaf(qq[1], bfhi(w.x), d); d = fmaf(qq[2], bflo(w.y), d); d = fmaf(qq[3], bfhi(w.y), d);
                    d = fmaf(qq[4], bflo(w.z), d); d = fmaf(qq[5], bfhi(w.z), d); d = fmaf(qq[6], bflo(w.w), d); d = fmaf(qq[7], bfhi(w.w), d); }
                s4[hh] = d * 0.125f; }
        }
        if (tid < 256) {
#pragma unroll
            for (int hh = 0; hh < 4; ++hh) { const float v = wave_max(s4[hh]); if (C.lane == 0) red[hh * 4 + C.wave] = v; }
        }
        __syncthreads();
        float mx[4];
#pragma unroll
        for (int hh = 0; hh < 4; ++hh) mx[hh] = fmaxf(fmaxf(red[hh * 4], red[hh * 4 + 1]), fmaxf(red[hh * 4 + 2], red[hh * 4 + 3]));
        __syncthreads();
        if (tid < 256) {
#pragma unroll
            for (int hh = 0; hh < 4; ++hh) { const float e = (tid < cnt) ? expf(s4[hh] - mx[hh]) : 0.f; ps[hh * 256 + tid] = e; const float v = wave_sum(e); if (C.lane == 0) red[hh * 4 + C.wave] = v; }
        }
        __syncthreads();
        if (tid < 256) {
            const int hh = tid >> 6;
            const float lsum = red[hh * 4] + red[hh * 4 + 1] + red[hh * 4 + 2] + red[hh * 4 + 3];
            float o = 0.f;
            for (int j = 0; j < cnt; ++j) o = fmaf(ps[hh * 256 + j], bf2f(CV[(((size_t)b << 12) + sel[j]) * 256 + tid]), o);
            const float z = bf2f(CZ[(size_t)m * 256 + tid]);
            CQ[(size_t)m * 256 + tid] = (bf16)f2bf(o / lsum * siluf_(z));
        }
        __syncthreads();
    }
}

typedef short bf16x8_t __attribute__((ext_vector_type(8)));
__device__ __forceinline__ float dpp_f(float x, const int ctrl_sel) {
    const int xi = __builtin_bit_cast(int, x); int r;
    if (ctrl_sel == 0) r = __builtin_amdgcn_update_dpp(xi, xi, 0xB1, 0xF, 0xF, false);
    else if (ctrl_sel == 1) r = __builtin_amdgcn_update_dpp(xi, xi, 0x4E, 0xF, 0xF, false);
    else r = __builtin_amdgcn_update_dpp(xi, xi, 0x141, 0xF, 0xF, false);
    return __builtin_bit_cast(float, r);
}
__device__ __forceinline__ float red8(float x) { x += dpp_f(x, 0); x += dpp_f(x, 1); x += dpp_f(x, 2); return x; }

constexpr int DSTEP_T = 320;
constexpr int D_LDS_STEP = 0, D_LDS_VS = 81920, D_LDS_TWD = 98304, D_LDS_ADS = 106496;
__device__ __forceinline__ void mixD1(Ctx C, const Params& P, int l) {
    OPQ(C);
    unsigned char* ws = P.ws;
    const bf16* DR = PLP(ws, PL_DR); const bf16* DK = PLP(ws, PL_DK); const bf16* DV = PLP(ws, PL_DV); const float* MS = (const float*)(ws + WS_MISC);
    const float* mu = P.in[6] + l * 896; const float* w0 = P.in[7] + l * 256; const float* w_up = P.in[8] + (size_t)l * 64 * 256; const float* a0 = P.in[9] + l * 256;
    const float* a_up = P.in[10] + (size_t)l * 64 * 256; const float* k_k = P.in[11] + l * 256; const float* k_a = P.in[12] + l * 256; const float* r_k = P.in[13] + l * 256;
    bf16* OL = (bf16*)(ws + WS_OL); bf16* CCp = (bf16*)(ws + WS_CC); float* BON = (float*)(ws + WS_DBON); float* AB = (float*)(ws + WS_DAB);
    LAS float* STEP = (LAS float*)(C.lds + D_LDS_STEP); LAS float* VS = (LAS float*)(C.lds + D_LDS_VS);
    LAS bf16* TWD = (LAS bf16*)(C.lds + D_LDS_TWD); LAS bf16* ADS = (LAS bf16*)(C.lds + D_LDS_ADS);
    const int tid = C.tid, lane = C.lane, wave = C.wave;
    const int tt = tid >> 3, c8 = tid & 7;
    for (int u = C.bid; u < 256; u += C.G) {
        const int b = u >> 5, h = (u >> 3) & 3, seg = u & 7, hc0 = h * 64;
        __syncthreads();
        {
            const int i = tid >> 3;
            const f32x4 wa = *(const f32x4*)(w_up + (size_t)i * 256 + hc0 + 8 * c8), wb = *(const f32x4*)(w_up + (size_t)i * 256 + hc0 + 8 * c8 + 4);
            const f32x4 aa = *(const f32x4*)(a_up + (size_t)i * 256 + hc0 + 8 * c8), ab = *(const f32x4*)(a_up + (size_t)i * 256 + hc0 + 8 * c8 + 4);
#pragma unroll
            for (int j = 0; j < 4; ++j) { TWD[(8 * c8 + j) * 64 + i] = (bf16)f2bf(wa[j]); TWD[(8 * c8 + 4 + j) * 64 + i] = (bf16)f2bf(wb[j]);
                                          ADS[(8 * c8 + j) * 64 + i] = (bf16)f2bf(aa[j]); ADS[(8 * c8 + 4 + j) * 64 + i] = (bf16)f2bf(ab[j]); }
        }
        __syncthreads();
        const int mat = wave >> 2, mt = wave & 3, fr = lane & 15, fq = lane >> 4;
        bf16x8_t bfrag[4][2];
#pragma unroll
        for (int nt = 0; nt < 4; ++nt)
#pragma unroll
            for (int k2 = 0; k2 < 2; ++k2) bfrag[nt][k2] = *(const LAS bf16x8_t*)((mat ? ADS : TWD) + (16 * nt + fr) * 64 + 32 * k2 + 8 * fq);
        float bias4[4];
#pragma unroll
        for (int nt = 0; nt < 4; ++nt) bias4[nt] = (mat ? a0 : w0)[hc0 + 16 * nt + fr];
        __syncthreads();
        float S[8], H[8];
#pragma unroll
        for (int j = 0; j < 8; ++j) { S[j] = 0.f; H[j] = (8 * c8 + j == tt) ? 1.f : 0.f; }
        for (int blk = 0; blk < 8; ++blk) {
            const int tloc0 = seg * 512 + blk * 64;
            const size_t m = ((size_t)b << 12) + tloc0 + tt;
            const bool has_prev = (tloc0 + tt) > 0;
            {
                const int ch = hc0 + 8 * c8;
                const v4u rc = *(const v4u*)(DR + m * 256 + ch), kc = *(const v4u*)(DK + m * 256 + ch), vc = *(const v4u*)(DV + m * 256 + ch);
                v4u rp = (v4u){0u, 0u, 0u, 0u}, kp = rp, vp = rp;
                if (has_prev) { rp = *(const v4u*)(DR + (m - 1) * 256 + ch); kp = *(const v4u*)(DK + (m - 1) * 256 + ch); vp = *(const v4u*)(DV + (m - 1) * 256 + ch); }
                LAS float* st = STEP + tt * DSTEP_T + c8 * 40;
#pragma unroll
                for (int q = 0; q < 4; ++q) {
                    const unsigned rcw = rc[q], rpw = rp[q], kcw = kc[q], kpw = kp[q], vcw = vc[q], vpw = vp[q];
                    const float mr0 = mu[ch + 2 * q], mr1 = mu[ch + 2 * q + 1], mk0 = mu[256 + ch + 2 * q], mk1 = mu[256 + ch + 2 * q + 1], mv0 = mu[512 + ch + 2 * q], mv1 = mu[512 + ch + 2 * q + 1];
                    float c0 = bflo(rcw), c1 = bfhi(rcw);
                    st[32 + 2 * q] = c0 + mr0 * (bflo(rpw) - c0); st[32 + 2 * q + 1] = c1 + mr1 * (bfhi(rpw) - c1);
                    c0 = bflo(kcw); c1 = bfhi(kcw);
                    st[24 + 2 * q] = c0 + mk0 * (bflo(kpw) - c0); st[24 + 2 * q + 1] = c1 + mk1 * (bfhi(kpw) - c1);
                    c0 = bflo(vcw); c1 = bfhi(vcw);
                    VS[tt * 64 + 8 * c8 + 2 * q] = c0 + mv0 * (bflo(vpw) - c0); VS[tt * 64 + 8 * c8 + 2 * q + 1] = c1 + mv1 * (bfhi(vpw) - c1);
                }
                const f32x4 wc0 = *(const f32x4*)(MS + m * 256 + 72 + 8 * c8), wc1 = *(const f32x4*)(MS + m * 256 + 76 + 8 * c8);
                const f32x4 ac0 = *(const f32x4*)(MS + m * 256 + 136 + 8 * c8), ac1 = *(const f32x4*)(MS + m * 256 + 140 + 8 * c8);
                f32x4 wp0 = (f32x4){0.f, 0.f, 0.f, 0.f}, wp1 = wp0, ap0 = wp0, ap1 = wp0;
                if (has_prev) { wp0 = *(const f32x4*)(MS + (m - 1) * 256 + 72 + 8 * c8); wp1 = *(const f32x4*)(MS + (m - 1) * 256 + 76 + 8 * c8);
                                ap0 = *(const f32x4*)(MS + (m - 1) * 256 + 136 + 8 * c8); ap1 = *(const f32x4*)(MS + (m - 1) * 256 + 140 + 8 * c8); }
                float tw[8], ad[8];
#pragma unroll
                for (int j = 0; j < 4; ++j) {
                    const float m0 = mu[768 + 8 * c8 + j], m1 = mu[768 + 8 * c8 + 4 + j], n0 = mu[832 + 8 * c8 + j], n1 = mu[832 + 8 * c8 + 4 + j];
                    tw[j] = tanhf(wc0[j] + m0 * (wp0[j] - wc0[j])); tw[4 + j] = tanhf(wc1[j] + m1 * (wp1[j] - wc1[j]));
                    ad[j] = ac0[j] + n0 * (ap0[j] - ac0[j]); ad[4 + j] = ac1[j] + n1 * (ap1[j] - ac1[j]);
                }
                v4u tv, av; tv.x = pk2(tw[0], tw[1]); tv.y = pk2(tw[2], tw[3]); tv.z = pk2(tw[4], tw[5]); tv.w = pk2(tw[6], tw[7]);
                av.x = pk2(ad[0], ad[1]); av.y = pk2(ad[2], ad[3]); av.z = pk2(ad[4], ad[5]); av.w = pk2(ad[6], ad[7]);
                *(LAS v4u*)(TWD + tt * 64 + 8 * c8) = tv; *(LAS v4u*)(ADS + tt * 64 + 8 * c8) = av;
            }
            __syncthreads();
            {
                const LAS bf16* Asrc = mat ? ADS : TWD;
                const bf16x8_t a0f = *(const LAS bf16x8_t*)(Asrc + (16 * mt + fr) * 64 + 8 * fq), a1f = *(const LAS bf16x8_t*)(Asrc + (16 * mt + fr) * 64 + 32 + 8 * fq);
#pragma unroll
                for (int nt = 0; nt < 4; ++nt) {
                    f32x4 acc = (f32x4){0.f, 0.f, 0.f, 0.f};
                    acc = __builtin_amdgcn_mfma_f32_16x16x32_bf16(a0f, bfrag[nt][0], acc, 0, 0, 0);
                    acc = __builtin_amdgcn_mfma_f32_16x16x32_bf16(a1f, bfrag[nt][1], acc, 0, 0, 0);
                    const int c = 16 * nt + fr;
#pragma unroll
                    for (int j = 0; j < 4; ++j) {
                        const int t = 16 * mt + 4 * fq + j; const float x = acc[j] + bias4[nt]; float val;
                        if (mat == 0) { const float nx = -x; const float sp = fmaxf(nx, 0.f) + log1pf(expf(-fabsf(nx))); val = expf(-expf(-sp - 0.5f)); }
                        else val = 1.f / (1.f + expf(-x));
                        STEP[t * DSTEP_T + (c >> 3) * 40 + (mat ? 16 : 8) + (c & 7)] = val;
                    }
                }
            }
            __syncthreads();
            {
                const int ch = hc0 + 8 * c8; LAS float* st = STEP + tt * DSTEP_T + c8 * 40;
                float kkr[8], ssq = 0.f, bon = 0.f;
#pragma unroll
                for (int j = 0; j < 8; ++j) { const float kx = st[24 + j], a = st[16 + j];
                    kkr[j] = kx * k_k[ch + j]; ssq = fmaf(kkr[j], kkr[j], ssq);
                    const float kf = kx * (1.f + (a - 1.f) * k_a[ch + j]); st[24 + j] = kf; bon = fmaf(st[32 + j] * kf, r_k[ch + j], bon); }
                ssq = red8(ssq); bon = red8(bon);
                const float inv = 1.f / fmaxf(sqrtf(ssq), 1e-12f);
#pragma unroll
                for (int j = 0; j < 8; ++j) { const float kk = kkr[j] * inv; st[j] = kk; st[16 + j] = kk * st[16 + j]; }
                if (c8 == 0) BON[m * 4 + h] = bon;
            }
            __syncthreads();
            for (int t = 0; t < 64; ++t) {
                const LAS f32x4* sp = (const LAS f32x4*)(STEP + t * DSTEP_T + c8 * 40);
                const f32x4 k0 = sp[0], k1 = sp[1], w0v = sp[2], w1v = sp[3], b0 = sp[4], b1 = sp[5], f0 = sp[6], f1 = sp[7], r0 = sp[8], r1 = sp[9];
                const float vv = VS[t * 64 + tt];
                float dS = 0.f, dH = 0.f;
#pragma unroll
                for (int j = 0; j < 4; ++j) { dS = fmaf(S[j], k0[j], dS); dH = fmaf(H[j], k0[j], dH); }
#pragma unroll
                for (int j = 0; j < 4; ++j) { dS = fmaf(S[4 + j], k1[j], dS); dH = fmaf(H[4 + j], k1[j], dH); }
                dS = -red8(dS); dH = -red8(dH);
                float oS = 0.f, oH = 0.f;
#pragma unroll
                for (int j = 0; j < 4; ++j) {
                    S[j] = fmaf(S[j], w0v[j], fmaf(dS, b0[j], vv * f0[j])); H[j] = fmaf(H[j], w0v[j], dH * b0[j]);
                    oS = fmaf(S[j], r0[j], oS); oH = fmaf(H[j], r0[j], oH);
                }
#pragma unroll
                for (int j = 0; j < 4; ++j) {
                    S[4 + j] = fmaf(S[4 + j], w1v[j], fmaf(dS, b1[j], vv * f1[j])); H[4 + j] = fmaf(H[4 + j], w1v[j], dH * b1[j]);
                    oS = fmaf(S[4 + j], r1[j], oS); oH = fmaf(H[4 + j], r1[j], oH);
                }
                oS = red8(oS); oH = red8(oH);
                if (c8 == 0) { const size_t mo = (((size_t)b << 12) + tloc0 + t) * 256 + hc0 + tt; OL[mo] = (bf16)f2bf(oS); CCp[mo] = (bf16)f2bf(oH); }
            }
            __syncthreads();
        }
        {
            float* ab = AB + (size_t)u * 8192;
            *(f32x4*)(ab + tt * 64 + 8 * c8) = (f32x4){H[0], H[1], H[2], H[3]}; *(f32x4*)(ab + tt * 64 + 8 * c8 + 4) = (f32x4){H[4], H[5], H[6], H[7]};
            *(f32x4*)(ab + 4096 + tt * 64 + 8 * c8) = (f32x4){S[0], S[1], S[2], S[3]}; *(f32x4*)(ab + 4096 + tt * 64 + 8 * c8 + 4) = (f32x4){S[4], S[5], S[6], S[7]};
        }
    }
}
__device__ __forceinline__ void mixD2(Ctx C, unsigned char* ws) {
    OPQ(C);
    if (C.bid >= 32) return;
    const float* AB = (const float*)(ws + WS_DAB); float* SS = (float*)(ws + WS_DSS);
    LAS float* SL = (LAS float*)C.lds; LAS float* AL = SL + 4096;
    const int tid = C.tid, rr = tid >> 3, ks = tid & 7;
    float S[8];
#pragma unroll
    for (int j = 0; j < 8; ++j) S[j] = 0.f;
    for (int seg = 0; seg < 8; ++seg) {
        const int u = C.bid * 8 + seg;
        float* so = SS + (size_t)u * 4096 + rr * 64 + 8 * ks;
        *(f32x4*)so = (f32x4){S[0], S[1], S[2], S[3]}; *(f32x4*)(so + 4) = (f32x4){S[4], S[5], S[6], S[7]};
        if (seg == 7) break;
        __syncthreads();
        *(LAS f32x4*)(SL + rr * 64 + 8 * ks) = (f32x4){S[0], S[1], S[2], S[3]}; *(LAS f32x4*)(SL + rr * 64 + 8 * ks + 4) = (f32x4){S[4], S[5], S[6], S[7]};
        const float* ab = AB + (size_t)u * 8192;
        *(LAS f32x4*)(AL + tid * 8) = *(const f32x4*)(ab + tid * 8); *(LAS f32x4*)(AL + tid * 8 + 4) = *(const f32x4*)(ab + tid * 8 + 4);
        const f32x4 bb0 = *(const f32x4*)(ab + 4096 + rr * 64 + 8 * ks), bb1 = *(const f32x4*)(ab + 4096 + rr * 64 + 8 * ks + 4);
        __syncthreads();
#pragma unroll
        for (int j = 0; j < 4; ++j) { S[j] = bb0[j]; S[4 + j] = bb1[j]; }
#pragma nounroll
        for (int i = 0; i < 64; ++i) {
            const float s = SL[rr * 64 + i];
            const f32x4 a0 = *(const LAS f32x4*)(AL + i * 64 + 8 * ks), a1 = *(const LAS f32x4*)(AL + i * 64 + 8 * ks + 4);
#pragma unroll
            for (int j = 0; j < 4; ++j) { S[j] = fmaf(s, a0[j], S[j]); S[4 + j] = fmaf(s, a1[j], S[4 + j]); }
        }
    }
}
__device__ __forceinline__ void mixD3(Ctx C, const Params& P, int l) {
    OPQ(C);
    unsigned char* ws = P.ws;
    bf16* DR = PLP(ws, PL_DR); const bf16* DV = PLP(ws, PL_DV); const bf16* DZ = PLP(ws, PL_DZ);
    const bf16* OL = (const bf16*)(ws + WS_OL); const bf16* CCp = (const bf16*)(ws + WS_CC); const float* BON = (const float*)(ws + WS_DBON); const float* SS = (const float*)(ws + WS_DSS);
    const float* mu = P.in[6] + l * 896; const float* gn_g = P.in[14] + l * 256; const float* gn_b = P.in[15] + l * 256;
    const int lane = C.lane, wave = C.wave;
    for (int u = C.bid; u < 256; u += C.G) {
        const int b = u >> 5, h = (u >> 3) & 3, seg = u & 7, hc = h * 64 + lane;
        float S[64];
        {
            const f32x4* sp = (const f32x4*)(SS + (size_t)u * 4096 + lane * 64);
#pragma unroll
            for (int q = 0; q < 16; ++q) { const f32x4 x = sp[q]; S[4 * q] = x[0]; S[4 * q + 1] = x[1]; S[4 * q + 2] = x[2]; S[4 * q + 3] = x[3]; }
        }
        const float muv = mu[512 + hc], gg = gn_g[hc], gb = gn_b[hc];
        for (int t = 0; t < 64; ++t) {
            const int tl = seg * 512 + wave * 64 + t;
            const size_t m = ((size_t)b << 12) + tl;
            const float cv = bf2f(CCp[m * 256 + hc]);
            float o = bf2f(OL[m * 256 + hc]);
#pragma unroll
            for (int i = 0; i < 64; ++i) o = fmaf(S[i], __builtin_bit_cast(float, __builtin_amdgcn_readlane(__builtin_bit_cast(int, cv), i)), o);
            const float mean = wave_sum(o) * (1.f / 64.f); const float d = o - mean; const float var = wave_sum(d * d) * (1.f / 64.f);
            float y = d * rsqrtf(var + 64e-5f) * gg + gb;
            const float vcur = bf2f(DV[m * 256 + hc]); const float vprev = (tl > 0) ? bf2f(DV[(m - 1) * 256 + hc]) : 0.f;
            y += BON[m * 4 + h] * (vcur + muv * (vprev - vcur));
            const float z = bf2f(DZ[m * 256 + hc]);
            DR[m * 256 + hc] = (bf16)f2bf(y * siluf_(z));
        }
    }
}

template <bool OUT>
__device__ __forceinline__ void mixB_chunks(Ctx C, unsigned char* ws, const float* normg) {
    OPQ(C);
    bf16* BQ = PLP(ws, PL_BQ); const bf16* BI = PLP(ws, PL_BI); const bf16* BZ = PLP(ws, PL_BZ); const float* BF = (const float*)(ws + WS_BF);
    float* BS = (float*)(ws + WS_BS); float* BG = (float*)(ws + WS_BG);
    LAS float* FT = (LAS float*)(C.lds + C.wave * 8192); LAS float* QT = FT + 1024;
    const int lane = C.lane;
    const float gnorm = OUT ? normg[lane] : 0.f;
    for (int item = C.bid * 8 + C.wave; item < 2048; item += C.G * 8) {
        const int bh = item >> 6, c = item & 63, b = bh >> 2, h = bh & 3;
        const size_t m0 = ((size_t)b << 12) + c * 64;
        float S[64];
        if (OUT) {
            const float* sp = BS + (size_t)item * 4096 + lane;
#pragma unroll
            for (int d = 0; d < 64; ++d) S[d] = sp[d * 64];
        } else {
#pragma unroll
            for (int d = 0; d < 64; ++d) S[d] = 0.f;
        }
        float g = 1.f;
        for (int t0 = 0; t0 < 64; t0 += 16) {
#pragma unroll
            for (int s = 0; s < 16; ++s) {
                const size_t m = m0 + t0 + s;
                FT[s * 64 + lane] = BF[m * 256 + h * 64 + lane];
                if (OUT) QT[s * 64 + lane] = bf2f(BQ[m * 256 + h * 64 + lane]);
            }
            LDS_WAIT(); asm volatile("" ::: "memory");
            if (!OUT) {
#pragma unroll
                for (int s = 0; s < 16; ++s) g *= FT[s * 64 + lane];
            }
#pragma nounroll
            for (int s = 0; s < 16; ++s) {
                const size_t m = m0 + t0 + s;
                const float iv = bf2f(BI[m * 256 + h * 64 + lane]);
                const LAS f32x4* fp = (const LAS f32x4*)(FT + s * 64); const LAS f32x4* qp = (const LAS f32x4*)(QT + s * 64);
                float o = 0.f;
#pragma unroll
                for (int q4 = 0; q4 < 16; ++q4) {
                    const f32x4 f4 = fp[q4];
#pragma unroll
                    for (int j = 0; j < 4; ++j) S[4 * q4 + j] = fmaf(f4[j], S[4 * q4 + j] - iv, iv);
                    if (OUT) { const f32x4 qv = qp[q4];
#pragma unroll
                        for (int j = 0; j < 4; ++j) o = fmaf(qv[j], S[4 * q4 + j], o); }
                }
                if (OUT) {
                    const float r = rsqrtf(wave_sum(o * o) * (1.f / 64.f) + 1e-6f);
                    const float z = bf2f(BZ[m * 256 + h * 64 + lane]);
                    BQ[m * 256 + h * 64 + lane] = (bf16)f2bf(o * r * gnorm * siluf_(z));
                }
            }
            LDS_WAIT(); asm volatile("" ::: "memory");
        }
        if (!OUT) {
            float* sp = BS + (size_t)item * 4096 + lane;
#pragma unroll
            for (int d = 0; d < 64; ++d) sp[d * 64] = S[d];
            BG[item * 64 + lane] = g;
        }
    }
}
__device__ __forceinline__ void mixB_scan(Ctx C, unsigned char* ws) {
    OPQ(C);
    float* BS = (float*)(ws + WS_BS); const float* BG = (const float*)(ws + WS_BG);
    for (int e = C.bid * 512 + C.tid; e < 32 * 4096; e += C.G * 512) {
        const int bh = e >> 12, dv = e & 4095, d = dv >> 6;
        float S = 0.f;
#pragma unroll 8
        for (int c = 0; c < 64; ++c) {
            const size_t idx = ((size_t)(bh * 64 + c) << 12) + dv;
            const float sl = BS[idx], g = BG[(bh * 64 + c) * 64 + d];
            BS[idx] = S;
            S = fmaf(g, S, sl);
        }
    }
}

typedef float f32x16 __attribute__((ext_vector_type(16)));
__device__ __forceinline__ int crow_(int r, int hi) { return (r & 3) + 8 * (r >> 2) + 4 * hi; }
__device__ __forceinline__ void mixA_fast(Ctx C, unsigned char* ws, const float* bias) {
    OPQ(C);
    bf16* AQ = PLP(ws, PL_AQ); const bf16* AK = PLP(ws, PL_AK); const bf16* AVT = PLP(ws, PL_AV); const bf16* AZ = PLP(ws, PL_AZ);
    LAS float* BL = (LAS float*)C.lds;
    __syncthreads();
    for (int i = C.tid; i < 768; i += 512) BL[i] = bias[i] * 1.4426950408889634f;
    __syncthreads();
    const int lane = C.lane, q = lane & 31, hi = lane >> 5;
    for (int item = C.bid * 8 + C.wave; item < 2048; item += C.G * 8) {
        const int h = item & 3, c = (item >> 2) & 63, b = item >> 8;
        const size_t mq0 = ((size_t)b << 12) + c * 64;
        bf16x8_t qf[2][4];
#pragma unroll
        for (int qb = 0; qb < 2; ++qb)
#pragma unroll
            for (int s = 0; s < 4; ++s) qf[qb][s] = *(const bf16x8_t*)(AQ + (mq0 + 32 * qb + q) * 256 + h * 64 + 16 * s + 8 * hi);
        f32x16 O[2][2];
#pragma unroll
        for (int qb = 0; qb < 2; ++qb)
#pragma unroll
            for (int db = 0; db < 2; ++db)
#pragma unroll
                for (int r = 0; r < 16; ++r) O[qb][db][r] = 0.f;
        float mrun[2] = {-1e30f, -1e30f}, lrun[2] = {0.f, 0.f};
        const int klo = (c >= 8) ? (c - 8) * 64 : 0;
        const int nkb = (c * 64 + 64 - klo) >> 5;
        const LAS float* bh = BL + h * 192;
        for (int kb = 0; kb < nkb; ++kb) {
            const int kbase = klo + 32 * kb;
            const size_t mk = ((size_t)b << 12) + kbase;
            bf16x8_t kf[4];
#pragma unroll
            for (int s = 0; s < 4; ++s) kf[s] = *(const bf16x8_t*)(AK + (mk + q) * 256 + h * 64 + 16 * s + 8 * hi);
            bf16x8_t vt[2][2];
#pragma unroll
            for (int db = 0; db < 2; ++db)
#pragma unroll
                for (int s2 = 0; s2 < 2; ++s2) {
                    const bf16* vp = AVT + ((size_t)(b * 256 + h * 64 + 32 * db + q) << 12) + kbase + 16 * s2 + 4 * hi;
                    const v2u lo = *(const v2u*)vp, hi2 = *(const v2u*)(vp + 8);
                    v4u w; w.x = lo.x; w.y = lo.y; w.z = hi2.x; w.w = hi2.y;
                    vt[db][s2] = __builtin_bit_cast(bf16x8_t, w);
                }
#pragma unroll
            for (int qb = 0; qb < 2; ++qb) {
                f32x16 st;
#pragma unroll
                for (int r = 0; r < 16; ++r) st[r] = 0.f;
#pragma unroll
                for (int s = 0; s < 4; ++s) st = __builtin_amdgcn_mfma_f32_32x32x16_bf16(kf[s], qf[qb][s], st, 0, 0, 0);
                const int qpos = c * 64 + 32 * qb + q;
                float mx = -1e30f;
#pragma unroll
                for (int r = 0; r < 16; ++r) {
                    int rel = qpos - (kbase + crow_(r, hi)); rel = rel < -63 ? -63 : (rel > 128 ? 128 : rel);
                    st[r] = fmaf(st[r], 0.125f * 1.4426950408889634f, bh[rel + 63]);
                    mx = fmaxf(mx, st[r]);
                }
                mx = xh_max(mx);
                const float mn = fmaxf(mrun[qb], mx);
                const float al = __builtin_amdgcn_exp2f(mrun[qb] - mn);
                mrun[qb] = mn;
                float ps = 0.f;
#pragma unroll
                for (int r = 0; r < 16; ++r) { st[r] = __builtin_amdgcn_exp2f(st[r] - mn); ps += st[r]; }
                ps = xh_sum(ps);
                lrun[qb] = lrun[qb] * al + ps;
#pragma unroll
                for (int db = 0; db < 2; ++db)
#pragma unroll
                    for (int r = 0; r < 16; ++r) O[qb][db][r] *= al;
                v4u p0, p1;
                p0.x = pk2(st[0], st[1]); p0.y = pk2(st[2], st[3]); p0.z = pk2(st[4], st[5]); p0.w = pk2(st[6], st[7]);
                p1.x = pk2(st[8], st[9]); p1.y = pk2(st[10], st[11]); p1.z = pk2(st[12], st[13]); p1.w = pk2(st[14], st[15]);
                const bf16x8_t pf0 = __builtin_bit_cast(bf16x8_t, p0), pf1 = __builtin_bit_cast(bf16x8_t, p1);
#pragma unroll
                for (int db = 0; db < 2; ++db) {
                    O[qb][db] = __builtin_amdgcn_mfma_f32_32x32x16_bf16(vt[db][0], pf0, O[qb][db], 0, 0, 0);
                    O[qb][db] = __builtin_amdgcn_mfma_f32_32x32x16_bf16(vt[db][1], pf1, O[qb][db], 0, 0, 0);
                }
            }
        }
#pragma unroll
        for (int qb = 0; qb < 2; ++qb) {
            const float invl = 1.f / lrun[qb];
            const size_t mrow = (mq0 + 32 * qb + q) * 256 + h * 64;
#pragma unroll
            for (int db = 0; db < 2; ++db)
#pragma unroll
                for (int g = 0; g < 4; ++g) {
                    const int col = 32 * db + 8 * g + 4 * hi;
                    const v2u z = *(const v2u*)(AZ + mrow + col);
                    const float z0 = bflo(z.x), z1 = bfhi(z.x), z2 = bflo(z.y), z3 = bfhi(z.y);
                    v2u w;
                    w.x = pk2(O[qb][db][4 * g] * invl * z0 * fsig(z0), O[qb][db][4 * g + 1] * invl * z1 * fsig(z1));
                    w.y = pk2(O[qb][db][4 * g + 2] * invl * z2 * fsig(z2), O[qb][db][4 * g + 3] * invl * z3 * fsig(z3));
                    *(v2u*)(AQ + mrow + col) = w;
                }
        }
    }
}

constexpr int C_NB = 512, C_CAP = 64;
constexpr int C_LDS_HIST = 0, C_LDS_QIF = 32768, C_LDS_BMP = 65536, C_LDS_QP = 98304, C_LDS_WQ = 100352, C_LDS_SCR = 101376;
enum { QP_LO = 0, QP_SC = 1, QP_CRIT = 2, QP_LO2 = 3, QP_SC2 = 4, QP_CRIT2 = 5, QP_KREM = 6, QP_CNT = 7, QP_LVL = 8, QP_CC = 9 };
__device__ __forceinline__ int c_bin(float s, float lo, float sc) { float x = (s - lo) * sc; x = fminf(fmaxf(x, 0.f), (float)(C_NB - 1)); return (int)x; }
__device__ __forceinline__ float relu_asm(float x) { return __builtin_amdgcn_fmed3f(x, 0.f, __builtin_inff()); }
__device__ __forceinline__ void mixC_fast(Ctx C, unsigned char* ws) {
    OPQ(C);
    bf16* CQ = PLP(ws, PL_CQ); const bf16* CK = PLP(ws, PL_CK); const bf16* CVT = PLP(ws, PL_CV); const bf16* CZ = PLP(ws, PL_CZ);
    const bf16* QI0 = PLP(ws, PL_CQI0); const bf16* QI1 = PLP(ws, PL_CQI1); const bf16* KI = (const bf16*)(ws + WS_KI); const float* MS = (const float*)(ws + WS_MISC);
    LAS unsigned* HIST = (LAS unsigned*)(C.lds + C_LDS_HIST); LAS unsigned* BMP = (LAS unsigned*)(C.lds + C_LDS_BMP);
    LAS float* QPf = (LAS float*)(C.lds + C_LDS_QP); LAS int* QPi = (LAS int*)(C.lds + C_LDS_QP); LAS float* WQ = (LAS float*)(C.lds + C_LDS_WQ);
    LAS unsigned long long* LIST = (LAS unsigned long long*)(C.lds + C_LDS_HIST);
    LAS unsigned char* QIFL = C.lds + C_LDS_QIF;
    const int wave = C.wave;
    for (int pass2 = 0; pass2 < 2; ++pass2)
    for (int ui = C.bid; ui < 256; ui += C.G) {
        const int b = ui & 7, c = pass2 == 0 ? 63 - (ui >> 3) : (ui >> 3);
        const int n = 64 * (c + 1), nkb = n >> 5;
        const size_t mq0 = ((size_t)b << 12) + c * 64, mk0 = (size_t)b << 12;
        __syncthreads();
        if (c <= 3) {
            const int tid0 = wave * 64 + lane_id_fresh();
            for (int i = tid0; i < 64 * 128; i += 512) BMP[i] = ((i & 127) < nkb) ? 0xFFFFFFFFu : 0u;
        } else {
          for (int qb = 0; qb < 2; ++qb) {
            {
                const int lane = lane_id_fresh();
#pragma nounroll
                for (int qq = 0; qq < 4; ++qq) {
                    const int qx = wave * 4 + qq; const size_t m = mq0 + 32 * qb + qx;
                    const int hh = lane >> 3;
                    const v4u w = *(const v4u*)((hh < 4 ? QI0 : QI1) + m * 256 + (hh & 3) * 64 + 8 * (lane & 7));
                    float ssq;
                    { const float a0 = bflo(w.x), a1 = bfhi(w.x), a2 = bflo(w.y), a3 = bfhi(w.y), a4 = bflo(w.z), a5 = bfhi(w.z), a6 = bflo(w.w), a7 = bfhi(w.w);
                      ssq = a0 * a0 + a1 * a1 + a2 * a2 + a3 * a3 + a4 * a4 + a5 * a5 + a6 * a6 + a7 * a7; }
                    ssq = red8(ssq);
                    const float wv = MS[m * 256 + 64 + hh] * (0.35355339059327373f * 0.125f);
                    float tm = 0.4f * wv * sqrtf(ssq), tv = 0.34f * wv * wv * ssq;
                    tm += dppf(tm, 4); tm += swz16f(tm); tm = xh_sum(tm);
                    tv += dppf(tv, 4); tv += swz16f(tv); tv = xh_sum(tv);
                    if ((lane & 7) == 0) WQ[qx * 8 + hh] = wv;
                    if (lane == 0) { const float sd = fmaxf(sqrtf(tv), 1e-20f);
                        QPf[qx * 16 + QP_LO] = tm - 6.f * sd; QPf[qx * 16 + QP_SC] = (float)C_NB / (16.f * sd);
                        QPi[qx * 16 + QP_KREM] = 256; QPi[qx * 16 + QP_CNT] = 0; QPi[qx * 16 + QP_LVL] = 0; QPi[qx * 16 + QP_CRIT] = -1; QPi[qx * 16 + QP_CRIT2] = -1; }
                }
                const int q = lane & 31, hi = lane >> 5;
#pragma unroll
                for (int s = 0; s < 4; ++s) *(LAS bf16x8_t*)(QIFL + (wave * 4 + s) * 1024 + lane * 16) = *(const bf16x8_t*)((wave < 4 ? QI0 : QI1) + (mq0 + 32 * qb + q) * 256 + (wave & 3) * 64 + 16 * s + 8 * hi);
            }
            int mode = 0;
            while (true) {
                {
                    const int lane = lane_id_fresh(), q = lane & 31, hi = lane >> 5;
                    if (mode < 2) { for (int i = wave * 64 + lane; i < 32 * 256; i += 512) HIST[i] = 0u; }
                    __syncthreads();
                    const float lo1 = QPf[q * 16 + QP_LO], sc1 = QPf[q * 16 + QP_SC]; const int crit1 = QPi[q * 16 + QP_CRIT]; const int lvl = QPi[q * 16 + QP_LVL];
                    for (int kb = wave; kb < nkb; kb += 8) {
                        const int kbase = 32 * kb;
                        bf16x8_t kif[4];
#pragma unroll
                        for (int s = 0; s < 4; ++s) kif[s] = *(const bf16x8_t*)(KI + (mk0 + kbase + q) * 64 + 16 * s + 8 * hi);
                        f32x16 I;
#pragma unroll
                        for (int r = 0; r < 16; ++r) I[r] = 0.f;
#pragma unroll
                        for (int hh = 0; hh < 8; ++hh) {
                            f32x16 D;
#pragma unroll
                            for (int r = 0; r < 16; ++r) D[r] = 0.f;
#pragma unroll
                            for (int s = 0; s < 4; ++s) D = __builtin_amdgcn_mfma_f32_32x32x16_bf16(kif[s], *(const LAS bf16x8_t*)(QIFL + (hh * 4 + s) * 1024 + lane * 16), D, 0, 0, 0);
                            const float wqh = WQ[q * 8 + hh];
#pragma unroll
                            for (int r = 0; r < 16; ++r) I[r] = fmaf(relu_asm(D[r]), wqh, I[r]);
                        }
                        if (mode == 0) {
#pragma unroll
                            for (int r = 0; r < 16; ++r) { const int bn = c_bin(I[r], lo1, sc1); atomicAdd((unsigned*)&HIST[q * 256 + (bn >> 1)], 1u << (16 * (bn & 1))); }
                        } else if (mode == 1) {
                            if (lvl == 1) {
                                const float lo2 = QPf[q * 16 + QP_LO2], sc2 = QPf[q * 16 + QP_SC2];
#pragma unroll
                                for (int r = 0; r < 16; ++r) { if (c_bin(I[r], lo1, sc1) == crit1) { const int bn = c_bin(I[r], lo2, sc2); atomicAdd((unsigned*)&HIST[q * 256 + (bn >> 1)], 1u << (16 * (bn & 1))); } }
                            }
                        } else {
                            unsigned bits = 0u;
#pragma unroll
                            for (int r = 0; r < 16; ++r) {
                                const int b1 = c_bin(I[r], lo1, sc1);
                                bool sel = b1 > crit1, cand = (b1 == crit1);
                                if (cand && lvl == 1) { const int b2 = c_bin(I[r], QPf[q * 16 + QP_LO2], QPf[q * 16 + QP_SC2]); const int crit2 = QPi[q * 16 + QP_CRIT2]; sel = b2 > crit2; cand = (b2 == crit2); }
                                if (sel) bits |= 1u << ((r & 3) + 8 * (r >> 2));
                                if (cand) { const unsigned pos = atomicAdd((unsigned*)&QPi[q * 16 + QP_CNT], 1u);
                                    if (pos < (unsigned)C_CAP) LIST[q * C_CAP + pos] = ((unsigned long long)__float_as_uint(I[r]) << 32) | (unsigned)(kbase + crow_(r, hi)); }
                            }
                            bits <<= 4 * hi;
                            bits = xh_or(bits);
                            if (hi == 0) BMP[(32 * qb + q) * 128 + kb] = bits;
                        }
                    }
                }
                __syncthreads();
                if (mode == 2) break;
                {
                    const int lane = lane_id_fresh();
                    LAS unsigned* SCR = (LAS unsigned*)(C.lds + C_LDS_SCR + wave * 256);
#pragma nounroll
                    for (int qq = 0; qq < 4; ++qq) {
                        const int qx = wave * 4 + qq;
                        const int lv = QPi[qx * 16 + QP_LVL];
                        if (mode == 1 && lv == 0) continue;
                        const int krem = QPi[qx * 16 + QP_KREM];
                        unsigned cnt[8]; unsigned s = 0u;
#pragma unroll
                        for (int j = 0; j < 4; ++j) { const unsigned w = HIST[qx * 256 + lane * 4 + j]; cnt[2 * j] = w & 0xffffu; cnt[2 * j + 1] = w >> 16; s += (w & 0xffffu) + (w >> 16); }
                        SCR[lane] = s; LDS_WAIT(); asm volatile("" ::: "memory");
                        unsigned incl = 0u;
#pragma unroll 8
                        for (int l2 = 0; l2 < 64; ++l2) { const unsigned t = SCR[l2]; incl += (l2 >= lane) ? t : 0u; }
                        LDS_WAIT(); asm volatile("" ::: "memory");
                        unsigned run = incl - s;
                        int fcrit = -1; unsigned frun = 0u, fcnt = 0u;
#pragma unroll
                        for (int j = 7; j >= 0; --j) {
                            const bool hit = run < (unsigned)krem && run + cnt[j] >= (unsigned)krem;
                            fcrit = hit ? lane * 8 + j : fcrit; frun = hit ? run : frun; fcnt = hit ? cnt[j] : fcnt;
                            run += cnt[j];
                        }
                        if (fcrit >= 0) {
                            QPi[qx * 16 + QP_KREM] = krem - (int)frun; QPi[qx * 16 + QP_CC] = (int)fcnt;
                            if (mode == 0) { QPi[qx * 16 + QP_CRIT] = fcrit;
                                if (fcnt > (unsigned)C_CAP) { const float lo = QPf[qx * 16 + QP_LO], sc = QPf[qx * 16 + QP_SC];
                                    QPf[qx * 16 + QP_LO2] = lo + (float)fcrit / sc; QPf[qx * 16 + QP_SC2] = sc * (float)C_NB; QPi[qx * 16 + QP_LVL] = 1; } }
                            else QPi[qx * 16 + QP_CRIT2] = fcrit;
                        }
                    }
                }
                __syncthreads();
                if (mode == 0) { bool need_l2 = false; for (int qx = 0; qx < 32; ++qx) need_l2 |= (QPi[qx * 16 + QP_LVL] == 1); mode = need_l2 ? 1 : 2; }
                else mode = 2;
                __syncthreads();
            }
            {
                const int lane = lane_id_fresh();
#pragma nounroll
                for (int qq = 0; qq < 4; ++qq) {
                    const int qx = wave * 4 + qq;
                    int cn = QPi[qx * 16 + QP_CNT]; cn = cn < C_CAP ? cn : C_CAP;
                    const int need = QPi[qx * 16 + QP_KREM];
                    if (lane < cn) {
                        const unsigned long long me = LIST[qx * C_CAP + lane];
                        const float mv = __uint_as_float((unsigned)(me >> 32)); const unsigned mi = (unsigned)me;
                        int rank = 0;
                        for (int j = 0; j < cn; ++j) { const unsigned long long o = LIST[qx * C_CAP + j]; const float ov = __uint_as_float((unsigned)(o >> 32)); const unsigned oi = (unsigned)o;
                            rank += (ov > mv || (ov == mv && oi < mi)) ? 1 : 0; }
                        if (rank < need) atomicOr((unsigned*)&BMP[(32 * qb + qx) * 128 + (mi >> 5)], 1u << (mi & 31));
                    }
                }
            }
            __syncthreads();
          }
        }
        __syncthreads();
        {
            const int lane = lane_id_fresh(), q = lane & 31, hi = lane >> 5;
            const int qb = wave & 1, h = wave >> 1, ql = 32 * qb + q;
            bf16x8_t qf[4];
#pragma unroll
            for (int s = 0; s < 4; ++s) qf[s] = *(const bf16x8_t*)(CQ + (mq0 + ql) * 256 + h * 64 + 16 * s + 8 * hi);
            f32x16 O[2];
#pragma unroll
            for (int db = 0; db < 2; ++db)
#pragma unroll
                for (int r = 0; r < 16; ++r) O[db][r] = 0.f;
            float mrun = -1e30f, lrun = 0.f;
            for (int kb = 0; kb < nkb; ++kb) {
                const int kbase = 32 * kb;
                const unsigned word = BMP[ql * 128 + kb] >> (4 * hi);
                bf16x8_t kf[4];
#pragma unroll
                for (int s = 0; s < 4; ++s) kf[s] = *(const bf16x8_t*)(CK + (mk0 + kbase + q) * 256 + h * 64 + 16 * s + 8 * hi);
                bf16x8_t vt[2][2];
#pragma unroll
                for (int db = 0; db < 2; ++db)
#pragma unroll
                    for (int s2 = 0; s2 < 2; ++s2) {
                        const bf16* vp = CVT + ((size_t)(b * 256 + h * 64 + 32 * db + q) << 12) + kbase + 16 * s2 + 4 * hi;
                        const v2u lo = *(const v2u*)vp, hi2 = *(const v2u*)(vp + 8);
                        v4u w; w.x = lo.x; w.y = lo.y; w.z = hi2.x; w.w = hi2.y;
                        vt[db][s2] = __builtin_bit_cast(bf16x8_t, w);
                    }
                f32x16 st;
#pragma unroll
                for (int r = 0; r < 16; ++r) st[r] = 0.f;
#pragma unroll
                for (int s = 0; s < 4; ++s) st = __builtin_amdgcn_mfma_f32_32x32x16_bf16(kf[s], qf[s], st, 0, 0, 0);
                float mx = -INFINITY;
#pragma unroll
                for (int r = 0; r < 16; ++r) {
                    const bool on = (word >> ((r & 3) + 8 * (r >> 2))) & 1u;
                    st[r] = on ? st[r] * (0.125f * 1.4426950408889634f) : -INFINITY;
                    mx = fmaxf(mx, st[r]);
                }
                mx = xh_max(mx);
                const float mn = fmaxf(mrun, mx);
                const float al = __builtin_amdgcn_exp2f(mrun - mn);
                mrun = mn;
                float ps = 0.f;
#pragma unroll
                for (int r = 0; r < 16; ++r) { st[r] = __builtin_amdgcn_exp2f(st[r] - mn); ps += st[r]; }
                ps = xh_sum(ps);
                lrun = lrun * al + ps;
#pragma unroll
                for (int db = 0; db < 2; ++db)
#pragma unroll
                    for (int r = 0; r < 16; ++r) O[db][r] *= al;
                v4u p0, p1;
                p0.x = pk2(st[0], st[1]); p0.y = pk2(st[2], st[3]); p0.z = pk2(st[4], st[5]); p0.w = pk2(st[6], st[7]);
                p1.x = pk2(st[8], st[9]); p1.y = pk2(st[10], st[11]); p1.z = pk2(st[12], st[13]); p1.w = pk2(st[14], st[15]);
                const bf16x8_t pf0 = __builtin_bit_cast(bf16x8_t, p0), pf1 = __builtin_bit_cast(bf16x8_t, p1);
#pragma unroll
                for (int db = 0; db < 2; ++db) {
                    O[db] = __builtin_amdgcn_mfma_f32_32x32x16_bf16(vt[db][0], pf0, O[db], 0, 0, 0);
                    O[db] = __builtin_amdgcn_mfma_f32_32x32x16_bf16(vt[db][1], pf1, O[db], 0, 0, 0);
                }
            }
            const float invl = 1.f / lrun;
            const size_t mrow = (mq0 + ql) * 256 + h * 64;
#pragma unroll
            for (int db = 0; db < 2; ++db)
#pragma unroll
                for (int g = 0; g < 4; ++g) {
                    const int col = 32 * db + 8 * g + 4 * hi;
                    const v2u z = *(const v2u*)(CZ + mrow + col);
                    const float z0 = bflo(z.x), z1 = bfhi(z.x), z2 = bflo(z.y), z3 = bfhi(z.y);
                    v2u w;
                    w.x = pk2(O[db][4 * g] * invl * z0 * fsig(z0), O[db][4 * g + 1] * invl * z1 * fsig(z1));
                    w.y = pk2(O[db][4 * g + 2] * invl * z2 * fsig(z2), O[db][4 * g + 3] * invl * z3 * fsig(z3));
                    *(v2u*)(CQ + mrow + col) = w;
                }
        }
    }
}
#define GRID_BAR() do { xcd_barrier(bar, C.wave == 0 && lane_id_fresh() == 0); } while (0)
template <int l>
__device__ __forceinline__ void layer_body(Ctx C, const Params& P, const XcdBarrier& bar) {
    unsigned char* ws = P.ws;
    const float* xin = (l == 0) ? P.in[0] : P.out;
    {
        pg8::Gemm g{(const pg8::bf16_t*)(ws + WS_H), (const pg8::bf16_t*)(ws + WS_W1T), NTOK, NG1, 1024};
        pg8::StaticOrder S; S.init(NTOK, NG1, C.G, C.bid);
        EpiG1 E{ws, (const float*)(ws + WS_LB) + l * 256};
        pg8::gemm_phase<EpiG1, pg8::StaticOrder, true, true>(C.lds, g, S, E, C.wave);
    }
    GRID_BAR();
    mixD1(C, P, l);
    __syncthreads();
    mixB_chunks<false>(C, ws, nullptr);
    GRID_BAR();
    mixD2(C, ws);
    mixB_scan(C, ws);
    GRID_BAR();
    mixD3(C, P, l);
    __syncthreads();
    mixB_chunks<true>(C, ws, P.in[5] + l * 64);
    mixA_fast(C, ws, P.in[3] + l * 4 * 192);
    __syncthreads();
    mixC_fast(C, ws);
    GRID_BAR();
#pragma nounroll
    for (int br = 0; br < 4; ++br) {
        pg8::Gemm g{(const pg8::bf16_t*)PLP(ws, br), (const pg8::bf16_t*)(ws + WS_WBT + (size_t)br * 1024 * 256 * 2), NTOK, 1024, 256};
        pg8::StaticOrder S; S.init(NTOK, 1024, C.G, C.bid);
        EpiBf E{(bf16*)(ws + WS_PB) + (size_t)br * NTOK * 1024, 1024};
        pg8::gemm_phase<EpiBf, pg8::StaticOrder, true, true>(C.lds, g, S, E, C.wave);
    }
    GRID_BAR();
    {
        pg8::Gemm g{(const pg8::bf16_t*)(ws + WS_H), (const pg8::bf16_t*)(ws + WS_WGT), NTOK, 4096, 1024};
        pg8::StaticOrder S; S.init(NTOK, 4096, C.G, C.bid);
        EpiGate E{(const bf16*)(ws + WS_PB), (bf16*)(ws + WS_Y)};
        pg8::gemm_phase<EpiGate, pg8::StaticOrder, true, true>(C.lds, g, S, E, C.wave);
    }
    GRID_BAR();
    {
        pg8::Gemm g{(const pg8::bf16_t*)(ws + WS_Y), (const pg8::bf16_t*)(ws + WS_WOT), NTOK, 1024, 1024};
        pg8::StaticOrder S; S.init(NTOK, 1024, C.G, C.bid);
        EpiRes E{xin, P.out};
        pg8::gemm_phase<EpiRes, pg8::StaticOrder, true, true>(C.lds, g, S, E, C.wave);
    }
    GRID_BAR();
    if (l == 0) { norm_rows_bf16(C, P.out, P.in[1] + 1024, (bf16*)(ws + WS_H)); convert_weights(C, P, 1); GRID_BAR(); }
    else {
        OPQ(C); const int gw = C.bid * 8 + C.wave, NGW = C.G * 8;
        for (int m = gw; m < NTOK; m += NGW) rms_row(P.out + (size_t)m * 1024, P.in[18], nullptr, P.out + (size_t)m * 1024, C.lane);
    }
}
__global__ void __launch_bounds__(512, 2) mega_fwd(Params P) {
    extern __shared__ __attribute__((aligned(16))) unsigned char lds_raw[];
    Ctx C; C.lds = (LAS unsigned char*)lds_raw; C.wave = __builtin_amdgcn_readfirstlane((int)threadIdx.x >> 6); C.G = gridDim.x; C.bid = blockIdx.x; OPQ(C);
    unsigned char* ws = P.ws;
    for (int u = C.tid; u < (LDS_BYTES - LDSCTL_OFF) / 4; u += 512) ((LAS unsigned*)(C.lds + LDSCTL_OFF))[u] = 0u;
    __syncthreads();
    volatile LAS unsigned* MISCW = (volatile LAS unsigned*)(C.lds + MISC_OFF);
    XcdBarrier bar = xcd_barrier_post((unsigned*)(ws + WS_CTL) + CW_BAR, MISCW + 8);
    setup_tables(C, P);
    convert_weights(C, P, 0);
    norm_rows_bf16(C, P.in[0], P.in[1], (bf16*)(ws + WS_H));
    GRID_BAR();
    layer_body<0>(C, P, bar);
    layer_body<1>(C, P, bar);
}

extern "C" void kernel_launch(void* const* d_in, const int* in_sizes, int n_in, void* d_out, int out_size, void* d_ws, size_t ws_size, hipStream_t stream) {
    static int grid = 0;
    if (grid == 0) {
        if (n_in != 19 || ws_size < WS_END) { fprintf(stderr, "kernel_launch: need 19 inputs and %zu bytes of workspace (got %d, %zu)\n", (size_t)WS_END, n_in, ws_size); grid = -1; return; }
        int dev = 0, cus = 0, per_cu = 0;
        if (hipGetDevice(&dev) != hipSuccess || hipDeviceGetAttribute(&cus, hipDeviceAttributeMultiprocessorCount, dev) != hipSuccess) { grid = -1; return; }
        if (hipFuncSetAttribute((const void*)mega_fwd, hipFuncAttributeMaxDynamicSharedMemorySize, LDS_BYTES) != hipSuccess) { grid = -1; return; }
        (void)hipOccupancyMaxActiveBlocksPerMultiprocessor(&per_cu, (const void*)mega_fwd, 512, LDS_BYTES);
        (void)hipGetLastError();
        grid = cus;
    }
    if (grid < 0) return;
    if (hipMemsetAsync((char*)d_ws + WS_CTL, 0, CTL_ZERO_BYTES, stream) != hipSuccess) return;
    Params p{};
    for (int i = 0; i < 19; ++i) p.in[i] = (const float*)d_in[i];
    p.out = (float*)d_out; p.ws = (unsigned char*)d_ws;
    hipLaunchKernelGGL(mega_fwd, dim3(grid), dim3(512), LDS_BYTES, stream, p);
}
```

```cpp
#define EXP 0
#include <hip/hip_runtime.h>
#include <cstdio>
#include <cstdint>
#include <math.h>

#define DM 1024
#define SEQ 4096
#define NBATCH 8
#define NTOK (NBATCH * SEQ)
#define INC 8904
#define C_AQ 0
#define C_AK 256
#define C_AV 512
#define C_AZ 768
#define C_BQ 1024
#define C_BF 1280
#define C_BI 1536
#define C_BZ 1792
#define C_CQ 2048
#define C_CK 2304
#define C_CV 2560
#define C_CZ 2816
#define C_CQI 3072
#define C_CKI 3584
#define C_CWI 3648
#define C_PD 3656
#define C_DR 3656
#define C_DK 3912
#define C_DV 4168
#define C_DWD 4424
#define C_DAD 4488
#define C_DZ 4552
#define C_PG 4808
#define NG1 4864

namespace pg8 {
#define PG8_LAS __attribute__((address_space(3)))
typedef unsigned short bf16_t;
typedef short bf16x8 __attribute__((ext_vector_type(8)));
typedef float f32x4 __attribute__((ext_vector_type(4)));
typedef unsigned u32x4 __attribute__((ext_vector_type(4)));
constexpr int BM = 256, BK = 64, HALF = 128, HTB = HALF * BK * 2  , STAGE_BYTES = 8 * HTB, NXCD = 8, WGM = 8;

__host__ __device__ __forceinline__ int lds_byte(int r, int c) { const int st = (r >> 4) * 2 + (c >> 5), rr = r & 15, cc = c & 31, ob = rr * 64 + cc * 2; return st * 1024 + (ob ^ (((ob >> 9) & 1) << 5)); }
__host__ __device__ __forceinline__ void stage_rc(int b, int& R, int& C) { const int st = b / 1024, sb = b % 1024, swz = sb ^ (((sb >> 9) & 1) << 5); R = (st >> 1) * 16 + swz / 64; C = (st & 1) * 32 + (swz % 64) / 2; }
__host__ __device__ __forceinline__ int perm32(int rho) { const int n = rho >> 4, i = rho & 15; return 8 * (i >> 2) + 4 * n + (i & 3); }

struct Unit { int pm, pn; };
struct Gemm { const bf16_t* A; const bf16_t* Bt; int M, N, K; };

struct StaticOrder {
    int nM, nN, nwg, G, c;
    __host__ __device__ void init(int M, int N, int G_, int c_) { nM = M / BM; nN = N / BM; nwg = nM * nN; G = G_; c = c_; }
    __host__ __device__ bool next(int i, Unit& u) const {
        const long L = (long)i * G + c; if (L >= nwg) return false;
        int wgid = (int)L; { const int q = nwg / NXCD, r = nwg % NXCD, xcd = wgid % NXCD, off = wgid / NXCD; wgid = (xcd < r ? xcd * (q + 1) : r * (q + 1) + (xcd - r) * q) + off; }
        const int nig = WGM * nN, gid = wgid / nig, fm = gid * WGM, gsz = (nM - fm) < WGM ? (nM - fm) : WGM;
        u.pm = fm + ((wgid % nig) % gsz); u.pn = (wgid % nig) / gsz; return true;
    }
    __device__ __forceinline__ void a_ready(const Unit&) const {}
    __device__ __forceinline__ void done(const Unit&) const {}
};

__device__ __forceinline__ unsigned cvt_pk_bf16(float lo, float hi) { unsigned r; asm volatile("v_cvt_pk_bf16_f32 %0, %1, %2" : "=v"(r) : "v"(lo), "v"(hi)); return r; }
template <class Epi, class Sched, bool ALIGN_EPI = false, bool SP2 = false>
__device__ __forceinline__ void gemm_phase(PG8_LAS unsigned char* lds, const Gemm g, const Sched& S, const Epi& E, const int wave_in) {
    int lane_; asm volatile("v_mbcnt_lo_u32_b32 %0, -1, 0\n\tv_mbcnt_hi_u32_b32 %0, -1, %0" : "=v"(lane_));
    const int wid = wave_in, lane = lane_, tid = wid * 64 + lane, wr = wid >> 2, wc = wid & 3, fr = lane & 15, fq = lane >> 4;
    const int K = g.K, nt = K / BK;
    unsigned voffA[2], voffB[2];
#pragma unroll
    for (int i = 0; i < 2; ++i) { int R, C; stage_rc(tid * 16 + i * 8192, R, C); const int Rb = Epi::PERM ? ((R & ~31) + perm32(R & 31)) : R;
        voffA[i] = (unsigned)(R * K + C) * 2u; voffB[i] = (unsigned)(Rb * K + C) * 2u; }
    const size_t kstep = (size_t)(BK * 2);
    const size_t hstep = (size_t)HALF * K * 2;
    const size_t tstep = 2 * hstep;
    const unsigned ldsw = (unsigned)wid * 1024u;
    const int aoff = lds_byte(wr * 64 + fr, fq * 8), boff = lds_byte(wc * 32 + fr, fq * 8);
#define PG8_SA(b, h) (((b) * 2 + (h)) * HTB)
#define PG8_SB(b, h) ((4 + (b) * 2 + (h)) * HTB)
#define PG8_STAGE(bufoff, gbase, voff) do { _Pragma("unroll") for (int _i = 0; _i < 2; ++_i) \
        __builtin_amdgcn_global_load_lds((const unsigned*)((const char*)(gbase) + (voff)[_i]), (PG8_LAS unsigned*)(lds + (bufoff) + ldsw + _i * 8192), 16, 0, 0); } while (0)
#define PG8_LDA(dst, b, h) do { _Pragma("unroll") for (int m = 0; m < 4; ++m) _Pragma("unroll") for (int k = 0; k < 2; ++k) dst[m][k] = *(const PG8_LAS bf16x8*)(lds + PG8_SA(b, h) + aoff + m * 2048 + k * 1024); } while (0)
#define PG8_LDB(dst, b, h) do { _Pragma("unroll") for (int n = 0; n < 2; ++n) _Pragma("unroll") for (int k = 0; k < 2; ++k) dst[n][k] = *(const PG8_LAS bf16x8*)(lds + PG8_SB(b, h) + boff + n * 2048 + k * 1024); } while (0)
#define PG8_MMA(ai, bj, At, Bt) do { __builtin_amdgcn_s_setprio(1); _Pragma("unroll") for (int m = 0; m < 4; ++m) _Pragma("unroll") for (int n = 0; n < 2; ++n) _Pragma("unroll") for (int k = 0; k < 2; ++k) \
        acc[ai][bj][m][n] = __builtin_amdgcn_mfma_f32_16x16x32_bf16(Bt[n][k], At[m][k], acc[ai][bj][m][n], 0, 0, 0); __builtin_amdgcn_s_setprio(0); } while (0)
#define PG8_WAIT_V(n) asm volatile("s_waitcnt vmcnt(" #n ")" ::: "memory")
#define PG8_WAIT_L(n) asm volatile("s_waitcnt lgkmcnt(" #n ")" ::: "memory")
#define PG8_BAR __builtin_amdgcn_s_barrier()
#define PG8_SCHED __builtin_amdgcn_sched_barrier(0)
    Unit cur, nxt; int ui = 0;
    if (!S.next(0, cur)) return;
    f32x4 acc[2][2][4][2];
#pragma unroll
    for (int a = 0; a < 2; ++a)
#pragma unroll
        for (int b = 0; b < 2; ++b)
#pragma unroll
            for (int m = 0; m < 4; ++m)
#pragma unroll
                for (int n = 0; n < 2; ++n) acc[a][b][m][n] = (f32x4){0.f, 0.f, 0.f, 0.f};
    bf16x8 At[4][2], B0[2][2], B1[2][2];
    const char* cA = (const char*)g.A + (size_t)cur.pm * tstep; const char* cB = (const char*)g.Bt + (size_t)cur.pn * tstep;
    S.a_ready(cur);
    if constexpr (SP2) {
        PG8_STAGE(PG8_SB(0, 0), cB, voffB); PG8_STAGE(PG8_SB(0, 1), cB + hstep, voffB); PG8_STAGE(PG8_SA(0, 0), cA, voffA); PG8_STAGE(PG8_SA(0, 1), cA + hstep, voffA);
        if (wr == 1) PG8_BAR;
        PG8_WAIT_V(2); PG8_BAR;
        PG8_STAGE(PG8_SB(1, 0), cB + kstep, voffB); PG8_STAGE(PG8_SA(1, 0), cA + kstep, voffA); PG8_STAGE(PG8_SB(1, 1), cB + hstep + kstep, voffB);
        PG8_WAIT_V(6); PG8_BAR;
    } else {
        PG8_STAGE(PG8_SB(0, 0), cB, voffB); PG8_STAGE(PG8_SA(0, 0), cA, voffA); PG8_STAGE(PG8_SB(0, 1), cB + hstep, voffB); PG8_STAGE(PG8_SA(0, 1), cA + hstep, voffA);
        if (wr == 1) PG8_BAR;
        PG8_WAIT_V(4); PG8_BAR;
        PG8_STAGE(PG8_SB(1, 0), cB + kstep, voffB); PG8_STAGE(PG8_SA(1, 0), cA + kstep, voffA); PG8_STAGE(PG8_SB(1, 1), cB + hstep + kstep, voffB);
        PG8_WAIT_V(6); PG8_BAR;
    }
    for (;;) {
        const bool has_next = S.next(ui + 1, nxt);
        const char* nA = has_next ? (const char*)g.A + (size_t)nxt.pm * tstep : cA; const char* nB = has_next ? (const char*)g.Bt + (size_t)nxt.pn * tstep : cB;
        for (int t = 0; t < nt; t += 2) {
            const bool last = (t == nt - 2);
            const char* a1 = cA + (size_t)(t + 1) * kstep;
            const char* a2 = last ? nA : cA + (size_t)(t + 2) * kstep; const char* b2 = last ? nB : cB + (size_t)(t + 2) * kstep;
            const char* a3 = a2 + kstep; const char* b3 = b2 + kstep;
            if (last && has_next) S.a_ready(nxt);
            if constexpr (SP2) {
            PG8_LDB(B0, 0, 0); PG8_LDB(B1, 0, 1); PG8_SCHED; PG8_LDA(At, 0, 0); PG8_STAGE(PG8_SA(1, 1), a1 + hstep, voffA);
            PG8_WAIT_V(8); PG8_WAIT_L(0); PG8_BAR; PG8_MMA(0, 0, At, B0); PG8_MMA(0, 1, At, B1); PG8_BAR; PG8_SCHED;
            PG8_LDA(At, 0, 1); PG8_STAGE(PG8_SB(0, 0), b2, voffB); PG8_STAGE(PG8_SB(0, 1), b2 + hstep, voffB); PG8_STAGE(PG8_SA(0, 0), a2, voffA);
            PG8_WAIT_V(8); PG8_WAIT_L(0); PG8_BAR; PG8_MMA(1, 0, At, B0); PG8_MMA(1, 1, At, B1); PG8_BAR; PG8_SCHED;
            PG8_LDB(B0, 1, 0); PG8_LDB(B1, 1, 1); PG8_SCHED; PG8_LDA(At, 1, 0); PG8_STAGE(PG8_SA(0, 1), a2 + hstep, voffA);
            PG8_WAIT_V(8); PG8_WAIT_L(0); PG8_BAR; PG8_MMA(0, 0, At, B0); PG8_MMA(0, 1, At, B1); PG8_BAR; PG8_SCHED;
            PG8_LDA(At, 1, 1); PG8_STAGE(PG8_SB(1, 0), b3, voffB); PG8_STAGE(PG8_SB(1, 1), b3 + hstep, voffB); PG8_STAGE(PG8_SA(1, 0), a3, voffA);
            PG8_WAIT_V(8); PG8_WAIT_L(0); PG8_BAR; PG8_MMA(1, 0, At, B0); PG8_MMA(1, 1, At, B1); PG8_BAR; PG8_SCHED;
            } else {
            PG8_LDB(B0, 0, 0); PG8_SCHED; PG8_LDA(At, 0, 0); PG8_STAGE(PG8_SA(1, 1), a1 + hstep, voffA);
            PG8_WAIT_L(8); PG8_BAR; PG8_WAIT_L(0); PG8_MMA(0, 0, At, B0); PG8_BAR; PG8_SCHED;
            PG8_LDB(B1, 0, 1); PG8_STAGE(PG8_SB(0, 0), b2, voffB);
            PG8_BAR; PG8_WAIT_L(0); PG8_MMA(0, 1, At, B1); PG8_BAR;
            PG8_LDA(At, 0, 1); PG8_STAGE(PG8_SA(0, 0), a2, voffA);
            PG8_BAR; PG8_WAIT_L(0); PG8_MMA(1, 0, At, B0); PG8_BAR; PG8_SCHED;
            PG8_STAGE(PG8_SB(0, 1), b2 + hstep, voffB);
            PG8_WAIT_V(6); PG8_BAR; PG8_MMA(1, 1, At, B1); PG8_BAR;
            PG8_LDB(B0, 1, 0); PG8_SCHED; PG8_LDA(At, 1, 0); PG8_STAGE(PG8_SA(0, 1), a2 + hstep, voffA);
            PG8_WAIT_L(8); PG8_BAR; PG8_WAIT_L(0); PG8_MMA(0, 0, At, B0); PG8_BAR; PG8_SCHED;
            PG8_LDB(B1, 1, 1); PG8_STAGE(PG8_SB(1, 0), b3, voffB);
            PG8_BAR; PG8_WAIT_L(0); PG8_MMA(0, 1, At, B1); PG8_BAR;
            PG8_LDA(At, 1, 1); PG8_STAGE(PG8_SA(1, 0), a3, voffA);
            PG8_BAR; PG8_WAIT_L(0); PG8_MMA(1, 0, At, B0); PG8_BAR; PG8_SCHED;
            PG8_STAGE(PG8_SB(1, 1), b3 + hstep, voffB);
            PG8_WAIT_V(6); PG8_BAR; PG8_MMA(1, 1, At, B1); PG8_BAR;
            }
        }
        if constexpr (ALIGN_EPI) { if (wr == 0) PG8_BAR; }
        if constexpr (!Epi::AFTER_DRAIN) { E(acc, cur, wr, wc, fr, fq); S.done(cur); }
        if (!has_next) break;
#pragma unroll
        for (int a = 0; a < 2; ++a)
#pragma unroll
            for (int b = 0; b < 2; ++b)
#pragma unroll
                for (int m = 0; m < 4; ++m)
#pragma unroll
                    for (int n = 0; n < 2; ++n) acc[a][b][m][n] = (f32x4){0.f, 0.f, 0.f, 0.f};
        cur = nxt; cA = nA; cB = nB; ++ui;
        if constexpr (ALIGN_EPI) { if (wr == 1) PG8_BAR; }
    }
    PG8_WAIT_V(0);
    if constexpr (!ALIGN_EPI) { if (wr == 0) PG8_BAR; }
    PG8_BAR;
    if constexpr (Epi::AFTER_DRAIN) { E.fused(acc, cur, wr, wc, fr, fq, lds, wid, lane); S.done(cur); }
#undef PG8_SA
#undef PG8_SB
#undef PG8_STAGE
#undef PG8_LDA
#undef PG8_LDB
#undef PG8_MMA
#undef PG8_WAIT_V
#undef PG8_WAIT_L
#undef PG8_BAR
#undef PG8_SCHED
}
}

#define GAS __attribute__((address_space(1)))
#define LAS __attribute__((address_space(3)))
typedef unsigned short bf16;
typedef unsigned v4u __attribute__((ext_vector_type(4)));
typedef unsigned v2u __attribute__((ext_vector_type(2)));
typedef float f32x4 __attribute__((ext_vector_type(4)));
typedef GAS unsigned gu32;
#define RLX_AGENT __ATOMIC_RELAXED, __HIP_MEMORY_SCOPE_AGENT
#define LDS_WAIT() asm volatile("s_waitcnt lgkmcnt(0)" ::: "memory")
#define VM_WAIT() asm volatile("s_waitcnt vmcnt(0)" ::: "memory")
__device__ __forceinline__ unsigned f2bf(float f) { unsigned u = __builtin_bit_cast(unsigned, f); return (u + 0x7fffu + ((u >> 16) & 1u)) >> 16; }
typedef float f32x2_t_ __attribute__((ext_vector_type(2))); typedef __bf16 bf16x2_t_ __attribute__((ext_vector_type(2)));
__device__ __forceinline__ unsigned pk2(float lo, float hi) { const f32x2_t_ v = {lo, hi}; const bf16x2_t_ b = __builtin_convertvector(v, bf16x2_t_); return __builtin_bit_cast(unsigned, b); }
__device__ __forceinline__ float bf2f(unsigned short b) { return __builtin_bit_cast(float, (unsigned)b << 16); }
__device__ __forceinline__ float bflo(unsigned w) { return __builtin_bit_cast(float, w << 16); }
__device__ __forceinline__ float bfhi(unsigned w) { return __builtin_bit_cast(float, w & 0xffff0000u); }
__device__ __forceinline__ float sigmoidf_(float x) { return 1.f / (1.f + expf(-x)); }
__device__ __forceinline__ float fsig(float x) { return __builtin_amdgcn_rcpf(1.f + __builtin_amdgcn_exp2f(-1.4426950408889634f * x)); }
__device__ __forceinline__ float siluf_(float x) { return x / (1.f + expf(-x)); }
__device__ __forceinline__ float dppf(float x, const int sel) {
    const int xi = __builtin_bit_cast(int, x); int r;
    if (sel == 0) r = __builtin_amdgcn_update_dpp(xi, xi, 0xB1, 0xF, 0xF, false);
    else if (sel == 1) r = __builtin_amdgcn_update_dpp(xi, xi, 0x4E, 0xF, 0xF, false);
    else if (sel == 2) r = __builtin_amdgcn_update_dpp(xi, xi, 0x141, 0xF, 0xF, false);
    else if (sel == 3) r = __builtin_amdgcn_update_dpp(xi, xi, 0x140, 0xF, 0xF, false);
    else r = __builtin_amdgcn_update_dpp(xi, xi, 0x128, 0xF, 0xF, false);
    return __builtin_bit_cast(float, r);
}
__device__ __forceinline__ float swz16f(float x) { return __builtin_bit_cast(float, __builtin_amdgcn_ds_swizzle(__builtin_bit_cast(int, x), 0x401F)); }
__device__ __forceinline__ float xh_sum(float x) { auto rr = __builtin_amdgcn_permlane32_swap(__float_as_uint(x), __float_as_uint(x), false, false); return __uint_as_float(rr[0]) + __uint_as_float(rr[1]); }
__device__ __forceinline__ float xh_max(float x) { auto rr = __builtin_amdgcn_permlane32_swap(__float_as_uint(x), __float_as_uint(x), false, false); return fmaxf(__uint_as_float(rr[0]), __uint_as_float(rr[1])); }
__device__ __forceinline__ unsigned xh_or(unsigned x) { auto rr = __builtin_amdgcn_permlane32_swap(x, x, false, false); return rr[0] | rr[1]; }
__device__ __forceinline__ float wave_sum(float v) {
    v += dppf(v, 0); v += dppf(v, 1); v += dppf(v, 2); v += dppf(v, 3); v += swz16f(v); return xh_sum(v);
}
__device__ __forceinline__ float wave_max(float v) {
    v = fmaxf(v, dppf(v, 0)); v = fmaxf(v, dppf(v, 1)); v = fmaxf(v, dppf(v, 2)); v = fmaxf(v, dppf(v, 3)); v = fmaxf(v, swz16f(v)); return xh_max(v);
}

constexpr size_t MiB = 1u << 20;
constexpr size_t WS_CTL = 0, CTL_ZERO_BYTES = 1 * MiB;
constexpr size_t WS_COS = 1 * MiB, WS_SIN = 1 * MiB + 512 * 1024;
constexpr size_t WS_LB = 2 * MiB;
constexpr size_t WS_DBON = 3 * MiB;
constexpr size_t WS_DAB = 4 * MiB;
constexpr size_t WS_DSS = 12 * MiB;
constexpr size_t WS_W1T = 16 * MiB;
constexpr size_t WS_WGT = 26 * MiB;
constexpr size_t WS_WBT = 34 * MiB;
constexpr size_t WS_WOT = 36 * MiB;
constexpr size_t WS_KI = 38 * MiB;
constexpr size_t WS_H = 42 * MiB;
constexpr size_t WS_PL = 106 * MiB;
constexpr size_t PLANE = 16 * MiB;
constexpr size_t WS_BF = WS_PL + 17 * PLANE;
constexpr size_t WS_MISC = WS_BF + 32 * MiB;
constexpr size_t WS_OL = WS_MISC + 32 * MiB;
constexpr size_t WS_CC = WS_OL + 16 * MiB;
constexpr size_t WS_BS = WS_CC + 16 * MiB;
constexpr size_t WS_BG = WS_BS + 32 * MiB;
constexpr size_t WS_END = WS_BG + 1 * MiB;
constexpr size_t WS_Y = WS_PL;
constexpr size_t WS_PB = WS_PL + 4 * PLANE;
static_assert(WS_PB + (size_t)4 * NTOK * 1024 * 2 <= WS_OL, "P_b overlay");
enum { PL_AQ = 0, PL_BQ = 1, PL_CQ = 2, PL_DR = 3, PL_AK = 4, PL_AV = 5, PL_AZ = 6, PL_BI = 7, PL_BZ = 8, PL_CK = 9, PL_CV = 10, PL_CZ = 11, PL_CQI0 = 12, PL_CQI1 = 13, PL_DK = 14, PL_DV = 15, PL_DZ = 16 };
#define PLP(ws, i) ((bf16*)((ws) + WS_PL + (size_t)(i) * PLANE))
constexpr int CW_BAR = 4096;

constexpr int RING_BYTES = 131072;
constexpr int LDSCTL_OFF = RING_BYTES, MISC_OFF = LDSCTL_OFF + 320;
constexpr int LDS_BYTES = 147456;

__device__ __forceinline__ int rope_j(int head, int dim) {
    const int bj = head >> 1, wc = ((head & 1) << 1) | ((dim >> 4) & 1), n = dim >> 5, fq = (dim >> 2) & 3, i = dim & 3;
    return 128 * bj + 32 * wc + 16 * n + 4 * fq + i;
}
__device__ __forceinline__ int win_dst_row(int c, int& which) {
    which = 0;
    if (c < 2048) return c;
    if (c < 2304) { const int l = c - 2048; return 8 * 256 + rope_j(l >> 6, l & 63); }
    if (c < 2560) { const int l = c - 2304; return 9 * 256 + rope_j(l >> 6, l & 63); }
    if (c < 3072) return c;
    if (c < 3584) { const int l = c - 3072; return (12 + (l >> 8)) * 256 + rope_j((l >> 6) & 3, l & 63); }
    if (c < 3648) return 14 * 256 + rope_j(0, c - 3584);
    if (c < 3656) return 14 * 256 + 64 + (c - 3648);
    if (c < 3912) return 15 * 256 + (c - 3656);
    if (c < 4168) return 16 * 256 + (c - 3912);
    if (c < 4424) return 17 * 256 + (c - 4168);
    if (c < 4488) return 14 * 256 + 72 + (c - 4424);
    if (c < 4552) return 14 * 256 + 136 + (c - 4488);
    if (c < 4808) return 18 * 256 + (c - 4552);
    which = 1;
    { const int g = c - 4808, br = g >> 10, y = g & 1023, pn = y >> 6, wc = (y >> 4) & 3, fq = (y >> 2) & 3, i = y & 3;
      return 256 * pn + 128 * (br >> 1) + 32 * wc + 16 * (br & 1) + 4 * fq + i; }
}

__device__ __forceinline__ size_t kfrag_off(int bh, int t, int d) { return ((((size_t)bh * 128 + (t >> 5)) * 4 + (d >> 4)) * 64 + ((t & 31) + 32 * ((d >> 3) & 1))) * 8 + (d & 7); }
__device__ __forceinline__ size_t vfrag_off(int bh, int t, int d) { const int kk = t & 31, r16 = kk & 15;
    return (((((size_t)bh * 128 + (t >> 5)) * 2 + (d >> 5)) * 2 + (kk >> 4)) * 64 + ((d & 31) + 32 * ((r16 >> 2) & 1))) * 8 + 4 * (r16 >> 3) + (r16 & 3); }

struct EpiG1 {
    static constexpr bool PERM = false, AFTER_DRAIN = false;
    unsigned char* ws; const float* lbl;
    __device__ __forceinline__ void operator()(const f32x4 (&acc)[2][2][4][2], const pg8::Unit& u, int wr, int wc, int fr, int fq) const {
        asm volatile("" : "+v"(fr), "+v"(fq));
        const int pn = u.pn;
        const int rbase = u.pm * 256 + wr * 64 + fr;
        const int cq = wc * 32 + 4 * fq;
        if (pn == 5) {
            float* BF = (float*)(ws + WS_BF);
#pragma unroll
            for (int bj = 0; bj < 2; ++bj)
#pragma unroll
                for (int n = 0; n < 2; ++n) {
                    const int col = cq + bj * 128 + n * 16;
                    const f32x4 l4 = *(const f32x4*)(lbl + col);
#pragma unroll
                    for (int ai = 0; ai < 2; ++ai)
#pragma unroll
                        for (int m = 0; m < 4; ++m) {
                            const f32x4 x = acc[ai][bj][m][n]; f32x4 o;
#pragma unroll
                            for (int i = 0; i < 4; ++i) o[i] = 1.f - (1.f - l4[i]) * fsig(-x[i]);
                            *(f32x4*)(BF + (size_t)(rbase + ai * 128 + m * 16) * 256 + col) = o;
                            asm volatile("" ::: "memory");
                        }
                }
        } else if (pn == 14) {
            float* MS = (float*)(ws + WS_MISC);
            const float* tcos = (const float*)(ws + WS_COS); const float* tsin = (const float*)(ws + WS_SIN);
#pragma unroll
            for (int bj = 0; bj < 2; ++bj) {
                if (bj == 0 && wc < 2) {
                    const int d0 = 16 * (wc & 1) + 4 * fq;
#pragma unroll
                    for (int ai = 0; ai < 2; ++ai)
#pragma unroll
                        for (int m = 0; m < 4; ++m) {
                            const int row = rbase + ai * 128 + m * 16, pos = row & (SEQ - 1);
                            const f32x4 c4 = *(const f32x4*)(tcos + pos * 32 + d0), s4 = *(const f32x4*)(tsin + pos * 32 + d0);
                            const f32x4 x1 = acc[ai][0][m][0], x2 = acc[ai][0][m][1];
                            const f32x4 y1 = x1 * c4 - x2 * s4, y2 = x2 * c4 + x1 * s4;
                            *(f32x4*)(MS + (size_t)row * 256 + d0) = y1;
                            *(f32x4*)(MS + (size_t)row * 256 + 32 + d0) = y2;
                            bf16* KIp = (bf16*)(ws + WS_KI);
                            v2u w1, w2; w1.x = pk2(y1[0], y1[1]); w1.y = pk2(y1[2], y1[3]); w2.x = pk2(y2[0], y2[1]); w2.y = pk2(y2[2], y2[3]);
                            *(v2u*)(KIp + kfrag_off(row >> 12, pos, d0)) = w1; *(v2u*)(KIp + kfrag_off(row >> 12, pos, 32 + d0)) = w2;
                            asm volatile("" ::: "memory");
                        }
                } else {
#pragma unroll
                    for (int n = 0; n < 2; ++n)
#pragma unroll
                        for (int ai = 0; ai < 2; ++ai)
#pragma unroll
                            for (int m = 0; m < 4; ++m)
                                *(f32x4*)(MS + (size_t)(rbase + ai * 128 + m * 16) * 256 + cq + bj * 128 + n * 16) = acc[ai][bj][m][n];
                }
            }
        } else {
            const unsigned long long lo = 0ull | (0ull << 0) | (4ull << 5) | (5ull << 10) | (6ull << 15) | (1ull << 20) | (0ull << 25) | (7ull << 30) | (8ull << 35) | (2ull << 40) | (9ull << 45) | (10ull << 50) | (11ull << 55);
            const unsigned long long hi = (12ull << 0) | (13ull << 5) | (0ull << 10) | (3ull << 15) | (14ull << 20) | (15ull << 25) | (16ull << 30);
            const int plane = (int)((pn < 12 ? (lo >> (5 * pn)) : (hi >> (5 * (pn - 12)))) & 31ull);
            bf16* PLN = PLP(ws, plane);
            if (pn == 8 || pn == 9 || pn == 12 || pn == 13) {
                const float* tcos = (const float*)(ws + WS_COS); const float* tsin = (const float*)(ws + WS_SIN);
                const int d0 = 16 * (wc & 1) + 4 * fq;
#pragma unroll
                for (int ai = 0; ai < 2; ++ai)
#pragma unroll
                    for (int m = 0; m < 4; ++m) {
                        const int row = rbase + ai * 128 + m * 16, pos = row & (SEQ - 1);
                        const f32x4 c4 = *(const f32x4*)(tcos + pos * 32 + d0), s4 = *(const f32x4*)(tsin + pos * 32 + d0);
#pragma unroll
                        for (int bj = 0; bj < 2; ++bj) {
                            const int head = 2 * bj + (wc >> 1);
                            const f32x4 x1 = acc[ai][bj][m][0], x2 = acc[ai][bj][m][1];
                            const f32x4 y1 = x1 * c4 - x2 * s4, y2 = x2 * c4 + x1 * s4;
                            v2u w1, w2; w1.x = pk2(y1[0], y1[1]); w1.y = pk2(y1[2], y1[3]); w2.x = pk2(y2[0], y2[1]); w2.y = pk2(y2[2], y2[3]);
                            if (pn == 9) {
                                const int bh = (row >> 12) * 4 + head;
                                *(v2u*)(PLN + kfrag_off(bh, pos, d0)) = w1; *(v2u*)(PLN + kfrag_off(bh, pos, 32 + d0)) = w2;
                            } else {
                                *(v2u*)(PLN + (size_t)row * 256 + head * 64 + d0) = w1;
                                *(v2u*)(PLN + (size_t)row * 256 + head * 64 + 32 + d0) = w2;
                            }
                        }
                        asm volatile("" ::: "memory");
                    }
            } else if (pn == 2 || pn == 10) {
#pragma unroll
                for (int ai = 0; ai < 2; ++ai)
#pragma unroll
                    for (int m = 0; m < 4; ++m) {
                        const int row = rbase + ai * 128 + m * 16, bb = row >> 12, tq = row & (SEQ - 1);
#pragma unroll
                        for (int bj = 0; bj < 2; ++bj)
#pragma unroll
                            for (int n = 0; n < 2; ++n) {
                                const f32x4 x = acc[ai][bj][m][n]; const int col = cq + bj * 128 + n * 16;
                                bf16* p = PLN + vfrag_off(bb * 4 + (col >> 6), tq, col & 63);
#pragma unroll
                                for (int i = 0; i < 4; ++i) p[8 * i] = (bf16)f2bf(x[i]);
                            }
                        asm volatile("" ::: "memory");
                    }
            } else if (pn == 1) {
#pragma unroll
                for (int ai = 0; ai < 2; ++ai)
#pragma unroll
                    for (int m = 0; m < 4; ++m) {
                        const int row = rbase + ai * 128 + m * 16, bb = row >> 12, tq = row & (SEQ - 1);
#pragma unroll
                        for (int bj = 0; bj < 2; ++bj)
#pragma unroll
                            for (int n = 0; n < 2; ++n) {
                                const f32x4 x = acc[ai][bj][m][n]; const int col = cq + bj * 128 + n * 16;
                                v2u w; w.x = pk2(x[0], x[1]); w.y = pk2(x[2], x[3]);
                                *(v2u*)(PLN + kfrag_off(bb * 4 + (col >> 6), tq, col & 63)) = w;
                            }
                        asm volatile("" ::: "memory");
                    }
            } else if (pn == 4) {
#pragma unroll
                for (int ai = 0; ai < 2; ++ai)
#pragma unroll
                    for (int m = 0; m < 4; ++m) {
                        bf16* rowp = PLN + (size_t)(rbase + ai * 128 + m * 16) * 256 + cq;
#pragma unroll
                        for (int bj = 0; bj < 2; ++bj)
#pragma unroll
                            for (int n = 0; n < 2; ++n) {
                                f32x4 x = acc[ai][bj][m][n];
#pragma unroll
                                for (int i = 0; i < 4; ++i) x[i] = x[i] * fsig(x[i]);
                                v2u w; w.x = pk2(x[0], x[1]); w.y = pk2(x[2], x[3]);
                                *(v2u*)(rowp + bj * 128 + n * 16) = w;
                            }
                        asm volatile("" ::: "memory");
                    }
            } else {
#pragma unroll
                for (int ai = 0; ai < 2; ++ai)
#pragma unroll
                    for (int m = 0; m < 4; ++m) {
                        bf16* rowp = PLN + (size_t)(rbase + ai * 128 + m * 16) * 256 + cq;
#pragma unroll
                        for (int bj = 0; bj < 2; ++bj)
#pragma unroll
                            for (int n = 0; n < 2; ++n) {
                                const f32x4 x = acc[ai][bj][m][n];
                                v2u w; w.x = pk2(x[0], x[1]); w.y = pk2(x[2], x[3]);
                                *(v2u*)(rowp + bj * 128 + n * 16) = w;
                            }
                        asm volatile("" ::: "memory");
                    }
            }
        }
    }
};
struct EpiBf {
    static constexpr bool PERM = false, AFTER_DRAIN = false;
    bf16* O; int ldc;
    __device__ __forceinline__ void operator()(const f32x4 (&acc)[2][2][4][2], const pg8::Unit& u, int wr, int wc, int fr, int fq) const {
        asm volatile("" : "+v"(fr), "+v"(fq));
        const int rbase = u.pm * 256 + wr * 64 + fr, cb = u.pn * 256 + wc * 32 + 4 * fq;
#pragma unroll
        for (int ai = 0; ai < 2; ++ai)
#pragma unroll
            for (int m = 0; m < 4; ++m) {
                bf16* rowp = O + (size_t)(rbase + ai * 128 + m * 16) * ldc + cb;
#pragma unroll
                for (int bj = 0; bj < 2; ++bj)
#pragma unroll
                    for (int n = 0; n < 2; ++n) { const f32x4 x = acc[ai][bj][m][n]; v2u w; w.x = pk2(x[0], x[1]); w.y = pk2(x[2], x[3]); *(v2u*)(rowp + bj * 128 + n * 16) = w; }
            }
    }
};
struct EpiGate {
    static constexpr bool PERM = false, AFTER_DRAIN = false;
    const bf16* PB; bf16* Y;
    __device__ __forceinline__ void operator()(const f32x4 (&acc)[2][2][4][2], const pg8::Unit& u, int wr, int wc, int fr, int fq) const {
        asm volatile("" : "+v"(fr), "+v"(fq));
        const int rbase = u.pm * 256 + wr * 64 + fr, yc = u.pn * 64 + wc * 16 + 4 * fq;
#pragma unroll
        for (int ai = 0; ai < 2; ++ai)
#pragma unroll
            for (int m = 0; m < 4; ++m) {
                const size_t row = (size_t)(rbase + ai * 128 + m * 16);
                f32x4 y = (f32x4){0.f, 0.f, 0.f, 0.f};
#pragma unroll
                for (int br = 0; br < 4; ++br) {
                    const v2u pw = *(const v2u*)(PB + ((size_t)br * NTOK + row) * 1024 + yc);
                    const f32x4 g = acc[ai][br >> 1][m][br & 1];
                    y[0] += bflo(pw.x) * fsig(g[0]); y[1] += bfhi(pw.x) * fsig(g[1]);
                    y[2] += bflo(pw.y) * fsig(g[2]); y[3] += bfhi(pw.y) * fsig(g[3]);
                }
                v2u w; w.x = pk2(y[0], y[1]); w.y = pk2(y[2], y[3]);
                *(v2u*)(Y + row * 1024 + yc) = w;
                asm volatile("" ::: "memory");
            }
    }
};
struct EpiRes {
    static constexpr bool PERM = false, AFTER_DRAIN = false;
    const float* R; float* O;
    __device__ __forceinline__ void operator()(const f32x4 (&acc)[2][2][4][2], const pg8::Unit& u, int wr, int wc, int fr, int fq) const {
        asm volatile("" : "+v"(fr), "+v"(fq));
        const int rbase = u.pm * 256 + wr * 64 + fr, cb = u.pn * 256 + wc * 32 + 4 * fq;
#pragma unroll
        for (int ai = 0; ai < 2; ++ai)
#pragma unroll
            for (int m = 0; m < 4; ++m) {
                const size_t off = (size_t)(rbase + ai * 128 + m * 16) * 1024 + cb;
#pragma unroll
                for (int bj = 0; bj < 2; ++bj)
#pragma unroll
                    for (int n = 0; n < 2; ++n) { const f32x4 r = *(const f32x4*)(R + off + bj * 128 + n * 16); *(f32x4*)(O + off + bj * 128 + n * 16) = r + acc[ai][bj][m][n]; }
            }
    }
};
#define XB_TMO      128
#define XB_XCNT(j)  (256  + 64 * (j))
#define XB_XSUB(j)  (1280 + 64 * (j))
#define XB_XGEN(j)  (2304 + 64 * (j))
#define XB_TOP      3328
#define XB_TOPGEN   3392
#define XCD_BAR_WORDS 3456
#define XB_SPIN_CAP (1u << 18)

__device__ __forceinline__ unsigned xb_ld(unsigned* p)              { return __hip_atomic_load(p, __ATOMIC_RELAXED, __HIP_MEMORY_SCOPE_AGENT); }
__device__ __forceinline__ unsigned xb_add(unsigned* p, unsigned v) { return __hip_atomic_fetch_add(p, v, __ATOMIC_RELAXED, __HIP_MEMORY_SCOPE_AGENT); }
__device__ __forceinline__ unsigned xb_xcc_id() { return (unsigned)__builtin_amdgcn_s_getreg((3 << 11) | 20) & 0xFu; }
#define XB_SPIN(cond, bar) do { unsigned _sp = 0; while (cond) { __builtin_amdgcn_s_sleep(1); \
    if ((++_sp & 255u) == 0u) { if (xb_ld(&(bar)[XB_TMO])) break; if (_sp > XB_SPIN_CAP) { atomicAdd(&(bar)[XB_TMO], 1u); break; } } } } while (0)

struct XcdBarrier {
    unsigned* bar; unsigned x;
    volatile LAS unsigned* st;
};

__device__ __forceinline__ XcdBarrier xcd_barrier_post(unsigned* bar, volatile LAS unsigned* st) {
    XcdBarrier b; b.bar = bar; b.x = xb_xcc_id(); b.st = st;
    if (threadIdx.x == 0) (void)xb_add(&bar[XB_XCNT(b.x)], 1u);
    return b;
}
__device__ __forceinline__ void xcd_barrier_complete(unsigned* bar, unsigned x, unsigned& nloc, unsigned& nx) {
    const unsigned G = gridDim.x * gridDim.y * gridDim.z;
    unsigned sum, cnt, mine, sp = 0u;
    for (;;) {
        sum = 0u; cnt = 0u; mine = 0u;
#pragma unroll
        for (unsigned j = 0; j < 16; ++j) { const unsigned c = xb_ld(&bar[XB_XCNT(j)]); sum += c; cnt += (c > 0u) ? 1u : 0u; mine = (j == x) ? c : mine; }
        if (sum == G) break;
        __builtin_amdgcn_s_sleep(1);
        if ((++sp & 255u) == 0u) { if (xb_ld(&bar[XB_TMO])) break; if (sp > XB_SPIN_CAP) { atomicAdd(&bar[XB_TMO], 1u); break; } }
    }
    nloc = mine > 0u ? mine : 1u; nx = cnt > 0u ? cnt : 1u;
}

__device__ __forceinline__ void xcd_barrier(const XcdBarrier& b_in, const bool t0) {
    XcdBarrier b = b_in; asm volatile("" : "+s"(b.bar), "+s"(b.x));
    asm volatile("s_waitcnt vmcnt(0)" ::: "memory");
    __syncthreads();
    if (t0) {
        unsigned* bar = b.bar;
        __builtin_amdgcn_s_waitcnt(0);
        unsigned nloc = b.st[0], nx = b.st[1];
        if (nloc == 0u) { xcd_barrier_complete(bar, b.x, nloc, nx); b.st[0] = nloc; b.st[1] = nx; }
        const unsigned old = xb_add(&bar[XB_XSUB(b.x)], 1u);
        const unsigned gen = old / nloc;
        if (old + 1u == (gen + 1u) * nloc) {
            __builtin_amdgcn_fence(__ATOMIC_RELEASE, "agent");
            asm volatile("s_waitcnt vmcnt(0)" ::: "memory");
            const unsigned og = xb_add(&bar[XB_TOP], 1u);
            const unsigned tg = og / nx;
            if (og + 1u == (tg + 1u) * nx) xb_add(&bar[XB_TOPGEN], 1u);
            else XB_SPIN(xb_ld(&bar[XB_TOPGEN]) == tg, bar);
            __builtin_amdgcn_fence(__ATOMIC_ACQUIRE, "agent");
            xb_add(&bar[XB_XGEN(b.x)], 1u);
            asm volatile("s_waitcnt vmcnt(0)" ::: "memory");
        } else {
            XB_SPIN(xb_ld(&bar[XB_XGEN(b.x)]) == gen, bar);
            __builtin_amdgcn_fence(__ATOMIC_ACQUIRE, "agent");
            asm volatile("s_waitcnt vmcnt(0)" ::: "memory");
        }
    }
    __syncthreads();
}

struct Params { const float* in[19]; float* out; unsigned char* ws; };
struct Ctx {
    LAS unsigned char* lds; int tid, lane, wave, G, bid;
};
__device__ __forceinline__ int lane_id_fresh() { int l; asm volatile("v_mbcnt_lo_u32_b32 %0, -1, 0\n\tv_mbcnt_hi_u32_b32 %0, -1, %0" : "=v"(l)); return l; }
#define OPQ(C) do { (C).lane = lane_id_fresh(); (C).tid = (C).wave * 64 + (C).lane; } while (0)

template <class MapFn>
__device__ __forceinline__ void transpose_item(const float* W, int K, int N, LAS float* scr, int item, int lane, MapFn map) {
    const int nblk = (N + 31) / 32, kb = item / nblk, nb = item % nblk, k0 = 64 * kb, n0 = 32 * nb;
    const int ncol = n0 + (lane & 31);
#pragma unroll 8
    for (int i = 0; i < 32; ++i) { const int kk = 2 * i + (lane >> 5); scr[kk * 33 + (lane & 31)] = (ncol < N) ? W[(size_t)(k0 + kk) * N + ncol] : 0.f; }
    LDS_WAIT(); asm volatile("" ::: "memory");
    const int c = lane & 7;
#pragma unroll
    for (int j = 0; j < 4; ++j) {
        const int n = (lane >> 3) + 8 * j; const LAS float* s = scr + (8 * c) * 33 + n;
        v4u o; o.x = pk2(s[0 * 33], s[1 * 33]); o.y = pk2(s[2 * 33], s[3 * 33]); o.z = pk2(s[4 * 33], s[5 * 33]); o.w = pk2(s[6 * 33], s[7 * 33]);
        if (n0 + n < N) { bf16* dst = map(n0 + n); *(v4u*)(dst + k0 + 8 * c) = o; }
    }
    LDS_WAIT(); asm volatile("" ::: "memory");
}
__device__ __forceinline__ void convert_weights(Ctx C, const Params& P, int l) {
    OPQ(C);
    LAS float* scr = (LAS float*)(C.lds + C.wave * 16384);
    const int gw = C.bid * 8 + C.wave, NGW = C.G * 8;
    unsigned char* ws = P.ws;
    bf16* W1t = (bf16*)(ws + WS_W1T); bf16* Wgt = (bf16*)(ws + WS_WGT);
    bf16* Wbt = (bf16*)(ws + WS_WBT); bf16* Wot = (bf16*)(ws + WS_WOT);
    const float* w_in = P.in[2] + (size_t)l * 1024 * INC; const float* w_br = P.in[16] + (size_t)l * 4 * 256 * 1024; const float* w_out = P.in[17] + (size_t)l * 1024 * 1024;
    constexpr int I_IN = 16 * ((INC + 31) / 32), I_BR = 4 * 32, I_OUT = 16 * 32;
    constexpr int NITEMS = I_IN + 4 * I_BR + I_OUT;
    for (int it = gw; it < NITEMS; it += NGW) {
        int r = it;
        if (r < I_IN) { transpose_item(w_in, 1024, INC, scr, r, C.lane, [&](int c) -> bf16* { int which; const int row = win_dst_row(c, which); return (which ? Wgt : W1t) + (size_t)row * 1024; }); continue; }
        r -= I_IN;
        if (r < 4 * I_BR) { const int br = r / I_BR, ri = r % I_BR; transpose_item(w_br + (size_t)br * 256 * 1024, 256, 1024, scr, ri, C.lane, [&](int c) -> bf16* { return Wbt + ((size_t)br * 1024 + c) * 256; }); continue; }
        r -= 4 * I_BR;
        transpose_item(w_out, 1024, 1024, scr, r, C.lane, [&](int c) -> bf16* { return Wot + (size_t)c * 1024; });
    }
    for (int i = C.bid * 512 + C.tid; i < 56 * 1024 / 8; i += C.G * 512) *(v4u*)(W1t + (size_t)(14 * 256 + 200) * 1024 + (size_t)i * 8) = (v4u){0u, 0u, 0u, 0u};
}
__device__ __forceinline__ void rms_row(const float* xrow, const float* g, bf16* obf, float* of32, int lane) {
    const f32x4* xr = (const f32x4*)xrow + lane;
    f32x4 v[4]; float s = 0.f;
#pragma unroll
    for (int j = 0; j < 4; ++j) { v[j] = xr[64 * j]; s += (v[j].x * v[j].x + v[j].y * v[j].y) + (v[j].z * v[j].z + v[j].w * v[j].w); }
    const float inv = rsqrtf(wave_sum(s) * (1.f / 1024.f) + 1e-6f);
#pragma unroll
    for (int j = 0; j < 4; ++j) {
        const f32x4 gg = ((const f32x4*)g)[lane + 64 * j];
        const f32x4 o = v[j] * inv * gg;
        if (obf) { v2u w; w.x = pk2(o.x, o.y); w.y = pk2(o.z, o.w); ((v2u*)obf)[lane + 64 * j] = w; }
        else ((f32x4*)of32)[lane + 64 * j] = o;
    }
}
__device__ __forceinline__ void norm_rows_bf16(Ctx C, const float* x, const float* g, bf16* h) {
    OPQ(C);
    const int gw = C.bid * 8 + C.wave, NGW = C.G * 8;
    for (int m = gw; m < NTOK; m += NGW) rms_row(x + (size_t)m * 1024, g, h + (size_t)m * 1024, nullptr, C.lane);
}
__device__ __forceinline__ void setup_tables(Ctx C, const Params& P) {
    OPQ(C);
    float* tcos = (float*)(P.ws + WS_COS); float* tsin = (float*)(P.ws + WS_SIN); float* lb = (float*)(P.ws + WS_LB);
    for (int i = C.bid * 512 + C.tid; i < SEQ * 32; i += C.G * 512) {
        const int pos = i >> 5, j = i & 31;
        const float freq = (float)pow(10000.0, -(double)j / 32.0);
        const float ang = (float)pos * freq;
        tcos[i] = (float)cos((double)ang); tsin[i] = (float)sin((double)ang);
    }
    if (C.bid == 0 && C.tid < 256) {
        const float l0 = P.in[4][C.tid], l1 = P.in[4][256 + C.tid];
        lb[C.tid] = 0.f; lb[256 + C.tid] = 1.f / (1.f + expf(l0 - l1));
    }
}

__device__ __forceinline__ void mixA_simple(Ctx C, unsigned char* ws, const float* bias) {
    OPQ(C);
    bf16* AQ = PLP(ws, PL_AQ); const bf16* AK = PLP(ws, PL_AK); const bf16* AV = PLP(ws, PL_AV); const bf16* AZ = PLP(ws, PL_AZ);
    for (int it = C.bid * 512 + C.tid; it < 4 * NTOK; it += C.G * 512) {
        const int h = it / NTOK, m = it % NTOK, b = m >> 12, t = m & 4095, c = t >> 6, qi = t & 63;
        float q[64], o[64];
        {
            const v4u* qp = (const v4u*)(AQ + (size_t)m * 256 + h * 64);
#pragma unroll
            for (int j = 0; j < 8; ++j) { const v4u w = qp[j]; q[8 * j] = bflo(w.x); q[8 * j + 1] = bfhi(w.x); q[8 * j + 2] = bflo(w.y); q[8 * j + 3] = bfhi(w.y); q[8 * j + 4] = bflo(w.z); q[8 * j + 5] = bfhi(w.z); q[8 * j + 6] = bflo(w.w); q[8 * j + 7] = bfhi(w.w); }
        }
#pragma unroll
        for (int d = 0; d < 64; ++d) o[d] = 0.f;
        float mx = -INFINITY, l = 0.f;
        const float* bh = bias + h * 192;
        for (int kj = 0; kj < 576; ++kj) {
            const int kp = c * 64 - 512 + kj;
            if (kp < 0) continue;
            const size_t mk = ((size_t)b << 12) + kp;
            const v4u* kr = (const v4u*)(AK + mk * 256 + h * 64); const v4u* vr = (const v4u*)(AV + mk * 256 + h * 64);
            float s = 0.f;
#pragma unroll
            for (int j = 0; j < 8; ++j) { const v4u w = kr[j];
                s = fmaf(q[8 * j], bflo(w.x), s); s = fmaf(q[8 * j + 1], bfhi(w.x), s); s = fmaf(q[8 * j + 2], bflo(w.y), s); s = fmaf(q[8 * j + 3], bfhi(w.y), s);
                s = fmaf(q[8 * j + 4], bflo(w.z), s); s = fmaf(q[8 * j + 5], bfhi(w.z), s); s = fmaf(q[8 * j + 6], bflo(w.w), s); s = fmaf(q[8 * j + 7], bfhi(w.w), s); }
            int rel = qi + 512 - kj; rel = rel < -63 ? -63 : (rel > 128 ? 128 : rel);
            s = s * 0.125f + bh[rel + 63];
            const float mn = fmaxf(mx, s), al = expf(mx - mn), pe = expf(s - mn);
            l = l * al + pe; mx = mn;
#pragma unroll
            for (int j = 0; j < 8; ++j) { const v4u w = vr[j];
                o[8 * j] = fmaf(pe, bflo(w.x), o[8 * j] * al); o[8 * j + 1] = fmaf(pe, bfhi(w.x), o[8 * j + 1] * al); o[8 * j + 2] = fmaf(pe, bflo(w.y), o[8 * j + 2] * al); o[8 * j + 3] = fmaf(pe, bfhi(w.y), o[8 * j + 3] * al);
                o[8 * j + 4] = fmaf(pe, bflo(w.z), o[8 * j + 4] * al); o[8 * j + 5] = fmaf(pe, bfhi(w.z), o[8 * j + 5] * al); o[8 * j + 6] = fmaf(pe, bflo(w.w), o[8 * j + 6] * al); o[8 * j + 7] = fmaf(pe, bfhi(w.w), o[8 * j + 7] * al); }
        }
        const float invl = 1.f / l;
        const v4u* zp = (const v4u*)(AZ + (size_t)m * 256 + h * 64); v4u* op = (v4u*)(AQ + (size_t)m * 256 + h * 64);
#pragma unroll
        for (int j = 0; j < 8; ++j) { const v4u z = zp[j]; v4u w;
            w.x = pk2(o[8 * j] * invl * siluf_(bflo(z.x)), o[8 * j + 1] * invl * siluf_(bfhi(z.x))); w.y = pk2(o[8 * j + 2] * invl * siluf_(bflo(z.y)), o[8 * j + 3] * invl * siluf_(bfhi(z.y)));
            w.z = pk2(o[8 * j + 4] * invl * siluf_(bflo(z.z)), o[8 * j + 5] * invl * siluf_(bfhi(z.z))); w.w = pk2(o[8 * j + 6] * invl * siluf_(bflo(z.w)), o[8 * j + 7] * invl * siluf_(bfhi(z.w)));
            op[j] = w; }
    }
}
__device__ __forceinline__ void mixB_simple(Ctx C, unsigned char* ws, const float* normg) {
    OPQ(C);
    if (C.bid < 32 || C.bid >= 36) return;
    const int gw = (C.bid - 32) * 8 + C.wave;
    const int b = gw >> 2, h = gw & 3, v = C.lane;
    bf16* BQ = PLP(ws, PL_BQ); const bf16* BI = PLP(ws, PL_BI); const bf16* BZ = PLP(ws, PL_BZ); const float* BF = (const float*)(ws + WS_BF);
    float S[64];
#pragma unroll
    for (int d = 0; d < 64; ++d) S[d] = 0.f;
    const float g = normg[v];
    for (int t = 0; t < SEQ; ++t) {
        const size_t m = ((size_t)b << 12) + t;
        const float* fr = BF + m * 256 + h * 64; const bf16* qr = BQ + m * 256 + h * 64;
        const float iv = bf2f(BI[m * 256 + h * 64 + v]); const float z = bf2f(BZ[m * 256 + h * 64 + v]);
        float o = 0.f;
#pragma unroll
        for (int d = 0; d < 64; ++d) { S[d] = fmaf(fr[d], S[d] - iv, iv); o = fmaf(bf2f(qr[d]), S[d], o); }
        const float r = rsqrtf(wave_sum(o * o) * (1.f / 64.f) + 1e-6f);
        asm volatile("" ::: "memory");
        BQ[m * 256 + h * 64 + v] = (bf16)f2bf(o * r * g * siluf_(z));
    }
}
__device__ __forceinline__ void mixD_simple(Ctx C, unsigned char* ws, const Params& P, int l) {
    OPQ(C);
    if (C.bid >= 32) return;
    const int b = C.bid >> 2, h = C.bid & 3, tid = C.tid;
    bf16* DR = PLP(ws, PL_DR); const bf16* DK = PLP(ws, PL_DK); const bf16* DV = PLP(ws, PL_DV); const bf16* DZ = PLP(ws, PL_DZ); const float* MS = (const float*)(ws + WS_MISC);
    const float* mu = P.in[6] + l * 896; const float* w0 = P.in[7] + l * 256; const float* w_up = P.in[8] + (size_t)l * 64 * 256; const float* a0 = P.in[9] + l * 256;
    const float* a_up = P.in[10] + (size_t)l * 64 * 256; const float* k_k = P.in[11] + l * 256; const float* k_a = P.in[12] + l * 256; const float* r_k = P.in[13] + l * 256;
    const float* gn_g = P.in[14] + l * 256; const float* gn_b = P.in[15] + l * 256;
    LAS float* L = (LAS float*)C.lds;
    LAS float* twd = L; LAS float* ads = L + 64; LAS float* rs = L + 128; LAS float* kr = L + 192; LAS float* vs = L + 256;
    LAS float* wv = L + 320; LAS float* av = L + 384; LAS float* kkv = L + 448; LAS float* kfv = L + 512; LAS float* bv = L + 576; LAS float* ob = L + 640; LAS float* bon = L + 704;
    const int v = tid >> 3, ks = tid & 7;
    float S[8];
#pragma unroll
    for (int i = 0; i < 8; ++i) S[i] = 0.f;
    const int grp = tid >> 6, cc = tid & 63;
    float prev = 0.f, mucol = 0.f;
    if (grp == 0) mucol = mu[768 + cc]; else if (grp == 1) mucol = mu[832 + cc]; else if (grp == 2) mucol = mu[h * 64 + cc]; else if (grp == 3) mucol = mu[256 + h * 64 + cc]; else if (grp == 4) mucol = mu[512 + h * 64 + cc];
    for (int t = 0; t < SEQ; ++t) {
        const size_t m = ((size_t)b << 12) + t;
        if (grp < 5) {
            float cur;
            if (grp == 0) cur = MS[m * 256 + 72 + cc]; else if (grp == 1) cur = MS[m * 256 + 136 + cc];
            else if (grp == 2) cur = bf2f(DR[m * 256 + h * 64 + cc]); else if (grp == 3) cur = bf2f(DK[m * 256 + h * 64 + cc]); else cur = bf2f(DV[m * 256 + h * 64 + cc]);
            const float sh = cur + mucol * (prev - cur); prev = cur;
            if (grp == 0) twd[cc] = tanhf(sh); else if (grp == 1) ads[cc] = sh; else if (grp == 2) rs[cc] = sh; else if (grp == 3) kr[cc] = sh; else vs[cc] = sh;
        }
        __syncthreads();
        if (tid < 128) {
            const int c = tid & 63, hc = h * 64 + c;
            if (tid < 64) { float wl = w0[hc];
_Pragma("nounroll")
                for (int i = 0; i < 64; ++i) wl = fmaf(twd[i], w_up[i * 256 + hc], wl);
                const float x = -wl; const float sp = fmaxf(x, 0.f) + log1pf(expf(-fabsf(x))); wv[c] = expf(-expf(-sp - 0.5f)); }
            else { float al = a0[hc];
_Pragma("nounroll")
                for (int i = 0; i < 64; ++i) al = fmaf(ads[i], a_up[i * 256 + hc], al); av[c] = sigmoidf_(al); }
        }
        __syncthreads();
        if (tid < 64) {
            const int hc = h * 64 + tid; const float kx = kr[tid], a = av[tid];
            const float kkr = kx * k_k[hc]; const float nrm = sqrtf(wave_sum(kkr * kkr)); const float kk = kkr / fmaxf(nrm, 1e-12f);
            const float kf = kx * (1.f + (a - 1.f) * k_a[hc]);
            kkv[tid] = kk; kfv[tid] = kf; bv[tid] = kk * a;
            const float bsum = wave_sum(rs[tid] * kf * r_k[hc]); if (tid == 0) bon[0] = bsum;
        }
        __syncthreads();
        {
            float sa = 0.f;
#pragma unroll
            for (int i = 0; i < 8; ++i) sa = fmaf(S[i], kkv[8 * ks + i], sa);
            sa += __shfl_xor(sa, 1); sa += __shfl_xor(sa, 2); sa += __shfl_xor(sa, 4); sa = -sa;
            const float vv = vs[v]; float o = 0.f;
#pragma unroll
            for (int i = 0; i < 8; ++i) { S[i] = fmaf(S[i], wv[8 * ks + i], fmaf(sa, bv[8 * ks + i], vv * kfv[8 * ks + i])); o = fmaf(S[i], rs[8 * ks + i], o); }
            o += __shfl_xor(o, 1); o += __shfl_xor(o, 2); o += __shfl_xor(o, 4);
            if (ks == 0) ob[v] = o;
        }
        __syncthreads();
        if (tid < 64) {
            const int hc = h * 64 + tid; const float o = ob[tid];
            const float mean = wave_sum(o) * (1.f / 64.f); const float d = o - mean; const float var = wave_sum(d * d) * (1.f / 64.f);
            float y = d * rsqrtf(var + 64e-5f) * gn_g[hc] + gn_b[hc];
            y += bon[0] * vs[tid];
            const float z = bf2f(DZ[m * 256 + hc]);
            DR[m * 256 + hc] = (bf16)f2bf(y * siluf_(z));
        }
        __syncthreads();
    }
}
__device__ __forceinline__ void mixC_simple(Ctx C, unsigned char* ws) {
    OPQ(C);
    bf16* CQ = PLP(ws, PL_CQ); const bf16* CK = PLP(ws, PL_CK); const bf16* CV = PLP(ws, PL_CV); const bf16* CZ = PLP(ws, PL_CZ);
    const bf16* QI0 = PLP(ws, PL_CQI0); const bf16* QI1 = PLP(ws, PL_CQI1); const float* MS = (const float*)(ws + WS_MISC);
    LAS float* L = (LAS float*)C.lds;
    LAS float* qs = L;
    LAS float* q4 = L + 512;
    LAS float* wq = L + 768;
    LAS float* sc = L + 1024;
    LAS float* ps = L + 5120;
    LAS int* sel = (LAS int*)(L + 6144);
    LAS unsigned* hist = (LAS unsigned*)(L + 6400);
    LAS float* red = L + 6656;
    LAS unsigned* sw = (LAS unsigned*)(L + 6672);
    const int tid = C.tid;
    for (int m = C.bid; m < NTOK; m += C.G) {
        const int b = m >> 12, t = m & 4095, n = ((t >> 6) + 1) * 64;
        qs[tid] = bf2f(tid < 256 ? QI0[(size_t)m * 256 + tid] : QI1[(size_t)m * 256 + tid - 256]);
        if (tid < 256) q4[tid] = bf2f(CQ[(size_t)m * 256 + tid]);
        if (tid < 8) wq[tid] = MS[(size_t)m * 256 + 64 + tid] * 0.35355339059327373f;
        __syncthreads();
        for (int s = tid; s < n; s += 512) {
            const f32x4* kp = (const f32x4*)(MS + (((size_t)b << 12) + s) * 256);
            float kv[64];
#pragma unroll
            for (int j = 0; j < 16; ++j) { const f32x4 w = kp[j]; kv[4 * j] = w.x; kv[4 * j + 1] = w.y; kv[4 * j + 2] = w.z; kv[4 * j + 3] = w.w; }
            float acc = 0.f;
            for (int hh = 0; hh < 8; ++hh) {
                float d = 0.f;
#pragma unroll
                for (int c = 0; c < 64; ++c) d = fmaf(qs[hh * 64 + c], kv[c], d);
                d = fmaxf(d * 0.125f, 0.f);
                acc = fmaf(d, wq[hh], acc);
            }
            sc[s] = acc;
        }
        __syncthreads();
        int cnt;
        if (n <= 256) { if (tid < n) sel[tid] = tid; cnt = n; }
        else {
            unsigned key[8];
#pragma unroll
            for (int j = 0; j < 8; ++j) { const int idx = tid + 512 * j; unsigned kk = 0u; if (idx < n) { const unsigned u = __float_as_uint(sc[idx]); kk = (u & 0x80000000u) ? ~u : (u | 0x80000000u); } key[j] = kk; }
            if (tid == 0) { sw[0] = 0u; sw[1] = 256u; sw[3] = 0u; }
            unsigned mask = 0u;
            for (int pass = 3; pass >= 0; --pass) {
                const int shift = pass * 8;
                if (tid < 256) hist[tid] = 0u;
                __syncthreads();
                const unsigned prefix = sw[0];
#pragma unroll
                for (int j = 0; j < 8; ++j) { const int idx = tid + 512 * j; if (idx < n && (key[j] & mask) == prefix) atomicAdd((unsigned*)&hist[(key[j] >> shift) & 255u], 1u); }
                __syncthreads();
                if (tid == 0) { const unsigned k = sw[1]; unsigned c = 0u; int bb = 255; for (; bb > 0; --bb) { if (c + hist[bb] >= k) break; c += hist[bb]; }
                    sw[1] = k - c; sw[0] = prefix | ((unsigned)bb << shift); sw[2] = hist[bb]; }
                mask |= (0xFFu << shift);
                __syncthreads();
            }
            const unsigned thr = sw[0], need = sw[1], eqc = sw[2];
            if (tid == 0) { int cut = SEQ;
                if (eqc != need) { unsigned c = 0u; for (int i = 0; i < n; ++i) { const unsigned u = __float_as_uint(sc[i]); const unsigned kk = (u & 0x80000000u) ? ~u : (u | 0x80000000u); if (kk == thr) { ++c; if (c == need) { cut = i; break; } } } }
                sw[4] = (unsigned)cut; }
            __syncthreads();
            const int cut = (int)sw[4];
#pragma unroll
            for (int j = 0; j < 8; ++j) { const int idx = tid + 512 * j; if (idx < n && (key[j] > thr || (key[j] == thr && idx <= cut))) { const unsigned pos = atomicAdd((unsigned*)&sw[3], 1u); if (pos < 256u) sel[pos] = idx; } }
            cnt = 256;
        }
        __syncthreads();
        float s4[4] = {-INFINITY, -INFINITY, -INFINITY, -INFINITY};
        if (tid < cnt) {
            const v4u* kr = (const v4u*)(CK + (((size_t)b << 12) + sel[tid]) * 256);
#pragma unroll
            for (int hh = 0; hh < 4; ++hh) { float d = 0.f;
#pragma unroll
                for (int j = 0; j < 8; ++j) { const v4u w = kr[hh * 8 + j]; const LAS float* qq = q4 + hh * 64 + 8 * j;
                    d = fmaf(qq[0], bflo(w.x), d); d = fmaf(qq[1], bfhi(w.x), d); d = fmaf(qq[2], bflo(w.y), d); d = fmaf(qq[3], bfhi(w.y), d);
                    d = fmaf(qq[4], bflo(w.z), d); d = fmaf(qq[5], bfhi(w.z), d); d = fmaf(qq[6], bflo(w.w), d); d = fmaf(qq[7], bfhi(w.w), d); }
                s4[hh] = d * 0.125f; }
        }
        if (tid < 256) {
#pragma unroll
            for (int hh = 0; hh < 4; ++hh) { const float v = wave_max(s4[hh]); if (C.lane == 0) red[hh * 4 + C.wave] = v; }
        }
        __syncthreads();
        float mx[4];
#pragma unroll
        for (int hh = 0; hh < 4; ++hh) mx[hh] = fmaxf(fmaxf(red[hh * 4], red[hh * 4 + 1]), fmaxf(red[hh * 4 + 2], red[hh * 4 + 3]));
        __syncthreads();
        if (tid < 256) {
#pragma unroll
            for (int hh = 0; hh < 4; ++hh) { const float e = (tid < cnt) ? expf(s4[hh] - mx[hh]) : 0.f; ps[hh * 256 + tid] = e; const float v = wave_sum(e); if (C.lane == 0) red[hh * 4 + C.wave] = v; }
        }
        __syncthreads();
        if (tid < 256) {
            const int hh = tid >> 6;
            const float lsum = red[hh * 4] + red[hh * 4 + 1] + red[hh * 4 + 2] + red[hh * 4 + 3];
            float o = 0.f;
            for (int j = 0; j < cnt; ++j) o = fmaf(ps[hh * 256 + j], bf2f(CV[(((size_t)b << 12) + sel[j]) * 256 + tid]), o);
            const float z = bf2f(CZ[(size_t)m * 256 + tid]);
            CQ[(size_t)m * 256 + tid] = (bf16)f2bf(o / lsum * siluf_(z));
        }
        __syncthreads();
    }
}

typedef short bf16x8_t __attribute__((ext_vector_type(8)));
__device__ __forceinline__ float dpp_f(float x, const int ctrl_sel) {
    const int xi = __builtin_bit_cast(int, x); int r;
    if (ctrl_sel == 0) r = __builtin_amdgcn_update_dpp(xi, xi, 0xB1, 0xF, 0xF, false);
    else if (ctrl_sel == 1) r = __builtin_amdgcn_update_dpp(xi, xi, 0x4E, 0xF, 0xF, false);
    else r = __builtin_amdgcn_update_dpp(xi, xi, 0x141, 0xF, 0xF, false);
    return __builtin_bit_cast(float, r);
}
__device__ __forceinline__ float red8(float x) { x += dpp_f(x, 0); x += dpp_f(x, 1); x += dpp_f(x, 2); return x; }

constexpr int DSTEP_T = 320;
constexpr int D_LDS_STEP = 0, D_LDS_VS = 81920, D_LDS_TWD = 98304, D_LDS_ADS = 106496;
__device__ __forceinline__ void mixD1(Ctx C, const Params& P, int l) {
    OPQ(C);
    unsigned char* ws = P.ws;
    const bf16* DR = PLP(ws, PL_DR); const bf16* DK = PLP(ws, PL_DK); const bf16* DV = PLP(ws, PL_DV); const float* MS = (const float*)(ws + WS_MISC);
    const float* mu = P.in[6] + l * 896; const float* w0 = P.in[7] + l * 256; const float* w_up = P.in[8] + (size_t)l * 64 * 256; const float* a0 = P.in[9] + l * 256;
    const float* a_up = P.in[10] + (size_t)l * 64 * 256; const float* k_k = P.in[11] + l * 256; const float* k_a = P.in[12] + l * 256; const float* r_k = P.in[13] + l * 256;
    bf16* OL = (bf16*)(ws + WS_OL); bf16* CCp = (bf16*)(ws + WS_CC); float* BON = (float*)(ws + WS_DBON); float* AB = (float*)(ws + WS_DAB);
    LAS float* STEP = (LAS float*)(C.lds + D_LDS_STEP); LAS float* VS = (LAS float*)(C.lds + D_LDS_VS);
    LAS bf16* TWD = (LAS bf16*)(C.lds + D_LDS_TWD); LAS bf16* ADS = (LAS bf16*)(C.lds + D_LDS_ADS);
    const int tid = C.tid, lane = C.lane, wave = C.wave;
    const int tt = tid >> 3, c8 = tid & 7;
    for (int u = C.bid; u < 256; u += C.G) {
        const int b = u >> 5, h = (u >> 3) & 3, seg = u & 7, hc0 = h * 64;
        __syncthreads();
        {
            const int i = tid >> 3;
            const f32x4 wa = *(const f32x4*)(w_up + (size_t)i * 256 + hc0 + 8 * c8), wb = *(const f32x4*)(w_up + (size_t)i * 256 + hc0 + 8 * c8 + 4);
            const f32x4 aa = *(const f32x4*)(a_up + (size_t)i * 256 + hc0 + 8 * c8), ab = *(const f32x4*)(a_up + (size_t)i * 256 + hc0 + 8 * c8 + 4);
#pragma unroll
            for (int j = 0; j < 4; ++j) { TWD[(8 * c8 + j) * 64 + i] = (bf16)f2bf(wa[j]); TWD[(8 * c8 + 4 + j) * 64 + i] = (bf16)f2bf(wb[j]);
                                          ADS[(8 * c8 + j) * 64 + i] = (bf16)f2bf(aa[j]); ADS[(8 * c8 + 4 + j) * 64 + i] = (bf16)f2bf(ab[j]); }
        }
        __syncthreads();
        const int mat = wave >> 2, mt = wave & 3, fr = lane & 15, fq = lane >> 4;
        bf16x8_t bfrag[4][2];
#pragma unroll
        for (int nt = 0; nt < 4; ++nt)
#pragma unroll
            for (int k2 = 0; k2 < 2; ++k2) bfrag[nt][k2] = *(const LAS bf16x8_t*)((mat ? ADS : TWD) + (16 * nt + fr) * 64 + 32 * k2 + 8 * fq);
        float bias4[4];
#pragma unroll
        for (int nt = 0; nt < 4; ++nt) bias4[nt] = (mat ? a0 : w0)[hc0 + 16 * nt + fr];
        __syncthreads();
        float S[8], H[8];
#pragma unroll
        for (int j = 0; j < 8; ++j) { S[j] = 0.f; H[j] = (8 * c8 + j == tt) ? 1.f : 0.f; }
        for (int blk = 0; blk < 8; ++blk) {
            const int tloc0 = seg * 512 + blk * 64;
            const size_t m = ((size_t)b << 12) + tloc0 + tt;
            const bool has_prev = (tloc0 + tt) > 0;
            {
                const int ch = hc0 + 8 * c8;
                const v4u rc = *(const v4u*)(DR + m * 256 + ch), kc = *(const v4u*)(DK + m * 256 + ch), vc = *(const v4u*)(DV + m * 256 + ch);
                v4u rp = (v4u){0u, 0u, 0u, 0u}, kp = rp, vp = rp;
                if (has_prev) { rp = *(const v4u*)(DR + (m - 1) * 256 + ch); kp = *(const v4u*)(DK + (m - 1) * 256 + ch); vp = *(const v4u*)(DV + (m - 1) * 256 + ch); }
                LAS float* st = STEP + tt * DSTEP_T + c8 * 40;
#pragma unroll
                for (int q = 0; q < 4; ++q) {
                    const unsigned rcw = rc[q], rpw = rp[q], kcw = kc[q], kpw = kp[q], vcw = vc[q], vpw = vp[q];
                    const float mr0 = mu[ch + 2 * q], mr1 = mu[ch + 2 * q + 1], mk0 = mu[256 + ch + 2 * q], mk1 = mu[256 + ch + 2 * q + 1], mv0 = mu[512 + ch + 2 * q], mv1 = mu[512 + ch + 2 * q + 1];
                    float c0 = bflo(rcw), c1 = bfhi(rcw);
                    st[32 + 2 * q] = c0 + mr0 * (bflo(rpw) - c0); st[32 + 2 * q + 1] = c1 + mr1 * (bfhi(rpw) - c1);
                    c0 = bflo(kcw); c1 = bfhi(kcw);
                    st[24 + 2 * q] = c0 + mk0 * (bflo(kpw) - c0); st[24 + 2 * q + 1] = c1 + mk1 * (bfhi(kpw) - c1);
                    c0 = bflo(vcw); c1 = bfhi(vcw);
                    VS[tt * 64 + 8 * c8 + 2 * q] = c0 + mv0 * (bflo(vpw) - c0); VS[tt * 64 + 8 * c8 + 2 * q + 1] = c1 + mv1 * (bfhi(vpw) - c1);
                }
                const f32x4 wc0 = *(const f32x4*)(MS + m * 256 + 72 + 8 * c8), wc1 = *(const f32x4*)(MS + m * 256 + 76 + 8 * c8);
                const f32x4 ac0 = *(const f32x4*)(MS + m * 256 + 136 + 8 * c8), ac1 = *(const f32x4*)(MS + m * 256 + 140 + 8 * c8);
                f32x4 wp0 = (f32x4){0.f, 0.f, 0.f, 0.f}, wp1 = wp0, ap0 = wp0, ap1 = wp0;
                if (has_prev) { wp0 = *(const f32x4*)(MS + (m - 1) * 256 + 72 + 8 * c8); wp1 = *(const f32x4*)(MS + (m - 1) * 256 + 76 + 8 * c8);
                                ap0 = *(const f32x4*)(MS + (m - 1) * 256 + 136 + 8 * c8); ap1 = *(const f32x4*)(MS + (m - 1) * 256 + 140 + 8 * c8); }
                float tw[8], ad[8];
#pragma unroll
                for (int j = 0; j < 4; ++j) {
                    const float m0 = mu[768 + 8 * c8 + j], m1 = mu[768 + 8 * c8 + 4 + j], n0 = mu[832 + 8 * c8 + j], n1 = mu[832 + 8 * c8 + 4 + j];
                    tw[j] = tanhf(wc0[j] + m0 * (wp0[j] - wc0[j])); tw[4 + j] = tanhf(wc1[j] + m1 * (wp1[j] - wc1[j]));
                    ad[j] = ac0[j] + n0 * (ap0[j] - ac0[j]); ad[4 + j] = ac1[j] + n1 * (ap1[j] - ac1[j]);
                }
                v4u tv, av; tv.x = pk2(tw[0], tw[1]); tv.y = pk2(tw[2], tw[3]); tv.z = pk2(tw[4], tw[5]); tv.w = pk2(tw[6], tw[7]);
                av.x = pk2(ad[0], ad[1]); av.y = pk2(ad[2], ad[3]); av.z = pk2(ad[4], ad[5]); av.w = pk2(ad[6], ad[7]);
                *(LAS v4u*)(TWD + tt * 64 + 8 * c8) = tv; *(LAS v4u*)(ADS + tt * 64 + 8 * c8) = av;
            }
            __syncthreads();
            {
                const LAS bf16* Asrc = mat ? ADS : TWD;
                const bf16x8_t a0f = *(const LAS bf16x8_t*)(Asrc + (16 * mt + fr) * 64 + 8 * fq), a1f = *(const LAS bf16x8_t*)(Asrc + (16 * mt + fr) * 64 + 32 + 8 * fq);
#pragma unroll
                for (int nt = 0; nt < 4; ++nt) {
                    f32x4 acc = (f32x4){0.f, 0.f, 0.f, 0.f};
                    acc = __builtin_amdgcn_mfma_f32_16x16x32_bf16(a0f, bfrag[nt][0], acc, 0, 0, 0);
                    acc = __builtin_amdgcn_mfma_f32_16x16x32_bf16(a1f, bfrag[nt][1], acc, 0, 0, 0);
                    const int c = 16 * nt + fr;
#pragma unroll
                    for (int j = 0; j < 4; ++j) {
                        const int t = 16 * mt + 4 * fq + j; const float x = acc[j] + bias4[nt]; float val;
                        if (mat == 0) { const float nx = -x; const float sp = fmaxf(nx, 0.f) + log1pf(expf(-fabsf(nx))); val = expf(-expf(-sp - 0.5f)); }
                        else val = 1.f / (1.f + expf(-x));
                        STEP[t * DSTEP_T + (c >> 3) * 40 + (mat ? 16 : 8) + (c & 7)] = val;
                    }
                }
            }
            __syncthreads();
            {
                const int ch = hc0 + 8 * c8; LAS float* st = STEP + tt * DSTEP_T + c8 * 40;
                float kkr[8], ssq = 0.f, bon = 0.f;
#pragma unroll
                for (int j = 0; j < 8; ++j) { const float kx = st[24 + j], a = st[16 + j];
                    kkr[j] = kx * k_k[ch + j]; ssq = fmaf(kkr[j], kkr[j], ssq);
                    const float kf = kx * (1.f + (a - 1.f) * k_a[ch + j]); st[24 + j] = kf; bon = fmaf(st[32 + j] * kf, r_k[ch + j], bon); }
                ssq = red8(ssq); bon = red8(bon);
                const float inv = 1.f / fmaxf(sqrtf(ssq), 1e-12f);
#pragma unroll
                for (int j = 0; j < 8; ++j) { const float kk = kkr[j] * inv; st[j] = kk; st[16 + j] = kk * st[16 + j]; }
                if (c8 == 0) BON[m * 4 + h] = bon;
            }
            __syncthreads();
            for (int t = 0; t < 64; ++t) {
                const LAS f32x4* sp = (const LAS f32x4*)(STEP + t * DSTEP_T + c8 * 40);
                const f32x4 k0 = sp[0], k1 = sp[1], w0v = sp[2], w1v = sp[3], b0 = sp[4], b1 = sp[5], f0 = sp[6], f1 = sp[7], r0 = sp[8], r1 = sp[9];
                const float vv = VS[t * 64 + tt];
                float dS = 0.f, dH = 0.f;
#pragma unroll
                for (int j = 0; j < 4; ++j) { dS = fmaf(S[j], k0[j], dS); dH = fmaf(H[j], k0[j], dH); }
#pragma unroll
                for (int j = 0; j < 4; ++j) { dS = fmaf(S[4 + j], k1[j], dS); dH = fmaf(H[4 + j], k1[j], dH); }
                dS = -red8(dS); dH = -red8(dH);
                float oS = 0.f, oH = 0.f;
#pragma unroll
                for (int j = 0; j < 4; ++j) {
                    S[j] = fmaf(S[j], w0v[j], fmaf(dS, b0[j], vv * f0[j])); H[j] = fmaf(H[j], w0v[j], dH * b0[j]);
                    oS = fmaf(S[j], r0[j], oS); oH = fmaf(H[j], r0[j], oH);
                }
#pragma unroll
                for (int j = 0; j < 4; ++j) {
                    S[4 + j] = fmaf(S[4 + j], w1v[j], fmaf(dS, b1[j], vv * f1[j])); H[4 + j] = fmaf(H[4 + j], w1v[j], dH * b1[j]);
                    oS = fmaf(S[4 + j], r1[j], oS); oH = fmaf(H[4 + j], r1[j], oH);
                }
                oS = red8(oS); oH = red8(oH);
                if (c8 == 0) { const size_t mo = (((size_t)b << 12) + tloc0 + t) * 256 + hc0 + tt; OL[mo] = (bf16)f2bf(oS); CCp[mo] = (bf16)f2bf(oH); }
            }
            __syncthreads();
        }
        {
            float* ab = AB + (size_t)u * 8192;
            *(f32x4*)(ab + tt * 64 + 8 * c8) = (f32x4){H[0], H[1], H[2], H[3]}; *(f32x4*)(ab + tt * 64 + 8 * c8 + 4) = (f32x4){H[4], H[5], H[6], H[7]};
            *(f32x4*)(ab + 4096 + tt * 64 + 8 * c8) = (f32x4){S[0], S[1], S[2], S[3]}; *(f32x4*)(ab + 4096 + tt * 64 + 8 * c8 + 4) = (f32x4){S[4], S[5], S[6], S[7]};
        }
    }
}
__device__ __forceinline__ void mixD2(Ctx C, unsigned char* ws) {
    OPQ(C);
    if (C.bid >= 32) return;
    const float* AB = (const float*)(ws + WS_DAB); float* SS = (float*)(ws + WS_DSS);
    LAS float* SL = (LAS float*)C.lds; LAS float* AL = SL + 4096;
    const int tid = C.tid, rr = tid >> 3, ks = tid & 7;
    float S[8];
#pragma unroll
    for (int j = 0; j < 8; ++j) S[j] = 0.f;
    for (int seg = 0; seg < 8; ++seg) {
        const int u = C.bid * 8 + seg;
        float* so = SS + (size_t)u * 4096 + rr * 64 + 8 * ks;
        *(f32x4*)so = (f32x4){S[0], S[1], S[2], S[3]}; *(f32x4*)(so + 4) = (f32x4){S[4], S[5], S[6], S[7]};
        if (seg == 7) break;
        __syncthreads();
        *(LAS f32x4*)(SL + rr * 64 + 8 * ks) = (f32x4){S[0], S[1], S[2], S[3]}; *(LAS f32x4*)(SL + rr * 64 + 8 * ks + 4) = (f32x4){S[4], S[5], S[6], S[7]};
        const float* ab = AB + (size_t)u * 8192;
        *(LAS f32x4*)(AL + tid * 8) = *(const f32x4*)(ab + tid * 8); *(LAS f32x4*)(AL + tid * 8 + 4) = *(const f32x4*)(ab + tid * 8 + 4);
        const f32x4 bb0 = *(const f32x4*)(ab + 4096 + rr * 64 + 8 * ks), bb1 = *(const f32x4*)(ab + 4096 + rr * 64 + 8 * ks + 4);
        __syncthreads();
#pragma unroll
        for (int j = 0; j < 4; ++j) { S[j] = bb0[j]; S[4 + j] = bb1[j]; }
#pragma nounroll
        for (int i = 0; i < 64; ++i) {
            const float s = SL[rr * 64 + i];
            const f32x4 a0 = *(const LAS f32x4*)(AL + i * 64 + 8 * ks), a1 = *(const LAS f32x4*)(AL + i * 64 + 8 * ks + 4);
#pragma unroll
            for (int j = 0; j < 4; ++j) { S[j] = fmaf(s, a0[j], S[j]); S[4 + j] = fmaf(s, a1[j], S[4 + j]); }
        }
    }
}
__device__ __forceinline__ void mixD3(Ctx C, const Params& P, int l) {
    OPQ(C);
    unsigned char* ws = P.ws;
    bf16* DR = PLP(ws, PL_DR); const bf16* DV = PLP(ws, PL_DV); const bf16* DZ = PLP(ws, PL_DZ);
    const bf16* OL = (const bf16*)(ws + WS_OL); const bf16* CCp = (const bf16*)(ws + WS_CC); const float* BON = (const float*)(ws + WS_DBON); const float* SS = (const float*)(ws + WS_DSS);
    const float* mu = P.in[6] + l * 896; const float* gn_g = P.in[14] + l * 256; const float* gn_b = P.in[15] + l * 256;
    const int lane = C.lane, wave = C.wave;
    for (int u = C.bid; u < 256; u += C.G) {
        const int b = u >> 5, h = (u >> 3) & 3, seg = u & 7, hc = h * 64 + lane;
        float S[64];
        {
            const f32x4* sp = (const f32x4*)(SS + (size_t)u * 4096 + lane * 64);
#pragma unroll
            for (int q = 0; q < 16; ++q) { const f32x4 x = sp[q]; S[4 * q] = x[0]; S[4 * q + 1] = x[1]; S[4 * q + 2] = x[2]; S[4 * q + 3] = x[3]; }
        }
        const float muv = mu[512 + hc], gg = gn_g[hc], gb = gn_b[hc];
#pragma nounroll
        for (int t8 = 0; t8 < 64; t8 += 8) {
            const int tl0 = seg * 512 + wave * 64 + t8;
            const size_t m0 = ((size_t)b << 12) + tl0;
            float cv[8], ol[8], bon[8], vc[9], zz[8];
            vc[0] = (tl0 > 0) ? bf2f(DV[(m0 - 1) * 256 + hc]) : 0.f;
#pragma unroll
            for (int j = 0; j < 8; ++j) { const size_t m = m0 + j;
                cv[j] = bf2f(CCp[m * 256 + hc]); ol[j] = bf2f(OL[m * 256 + hc]); bon[j] = BON[m * 4 + h]; vc[j + 1] = bf2f(DV[m * 256 + hc]); zz[j] = bf2f(DZ[m * 256 + hc]); }
#pragma unroll
            for (int j = 0; j < 8; ++j) {
                float o = ol[j];
#pragma unroll
                for (int i = 0; i < 64; ++i) o = fmaf(S[i], __builtin_bit_cast(float, __builtin_amdgcn_readlane(__builtin_bit_cast(int, cv[j]), i)), o);
                const float mean = wave_sum(o) * (1.f / 64.f); const float d = o - mean; const float var = wave_sum(d * d) * (1.f / 64.f);
                float y = d * rsqrtf(var + 64e-5f) * gg + gb;
                y += bon[j] * (vc[j + 1] + muv * (vc[j] - vc[j + 1]));
                DR[(m0 + j) * 256 + hc] = (bf16)f2bf(y * siluf_(zz[j]));
            }
        }
    }
}

template <bool OUT>
__device__ __forceinline__ void mixB_chunks(Ctx C, unsigned char* ws, const float* normg, bf16* OUTP) {
    OPQ(C);
    const bf16* BQ = PLP(ws, PL_BQ); const bf16* BI = PLP(ws, PL_BI); const bf16* BZ = PLP(ws, PL_BZ); const float* BF = (const float*)(ws + WS_BF);
    float* BS = (float*)(ws + WS_BS); float* BG = (float*)(ws + WS_BG);
    LAS float* FT = (LAS float*)(C.lds + C.wave * 16384); LAS float* QT = FT + 1024; LAS float* IT = FT + 2048; LAS float* ZT = FT + 3072;
    const int lane = C.lane;
    const float gnorm = OUT ? normg[lane] : 0.f;
    for (int item = C.bid * 8 + C.wave; item < 2048; item += C.G * 8) {
        const int bh = item >> 6, c = item & 63, b = bh >> 2, h = bh & 3;
        const size_t m0 = ((size_t)b << 12) + c * 64;
        float S[64];
        if (OUT) {
            const float* sp = BS + (size_t)item * 4096 + lane;
#pragma unroll
            for (int d = 0; d < 64; ++d) S[d] = sp[d * 64];
        } else {
#pragma unroll
            for (int d = 0; d < 64; ++d) S[d] = 0.f;
        }
        float g = 1.f;
        for (int t0 = 0; t0 < 64; t0 += 16) {
#pragma unroll
            for (int s = 0; s < 16; ++s) {
                const size_t m = m0 + t0 + s;
                FT[s * 64 + lane] = BF[m * 256 + h * 64 + lane];
                IT[s * 64 + lane] = bf2f(BI[m * 256 + h * 64 + lane]);
                if (OUT) { QT[s * 64 + lane] = bf2f(BQ[m * 256 + h * 64 + lane]); ZT[s * 64 + lane] = bf2f(BZ[m * 256 + h * 64 + lane]); }
            }
            LDS_WAIT(); asm volatile("" ::: "memory");
            if (!OUT) {
#pragma unroll
                for (int s = 0; s < 16; ++s) g *= FT[s * 64 + lane];
            }
#pragma nounroll
            for (int s = 0; s < 16; ++s) {
                const size_t m = m0 + t0 + s;
                const float iv = IT[s * 64 + lane];
                const LAS f32x4* fp = (const LAS f32x4*)(FT + s * 64); const LAS f32x4* qp = (const LAS f32x4*)(QT + s * 64);
                float o = 0.f;
#pragma unroll
                for (int q4 = 0; q4 < 16; ++q4) {
                    const f32x4 f4 = fp[q4];
#pragma unroll
                    for (int j = 0; j < 4; ++j) S[4 * q4 + j] = fmaf(f4[j], S[4 * q4 + j] - iv, iv);
                    if (OUT) { const f32x4 qv = qp[q4];
#pragma unroll
                        for (int j = 0; j < 4; ++j) o = fmaf(qv[j], S[4 * q4 + j], o); }
                }
                if (OUT) {
                    const float r = rsqrtf(wave_sum(o * o) * (1.f / 64.f) + 1e-6f);
                    const float z = ZT[s * 64 + lane];
                    OUTP[m * 256 + h * 64 + lane] = (bf16)f2bf(o * r * gnorm * siluf_(z));
                }
            }
            LDS_WAIT(); asm volatile("" ::: "memory");
        }
        if (!OUT) {
            float* sp = BS + (size_t)item * 4096 + lane;
#pragma unroll
            for (int d = 0; d < 64; ++d) sp[d * 64] = S[d];
            BG[item * 64 + lane] = g;
        }
    }
}
__device__ __forceinline__ void mixB_scan(Ctx C, unsigned char* ws) {
    OPQ(C);
    float* BS = (float*)(ws + WS_BS); const float* BG = (const float*)(ws + WS_BG);
    for (int e = C.bid * 512 + C.tid; e < 32 * 4096; e += C.G * 512) {
        const int bh = e >> 12, dv = e & 4095, d = dv >> 6;
        float S = 0.f;
#pragma unroll 8
        for (int c = 0; c < 64; ++c) {
            const size_t idx = ((size_t)(bh * 64 + c) << 12) + dv;
            const float sl = BS[idx], g = BG[(bh * 64 + c) * 64 + d];
            BS[idx] = S;
            S = fmaf(g, S, sl);
        }
    }
}

typedef float f32x16 __attribute__((ext_vector_type(16)));
__device__ __forceinline__ int crow_(int r, int hi) { return (r & 3) + 8 * (r >> 2) + 4 * hi; }
__device__ __forceinline__ void mixA_fast(Ctx C, unsigned char* ws, const float* bias, bf16* OUTP) {
    OPQ(C);
    const bf16* AQ = PLP(ws, PL_AQ); const bf16* AK = PLP(ws, PL_AK); const bf16* AVT = PLP(ws, PL_AV); const bf16* AZ = PLP(ws, PL_AZ);
    LAS float* BL = (LAS float*)C.lds;
    __syncthreads();
    for (int i = C.tid; i < 768; i += 512) BL[i] = bias[i] * 1.4426950408889634f;
    __syncthreads();
    const int lane = C.lane, q = lane & 31, hi = lane >> 5;
    for (int item = C.bid * 8 + C.wave; item < 2048; item += C.G * 8) {
        const int h = item & 3, c = (item >> 2) & 63, b = item >> 8;
        const size_t mq0 = ((size_t)b << 12) + c * 64;
        bf16x8_t qf[2][4];
#pragma unroll
        for (int qb = 0; qb < 2; ++qb)
#pragma unroll
            for (int s = 0; s < 4; ++s) qf[qb][s] = *(const bf16x8_t*)(AQ + (mq0 + 32 * qb + q) * 256 + h * 64 + 16 * s + 8 * hi);
        f32x16 O[2][2];
#pragma unroll
        for (int qb = 0; qb < 2; ++qb)
#pragma unroll
            for (int db = 0; db < 2; ++db)
#pragma unroll
                for (int r = 0; r < 16; ++r) O[qb][db][r] = 0.f;
        float mrun[2] = {-1e30f, -1e30f}, lrun[2] = {0.f, 0.f};
        const int klo = (c >= 8) ? (c - 8) * 64 : 0;
        const int nkb = (c * 64 + 64 - klo) >> 5;
        const LAS float* bh = BL + h * 192;
        bf16x8_t kfn[4], vtn[2][2];
#define A_LOADKV(KB) do { const size_t kb_ = (size_t)(b * 4 + h) * 128 + ((klo >> 5) + (KB)); _Pragma("unroll") for (int s = 0; s < 4; ++s) kfn[s] = *(const bf16x8_t*)(AK + ((kb_ * 4 + s) * 64 + lane) * 8); \
            _Pragma("unroll") for (int db = 0; db < 2; ++db) _Pragma("unroll") for (int s2 = 0; s2 < 2; ++s2) vtn[db][s2] = *(const bf16x8_t*)(AVT + (((kb_ * 2 + db) * 2 + s2) * 64 + lane) * 8); } while (0)
        A_LOADKV(0);
        for (int kb = 0; kb < nkb; ++kb) {
            const int kbase = klo + 32 * kb;
            bf16x8_t kf[4];
#pragma unroll
            for (int s = 0; s < 4; ++s) kf[s] = kfn[s];
            bf16x8_t vt[2][2];
#pragma unroll
            for (int db = 0; db < 2; ++db)
#pragma unroll
                for (int s2 = 0; s2 < 2; ++s2) vt[db][s2] = vtn[db][s2];
            if (kb + 1 < nkb) A_LOADKV(kb + 1);
#pragma unroll
            for (int qb = 0; qb < 2; ++qb) {
                f32x16 st;
#pragma unroll
                for (int r = 0; r < 16; ++r) st[r] = 0.f;
#pragma unroll
                for (int s = 0; s < 4; ++s) st = __builtin_amdgcn_mfma_f32_32x32x16_bf16(kf[s], qf[qb][s], st, 0, 0, 0);
                const int qpos = c * 64 + 32 * qb + q;
                float mx = -1e30f;
                if (qpos - (kbase + 31) >= 128) {
                    const float bc = bh[191];
#pragma unroll
                    for (int r = 0; r < 16; ++r) { st[r] = fmaf(st[r], 0.125f * 1.4426950408889634f, bc); mx = fmaxf(mx, st[r]); }
                } else {
#pragma unroll
                    for (int r = 0; r < 16; ++r) {
                        int rel = qpos - (kbase + crow_(r, hi)); rel = rel < -63 ? -63 : (rel > 128 ? 128 : rel);
                        st[r] = fmaf(st[r], 0.125f * 1.4426950408889634f, bh[rel + 63]);
                        mx = fmaxf(mx, st[r]);
                    }
                }
                mx = xh_max(mx);
                const float mn = fmaxf(mrun[qb], mx);
                float ps = 0.f;
#pragma unroll
                for (int r = 0; r < 16; ++r) { st[r] = __builtin_amdgcn_exp2f(st[r] - mn); ps += st[r]; }
                ps = xh_sum(ps);
                if (__builtin_amdgcn_ballot_w64(mn != mrun[qb]) != 0ull) {
                    const float al = __builtin_amdgcn_exp2f(mrun[qb] - mn);
                    lrun[qb] *= al;
#pragma unroll
                    for (int db = 0; db < 2; ++db)
#pragma unroll
                        for (int r = 0; r < 16; ++r) O[qb][db][r] *= al;
                }
                mrun[qb] = mn;
                lrun[qb] += ps;
                v4u p0, p1;
                p0.x = pk2(st[0], st[1]); p0.y = pk2(st[2], st[3]); p0.z = pk2(st[4], st[5]); p0.w = pk2(st[6], st[7]);
                p1.x = pk2(st[8], st[9]); p1.y = pk2(st[10], st[11]); p1.z = pk2(st[12], st[13]); p1.w = pk2(st[14], st[15]);
                const bf16x8_t pf0 = __builtin_bit_cast(bf16x8_t, p0), pf1 = __builtin_bit_cast(bf16x8_t, p1);
#pragma unroll
                for (int db = 0; db < 2; ++db) {
                    O[qb][db] = __builtin_amdgcn_mfma_f32_32x32x16_bf16(vt[db][0], pf0, O[qb][db], 0, 0, 0);
                    O[qb][db] = __builtin_amdgcn_mfma_f32_32x32x16_bf16(vt[db][1], pf1, O[qb][db], 0, 0, 0);
                }
            }
        }
#undef A_LOADKV
#pragma unroll
        for (int qb = 0; qb < 2; ++qb) {
            const float invl = 1.f / lrun[qb];
            const size_t mrow = (mq0 + 32 * qb + q) * 256 + h * 64;
#pragma unroll
            for (int db = 0; db < 2; ++db)
#pragma unroll
                for (int g = 0; g < 4; ++g) {
                    const int col = 32 * db + 8 * g + 4 * hi;
                    const v2u z = *(const v2u*)(AZ + mrow + col);
                    const float z0 = bflo(z.x), z1 = bfhi(z.x), z2 = bflo(z.y), z3 = bfhi(z.y);
                    v2u w;
                    w.x = pk2(O[qb][db][4 * g] * invl * z0 * fsig(z0), O[qb][db][4 * g + 1] * invl * z1 * fsig(z1));
                    w.y = pk2(O[qb][db][4 * g + 2] * invl * z2 * fsig(z2), O[qb][db][4 * g + 3] * invl * z3 * fsig(z3));
                    *(v2u*)(OUTP + mrow + col) = w;
                }
        }
    }
}

constexpr int C_NB = 512, C_CAP = 64;
constexpr int C_LDS_HIST = 0, C_LDS_QIF = 33792, C_LDS_BMP = 66560, C_LDS_QP = 99328, C_LDS_WQ = 101376, C_LDS_SCR = 102400;
enum { QP_LO = 0, QP_SC = 1, QP_CRIT = 2, QP_LO2 = 3, QP_SC2 = 4, QP_CRIT2 = 5, QP_KREM = 6, QP_CNT = 7, QP_LVL = 8, QP_CC = 9 };
__device__ __forceinline__ int c_bin(float s, float lo, float sc) { float x = (s - lo) * sc; x = fminf(fmaxf(x, 0.f), (float)(C_NB - 1)); return (int)x; }
__device__ __forceinline__ float relu_asm(float x) { return __builtin_amdgcn_fmed3f(x, 0.f, __builtin_inff()); }
__device__ __forceinline__ void mixC_fast(Ctx C, unsigned char* ws, bf16* OUTP, const int parts = 3) {
    OPQ(C);
    const bf16* CQ = PLP(ws, PL_CQ); const bf16* CK = PLP(ws, PL_CK); const bf16* CVT = PLP(ws, PL_CV); const bf16* CZ = PLP(ws, PL_CZ);
    const bf16* QI0 = PLP(ws, PL_CQI0); const bf16* QI1 = PLP(ws, PL_CQI1); const bf16* KI = (const bf16*)(ws + WS_KI); const float* MS = (const float*)(ws + WS_MISC);
    LAS unsigned* HIST = (LAS unsigned*)(C.lds + C_LDS_HIST); LAS unsigned* BMP = (LAS unsigned*)(C.lds + C_LDS_BMP);
    LAS float* QPf = (LAS float*)(C.lds + C_LDS_QP); LAS int* QPi = (LAS int*)(C.lds + C_LDS_QP); LAS float* WQ = (LAS float*)(C.lds + C_LDS_WQ);
    LAS unsigned long long* LIST = (LAS unsigned long long*)(C.lds + C_LDS_HIST);
    LAS unsigned char* QIFL = C.lds + C_LDS_QIF;
    const int wave = C.wave;
    for (int pass2 = 0; pass2 < 2; ++pass2)
    for (int ui = C.bid; ui < 256; ui += C.G) {
        const int b = ui & 7, c = pass2 == 0 ? 63 - (ui >> 3) : (ui >> 3);
        const int n = 64 * (c + 1), nkb = n >> 5;
        const size_t mq0 = ((size_t)b << 12) + c * 64, mk0 = (size_t)b << 12;
        __syncthreads();
        unsigned long long tc0_ = (EXP >= 200) ? __builtin_amdgcn_s_memrealtime() : 0ull;
        if (!(parts & 1)) {} else if (c <= 3) {
            const int tid0 = wave * 64 + lane_id_fresh();
            for (int i = tid0; i < 64 * 128; i += 512) BMP[i] = ((i & 127) < nkb) ? 0xFFFFFFFFu : 0u;
        } else {
          for (int qb = 0; qb < 2; ++qb) {
            {
                const int lane = lane_id_fresh();
#pragma nounroll
                for (int qq = 0; qq < 4; ++qq) {
                    const int qx = wave * 4 + qq; const size_t m = mq0 + 32 * qb + qx;
                    const int hh = lane >> 3;
                    const v4u w = *(const v4u*)((hh < 4 ? QI0 : QI1) + m * 256 + (hh & 3) * 64 + 8 * (lane & 7));
                    float ssq;
                    { const float a0 = bflo(w.x), a1 = bfhi(w.x), a2 = bflo(w.y), a3 = bfhi(w.y), a4 = bflo(w.z), a5 = bfhi(w.z), a6 = bflo(w.w), a7 = bfhi(w.w);
                      ssq = a0 * a0 + a1 * a1 + a2 * a2 + a3 * a3 + a4 * a4 + a5 * a5 + a6 * a6 + a7 * a7; }
                    ssq = red8(ssq);
                    const float wv = MS[m * 256 + 64 + hh] * (0.35355339059327373f * 0.125f);
                    float tm = 0.4f * wv * sqrtf(ssq), tv = 0.34f * wv * wv * ssq;
                    tm += dppf(tm, 4); tm += swz16f(tm); tm = xh_sum(tm);
                    tv += dppf(tv, 4); tv += swz16f(tv); tv = xh_sum(tv);
                    if ((lane & 7) == 0) WQ[qx * 8 + hh] = wv;
                    if (lane == 0) { const float sd = fmaxf(sqrtf(tv), 1e-20f);
                        QPf[qx * 16 + QP_LO] = tm - 6.f * sd; QPf[qx * 16 + QP_SC] = (float)C_NB / (16.f * sd);
                        QPi[qx * 16 + QP_KREM] = 256; QPi[qx * 16 + QP_CNT] = 0; QPi[qx * 16 + QP_LVL] = 0; QPi[qx * 16 + QP_CRIT] = -1; QPi[qx * 16 + QP_CRIT2] = -1; }
                }
                const int q = lane & 31, hi = lane >> 5;
#pragma unroll
                for (int s = 0; s < 4; ++s) *(LAS bf16x8_t*)(QIFL + (wave * 4 + s) * 1024 + lane * 16) = *(const bf16x8_t*)((wave < 4 ? QI0 : QI1) + (mq0 + 32 * qb + q) * 256 + (wave & 3) * 64 + 16 * s + 8 * hi);
            }
            int mode = 0;
            while (true) {
                {
                    const int lane = lane_id_fresh(), q = lane & 31, hi = lane >> 5;
                    if (mode < 2) { for (int i = wave * 64 + lane; i < 32 * 257; i += 512) HIST[i] = 0u; }
                    __syncthreads();
                    const float lo1 = QPf[q * 16 + QP_LO], sc1 = QPf[q * 16 + QP_SC]; const int crit1 = QPi[q * 16 + QP_CRIT]; const int lvl = QPi[q * 16 + QP_LVL];
                    bf16x8_t kin[4];
                    if (wave < nkb) {
#pragma unroll
                        for (int s = 0; s < 4; ++s) kin[s] = *(const bf16x8_t*)(KI + ((((size_t)b * 128 + wave) * 4 + s) * 64 + lane) * 8);
                    }
                    for (int kb = wave; kb < nkb; kb += 8) {
                        const int kbase = 32 * kb;
                        bf16x8_t kif[4];
#pragma unroll
                        for (int s = 0; s < 4; ++s) kif[s] = kin[s];
                        if (kb + 8 < nkb) {
#pragma unroll
                            for (int s = 0; s < 4; ++s) kin[s] = *(const bf16x8_t*)(KI + ((((size_t)b * 128 + kb + 8) * 4 + s) * 64 + lane) * 8);
                        }
                        f32x16 I;
#pragma unroll
                        for (int r = 0; r < 16; ++r) I[r] = 0.f;
#pragma unroll
                        for (int hh = 0; hh < 8; ++hh) {
                            f32x16 D;
#pragma unroll
                            for (int r = 0; r < 16; ++r) D[r] = 0.f;
#pragma unroll
                            for (int s = 0; s < 4; ++s) D = __builtin_amdgcn_mfma_f32_32x32x16_bf16(kif[s], *(const LAS bf16x8_t*)(QIFL + (hh * 4 + s) * 1024 + lane * 16), D, 0, 0, 0);
                            const float wqh = WQ[q * 8 + hh];
#pragma unroll
                            for (int r = 0; r < 16; ++r) I[r] = fmaf(relu_asm(D[r]), wqh, I[r]);
                        }
                        if (mode == 0) {
#pragma unroll
                            for (int r = 0; r < 16; ++r) { const int bn = c_bin(I[r], lo1, sc1); atomicAdd((unsigned*)&HIST[q * 257 + (bn >> 1)], 1u << (16 * (bn & 1))); }
                        } else if (mode == 1) {
                            if (lvl == 1) {
                                const float lo2 = QPf[q * 16 + QP_LO2], sc2 = QPf[q * 16 + QP_SC2];
#pragma unroll
                                for (int r = 0; r < 16; ++r) { if (c_bin(I[r], lo1, sc1) == crit1) { const int bn = c_bin(I[r], lo2, sc2); atomicAdd((unsigned*)&HIST[q * 257 + (bn >> 1)], 1u << (16 * (bn & 1))); } }
                            }
                        } else {
                            unsigned bits = 0u;
#pragma unroll
                            for (int r = 0; r < 16; ++r) {
                                const int b1 = c_bin(I[r], lo1, sc1);
                                bool sel = b1 > crit1, cand = (b1 == crit1);
                                if (cand && lvl == 1) { const int b2 = c_bin(I[r], QPf[q * 16 + QP_LO2], QPf[q * 16 + QP_SC2]); const int crit2 = QPi[q * 16 + QP_CRIT2]; sel = b2 > crit2; cand = (b2 == crit2); }
                                if (sel) bits |= 1u << ((r & 3) + 8 * (r >> 2));
                                if (cand) { const unsigned pos = atomicAdd((unsigned*)&QPi[q * 16 + QP_CNT], 1u);
                                    if (pos < (unsigned)C_CAP) LIST[q * C_CAP + pos] = ((unsigned long long)__float_as_uint(I[r]) << 32) | (unsigned)(kbase + crow_(r, hi)); }
                            }
                            bits <<= 4 * hi;
                            bits = xh_or(bits);
                            if (hi == 0) BMP[(32 * qb + q) * 128 + kb] = bits;
                        }
                    }
                }
                __syncthreads();
                if (mode == 2) break;
                {
                    const int lane = lane_id_fresh();
                    LAS unsigned* SCR = (LAS unsigned*)(C.lds + C_LDS_SCR + wave * 256);
#pragma nounroll
                    for (int qq = 0; qq < 4; ++qq) {
                        const int qx = wave * 4 + qq;
                        const int lv = QPi[qx * 16 + QP_LVL];
                        if (mode == 1 && lv == 0) continue;
                        const int krem = QPi[qx * 16 + QP_KREM];
                        unsigned cnt[8]; unsigned s = 0u;
#pragma unroll
                        for (int j = 0; j < 4; ++j) { const unsigned w = HIST[qx * 257 + lane * 4 + j]; cnt[2 * j] = w & 0xffffu; cnt[2 * j + 1] = w >> 16; s += (w & 0xffffu) + (w >> 16); }
                        SCR[lane] = s; LDS_WAIT(); asm volatile("" ::: "memory");
                        unsigned incl = 0u;
#pragma unroll 8
                        for (int l2 = 0; l2 < 64; ++l2) { const unsigned t = SCR[l2]; incl += (l2 >= lane) ? t : 0u; }
                        LDS_WAIT(); asm volatile("" ::: "memory");
                        unsigned run = incl - s;
                        int fcrit = -1; unsigned frun = 0u, fcnt = 0u;
#pragma unroll
                        for (int j = 7; j >= 0; --j) {
                            const bool hit = run < (unsigned)krem && run + cnt[j] >= (unsigned)krem;
                            fcrit = hit ? lane * 8 + j : fcrit; frun = hit ? run : frun; fcnt = hit ? cnt[j] : fcnt;
                            run += cnt[j];
                        }
                        if (fcrit >= 0) {
                            QPi[qx * 16 + QP_KREM] = krem - (int)frun; QPi[qx * 16 + QP_CC] = (int)fcnt;
                            if (mode == 0) { QPi[qx * 16 + QP_CRIT] = fcrit;
                                if (fcnt > (unsigned)C_CAP) { const float lo = QPf[qx * 16 + QP_LO], sc = QPf[qx * 16 + QP_SC];
                                    QPf[qx * 16 + QP_LO2] = lo + (float)fcrit / sc; QPf[qx * 16 + QP_SC2] = sc * (float)C_NB; QPi[qx * 16 + QP_LVL] = 1; } }
                            else QPi[qx * 16 + QP_CRIT2] = fcrit;
                        }
                    }
                }
                __syncthreads();
                if (mode == 0) { bool need_l2 = false; for (int qx = 0; qx < 32; ++qx) need_l2 |= (QPi[qx * 16 + QP_LVL] == 1); mode = need_l2 ? 1 : 2; }
                else mode = 2;
                __syncthreads();
            }
            {
                const int lane = lane_id_fresh();
#pragma nounroll
                for (int qq = 0; qq < 4; ++qq) {
                    const int qx = wave * 4 + qq;
                    int cn = QPi[qx * 16 + QP_CNT]; cn = cn < C_CAP ? cn : C_CAP;
                    const int need = QPi[qx * 16 + QP_KREM];
                    if (lane < cn) {
                        const unsigned long long me = LIST[qx * C_CAP + lane];
                        const float mv = __uint_as_float((unsigned)(me >> 32)); const unsigned mi = (unsigned)me;
                        int rank = 0;
                        for (int j = 0; j < cn; ++j) { const unsigned long long o = LIST[qx * C_CAP + j]; const float ov = __uint_as_float((unsigned)(o >> 32)); const unsigned oi = (unsigned)o;
                            rank += (ov > mv || (ov == mv && oi < mi)) ? 1 : 0; }
                        if (rank < need) atomicOr((unsigned*)&BMP[(32 * qb + qx) * 128 + (mi >> 5)], 1u << (mi & 31));
                    }
                }
            }
            __syncthreads();
          }
        }
        __syncthreads();
        if (EXP >= 200 && wave == 0 && lane_id_fresh() == 0) { const unsigned long long tn_ = __builtin_amdgcn_s_memrealtime(); atomicAdd((unsigned*)(ws + WS_CTL) + 8192 + 16 * 4 + 2, (unsigned)(tn_ - tc0_)); tc0_ = tn_; }
        if (parts & 2) {
            const int lane = lane_id_fresh(), q = lane & 31, hi = lane >> 5;
            const int qb = wave & 1, h = wave >> 1, ql = 32 * qb + q;
            bf16x8_t qf[4];
#pragma unroll
            for (int s = 0; s < 4; ++s) qf[s] = *(const bf16x8_t*)(CQ + (mq0 + ql) * 256 + h * 64 + 16 * s + 8 * hi);
            f32x16 O[2];
#pragma unroll
            for (int db = 0; db < 2; ++db)
#pragma unroll
                for (int r = 0; r < 16; ++r) O[db][r] = 0.f;
            float mrun = -1e30f, lrun = 0.f;
            bf16x8_t kfn[4], vtn[2][2];
#define C_LOADKV(KB) do { const size_t kb_ = (size_t)(b * 4 + h) * 128 + (KB); _Pragma("unroll") for (int s = 0; s < 4; ++s) kfn[s] = *(const bf16x8_t*)(CK + ((kb_ * 4 + s) * 64 + lane) * 8); \
                _Pragma("unroll") for (int db = 0; db < 2; ++db) _Pragma("unroll") for (int s2 = 0; s2 < 2; ++s2) vtn[db][s2] = *(const bf16x8_t*)(CVT + (((kb_ * 2 + db) * 2 + s2) * 64 + lane) * 8); } while (0)
            C_LOADKV(0);
            for (int kb = 0; kb < nkb; ++kb) {
                const unsigned word = BMP[ql * 128 + kb] >> (4 * hi);
                bf16x8_t kf[4];
#pragma unroll
                for (int s = 0; s < 4; ++s) kf[s] = kfn[s];
                bf16x8_t vt[2][2];
#pragma unroll
                for (int db = 0; db < 2; ++db)
#pragma unroll
                    for (int s2 = 0; s2 < 2; ++s2) vt[db][s2] = vtn[db][s2];
                if (kb + 1 < nkb) C_LOADKV(kb + 1);
                f32x16 st;
#pragma unroll
                for (int r = 0; r < 16; ++r) st[r] = 0.f;
#pragma unroll
                for (int s = 0; s < 4; ++s) st = __builtin_amdgcn_mfma_f32_32x32x16_bf16(kf[s], qf[s], st, 0, 0, 0);
                float mx = -INFINITY;
#pragma unroll
                for (int r = 0; r < 16; ++r) {
                    const bool on = (word >> ((r & 3) + 8 * (r >> 2))) & 1u;
                    st[r] = on ? st[r] : -INFINITY;
                    mx = fmaxf(mx, st[r]);
                }
                mx = xh_max(mx) * (0.125f * 1.4426950408889634f);
                const float mn = fmaxf(mrun, mx);
                float ps = 0.f;
#pragma unroll
                for (int r = 0; r < 16; ++r) { st[r] = __builtin_amdgcn_exp2f(fmaf(st[r], 0.125f * 1.4426950408889634f, -mn)); ps += st[r]; }
                ps = xh_sum(ps);
                if (__builtin_amdgcn_ballot_w64(mn != mrun) != 0ull) {
                    const float al = __builtin_amdgcn_exp2f(mrun - mn);
                    lrun *= al;
#pragma unroll
                    for (int db = 0; db < 2; ++db)
#pragma unroll
                        for (int r = 0; r < 16; ++r) O[db][r] *= al;
                }
                mrun = mn;
                lrun += ps;
                v4u p0, p1;
                p0.x = pk2(st[0], st[1]); p0.y = pk2(st[2], st[3]); p0.z = pk2(st[4], st[5]); p0.w = pk2(st[6], st[7]);
                p1.x = pk2(st[8], st[9]); p1.y = pk2(st[10], st[11]); p1.z = pk2(st[12], st[13]); p1.w = pk2(st[14], st[15]);
                const bf16x8_t pf0 = __builtin_bit_cast(bf16x8_t, p0), pf1 = __builtin_bit_cast(bf16x8_t, p1);
#pragma unroll
                for (int db = 0; db < 2; ++db) {
                    O[db] = __builtin_amdgcn_mfma_f32_32x32x16_bf16(vt[db][0], pf0, O[db], 0, 0, 0);
                    O[db] = __builtin_amdgcn_mfma_f32_32x32x16_bf16(vt[db][1], pf1, O[db], 0, 0, 0);
                }
            }
#undef C_LOADKV
            const float invl = 1.f / lrun;
            const size_t mrow = (mq0 + ql) * 256 + h * 64;
#pragma unroll
            for (int db = 0; db < 2; ++db)
#pragma unroll
                for (int g = 0; g < 4; ++g) {
                    const int col = 32 * db + 8 * g + 4 * hi;
                    const v2u z = *(const v2u*)(CZ + mrow + col);
                    const float z0 = bflo(z.x), z1 = bfhi(z.x), z2 = bflo(z.y), z3 = bfhi(z.y);
                    v2u w;
                    w.x = pk2(O[db][4 * g] * invl * z0 * fsig(z0), O[db][4 * g + 1] * invl * z1 * fsig(z1));
                    w.y = pk2(O[db][4 * g + 2] * invl * z2 * fsig(z2), O[db][4 * g + 3] * invl * z3 * fsig(z3));
                    *(v2u*)(OUTP + mrow + col) = w;
                }
        }
        if (EXP >= 200) { __syncthreads(); if (wave == 0 && lane_id_fresh() == 0) { const unsigned long long tn_ = __builtin_amdgcn_s_memrealtime(); atomicAdd((unsigned*)(ws + WS_CTL) + 8192 + 16 * 5 + 2, (unsigned)(tn_ - tc0_)); } }
    }
}
#define GRID_BAR() do { xcd_barrier(bar, C.wave == 0 && lane_id_fresh() == 0); if (EXP >= 100) { volatile LAS unsigned* TSW = (volatile LAS unsigned*)(C.lds + MISC_OFF) + 12; const unsigned k_ = TSW[0] + 1u; if (C.wave == 0 && lane_id_fresh() == 0) { TSW[0] = k_; TSW[k_] = (unsigned)__builtin_amdgcn_s_memrealtime(); } } } while (0)
#ifndef EXP
#define EXP 0
#endif
#define REP(k) for (int rep_ = 0; rep_ < ((EXP == (k)) ? 2 : 1); ++rep_)
template <int l>
__device__ __forceinline__ void layer_body(Ctx C, const Params& P, const XcdBarrier& bar) {
    unsigned char* ws = P.ws;
    const float* xin = (l == 0) ? P.in[0] : P.out;
    bf16* DRY = (bf16*)P.out;
    REP(1) {
        pg8::Gemm g{(const pg8::bf16_t*)(ws + WS_H), (const pg8::bf16_t*)(ws + WS_W1T), NTOK, NG1, 1024};
        pg8::StaticOrder S; S.init(NTOK, NG1, C.G, C.bid);
        EpiG1 E{ws, (const float*)(ws + WS_LB) + l * 256};
        pg8::gemm_phase<EpiG1, pg8::StaticOrder, true, true>(C.lds, g, S, E, C.wave);
    }
    GRID_BAR();
    REP(2) { mixD1(C, P, l); __syncthreads(); }
    REP(3) { mixB_chunks<false>(C, ws, nullptr, nullptr); __syncthreads(); }
    GRID_BAR();
    REP(16) { mixD2(C, ws); __syncthreads(); }
    mixB_scan(C, ws);
    GRID_BAR();
#define SUBT(k) do { if (EXP >= 200) { __syncthreads(); if (C.wave == 0 && lane_id_fresh() == 0) { const unsigned long long tn_ = __builtin_amdgcn_s_memrealtime(); const unsigned d_ = (unsigned)(tn_ - tsub_); tsub_ = tn_; \
        unsigned* cw_ = (unsigned*)(ws + WS_CTL) + 8192 + 16 * (k); atomicMax(cw_ + l, d_); atomicAdd(cw_ + 2, d_); } } } while (0)
    unsigned long long tsub_ = (EXP >= 200) ? __builtin_amdgcn_s_memrealtime() : 0ull;
    REP(4) { mixD3(C, P, l); __syncthreads(); }
    SUBT(0);
    if (EXP == 5 && l == 0) { mixB_chunks<true>(C, ws, P.in[5] + l * 64, DRY); __syncthreads(); }
    mixB_chunks<true>(C, ws, P.in[5] + l * 64, PLP(ws, PL_BQ));
    SUBT(1);
    if (EXP == 6 && l == 0) { mixA_fast(C, ws, P.in[3] + l * 4 * 192, DRY); }
    mixA_fast(C, ws, P.in[3] + l * 4 * 192, PLP(ws, PL_AQ));
    __syncthreads();
    SUBT(2);
    if (EXP == 7 && l == 0) { mixC_fast(C, ws, DRY); __syncthreads(); }
    if (EXP == 17 && l == 0) { mixC_fast(C, ws, DRY, 1); __syncthreads(); }
    if (EXP == 18 && l == 0) { mixC_fast(C, ws, DRY, 2); __syncthreads(); }
    mixC_fast(C, ws, PLP(ws, PL_CQ));
    SUBT(3);
    GRID_BAR();
    REP(8) {
#pragma nounroll
    for (int br = 0; br < 4; ++br) {
        pg8::Gemm g{(const pg8::bf16_t*)PLP(ws, br), (const pg8::bf16_t*)(ws + WS_WBT + (size_t)br * 1024 * 256 * 2), NTOK, 1024, 256};
        pg8::StaticOrder S; S.init(NTOK, 1024, C.G, C.bid);
        EpiBf E{(bf16*)(ws + WS_PB) + (size_t)br * NTOK * 1024, 1024};
        pg8::gemm_phase<EpiBf, pg8::StaticOrder, true, true>(C.lds, g, S, E, C.wave);
    }
    }
    GRID_BAR();
    REP(9) {
        pg8::Gemm g{(const pg8::bf16_t*)(ws + WS_H), (const pg8::bf16_t*)(ws + WS_WGT), NTOK, 4096, 1024};
        pg8::StaticOrder S; S.init(NTOK, 4096, C.G, C.bid);
        EpiGate E{(const bf16*)(ws + WS_PB), (bf16*)(ws + WS_Y)};
        pg8::gemm_phase<EpiGate, pg8::StaticOrder, true, true>(C.lds, g, S, E, C.wave);
    }
    GRID_BAR();
    for (int rep_ = 0; rep_ < ((EXP == 10 && l == 0) ? 3 : 1); ++rep_) {
        pg8::Gemm g{(const pg8::bf16_t*)(ws + WS_Y), (const pg8::bf16_t*)(ws + WS_WOT), NTOK, 1024, 1024};
        pg8::StaticOrder S; S.init(NTOK, 1024, C.G, C.bid);
        EpiRes E{xin, P.out};
        pg8::gemm_phase<EpiRes, pg8::StaticOrder, true, true>(C.lds, g, S, E, C.wave);
    }
    GRID_BAR();
    if (l == 0) { REP(11) { norm_rows_bf16(C, P.out, P.in[1] + 1024, (bf16*)(ws + WS_H)); convert_weights(C, P, 1); } GRID_BAR(); }
    else {
        OPQ(C); const int gw = C.bid * 8 + C.wave, NGW = C.G * 8;
        for (int m = gw; m < NTOK; m += NGW) rms_row(P.out + (size_t)m * 1024, P.in[18], nullptr, P.out + (size_t)m * 1024, C.lane);
    }
    if (EXP == 12) { for (int i = 0; i < 20; ++i) GRID_BAR(); }
}
__global__ void __launch_bounds__(512, 2) mega_fwd(Params P) {
    extern __shared__ __attribute__((aligned(16))) unsigned char lds_raw[];
    Ctx C; C.lds = (LAS unsigned char*)lds_raw; C.wave = __builtin_amdgcn_readfirstlane((int)threadIdx.x >> 6); C.G = gridDim.x; C.bid = blockIdx.x; OPQ(C);
    unsigned char* ws = P.ws;
    for (int u = C.tid; u < (LDS_BYTES - LDSCTL_OFF) / 4; u += 512) ((LAS unsigned*)(C.lds + LDSCTL_OFF))[u] = 0u;
    __syncthreads();
    volatile LAS unsigned* MISCW = (volatile LAS unsigned*)(C.lds + MISC_OFF);
    XcdBarrier bar = xcd_barrier_post((unsigned*)(ws + WS_CTL) + CW_BAR, MISCW + 8);
    if (EXP >= 100 && C.wave == 0 && lane_id_fresh() == 0) { volatile LAS unsigned* TSW = (volatile LAS unsigned*)(C.lds + MISC_OFF) + 12; TSW[0] = 1u; TSW[1] = (unsigned)__builtin_amdgcn_s_memrealtime(); }
    __syncthreads();
    for (int rep_ = 0; rep_ < ((EXP == 13) ? 2 : 1); ++rep_) { setup_tables(C, P); }
    for (int rep_ = 0; rep_ < ((EXP == 14) ? 2 : 1); ++rep_) { convert_weights(C, P, 0); }
    for (int rep_ = 0; rep_ < ((EXP == 15) ? 2 : 1); ++rep_) { norm_rows_bf16(C, P.in[0], P.in[1], (bf16*)(ws + WS_H)); }
    GRID_BAR();
    layer_body<0>(C, P, bar);
    layer_body<1>(C, P, bar);
    if (EXP >= 100) {
        GRID_BAR();
        if (C.bid == 0 && C.wave == 0 && lane_id_fresh() == 0) {
            volatile LAS unsigned* TSW = (volatile LAS unsigned*)(C.lds + MISC_OFF) + 12;
            const int j = EXP - 100; unsigned dt;
            if (j >= 100) { const unsigned* cw_ = (const unsigned*)(P.ws + WS_CTL) + 8192 + 16 * ((j - 100) % 10);
                dt = (j < 110) ? (__hip_atomic_load(cw_, __ATOMIC_RELAXED, __HIP_MEMORY_SCOPE_AGENT) + __hip_atomic_load(cw_ + 1, __ATOMIC_RELAXED, __HIP_MEMORY_SCOPE_AGENT)) : (__hip_atomic_load(cw_ + 2, __ATOMIC_RELAXED, __HIP_MEMORY_SCOPE_AGENT) / 256u); }
            else if (j == 0) dt = TSW[2] - TSW[1];
            else if (j <= 7) dt = (TSW[2 + j] - TSW[1 + j]) + (TSW[10 + j] - TSW[9 + j]);
            else if (j == 8) dt = (TSW[10] - TSW[9]);
            else dt = (TSW[18] - TSW[17]);
            const unsigned long long t0 = __builtin_amdgcn_s_memrealtime();
            while (__builtin_amdgcn_s_memrealtime() - t0 < 10ull * dt) __builtin_amdgcn_s_sleep(8);
        }
    }
}

extern "C" void kernel_launch(void* const* d_in, const int* in_sizes, int n_in, void* d_out, int out_size, void* d_ws, size_t ws_size, hipStream_t stream) {
    static int grid = 0;
    if (grid == 0) {
        if (n_in != 19 || ws_size < WS_END) { fprintf(stderr, "kernel_launch: need 19 inputs and %zu bytes of workspace (got %d, %zu)\n", (size_t)WS_END, n_in, ws_size); grid = -1; return; }
        int dev = 0, cus = 0, per_cu = 0;
        if (hipGetDevice(&dev) != hipSuccess || hipDeviceGetAttribute(&cus, hipDeviceAttributeMultiprocessorCount, dev) != hipSuccess) { grid = -1; return; }
        if (hipFuncSetAttribute((const void*)mega_fwd, hipFuncAttributeMaxDynamicSharedMemorySize, LDS_BYTES) != hipSuccess) { grid = -1; return; }
        (void)hipOccupancyMaxActiveBlocksPerMultiprocessor(&per_cu, (const void*)mega_fwd, 512, LDS_BYTES);
        (void)hipGetLastError();
        grid = cus;
    }
    if (grid < 0) return;
    if (hipMemsetAsync((char*)d_ws + WS_CTL, 0, CTL_ZERO_BYTES, stream) != hipSuccess) return;
    Params p{};
    for (int i = 0; i < 19; ++i) p.in[i] = (const float*)d_in[i];
    p.out = (float*)d_out; p.ws = (unsigned char*)d_ws;
    hipLaunchKernelGGL(mega_fwd, dim3(grid), dim3(512), LDS_BYTES, stream, p);
}
```

```cpp
#define EXP 0
#include <hip/hip_runtime.h>
#include <cstdio>
#include <cstdint>
#include <math.h>

#define DM 1024
#define SEQ 4096
#define NBATCH 8
#define NTOK (NBATCH * SEQ)
#define INC 8904
#define C_AQ 0
#define C_AK 256
#define C_AV 512
#define C_AZ 768
#define C_BQ 1024
#define C_BF 1280
#define C_BI 1536
#define C_BZ 1792
#define C_CQ 2048
#define C_CK 2304
#define C_CV 2560
#define C_CZ 2816
#define C_CQI 3072
#define C_CKI 3584
#define C_CWI 3648
#define C_PD 3656
#define C_DR 3656
#define C_DK 3912
#define C_DV 4168
#define C_DWD 4424
#define C_DAD 4488
#define C_DZ 4552
#define C_PG 4808
#define NG1 4864

namespace pg8 {
#define PG8_LAS __attribute__((address_space(3)))
typedef unsigned short bf16_t;
typedef short bf16x8 __attribute__((ext_vector_type(8)));
typedef float f32x4 __attribute__((ext_vector_type(4)));
typedef unsigned u32x4 __attribute__((ext_vector_type(4)));
constexpr int BM = 256, BK = 64, HALF = 128, HTB = HALF * BK * 2  , STAGE_BYTES = 8 * HTB, NXCD = 8, WGM = 8;

__host__ __device__ __forceinline__ int lds_byte(int r, int c) { const int st = (r >> 4) * 2 + (c >> 5), rr = r & 15, cc = c & 31, ob = rr * 64 + cc * 2; return st * 1024 + (ob ^ (((ob >> 9) & 1) << 5)); }
__host__ __device__ __forceinline__ void stage_rc(int b, int& R, int& C) { const int st = b / 1024, sb = b % 1024, swz = sb ^ (((sb >> 9) & 1) << 5); R = (st >> 1) * 16 + swz / 64; C = (st & 1) * 32 + (swz % 64) / 2; }
__host__ __device__ __forceinline__ int perm32(int rho) { const int n = rho >> 4, i = rho & 15; return 8 * (i >> 2) + 4 * n + (i & 3); }

struct Unit { int pm, pn; };
struct Gemm { const bf16_t* A; const bf16_t* Bt; int M, N, K; };

struct StaticOrder {
    int nM, nN, nwg, G, c;
    __host__ __device__ void init(int M, int N, int G_, int c_) { nM = M / BM; nN = N / BM; nwg = nM * nN; G = G_; c = c_; }
    __host__ __device__ bool next(int i, Unit& u) const {
        const long L = (long)i * G + c; if (L >= nwg) return false;
        int wgid = (int)L; { const int q = nwg / NXCD, r = nwg % NXCD, xcd = wgid % NXCD, off = wgid / NXCD; wgid = (xcd < r ? xcd * (q + 1) : r * (q + 1) + (xcd - r) * q) + off; }
        const int nig = WGM * nN, gid = wgid / nig, fm = gid * WGM, gsz = (nM - fm) < WGM ? (nM - fm) : WGM;
        u.pm = fm + ((wgid % nig) % gsz); u.pn = (wgid % nig) / gsz; return true;
    }
    __device__ __forceinline__ void a_ready(const Unit&) const {}
    __device__ __forceinline__ void done(const Unit&) const {}
};

__device__ __forceinline__ unsigned cvt_pk_bf16(float lo, float hi) { unsigned r; asm volatile("v_cvt_pk_bf16_f32 %0, %1, %2" : "=v"(r) : "v"(lo), "v"(hi)); return r; }
template <class Epi, class Sched, bool ALIGN_EPI = false, bool SP2 = false>
__device__ __forceinline__ void gemm_phase(PG8_LAS unsigned char* lds, const Gemm g, const Sched& S, const Epi& E, const int wave_in) {
    int lane_; asm volatile("v_mbcnt_lo_u32_b32 %0, -1, 0\n\tv_mbcnt_hi_u32_b32 %0, -1, %0" : "=v"(lane_));
    const int wid = wave_in, lane = lane_, tid = wid * 64 + lane, wr = wid >> 2, wc = wid & 3, fr = lane & 15, fq = lane >> 4;
    const int K = g.K, nt = K / BK;
    unsigned voffA[2], voffB[2];
#pragma unroll
    for (int i = 0; i < 2; ++i) { int R, C; stage_rc(tid * 16 + i * 8192, R, C); const int Rb = Epi::PERM ? ((R & ~31) + perm32(R & 31)) : R;
        voffA[i] = (unsigned)(R * K + C) * 2u; voffB[i] = (unsigned)(Rb * K + C) * 2u; }
    const size_t kstep = (size_t)(BK * 2);
    const size_t hstep = (size_t)HALF * K * 2;
    const size_t tstep = 2 * hstep;
    const unsigned ldsw = (unsigned)wid * 1024u;
    const int aoff = lds_byte(wr * 64 + fr, fq * 8), boff = lds_byte(wc * 32 + fr, fq * 8);
#define PG8_SA(b, h) (((b) * 2 + (h)) * HTB)
#define PG8_SB(b, h) ((4 + (b) * 2 + (h)) * HTB)
#define PG8_STAGE(bufoff, gbase, voff) do { _Pragma("unroll") for (int _i = 0; _i < 2; ++_i) \
        __builtin_amdgcn_global_load_lds((const unsigned*)((const char*)(gbase) + (voff)[_i]), (PG8_LAS unsigned*)(lds + (bufoff) + ldsw + _i * 8192), 16, 0, 0); } while (0)
#define PG8_LDA(dst, b, h) do { _Pragma("unroll") for (int m = 0; m < 4; ++m) _Pragma("unroll") for (int k = 0; k < 2; ++k) dst[m][k] = *(const PG8_LAS bf16x8*)(lds + PG8_SA(b, h) + aoff + m * 2048 + k * 1024); } while (0)
#define PG8_LDB(dst, b, h) do { _Pragma("unroll") for (int n = 0; n < 2; ++n) _Pragma("unroll") for (int k = 0; k < 2; ++k) dst[n][k] = *(const PG8_LAS bf16x8*)(lds + PG8_SB(b, h) + boff + n * 2048 + k * 1024); } while (0)
#define PG8_MMA(ai, bj, At, Bt) do { __builtin_amdgcn_s_setprio(1); _Pragma("unroll") for (int m = 0; m < 4; ++m) _Pragma("unroll") for (int n = 0; n < 2; ++n) _Pragma("unroll") for (int k = 0; k < 2; ++k) \
        acc[ai][bj][m][n] = __builtin_amdgcn_mfma_f32_16x16x32_bf16(Bt[n][k], At[m][k], acc[ai][bj][m][n], 0, 0, 0); __builtin_amdgcn_s_setprio(0); } while (0)
#define PG8_WAIT_V(n) asm volatile("s_waitcnt vmcnt(" #n ")" ::: "memory")
#define PG8_WAIT_L(n) asm volatile("s_waitcnt lgkmcnt(" #n ")" ::: "memory")
#define PG8_BAR __builtin_amdgcn_s_barrier()
#define PG8_SCHED __builtin_amdgcn_sched_barrier(0)
    Unit cur, nxt; int ui = 0;
    if (!S.next(0, cur)) return;
    f32x4 acc[2][2][4][2];
#pragma unroll
    for (int a = 0; a < 2; ++a)
#pragma unroll
        for (int b = 0; b < 2; ++b)
#pragma unroll
            for (int m = 0; m < 4; ++m)
#pragma unroll
                for (int n = 0; n < 2; ++n) acc[a][b][m][n] = (f32x4){0.f, 0.f, 0.f, 0.f};
    bf16x8 At[4][2], B0[2][2], B1[2][2];
    const char* cA = (const char*)g.A + (size_t)cur.pm * tstep; const char* cB = (const char*)g.Bt + (size_t)cur.pn * tstep;
    S.a_ready(cur);
    if constexpr (SP2) {
        PG8_STAGE(PG8_SB(0, 0), cB, voffB); PG8_STAGE(PG8_SB(0, 1), cB + hstep, voffB); PG8_STAGE(PG8_SA(0, 0), cA, voffA); PG8_STAGE(PG8_SA(0, 1), cA + hstep, voffA);
        if (wr == 1) PG8_BAR;
        PG8_WAIT_V(2); PG8_BAR;
        PG8_STAGE(PG8_SB(1, 0), cB + kstep, voffB); PG8_STAGE(PG8_SA(1, 0), cA + kstep, voffA); PG8_STAGE(PG8_SB(1, 1), cB + hstep + kstep, voffB);
        PG8_WAIT_V(6); PG8_BAR;
    } else {
        PG8_STAGE(PG8_SB(0, 0), cB, voffB); PG8_STAGE(PG8_SA(0, 0), cA, voffA); PG8_STAGE(PG8_SB(0, 1), cB + hstep, voffB); PG8_STAGE(PG8_SA(0, 1), cA + hstep, voffA);
        if (wr == 1) PG8_BAR;
        PG8_WAIT_V(4); PG8_BAR;
        PG8_STAGE(PG8_SB(1, 0), cB + kstep, voffB); PG8_STAGE(PG8_SA(1, 0), cA + kstep, voffA); PG8_STAGE(PG8_SB(1, 1), cB + hstep + kstep, voffB);
        PG8_WAIT_V(6); PG8_BAR;
    }
    for (;;) {
        const bool has_next = S.next(ui + 1, nxt);
        const char* nA = has_next ? (const char*)g.A + (size_t)nxt.pm * tstep : cA; const char* nB = has_next ? (const char*)g.Bt + (size_t)nxt.pn * tstep : cB;
        for (int t = 0; t < nt; t += 2) {
            const bool last = (t == nt - 2);
            const char* a1 = cA + (size_t)(t + 1) * kstep;
            const char* a2 = last ? nA : cA + (size_t)(t + 2) * kstep; const char* b2 = last ? nB : cB + (size_t)(t + 2) * kstep;
            const char* a3 = a2 + kstep; const char* b3 = b2 + kstep;
            if (last && has_next) S.a_ready(nxt);
            if constexpr (SP2) {
            PG8_LDB(B0, 0, 0); PG8_LDB(B1, 0, 1); PG8_SCHED; PG8_LDA(At, 0, 0); PG8_STAGE(PG8_SA(1, 1), a1 + hstep, voffA);
            PG8_WAIT_V(8); PG8_WAIT_L(0); PG8_BAR; PG8_MMA(0, 0, At, B0); PG8_MMA(0, 1, At, B1); PG8_BAR; PG8_SCHED;
            PG8_LDA(At, 0, 1); PG8_STAGE(PG8_SB(0, 0), b2, voffB); PG8_STAGE(PG8_SB(0, 1), b2 + hstep, voffB); PG8_STAGE(PG8_SA(0, 0), a2, voffA);
            PG8_WAIT_V(8); PG8_WAIT_L(0); PG8_BAR; PG8_MMA(1, 0, At, B0); PG8_MMA(1, 1, At, B1); PG8_BAR; PG8_SCHED;
            PG8_LDB(B0, 1, 0); PG8_LDB(B1, 1, 1); PG8_SCHED; PG8_LDA(At, 1, 0); PG8_STAGE(PG8_SA(0, 1), a2 + hstep, voffA);
            PG8_WAIT_V(8); PG8_WAIT_L(0); PG8_BAR; PG8_MMA(0, 0, At, B0); PG8_MMA(0, 1, At, B1); PG8_BAR; PG8_SCHED;
            PG8_LDA(At, 1, 1); PG8_STAGE(PG8_SB(1, 0), b3, voffB); PG8_STAGE(PG8_SB(1, 1), b3 + hstep, voffB); PG8_STAGE(PG8_SA(1, 0), a3, voffA);
            PG8_WAIT_V(8); PG8_WAIT_L(0); PG8_BAR; PG8_MMA(1, 0, At, B0); PG8_MMA(1, 1, At, B1); PG8_BAR; PG8_SCHED;
            } else {
            PG8_LDB(B0, 0, 0); PG8_SCHED; PG8_LDA(At, 0, 0); PG8_STAGE(PG8_SA(1, 1), a1 + hstep, voffA);
            PG8_WAIT_L(8); PG8_BAR; PG8_WAIT_L(0); PG8_MMA(0, 0, At, B0); PG8_BAR; PG8_SCHED;
            PG8_LDB(B1, 0, 1); PG8_STAGE(PG8_SB(0, 0), b2, voffB);
            PG8_BAR; PG8_WAIT_L(0); PG8_MMA(0, 1, At, B1); PG8_BAR;
            PG8_LDA(At, 0, 1); PG8_STAGE(PG8_SA(0, 0), a2, voffA);
            PG8_BAR; PG8_WAIT_L(0); PG8_MMA(1, 0, At, B0); PG8_BAR; PG8_SCHED;
            PG8_STAGE(PG8_SB(0, 1), b2 + hstep, voffB);
            PG8_WAIT_V(6); PG8_BAR; PG8_MMA(1, 1, At, B1); PG8_BAR;
            PG8_LDB(B0, 1, 0); PG8_SCHED; PG8_LDA(At, 1, 0); PG8_STAGE(PG8_SA(0, 1), a2 + hstep, voffA);
            PG8_WAIT_L(8); PG8_BAR; PG8_WAIT_L(0); PG8_MMA(0, 0, At, B0); PG8_BAR; PG8_SCHED;
            PG8_LDB(B1, 1, 1); PG8_STAGE(PG8_SB(1, 0), b3, voffB);
            PG8_BAR; PG8_WAIT_L(0); PG8_MMA(0, 1, At, B1); PG8_BAR;
            PG8_LDA(At, 1, 1); PG8_STAGE(PG8_SA(1, 0), a3, voffA);
            PG8_BAR; PG8_WAIT_L(0); PG8_MMA(1, 0, At, B0); PG8_BAR; PG8_SCHED;
            PG8_STAGE(PG8_SB(1, 1), b3 + hstep, voffB);
            PG8_WAIT_V(6); PG8_BAR; PG8_MMA(1, 1, At, B1); PG8_BAR;
            }
        }
        if constexpr (ALIGN_EPI) { if (wr == 0) PG8_BAR; }
        if constexpr (!Epi::AFTER_DRAIN) { E(acc, cur, wr, wc, fr, fq); S.done(cur); }
        if (!has_next) break;
#pragma unroll
        for (int a = 0; a < 2; ++a)
#pragma unroll
            for (int b = 0; b < 2; ++b)
#pragma unroll
                for (int m = 0; m < 4; ++m)
#pragma unroll
                    for (int n = 0; n < 2; ++n) acc[a][b][m][n] = (f32x4){0.f, 0.f, 0.f, 0.f};
        cur = nxt; cA = nA; cB = nB; ++ui;
        if constexpr (ALIGN_EPI) { if (wr == 1) PG8_BAR; }
    }
    PG8_WAIT_V(0);
    if constexpr (!ALIGN_EPI) { if (wr == 0) PG8_BAR; }
    PG8_BAR;
    if constexpr (Epi::AFTER_DRAIN) { E.fused(acc, cur, wr, wc, fr, fq, lds, wid, lane); S.done(cur); }
#undef PG8_SA
#undef PG8_SB
#undef PG8_STAGE
#undef PG8_LDA
#undef PG8_LDB
#undef PG8_MMA
#undef PG8_WAIT_V
#undef PG8_WAIT_L
#undef PG8_BAR
#undef PG8_SCHED
}
}

#define GAS __attribute__((address_space(1)))
#define LAS __attribute__((address_space(3)))
typedef unsigned short bf16;
typedef unsigned v4u __attribute__((ext_vector_type(4)));
typedef unsigned v2u __attribute__((ext_vector_type(2)));
typedef float f32x4 __attribute__((ext_vector_type(4)));
typedef GAS unsigned gu32;
#define RLX_AGENT __ATOMIC_RELAXED, __HIP_MEMORY_SCOPE_AGENT
#define LDS_WAIT() asm volatile("s_waitcnt lgkmcnt(0)" ::: "memory")
#define VM_WAIT() asm volatile("s_waitcnt vmcnt(0)" ::: "memory")
__device__ __forceinline__ unsigned f2bf(float f) { unsigned u = __builtin_bit_cast(unsigned, f); return (u + 0x7fffu + ((u >> 16) & 1u)) >> 16; }
typedef float f32x2_t_ __attribute__((ext_vector_type(2))); typedef __bf16 bf16x2_t_ __attribute__((ext_vector_type(2)));
__device__ __forceinline__ unsigned pk2(float lo, float hi) { const f32x2_t_ v = {lo, hi}; const bf16x2_t_ b = __builtin_convertvector(v, bf16x2_t_); return __builtin_bit_cast(unsigned, b); }
__device__ __forceinline__ float bf2f(unsigned short b) { return __builtin_bit_cast(float, (unsigned)b << 16); }
__device__ __forceinline__ float bflo(unsigned w) { return __builtin_bit_cast(float, w << 16); }
__device__ __forceinline__ float bfhi(unsigned w) { return __builtin_bit_cast(float, w & 0xffff0000u); }
__device__ __forceinline__ float sigmoidf_(float x) { return 1.f / (1.f + expf(-x)); }
__device__ __forceinline__ float fsig(float x) { return __builtin_amdgcn_rcpf(1.f + __builtin_amdgcn_exp2f(-1.4426950408889634f * x)); }
__device__ __forceinline__ float siluf_(float x) { return x / (1.f + expf(-x)); }
__device__ __forceinline__ float dppf(float x, const int sel) {
    const int xi = __builtin_bit_cast(int, x); int r;
    if (sel == 0) r = __builtin_amdgcn_update_dpp(xi, xi, 0xB1, 0xF, 0xF, false);
    else if (sel == 1) r = __builtin_amdgcn_update_dpp(xi, xi, 0x4E, 0xF, 0xF, false);
    else if (sel == 2) r = __builtin_amdgcn_update_dpp(xi, xi, 0x141, 0xF, 0xF, false);
    else if (sel == 3) r = __builtin_amdgcn_update_dpp(xi, xi, 0x140, 0xF, 0xF, false);
    else r = __builtin_amdgcn_update_dpp(xi, xi, 0x128, 0xF, 0xF, false);
    return __builtin_bit_cast(float, r);
}
__device__ __forceinline__ float swz16f(float x) { return __builtin_bit_cast(float, __builtin_amdgcn_ds_swizzle(__builtin_bit_cast(int, x), 0x401F)); }
__device__ __forceinline__ float xh_sum(float x) { auto rr = __builtin_amdgcn_permlane32_swap(__float_as_uint(x), __float_as_uint(x), false, false); return __uint_as_float(rr[0]) + __uint_as_float(rr[1]); }
__device__ __forceinline__ float xh_max(float x) { auto rr = __builtin_amdgcn_permlane32_swap(__float_as_uint(x), __float_as_uint(x), false, false); return fmaxf(__uint_as_float(rr[0]), __uint_as_float(rr[1])); }
__device__ __forceinline__ unsigned xh_or(unsigned x) { auto rr = __builtin_amdgcn_permlane32_swap(x, x, false, false); return rr[0] | rr[1]; }
__device__ __forceinline__ float wave_sum(float v) {
    v += dppf(v, 0); v += dppf(v, 1); v += dppf(v, 2); v += dppf(v, 3); v += swz16f(v); return xh_sum(v);
}
__device__ __forceinline__ float wave_max(float v) {
    v = fmaxf(v, dppf(v, 0)); v = fmaxf(v, dppf(v, 1)); v = fmaxf(v, dppf(v, 2)); v = fmaxf(v, dppf(v, 3)); v = fmaxf(v, swz16f(v)); return xh_max(v);
}

constexpr size_t MiB = 1u << 20;
constexpr size_t WS_CTL = 0, CTL_ZERO_BYTES = 1 * MiB;
constexpr size_t WS_COS = 1 * MiB, WS_SIN = 1 * MiB + 512 * 1024;
constexpr size_t WS_LB = 2 * MiB;
constexpr size_t WS_DBON = 3 * MiB;
constexpr size_t WS_DAB = 4 * MiB;
constexpr size_t WS_DSS = 12 * MiB;
constexpr size_t WS_W1T = 16 * MiB;
constexpr size_t WS_WGT = 26 * MiB;
constexpr size_t WS_WBT = 34 * MiB;
constexpr size_t WS_WOT = 36 * MiB;
constexpr size_t WS_KI = 38 * MiB;
constexpr size_t WS_H = 42 * MiB;
constexpr size_t WS_PL = 106 * MiB;
constexpr size_t PLANE = 16 * MiB;
constexpr size_t WS_BF = WS_PL + 17 * PLANE;
constexpr size_t WS_MISC = WS_BF + 32 * MiB;
constexpr size_t WS_OL = WS_MISC + 32 * MiB;
constexpr size_t WS_CC = WS_OL + 16 * MiB;
constexpr size_t WS_BS = WS_CC + 16 * MiB;
constexpr size_t WS_BG = WS_BS + 32 * MiB;
constexpr size_t WS_END = WS_BG + 1 * MiB;
constexpr size_t WS_Y = WS_PL;
constexpr size_t WS_PB = WS_PL + 4 * PLANE;
static_assert(WS_PB + (size_t)4 * NTOK * 1024 * 2 <= WS_OL, "P_b overlay");
enum { PL_AQ = 0, PL_BQ = 1, PL_CQ = 2, PL_DR = 3, PL_AK = 4, PL_AV = 5, PL_AZ = 6, PL_BI = 7, PL_BZ = 8, PL_CK = 9, PL_CV = 10, PL_CZ = 11, PL_CQI0 = 12, PL_CQI1 = 13, PL_DK = 14, PL_DV = 15, PL_DZ = 16 };
#define PLP(ws, i) ((bf16*)((ws) + WS_PL + (size_t)(i) * PLANE))
constexpr int CW_BAR = 4096;

constexpr int RING_BYTES = 131072;
constexpr int LDSCTL_OFF = RING_BYTES, MISC_OFF = LDSCTL_OFF + 320;
constexpr int LDS_BYTES = 147456;

__device__ __forceinline__ int rope_j(int head, int dim) {
    const int bj = head >> 1, wc = ((head & 1) << 1) | ((dim >> 4) & 1), n = dim >> 5, fq = (dim >> 2) & 3, i = dim & 3;
    return 128 * bj + 32 * wc + 16 * n + 4 * fq + i;
}
__device__ __forceinline__ int win_dst_row(int c, int& which) {
    which = 0;
    if (c < 2048) return c;
    if (c < 2304) { const int l = c - 2048; return 8 * 256 + rope_j(l >> 6, l & 63); }
    if (c < 2560) { const int l = c - 2304; return 9 * 256 + rope_j(l >> 6, l & 63); }
    if (c < 3072) return c;
    if (c < 3584) { const int l = c - 3072; return (12 + (l >> 8)) * 256 + rope_j((l >> 6) & 3, l & 63); }
    if (c < 3648) return 14 * 256 + rope_j(0, c - 3584);
    if (c < 3656) return 14 * 256 + 64 + (c - 3648);
    if (c < 3912) return 15 * 256 + (c - 3656);
    if (c < 4168) return 16 * 256 + (c - 3912);
    if (c < 4424) return 17 * 256 + (c - 4168);
    if (c < 4488) return 14 * 256 + 72 + (c - 4424);
    if (c < 4552) return 14 * 256 + 136 + (c - 4488);
    if (c < 4808) return 18 * 256 + (c - 4552);
    which = 1;
    { const int g = c - 4808, br = g >> 10, y = g & 1023, pn = y >> 6, wc = (y >> 4) & 3, fq = (y >> 2) & 3, i = y & 3;
      return 256 * pn + 128 * (br >> 1) + 32 * wc + 16 * (br & 1) + 4 * fq + i; }
}

__device__ __forceinline__ size_t kfrag_off(int bh, int t, int d) { return ((((size_t)bh * 128 + (t >> 5)) * 4 + (d >> 4)) * 64 + ((t & 31) + 32 * ((d >> 3) & 1))) * 8 + (d & 7); }
__device__ __forceinline__ size_t vfrag_off(int bh, int t, int d) { const int kk = t & 31, r16 = kk & 15;
    return (((((size_t)bh * 128 + (t >> 5)) * 2 + (d >> 5)) * 2 + (kk >> 4)) * 64 + ((d & 31) + 32 * ((r16 >> 2) & 1))) * 8 + 4 * (r16 >> 3) + (r16 & 3); }

struct EpiG1 {
    static constexpr bool PERM = false, AFTER_DRAIN = false;
    unsigned char* ws; const float* lbl;
    __device__ __forceinline__ void operator()(const f32x4 (&acc)[2][2][4][2], const pg8::Unit& u, int wr, int wc, int fr, int fq) const {
        asm volatile("" : "+v"(fr), "+v"(fq));
        const int pn = u.pn;
        const int rbase = u.pm * 256 + wr * 64 + fr;
        const int cq = wc * 32 + 4 * fq;
        if (pn == 5) {
            float* BF = (float*)(ws + WS_BF);
#pragma unroll
            for (int bj = 0; bj < 2; ++bj)
#pragma unroll
                for (int n = 0; n < 2; ++n) {
                    const int col = cq + bj * 128 + n * 16;
                    const f32x4 l4 = *(const f32x4*)(lbl + col);
#pragma unroll
                    for (int ai = 0; ai < 2; ++ai)
#pragma unroll
                        for (int m = 0; m < 4; ++m) {
                            const f32x4 x = acc[ai][bj][m][n]; f32x4 o;
#pragma unroll
                            for (int i = 0; i < 4; ++i) o[i] = 1.f - (1.f - l4[i]) * fsig(-x[i]);
                            *(f32x4*)(BF + (size_t)(rbase + ai * 128 + m * 16) * 256 + col) = o;
                            asm volatile("" ::: "memory");
                        }
                }
        } else if (pn == 14) {
            float* MS = (float*)(ws + WS_MISC);
            const float* tcos = (const float*)(ws + WS_COS); const float* tsin = (const float*)(ws + WS_SIN);
#pragma unroll
            for (int bj = 0; bj < 2; ++bj) {
                if (bj == 0 && wc < 2) {
                    const int d0 = 16 * (wc & 1) + 4 * fq;
#pragma unroll
                    for (int ai = 0; ai < 2; ++ai)
#pragma unroll
                        for (int m = 0; m < 4; ++m) {
                            const int row = rbase + ai * 128 + m * 16, pos = row & (SEQ - 1);
                            const f32x4 c4 = *(const f32x4*)(tcos + pos * 32 + d0), s4 = *(const f32x4*)(tsin + pos * 32 + d0);
                            const f32x4 x1 = acc[ai][0][m][0], x2 = acc[ai][0][m][1];
                            const f32x4 y1 = x1 * c4 - x2 * s4, y2 = x2 * c4 + x1 * s4;
                            *(f32x4*)(MS + (size_t)row * 256 + d0) = y1;
                            *(f32x4*)(MS + (size_t)row * 256 + 32 + d0) = y2;
                            bf16* KIp = (bf16*)(ws + WS_KI);
                            v2u w1, w2; w1.x = pk2(y1[0], y1[1]); w1.y = pk2(y1[2], y1[3]); w2.x = pk2(y2[0], y2[1]); w2.y = pk2(y2[2], y2[3]);
                            *(v2u*)(KIp + kfrag_off(row >> 12, pos, d0)) = w1; *(v2u*)(KIp + kfrag_off(row >> 12, pos, 32 + d0)) = w2;
                            asm volatile("" ::: "memory");
                        }
                } else {
#pragma unroll
                    for (int n = 0; n < 2; ++n)
#pragma unroll
                        for (int ai = 0; ai < 2; ++ai)
#pragma unroll
                            for (int m = 0; m < 4; ++m)
                                *(f32x4*)(MS + (size_t)(rbase + ai * 128 + m * 16) * 256 + cq + bj * 128 + n * 16) = acc[ai][bj][m][n];
                }
            }
        } else {
            const unsigned long long lo = 0ull | (0ull << 0) | (4ull << 5) | (5ull << 10) | (6ull << 15) | (1ull << 20) | (0ull << 25) | (7ull << 30) | (8ull << 35) | (2ull << 40) | (9ull << 45) | (10ull << 50) | (11ull << 55);
            const unsigned long long hi = (12ull << 0) | (13ull << 5) | (0ull << 10) | (3ull << 15) | (14ull << 20) | (15ull << 25) | (16ull << 30);
            const int plane = (int)((pn < 12 ? (lo >> (5 * pn)) : (hi >> (5 * (pn - 12)))) & 31ull);
            bf16* PLN = PLP(ws, plane);
            if (pn == 8 || pn == 9 || pn == 12 || pn == 13) {
                const float* tcos = (const float*)(ws + WS_COS); const float* tsin = (const float*)(ws + WS_SIN);
                const int d0 = 16 * (wc & 1) + 4 * fq;
#pragma unroll
                for (int ai = 0; ai < 2; ++ai)
#pragma unroll
                    for (int m = 0; m < 4; ++m) {
                        const int row = rbase + ai * 128 + m * 16, pos = row & (SEQ - 1);
                        const f32x4 c4 = *(const f32x4*)(tcos + pos * 32 + d0), s4 = *(const f32x4*)(tsin + pos * 32 + d0);
#pragma unroll
                        for (int bj = 0; bj < 2; ++bj) {
                            const int head = 2 * bj + (wc >> 1);
                            const f32x4 x1 = acc[ai][bj][m][0], x2 = acc[ai][bj][m][1];
                            const f32x4 y1 = x1 * c4 - x2 * s4, y2 = x2 * c4 + x1 * s4;
                            v2u w1, w2; w1.x = pk2(y1[0], y1[1]); w1.y = pk2(y1[2], y1[3]); w2.x = pk2(y2[0], y2[1]); w2.y = pk2(y2[2], y2[3]);
                            if (pn == 9) {
                                const int bh = (row >> 12) * 4 + head;
                                *(v2u*)(PLN + kfrag_off(bh, pos, d0)) = w1; *(v2u*)(PLN + kfrag_off(bh, pos, 32 + d0)) = w2;
                            } else {
                                *(v2u*)(PLN + (size_t)row * 256 + head * 64 + d0) = w1;
                                *(v2u*)(PLN + (size_t)row * 256 + head * 64 + 32 + d0) = w2;
                            }
                        }
                        asm volatile("" ::: "memory");
                    }
            } else if (pn == 2 || pn == 10) {
#pragma unroll
                for (int ai = 0; ai < 2; ++ai)
#pragma unroll
                    for (int m = 0; m < 4; ++m) {
                        const int row = rbase + ai * 128 + m * 16, bb = row >> 12, tq = row & (SEQ - 1);
#pragma unroll
                        for (int bj = 0; bj < 2; ++bj)
#pragma unroll
                            for (int n = 0; n < 2; ++n) {
                                const f32x4 x = acc[ai][bj][m][n]; const int col = cq + bj * 128 + n * 16;
                                bf16* p = PLN + vfrag_off(bb * 4 + (col >> 6), tq, col & 63);
#pragma unroll
                                for (int i = 0; i < 4; ++i) p[8 * i] = (bf16)f2bf(x[i]);
                            }
                        asm volatile("" ::: "memory");
                    }
            } else if (pn == 1) {
#pragma unroll
                for (int ai = 0; ai < 2; ++ai)
#pragma unroll
                    for (int m = 0; m < 4; ++m) {
                        const int row = rbase + ai * 128 + m * 16, bb = row >> 12, tq = row & (SEQ - 1);
#pragma unroll
                        for (int bj = 0; bj < 2; ++bj)
#pragma unroll
                            for (int n = 0; n < 2; ++n) {
                                const f32x4 x = acc[ai][bj][m][n]; const int col = cq + bj * 128 + n * 16;
                                v2u w; w.x = pk2(x[0], x[1]); w.y = pk2(x[2], x[3]);
                                *(v2u*)(PLN + kfrag_off(bb * 4 + (col >> 6), tq, col & 63)) = w;
                            }
                        asm volatile("" ::: "memory");
                    }
            } else if (pn == 4) {
#pragma unroll
                for (int ai = 0; ai < 2; ++ai)
#pragma unroll
                    for (int m = 0; m < 4; ++m) {
                        bf16* rowp = PLN + (size_t)(rbase + ai * 128 + m * 16) * 256 + cq;
#pragma unroll
                        for (int bj = 0; bj < 2; ++bj)
#pragma unroll
                            for (int n = 0; n < 2; ++n) {
                                f32x4 x = acc[ai][bj][m][n];
#pragma unroll
                                for (int i = 0; i < 4; ++i) x[i] = x[i] * fsig(x[i]);
                                v2u w; w.x = pk2(x[0], x[1]); w.y = pk2(x[2], x[3]);
                                *(v2u*)(rowp + bj * 128 + n * 16) = w;
                            }
                        asm volatile("" ::: "memory");
                    }
            } else {
#pragma unroll
                for (int ai = 0; ai < 2; ++ai)
#pragma unroll
                    for (int m = 0; m < 4; ++m) {
                        bf16* rowp = PLN + (size_t)(rbase + ai * 128 + m * 16) * 256 + cq;
#pragma unroll
                        for (int bj = 0; bj < 2; ++bj)
#pragma unroll
                            for (int n = 0; n < 2; ++n) {
                                const f32x4 x = acc[ai][bj][m][n];
                                v2u w; w.x = pk2(x[0], x[1]); w.y = pk2(x[2], x[3]);
                                *(v2u*)(rowp + bj * 128 + n * 16) = w;
                            }
                        asm volatile("" ::: "memory");
                    }
            }
        }
    }
};
struct EpiBf {
    static constexpr bool PERM = false, AFTER_DRAIN = false;
    bf16* O; int ldc;
    __device__ __forceinline__ void operator()(const f32x4 (&acc)[2][2][4][2], const pg8::Unit& u, int wr, int wc, int fr, int fq) const {
        asm volatile("" : "+v"(fr), "+v"(fq));
        const int rbase = u.pm * 256 + wr * 64 + fr, cb = u.pn * 256 + wc * 32 + 4 * fq;
#pragma unroll
        for (int ai = 0; ai < 2; ++ai)
#pragma unroll
            for (int m = 0; m < 4; ++m) {
                bf16* rowp = O + (size_t)(rbase + ai * 128 + m * 16) * ldc + cb;
#pragma unroll
                for (int bj = 0; bj < 2; ++bj)
#pragma unroll
                    for (int n = 0; n < 2; ++n) { const f32x4 x = acc[ai][bj][m][n]; v2u w; w.x = pk2(x[0], x[1]); w.y = pk2(x[2], x[3]); *(v2u*)(rowp + bj * 128 + n * 16) = w; }
            }
    }
};
struct EpiGate {
    static constexpr bool PERM = false, AFTER_DRAIN = false;
    const bf16* PB; bf16* Y;
    __device__ __forceinline__ void operator()(const f32x4 (&acc)[2][2][4][2], const pg8::Unit& u, int wr, int wc, int fr, int fq) const {
        asm volatile("" : "+v"(fr), "+v"(fq));
        const int rbase = u.pm * 256 + wr * 64 + fr, yc = u.pn * 64 + wc * 16 + 4 * fq;
#pragma unroll
        for (int ai = 0; ai < 2; ++ai)
#pragma unroll
            for (int m = 0; m < 4; ++m) {
                const size_t row = (size_t)(rbase + ai * 128 + m * 16);
                f32x4 y = (f32x4){0.f, 0.f, 0.f, 0.f};
#pragma unroll
                for (int br = 0; br < 4; ++br) {
                    const v2u pw = *(const v2u*)(PB + ((size_t)br * NTOK + row) * 1024 + yc);
                    const f32x4 g = acc[ai][br >> 1][m][br & 1];
                    y[0] += bflo(pw.x) * fsig(g[0]); y[1] += bfhi(pw.x) * fsig(g[1]);
                    y[2] += bflo(pw.y) * fsig(g[2]); y[3] += bfhi(pw.y) * fsig(g[3]);
                }
                v2u w; w.x = pk2(y[0], y[1]); w.y = pk2(y[2], y[3]);
                *(v2u*)(Y + row * 1024 + yc) = w;
                asm volatile("" ::: "memory");
            }
    }
};
struct EpiRes {
    static constexpr bool PERM = false, AFTER_DRAIN = false;
    const float* R; float* O;
    __device__ __forceinline__ void operator()(const f32x4 (&acc)[2][2][4][2], const pg8::Unit& u, int wr, int wc, int fr, int fq) const {
        asm volatile("" : "+v"(fr), "+v"(fq));
        const int rbase = u.pm * 256 + wr * 64 + fr, cb = u.pn * 256 + wc * 32 + 4 * fq;
#pragma unroll
        for (int ai = 0; ai < 2; ++ai)
#pragma unroll
            for (int m = 0; m < 4; ++m) {
                const size_t off = (size_t)(rbase + ai * 128 + m * 16) * 1024 + cb;
#pragma unroll
                for (int bj = 0; bj < 2; ++bj)
#pragma unroll
                    for (int n = 0; n < 2; ++n) { const f32x4 r = *(const f32x4*)(R + off + bj * 128 + n * 16); *(f32x4*)(O + off + bj * 128 + n * 16) = r + acc[ai][bj][m][n]; }
            }
    }
};
#define XB_TMO      128
#define XB_XCNT(j)  (256  + 64 * (j))
#define XB_XSUB(j)  (1280 + 64 * (j))
#define XB_XGEN(j)  (2304 + 64 * (j))
#define XB_TOP      3328
#define XB_TOPGEN   3392
#define XCD_BAR_WORDS 3456
#define XB_SPIN_CAP (1u << 18)

__device__ __forceinline__ unsigned xb_ld(unsigned* p)              { return __hip_atomic_load(p, __ATOMIC_RELAXED, __HIP_MEMORY_SCOPE_AGENT); }
__device__ __forceinline__ unsigned xb_add(unsigned* p, unsigned v) { return __hip_atomic_fetch_add(p, v, __ATOMIC_RELAXED, __HIP_MEMORY_SCOPE_AGENT); }
__device__ __forceinline__ unsigned xb_xcc_id() { return (unsigned)__builtin_amdgcn_s_getreg((3 << 11) | 20) & 0xFu; }
#define XB_SPIN(cond, bar) do { unsigned _sp = 0; while (cond) { __builtin_amdgcn_s_sleep(1); \
    if ((++_sp & 255u) == 0u) { if (xb_ld(&(bar)[XB_TMO])) break; if (_sp > XB_SPIN_CAP) { atomicAdd(&(bar)[XB_TMO], 1u); break; } } } } while (0)

struct XcdBarrier {
    unsigned* bar; unsigned x;
    volatile LAS unsigned* st;
};

__device__ __forceinline__ XcdBarrier xcd_barrier_post(unsigned* bar, volatile LAS unsigned* st) {
    XcdBarrier b; b.bar = bar; b.x = xb_xcc_id(); b.st = st;
    if (threadIdx.x == 0) (void)xb_add(&bar[XB_XCNT(b.x)], 1u);
    return b;
}
__device__ __forceinline__ void xcd_barrier_complete(unsigned* bar, unsigned x, unsigned& nloc, unsigned& nx) {
    const unsigned G = gridDim.x * gridDim.y * gridDim.z;
    unsigned sum, cnt, mine, sp = 0u;
    for (;;) {
        sum = 0u; cnt = 0u; mine = 0u;
#pragma unroll
        for (unsigned j = 0; j < 16; ++j) { const unsigned c = xb_ld(&bar[XB_XCNT(j)]); sum += c; cnt += (c > 0u) ? 1u : 0u; mine = (j == x) ? c : mine; }
        if (sum == G) break;
        __builtin_amdgcn_s_sleep(1);
        if ((++sp & 255u) == 0u) { if (xb_ld(&bar[XB_TMO])) break; if (sp > XB_SPIN_CAP) { atomicAdd(&bar[XB_TMO], 1u); break; } }
    }
    nloc = mine > 0u ? mine : 1u; nx = cnt > 0u ? cnt : 1u;
}

__device__ __forceinline__ void xcd_barrier(const XcdBarrier& b_in, const bool t0) {
    XcdBarrier b = b_in; asm volatile("" : "+s"(b.bar), "+s"(b.x));
    asm volatile("s_waitcnt vmcnt(0)" ::: "memory");
    __syncthreads();
    if (t0) {
        unsigned* bar = b.bar;
        __builtin_amdgcn_s_waitcnt(0);
        unsigned nloc = b.st[0], nx = b.st[1];
        if (nloc == 0u) { xcd_barrier_complete(bar, b.x, nloc, nx); b.st[0] = nloc; b.st[1] = nx; }
        const unsigned old = xb_add(&bar[XB_XSUB(b.x)], 1u);
        const unsigned gen = old / nloc;
        if (old + 1u == (gen + 1u) * nloc) {
            __builtin_amdgcn_fence(__ATOMIC_RELEASE, "agent");
            asm volatile("s_waitcnt vmcnt(0)" ::: "memory");
            const unsigned og = xb_add(&bar[XB_TOP], 1u);
            const unsigned tg = og / nx;
            if (og + 1u == (tg + 1u) * nx) xb_add(&bar[XB_TOPGEN], 1u);
            else XB_SPIN(xb_ld(&bar[XB_TOPGEN]) == tg, bar);
            __builtin_amdgcn_fence(__ATOMIC_ACQUIRE, "agent");
            xb_add(&bar[XB_XGEN(b.x)], 1u);
            asm volatile("s_waitcnt vmcnt(0)" ::: "memory");
        } else {
            XB_SPIN(xb_ld(&bar[XB_XGEN(b.x)]) == gen, bar);
            __builtin_amdgcn_fence(__ATOMIC_ACQUIRE, "agent");
            asm volatile("s_waitcnt vmcnt(0)" ::: "memory");
        }
    }
    __syncthreads();
}

struct Params { const float* in[19]; float* out; unsigned char* ws; };
struct Ctx {
    LAS unsigned char* lds; int tid, lane, wave, G, bid;
};
__device__ __forceinline__ int lane_id_fresh() { int l; asm volatile("v_mbcnt_lo_u32_b32 %0, -1, 0\n\tv_mbcnt_hi_u32_b32 %0, -1, %0" : "=v"(l)); return l; }
#define OPQ(C) do { (C).lane = lane_id_fresh(); (C).tid = (C).wave * 64 + (C).lane; } while (0)

template <class MapFn>
__device__ __forceinline__ void transpose_item(const float* W, int K, int N, LAS float* scr, int item, int lane, MapFn map) {
    const int nblk = (N + 31) / 32, kb = item / nblk, nb = item % nblk, k0 = 64 * kb, n0 = 32 * nb;
    const int ncol = n0 + (lane & 31);
#pragma unroll 8
    for (int i = 0; i < 32; ++i) { const int kk = 2 * i + (lane >> 5); scr[kk * 33 + (lane & 31)] = (ncol < N) ? W[(size_t)(k0 + kk) * N + ncol] : 0.f; }
    LDS_WAIT(); asm volatile("" ::: "memory");
    const int c = lane & 7;
#pragma unroll
    for (int j = 0; j < 4; ++j) {
        const int n = (lane >> 3) + 8 * j; const LAS float* s = scr + (8 * c) * 33 + n;
        v4u o; o.x = pk2(s[0 * 33], s[1 * 33]); o.y = pk2(s[2 * 33], s[3 * 33]); o.z = pk2(s[4 * 33], s[5 * 33]); o.w = pk2(s[6 * 33], s[7 * 33]);
        if (n0 + n < N) { bf16* dst = map(n0 + n); *(v4u*)(dst + k0 + 8 * c) = o; }
    }
    LDS_WAIT(); asm volatile("" ::: "memory");
}
__device__ __forceinline__ void convert_weights(Ctx C, const Params& P, int l) {
    OPQ(C);
    LAS float* scr = (LAS float*)(C.lds + C.wave * 16384);
    const int gw = C.bid * 8 + C.wave, NGW = C.G * 8;
    unsigned char* ws = P.ws;
    bf16* W1t = (bf16*)(ws + WS_W1T); bf16* Wgt = (bf16*)(ws + WS_WGT);
    bf16* Wbt = (bf16*)(ws + WS_WBT); bf16* Wot = (bf16*)(ws + WS_WOT);
    const float* w_in = P.in[2] + (size_t)l * 1024 * INC; const float* w_br = P.in[16] + (size_t)l * 4 * 256 * 1024; const float* w_out = P.in[17] + (size_t)l * 1024 * 1024;
    constexpr int I_IN = 16 * ((INC + 31) / 32), I_BR = 4 * 32, I_OUT = 16 * 32;
    constexpr int NITEMS = I_IN + 4 * I_BR + I_OUT;
    for (int it = gw; it < NITEMS; it += NGW) {
        int r = it;
        if (r < I_IN) { transpose_item(w_in, 1024, INC, scr, r, C.lane, [&](int c) -> bf16* { int which; const int row = win_dst_row(c, which); return (which ? Wgt : W1t) + (size_t)row * 1024; }); continue; }
        r -= I_IN;
        if (r < 4 * I_BR) { const int br = r / I_BR, ri = r % I_BR; transpose_item(w_br + (size_t)br * 256 * 1024, 256, 1024, scr, ri, C.lane, [&](int c) -> bf16* { return Wbt + ((size_t)br * 1024 + c) * 256; }); continue; }
        r -= 4 * I_BR;
        transpose_item(w_out, 1024, 1024, scr, r, C.lane, [&](int c) -> bf16* { return Wot + (size_t)c * 1024; });
    }
    for (int i = C.bid * 512 + C.tid; i < 56 * 1024 / 8; i += C.G * 512) *(v4u*)(W1t + (size_t)(14 * 256 + 200) * 1024 + (size_t)i * 8) = (v4u){0u, 0u, 0u, 0u};
}
__device__ __forceinline__ void rms_row(const float* xrow, const float* g, bf16* obf, float* of32, int lane) {
    const f32x4* xr = (const f32x4*)xrow + lane;
    f32x4 v[4]; float s = 0.f;
#pragma unroll
    for (int j = 0; j < 4; ++j) { v[j] = xr[64 * j]; s += (v[j].x * v[j].x + v[j].y * v[j].y) + (v[j].z * v[j].z + v[j].w * v[j].w); }
    const float inv = rsqrtf(wave_sum(s) * (1.f / 1024.f) + 1e-6f);
#pragma unroll
    for (int j = 0; j < 4; ++j) {
        const f32x4 gg = ((const f32x4*)g)[lane + 64 * j];
        const f32x4 o = v[j] * inv * gg;
        if (obf) { v2u w; w.x = pk2(o.x, o.y); w.y = pk2(o.z, o.w); ((v2u*)obf)[lane + 64 * j] = w; }
        else ((f32x4*)of32)[lane + 64 * j] = o;
    }
}
__device__ __forceinline__ void norm_rows_bf16(Ctx C, const float* x, const float* g, bf16* h) {
    OPQ(C);
    const int gw = C.bid * 8 + C.wave, NGW = C.G * 8;
    for (int m = gw; m < NTOK; m += NGW) rms_row(x + (size_t)m * 1024, g, h + (size_t)m * 1024, nullptr, C.lane);
}
__device__ __forceinline__ void setup_tables(Ctx C, const Params& P) {
    OPQ(C);
    float* tcos = (float*)(P.ws + WS_COS); float* tsin = (float*)(P.ws + WS_SIN); float* lb = (float*)(P.ws + WS_LB);
    for (int i = C.bid * 512 + C.tid; i < SEQ * 32; i += C.G * 512) {
        const int pos = i >> 5, j = i & 31;
        const float freq = (float)pow(10000.0, -(double)j / 32.0);
        const float ang = (float)pos * freq;
        tcos[i] = (float)cos((double)ang); tsin[i] = (float)sin((double)ang);
    }
    if (C.bid == 0 && C.tid < 256) {
        const float l0 = P.in[4][C.tid], l1 = P.in[4][256 + C.tid];
        lb[C.tid] = 0.f; lb[256 + C.tid] = 1.f / (1.f + expf(l0 - l1));
    }
}

__device__ __forceinline__ void mixA_simple(Ctx C, unsigned char* ws, const float* bias) {
    OPQ(C);
    bf16* AQ = PLP(ws, PL_AQ); const bf16* AK = PLP(ws, PL_AK); const bf16* AV = PLP(ws, PL_AV); const bf16* AZ = PLP(ws, PL_AZ);
    for (int it = C.bid * 512 + C.tid; it < 4 * NTOK; it += C.G * 512) {
        const int h = it / NTOK, m = it % NTOK, b = m >> 12, t = m & 4095, c = t >> 6, qi = t & 63;
        float q[64], o[64];
        {
            const v4u* qp = (const v4u*)(AQ + (size_t)m * 256 + h * 64);
#pragma unroll
            for (int j = 0; j < 8; ++j) { const v4u w = qp[j]; q[8 * j] = bflo(w.x); q[8 * j + 1] = bfhi(w.x); q[8 * j + 2] = bflo(w.y); q[8 * j + 3] = bfhi(w.y); q[8 * j + 4] = bflo(w.z); q[8 * j + 5] = bfhi(w.z); q[8 * j + 6] = bflo(w.w); q[8 * j + 7] = bfhi(w.w); }
        }
#pragma unroll
        for (int d = 0; d < 64; ++d) o[d] = 0.f;
        float mx = -INFINITY, l = 0.f;
        const float* bh = bias + h * 192;
        for (int kj = 0; kj < 576; ++kj) {
            const int kp = c * 64 - 512 + kj;
            if (kp < 0) continue;
            const size_t mk = ((size_t)b << 12) + kp;
            const v4u* kr = (const v4u*)(AK + mk * 256 + h * 64); const v4u* vr = (const v4u*)(AV + mk * 256 + h * 64);
            float s = 0.f;
#pragma unroll
            for (int j = 0; j < 8; ++j) { const v4u w = kr[j];
                s = fmaf(q[8 * j], bflo(w.x), s); s = fmaf(q[8 * j + 1], bfhi(w.x), s); s = fmaf(q[8 * j + 2], bflo(w.y), s); s = fmaf(q[8 * j + 3], bfhi(w.y), s);
                s = fmaf(q[8 * j + 4], bflo(w.z), s); s = fmaf(q[8 * j + 5], bfhi(w.z), s); s = fmaf(q[8 * j + 6], bflo(w.w), s); s = fmaf(q[8 * j + 7], bfhi(w.w), s); }
            int rel = qi + 512 - kj; rel = rel < -63 ? -63 : (rel > 128 ? 128 : rel);
            s = s * 0.125f + bh[rel + 63];
            const float mn = fmaxf(mx, s), al = expf(mx - mn), pe = expf(s - mn);
            l = l * al + pe; mx = mn;
#pragma unroll
            for (int j = 0; j < 8; ++j) { const v4u w = vr[j];
                o[8 * j] = fmaf(pe, bflo(w.x), o[8 * j] * al); o[8 * j + 1] = fmaf(pe, bfhi(w.x), o[8 * j + 1] * al); o[8 * j + 2] = fmaf(pe, bflo(w.y), o[8 * j + 2] * al); o[8 * j + 3] = fmaf(pe, bfhi(w.y), o[8 * j + 3] * al);
                o[8 * j + 4] = fmaf(pe, bflo(w.z), o[8 * j + 4] * al); o[8 * j + 5] = fmaf(pe, bfhi(w.z), o[8 * j + 5] * al); o[8 * j + 6] = fmaf(pe, bflo(w.w), o[8 * j + 6] * al); o[8 * j + 7] = fmaf(pe, bfhi(w.w), o[8 * j + 7] * al); }
        }
        const float invl = 1.f / l;
        const v4u* zp = (const v4u*)(AZ + (size_t)m * 256 + h * 64); v4u* op = (v4u*)(AQ + (size_t)m * 256 + h * 64);
#pragma unroll
        for (int j = 0; j < 8; ++j) { const v4u z = zp[j]; v4u w;
            w.x = pk2(o[8 * j] * invl * siluf_(bflo(z.x)), o[8 * j + 1] * invl * siluf_(bfhi(z.x))); w.y = pk2(o[8 * j + 2] * invl * siluf_(bflo(z.y)), o[8 * j + 3] * invl * siluf_(bfhi(z.y)));
            w.z = pk2(o[8 * j + 4] * invl * siluf_(bflo(z.z)), o[8 * j + 5] * invl * siluf_(bfhi(z.z))); w.w = pk2(o[8 * j + 6] * invl * siluf_(bflo(z.w)), o[8 * j + 7] * invl * siluf_(bfhi(z.w)));
            op[j] = w; }
    }
}
__device__ __forceinline__ void mixB_simple(Ctx C, unsigned char* ws, const float* normg) {
    OPQ(C);
    if (C.bid < 32 || C.bid >= 36) return;
    const int gw = (C.bid - 32) * 8 + C.wave;
    const int b = gw >> 2, h = gw & 3, v = C.lane;
    bf16* BQ = PLP(ws, PL_BQ); const bf16* BI = PLP(ws, PL_BI); const bf16* BZ = PLP(ws, PL_BZ); const float* BF = (const float*)(ws + WS_BF);
    float S[64];
#pragma unroll
    for (int d = 0; d < 64; ++d) S[d] = 0.f;
    const float g = normg[v];
    for (int t = 0; t < SEQ; ++t) {
        const size_t m = ((size_t)b << 12) + t;
        const float* fr = BF + m * 256 + h * 64; const bf16* qr = BQ + m * 256 + h * 64;
        const float iv = bf2f(BI[m * 256 + h * 64 + v]); const float z = bf2f(BZ[m * 256 + h * 64 + v]);
        float o = 0.f;
#pragma unroll
        for (int d = 0; d < 64; ++d) { S[d] = fmaf(fr[d], S[d] - iv, iv); o = fmaf(bf2f(qr[d]), S[d], o); }
        const float r = rsqrtf(wave_sum(o * o) * (1.f / 64.f) + 1e-6f);
        asm volatile("" ::: "memory");
        BQ[m * 256 + h * 64 + v] = (bf16)f2bf(o * r * g * siluf_(z));
    }
}
__device__ __forceinline__ void mixD_simple(Ctx C, unsigned char* ws, const Params& P, int l) {
    OPQ(C);
    if (C.bid >= 32) return;
    const int b = C.bid >> 2, h = C.bid & 3, tid = C.tid;
    bf16* DR = PLP(ws, PL_DR); const bf16* DK = PLP(ws, PL_DK); const bf16* DV = PLP(ws, PL_DV); const bf16* DZ = PLP(ws, PL_DZ); const float* MS = (const float*)(ws + WS_MISC);
    const float* mu = P.in[6] + l * 896; const float* w0 = P.in[7] + l * 256; const float* w_up = P.in[8] + (size_t)l * 64 * 256; const float* a0 = P.in[9] + l * 256;
    const float* a_up = P.in[10] + (size_t)l * 64 * 256; const float* k_k = P.in[11] + l * 256; const float* k_a = P.in[12] + l * 256; const float* r_k = P.in[13] + l * 256;
    const float* gn_g = P.in[14] + l * 256; const float* gn_b = P.in[15] + l * 256;
    LAS float* L = (LAS float*)C.lds;
    LAS float* twd = L; LAS float* ads = L + 64; LAS float* rs = L + 128; LAS float* kr = L + 192; LAS float* vs = L + 256;
    LAS float* wv = L + 320; LAS float* av = L + 384; LAS float* kkv = L + 448; LAS float* kfv = L + 512; LAS float* bv = L + 576; LAS float* ob = L + 640; LAS float* bon = L + 704;
    const int v = tid >> 3, ks = tid & 7;
    float S[8];
#pragma unroll
    for (int i = 0; i < 8; ++i) S[i] = 0.f;
    const int grp = tid >> 6, cc = tid & 63;
    float prev = 0.f, mucol = 0.f;
    if (grp == 0) mucol = mu[768 + cc]; else if (grp == 1) mucol = mu[832 + cc]; else if (grp == 2) mucol = mu[h * 64 + cc]; else if (grp == 3) mucol = mu[256 + h * 64 + cc]; else if (grp == 4) mucol = mu[512 + h * 64 + cc];
    for (int t = 0; t < SEQ; ++t) {
        const size_t m = ((size_t)b << 12) + t;
        if (grp < 5) {
            float cur;
            if (grp == 0) cur = MS[m * 256 + 72 + cc]; else if (grp == 1) cur = MS[m * 256 + 136 + cc];
            else if (grp == 2) cur = bf2f(DR[m * 256 + h * 64 + cc]); else if (grp == 3) cur = bf2f(DK[m * 256 + h * 64 + cc]); else cur = bf2f(DV[m * 256 + h * 64 + cc]);
            const float sh = cur + mucol * (prev - cur); prev = cur;
            if (grp == 0) twd[cc] = tanhf(sh); else if (grp == 1) ads[cc] = sh; else if (grp == 2) rs[cc] = sh; else if (grp == 3) kr[cc] = sh; else vs[cc] = sh;
        }
        __syncthreads();
        if (tid < 128) {
            const int c = tid & 63, hc = h * 64 + c;
            if (tid < 64) { float wl = w0[hc];
_Pragma("nounroll")
                for (int i = 0; i < 64; ++i) wl = fmaf(twd[i], w_up[i * 256 + hc], wl);
                const float x = -wl; const float sp = fmaxf(x, 0.f) + log1pf(expf(-fabsf(x))); wv[c] = expf(-expf(-sp - 0.5f)); }
            else { float al = a0[hc];
_Pragma("nounroll")
                for (int i = 0; i < 64; ++i) al = fmaf(ads[i], a_up[i * 256 + hc], al); av[c] = sigmoidf_(al); }
        }
        __syncthreads();
        if (tid < 64) {
            const int hc = h * 64 + tid; const float kx = kr[tid], a = av[tid];
            const float kkr = kx * k_k[hc]; const float nrm = sqrtf(wave_sum(kkr * kkr)); const float kk = kkr / fmaxf(nrm, 1e-12f);
            const float kf = kx * (1.f + (a - 1.f) * k_a[hc]);
            kkv[tid] = kk; kfv[tid] = kf; bv[tid] = kk * a;
            const float bsum = wave_sum(rs[tid] * kf * r_k[hc]); if (tid == 0) bon[0] = bsum;
        }
        __syncthreads();
        {
            float sa = 0.f;
#pragma unroll
            for (int i = 0; i < 8; ++i) sa = fmaf(S[i], kkv[8 * ks + i], sa);
            sa += __shfl_xor(sa, 1); sa += __shfl_xor(sa, 2); sa += __shfl_xor(sa, 4); sa = -sa;
            const float vv = vs[v]; float o = 0.f;
#pragma unroll
            for (int i = 0; i < 8; ++i) { S[i] = fmaf(S[i], wv[8 * ks + i], fmaf(sa, bv[8 * ks + i], vv * kfv[8 * ks + i])); o = fmaf(S[i], rs[8 * ks + i], o); }
            o += __shfl_xor(o, 1); o += __shfl_xor(o, 2); o += __shfl_xor(o, 4);
            if (ks == 0) ob[v] = o;
        }
        __syncthreads();
        if (tid < 64) {
            const int hc = h * 64 + tid; const float o = ob[tid];
            const float mean = wave_sum(o) * (1.f / 64.f); const float d = o - mean; const float var = wave_sum(d * d) * (1.f / 64.f);
            float y = d * rsqrtf(var + 64e-5f) * gn_g[hc] + gn_b[hc];
            y += bon[0] * vs[tid];
            const float z = bf2f(DZ[m * 256 + hc]);
            DR[m * 256 + hc] = (bf16)f2bf(y * siluf_(z));
        }
        __syncthreads();
    }
}
__device__ __forceinline__ void mixC_simple(Ctx C, unsigned char* ws) {
    OPQ(C);
    bf16* CQ = PLP(ws, PL_CQ); const bf16* CK = PLP(ws, PL_CK); const bf16* CV = PLP(ws, PL_CV); const bf16* CZ = PLP(ws, PL_CZ);
    const bf16* QI0 = PLP(ws, PL_CQI0); const bf16* QI1 = PLP(ws, PL_CQI1); const float* MS = (const float*)(ws + WS_MISC);
    LAS float* L = (LAS float*)C.lds;
    LAS float* qs = L;
    LAS float* q4 = L + 512;
    LAS float* wq = L + 768;
    LAS float* sc = L + 1024;
    LAS float* ps = L + 5120;
    LAS int* sel = (LAS int*)(L + 6144);
    LAS unsigned* hist = (LAS unsigned*)(L + 6400);
    LAS float* red = L + 6656;
    LAS unsigned* sw = (LAS unsigned*)(L + 6672);
    const int tid = C.tid;
    for (int m = C.bid; m < NTOK; m += C.G) {
        const int b = m >> 12, t = m & 4095, n = ((t >> 6) + 1) * 64;
        qs[tid] = bf2f(tid < 256 ? QI0[(size_t)m * 256 + tid] : QI1[(size_t)m * 256 + tid - 256]);
        if (tid < 256) q4[tid] = bf2f(CQ[(size_t)m * 256 + tid]);
        if (tid < 8) wq[tid] = MS[(size_t)m * 256 + 64 + tid] * 0.35355339059327373f;
        __syncthreads();
        for (int s = tid; s < n; s += 512) {
            const f32x4* kp = (const f32x4*)(MS + (((size_t)b << 12) + s) * 256);
            float kv[64];
#pragma unroll
            for (int j = 0; j < 16; ++j) { const f32x4 w = kp[j]; kv[4 * j] = w.x; kv[4 * j + 1] = w.y; kv[4 * j + 2] = w.z; kv[4 * j + 3] = w.w; }
            float acc = 0.f;
            for (int hh = 0; hh < 8; ++hh) {
                float d = 0.f;
#pragma unroll
                for (int c = 0; c < 64; ++c) d = fmaf(qs[hh * 64 + c], kv[c], d);
                d = fmaxf(d * 0.125f, 0.f);
                acc = fmaf(d, wq[hh], acc);
            }
            sc[s] = acc;
        }
        __syncthreads();
        int cnt;
        if (n <= 256) { if (tid < n) sel[tid] = tid; cnt = n; }
        else {
            unsigned key[8];
#pragma unroll
            for (int j = 0; j < 8; ++j) { const int idx = tid + 512 * j; unsigned kk = 0u; if (idx < n) { const unsigned u = __float_as_uint(sc[idx]); kk = (u & 0x80000000u) ? ~u : (u | 0x80000000u); } key[j] = kk; }
            if (tid == 0) { sw[0] = 0u; sw[1] = 256u; sw[3] = 0u; }
            unsigned mask = 0u;
            for (int pass = 3; pass >= 0; --pass) {
                const int shift = pass * 8;
                if (tid < 256) hist[tid] = 0u;
                __syncthreads();
                const unsigned prefix = sw[0];
#pragma unroll
                for (int j = 0; j < 8; ++j) { const int idx = tid + 512 * j; if (idx < n && (key[j] & mask) == prefix) atomicAdd((unsigned*)&hist[(key[j] >> shift) & 255u], 1u); }
                __syncthreads();
                if (tid == 0) { const unsigned k = sw[1]; unsigned c = 0u; int bb = 255; for (; bb > 0; --bb) { if (c + hist[bb] >= k) break; c += hist[bb]; }
                    sw[1] = k - c; sw[0] = prefix | ((unsigned)bb << shift); sw[2] = hist[bb]; }
                mask |= (0xFFu << shift);
                __syncthreads();
            }
            const unsigned thr = sw[0], need = sw[1], eqc = sw[2];
            if (tid == 0) { int cut = SEQ;
                if (eqc != need) { unsigned c = 0u; for (int i = 0; i < n; ++i) { const unsigned u = __float_as_uint(sc[i]); const unsigned kk = (u & 0x80000000u) ? ~u : (u | 0x80000000u); if (kk == thr) { ++c; if (c == need) { cut = i; break; } } } }
                sw[4] = (unsigned)cut; }
            __syncthreads();
            const int cut = (int)sw[4];
#pragma unroll
            for (int j = 0; j < 8; ++j) { const int idx = tid + 512 * j; if (idx < n && (key[j] > thr || (key[j] == thr && idx <= cut))) { const unsigned pos = atomicAdd((unsigned*)&sw[3], 1u); if (pos < 256u) sel[pos] = idx; } }
            cnt = 256;
        }
        __syncthreads();
        float s4[4] = {-INFINITY, -INFINITY, -INFINITY, -INFINITY};
        if (tid < cnt) {
            const v4u* kr = (const v4u*)(CK + (((size_t)b << 12) + sel[tid]) * 256);
#pragma unroll
            for (int hh = 0; hh < 4; ++hh) { float d = 0.f;
#pragma unroll
                for (int j = 0; j < 8; ++j) { const v4u w = kr[hh * 8 + j]; const LAS float* qq = q4 + hh * 64 + 8 * j;
                    d = fmaf(qq[0], bflo(w.x), d); d = fmaf(qq[1], bfhi(w.x), d); d = fmaf(qq[2], bflo(w.y), d); d = fmaf(qq[3], bfhi(w.y), d);
                    d = fmaf(qq[4], bflo(w.z), d); d = fmaf(qq[5], bfhi(w.z), d); d = fmaf(qq[6], bflo(w.w), d); d = fmaf(qq[7], bfhi(w.w), d); }
                s4[hh] = d * 0.125f; }
        }
        if (tid < 256) {
#pragma unroll
            for (int hh = 0; hh < 4; ++hh) { const float v = wave_max(s4[hh]); if (C.lane == 0) red[hh * 4 + C.wave] = v; }
        }
        __syncthreads();
        float mx[4];
#pragma unroll
        for (int hh = 0; hh < 4; ++hh) mx[hh] = fmaxf(fmaxf(red[hh * 4], red[hh * 4 + 1]), fmaxf(red[hh * 4 + 2], red[hh * 4 + 3]));
        __syncthreads();
        if (tid < 256) {
#pragma unroll
            for (int hh = 0; hh < 4; ++hh) { const float e = (tid < cnt) ? expf(s4[hh] - mx[hh]) : 0.f; ps[hh * 256 + tid] = e; const float v = wave_sum(e); if (C.lane == 0) red[hh * 4 + C.wave] = v; }
        }
        __syncthreads();
        if (tid < 256) {
            const int hh = tid >> 6;
            const float lsum = red[hh * 4] + red[hh * 4 + 1] + red[hh * 4 + 2] + red[hh * 4 + 3];
            float o = 0.f;
            for (int j = 0; j < cnt; ++j) o = fmaf(ps[hh * 256 + j], bf2f(CV[(((size_t)b << 12) + sel[j]) * 256 + tid]), o);
            const float z = bf2f(CZ[(size_t)m * 256 + tid]);
            CQ[(size_t)m * 256 + tid] = (bf16)f2bf(o / lsum * siluf_(z));
        }
        __syncthreads();
    }
}

typedef short bf16x8_t __attribute__((ext_vector_type(8)));
__device__ __forceinline__ float dpp_f(float x, const int ctrl_sel) {
    const int xi = __builtin_bit_cast(int, x); int r;
    if (ctrl_sel == 0) r = __builtin_amdgcn_update_dpp(xi, xi, 0xB1, 0xF, 0xF, false);
    else if (ctrl_sel == 1) r = __builtin_amdgcn_update_dpp(xi, xi, 0x4E, 0xF, 0xF, false);
    else r = __builtin_amdgcn_update_dpp(xi, xi, 0x141, 0xF, 0xF, false);
    return __builtin_bit_cast(float, r);
}
__device__ __forceinline__ float red8(float x) { x += dpp_f(x, 0); x += dpp_f(x, 1); x += dpp_f(x, 2); return x; }

constexpr int DSTEP_T = 320;
constexpr int D_LDS_STEP = 0, D_LDS_VS = 81920, D_LDS_TWD = 98304, D_LDS_ADS = 106496;
__device__ __forceinline__ void mixD1(Ctx C, const Params& P, int l) {
    OPQ(C);
    unsigned char* ws = P.ws;
    const bf16* DR = PLP(ws, PL_DR); const bf16* DK = PLP(ws, PL_DK); const bf16* DV = PLP(ws, PL_DV); const float* MS = (const float*)(ws + WS_MISC);
    const float* mu = P.in[6] + l * 896; const float* w0 = P.in[7] + l * 256; const float* w_up = P.in[8] + (size_t)l * 64 * 256; const float* a0 = P.in[9] + l * 256;
    const float* a_up = P.in[10] + (size_t)l * 64 * 256; const float* k_k = P.in[11] + l * 256; const float* k_a = P.in[12] + l * 256; const float* r_k = P.in[13] + l * 256;
    bf16* OL = (bf16*)(ws + WS_OL); bf16* CCp = (bf16*)(ws + WS_CC); float* BON = (float*)(ws + WS_DBON); float* AB = (float*)(ws + WS_DAB);
    LAS float* STEP = (LAS float*)(C.lds + D_LDS_STEP); LAS float* VS = (LAS float*)(C.lds + D_LDS_VS);
    LAS bf16* TWD = (LAS bf16*)(C.lds + D_LDS_TWD); LAS bf16* ADS = (LAS bf16*)(C.lds + D_LDS_ADS);
    const int tid = C.tid, lane = C.lane, wave = C.wave;
    const int tt = tid >> 3, c8 = tid & 7;
    for (int u = C.bid; u < 256; u += C.G) {
        const int b = u >> 5, h = (u >> 3) & 3, seg = u & 7, hc0 = h * 64;
        __syncthreads();
        {
            const int i = tid >> 3;
            const f32x4 wa = *(const f32x4*)(w_up + (size_t)i * 256 + hc0 + 8 * c8), wb = *(const f32x4*)(w_up + (size_t)i * 256 + hc0 + 8 * c8 + 4);
            const f32x4 aa = *(const f32x4*)(a_up + (size_t)i * 256 + hc0 + 8 * c8), ab = *(const f32x4*)(a_up + (size_t)i * 256 + hc0 + 8 * c8 + 4);
#pragma unroll
            for (int j = 0; j < 4; ++j) { TWD[(8 * c8 + j) * 64 + i] = (bf16)f2bf(wa[j]); TWD[(8 * c8 + 4 + j) * 64 + i] = (bf16)f2bf(wb[j]);
                                          ADS[(8 * c8 + j) * 64 + i] = (bf16)f2bf(aa[j]); ADS[(8 * c8 + 4 + j) * 64 + i] = (bf16)f2bf(ab[j]); }
        }
        __syncthreads();
        const int mat = wave >> 2, mt = wave & 3, fr = lane & 15, fq = lane >> 4;
        bf16x8_t bfrag[4][2];
#pragma unroll
        for (int nt = 0; nt < 4; ++nt)
#pragma unroll
            for (int k2 = 0; k2 < 2; ++k2) bfrag[nt][k2] = *(const LAS bf16x8_t*)((mat ? ADS : TWD) + (16 * nt + fr) * 64 + 32 * k2 + 8 * fq);
        float bias4[4];
#pragma unroll
        for (int nt = 0; nt < 4; ++nt) bias4[nt] = (mat ? a0 : w0)[hc0 + 16 * nt + fr];
        __syncthreads();
        float S[8], H[8];
#pragma unroll
        for (int j = 0; j < 8; ++j) { S[j] = 0.f; H[j] = (8 * c8 + j == tt) ? 1.f : 0.f; }
        v4u rc, kc, vc, rp, kp, vp; f32x4 wc0, wc1, ac0, ac1, wp0, wp1, ap0, ap1;
#define D1_LOADRAW(BLK) do { const int tl_ = seg * 512 + (BLK) * 64 + tt; const size_t m_ = ((size_t)b << 12) + tl_; const int ch_ = hc0 + 8 * c8; \
            rc = *(const v4u*)(DR + m_ * 256 + ch_); kc = *(const v4u*)(DK + m_ * 256 + ch_); vc = *(const v4u*)(DV + m_ * 256 + ch_); \
            wc0 = *(const f32x4*)(MS + m_ * 256 + 72 + 8 * c8); wc1 = *(const f32x4*)(MS + m_ * 256 + 76 + 8 * c8); ac0 = *(const f32x4*)(MS + m_ * 256 + 136 + 8 * c8); ac1 = *(const f32x4*)(MS + m_ * 256 + 140 + 8 * c8); \
            rp = (v4u){0u, 0u, 0u, 0u}; kp = rp; vp = rp; wp0 = (f32x4){0.f, 0.f, 0.f, 0.f}; wp1 = wp0; ap0 = wp0; ap1 = wp0; \
            if (tl_ > 0) { rp = *(const v4u*)(DR + (m_ - 1) * 256 + ch_); kp = *(const v4u*)(DK + (m_ - 1) * 256 + ch_); vp = *(const v4u*)(DV + (m_ - 1) * 256 + ch_); \
                wp0 = *(const f32x4*)(MS + (m_ - 1) * 256 + 72 + 8 * c8); wp1 = *(const f32x4*)(MS + (m_ - 1) * 256 + 76 + 8 * c8); ap0 = *(const f32x4*)(MS + (m_ - 1) * 256 + 136 + 8 * c8); ap1 = *(const f32x4*)(MS + (m_ - 1) * 256 + 140 + 8 * c8); } } while (0)
        D1_LOADRAW(0);
        for (int blk = 0; blk < 8; ++blk) {
            const int tloc0 = seg * 512 + blk * 64;
            const size_t m = ((size_t)b << 12) + tloc0 + tt;
            {
                const int ch = hc0 + 8 * c8;
                LAS float* st = STEP + tt * DSTEP_T + c8 * 40;
#pragma unroll
                for (int q = 0; q < 4; ++q) {
                    const unsigned rcw = rc[q], rpw = rp[q], kcw = kc[q], kpw = kp[q], vcw = vc[q], vpw = vp[q];
                    const float mr0 = mu[ch + 2 * q], mr1 = mu[ch + 2 * q + 1], mk0 = mu[256 + ch + 2 * q], mk1 = mu[256 + ch + 2 * q + 1], mv0 = mu[512 + ch + 2 * q], mv1 = mu[512 + ch + 2 * q + 1];
                    float c0 = bflo(rcw), c1 = bfhi(rcw);
                    st[32 + 2 * q] = c0 + mr0 * (bflo(rpw) - c0); st[32 + 2 * q + 1] = c1 + mr1 * (bfhi(rpw) - c1);
                    c0 = bflo(kcw); c1 = bfhi(kcw);
                    st[24 + 2 * q] = c0 + mk0 * (bflo(kpw) - c0); st[24 + 2 * q + 1] = c1 + mk1 * (bfhi(kpw) - c1);
                    c0 = bflo(vcw); c1 = bfhi(vcw);
                    VS[tt * 64 + 8 * c8 + 2 * q] = c0 + mv0 * (bflo(vpw) - c0); VS[tt * 64 + 8 * c8 + 2 * q + 1] = c1 + mv1 * (bfhi(vpw) - c1);
                }
                float tw[8], ad[8];
#pragma unroll
                for (int j = 0; j < 4; ++j) {
                    const float m0 = mu[768 + 8 * c8 + j], m1 = mu[768 + 8 * c8 + 4 + j], n0 = mu[832 + 8 * c8 + j], n1 = mu[832 + 8 * c8 + 4 + j];
                    tw[j] = tanhf(wc0[j] + m0 * (wp0[j] - wc0[j])); tw[4 + j] = tanhf(wc1[j] + m1 * (wp1[j] - wc1[j]));
                    ad[j] = ac0[j] + n0 * (ap0[j] - ac0[j]); ad[4 + j] = ac1[j] + n1 * (ap1[j] - ac1[j]);
                }
                v4u tv, av; tv.x = pk2(tw[0], tw[1]); tv.y = pk2(tw[2], tw[3]); tv.z = pk2(tw[4], tw[5]); tv.w = pk2(tw[6], tw[7]);
                av.x = pk2(ad[0], ad[1]); av.y = pk2(ad[2], ad[3]); av.z = pk2(ad[4], ad[5]); av.w = pk2(ad[6], ad[7]);
                *(LAS v4u*)(TWD + tt * 64 + 8 * c8) = tv; *(LAS v4u*)(ADS + tt * 64 + 8 * c8) = av;
            }
            __syncthreads();
            {
                const LAS bf16* Asrc = mat ? ADS : TWD;
                const bf16x8_t a0f = *(const LAS bf16x8_t*)(Asrc + (16 * mt + fr) * 64 + 8 * fq), a1f = *(const LAS bf16x8_t*)(Asrc + (16 * mt + fr) * 64 + 32 + 8 * fq);
#pragma unroll
                for (int nt = 0; nt < 4; ++nt) {
                    f32x4 acc = (f32x4){0.f, 0.f, 0.f, 0.f};
                    acc = __builtin_amdgcn_mfma_f32_16x16x32_bf16(a0f, bfrag[nt][0], acc, 0, 0, 0);
                    acc = __builtin_amdgcn_mfma_f32_16x16x32_bf16(a1f, bfrag[nt][1], acc, 0, 0, 0);
                    const int c = 16 * nt + fr;
#pragma unroll
                    for (int j = 0; j < 4; ++j) {
                        const int t = 16 * mt + 4 * fq + j; const float x = acc[j] + bias4[nt]; float val;
                        if (mat == 0) { const float nx = -x; const float sp = fmaxf(nx, 0.f) + log1pf(expf(-fabsf(nx))); val = expf(-expf(-sp - 0.5f)); }
                        else val = 1.f / (1.f + expf(-x));
                        STEP[t * DSTEP_T + (c >> 3) * 40 + (mat ? 16 : 8) + (c & 7)] = val;
                    }
                }
            }
            __syncthreads();
            {
                const int ch = hc0 + 8 * c8; LAS float* st = STEP + tt * DSTEP_T + c8 * 40;
                float kkr[8], ssq = 0.f, bon = 0.f;
#pragma unroll
                for (int j = 0; j < 8; ++j) { const float kx = st[24 + j], a = st[16 + j];
                    kkr[j] = kx * k_k[ch + j]; ssq = fmaf(kkr[j], kkr[j], ssq);
                    const float kf = kx * (1.f + (a - 1.f) * k_a[ch + j]); st[24 + j] = kf; bon = fmaf(st[32 + j] * kf, r_k[ch + j], bon); }
                ssq = red8(ssq); bon = red8(bon);
                const float inv = 1.f / fmaxf(sqrtf(ssq), 1e-12f);
#pragma unroll
                for (int j = 0; j < 8; ++j) { const float kk = kkr[j] * inv; st[j] = kk; st[16 + j] = kk * st[16 + j]; }
                if (c8 == 0) BON[m * 4 + h] = bon;
            }
            __syncthreads();
            if (blk + 1 < 8) D1_LOADRAW(blk + 1);
            for (int t = 0; t < 64; ++t) {
                const LAS f32x4* sp = (const LAS f32x4*)(STEP + t * DSTEP_T + c8 * 40);
                const f32x4 k0 = sp[0], k1 = sp[1], w0v = sp[2], w1v = sp[3], b0 = sp[4], b1 = sp[5], f0 = sp[6], f1 = sp[7], r0 = sp[8], r1 = sp[9];
                const float vv = VS[t * 64 + tt];
                float dS = 0.f, dH = 0.f;
#pragma unroll
                for (int j = 0; j < 4; ++j) { dS = fmaf(S[j], k0[j], dS); dH = fmaf(H[j], k0[j], dH); }
#pragma unroll
                for (int j = 0; j < 4; ++j) { dS = fmaf(S[4 + j], k1[j], dS); dH = fmaf(H[4 + j], k1[j], dH); }
                dS = -red8(dS); dH = -red8(dH);
                float oS = 0.f, oH = 0.f;
#pragma unroll
                for (int j = 0; j < 4; ++j) {
                    S[j] = fmaf(S[j], w0v[j], fmaf(dS, b0[j], vv * f0[j])); H[j] = fmaf(H[j], w0v[j], dH * b0[j]);
                    oS = fmaf(S[j], r0[j], oS); oH = fmaf(H[j], r0[j], oH);
                }
#pragma unroll
                for (int j = 0; j < 4; ++j) {
                    S[4 + j] = fmaf(S[4 + j], w1v[j], fmaf(dS, b1[j], vv * f1[j])); H[4 + j] = fmaf(H[4 + j], w1v[j], dH * b1[j]);
                    oS = fmaf(S[4 + j], r1[j], oS); oH = fmaf(H[4 + j], r1[j], oH);
                }
                oS = red8(oS); oH = red8(oH);
                if (c8 == 0) { const size_t mo = (((size_t)b << 12) + tloc0 + t) * 256 + hc0 + tt; OL[mo] = (bf16)f2bf(oS); CCp[mo] = (bf16)f2bf(oH); }
            }
            __syncthreads();
        }
#undef D1_LOADRAW
        {
            float* ab = AB + (size_t)u * 8192;
            *(f32x4*)(ab + tt * 64 + 8 * c8) = (f32x4){H[0], H[1], H[2], H[3]}; *(f32x4*)(ab + tt * 64 + 8 * c8 + 4) = (f32x4){H[4], H[5], H[6], H[7]};
            *(f32x4*)(ab + 4096 + tt * 64 + 8 * c8) = (f32x4){S[0], S[1], S[2], S[3]}; *(f32x4*)(ab + 4096 + tt * 64 + 8 * c8 + 4) = (f32x4){S[4], S[5], S[6], S[7]};
        }
    }
}
__device__ __forceinline__ void mixD2(Ctx C, unsigned char* ws) {
    OPQ(C);
    if (C.bid >= 32) return;
    const float* AB = (const float*)(ws + WS_DAB); float* SS = (float*)(ws + WS_DSS);
    LAS float* SL = (LAS float*)C.lds; LAS float* AL = SL + 4096;
    const int tid = C.tid, rr = tid >> 3, ks = tid & 7;
    float S[8];
#pragma unroll
    for (int j = 0; j < 8; ++j) S[j] = 0.f;
    for (int seg = 0; seg < 8; ++seg) {
        const int u = C.bid * 8 + seg;
        float* so = SS + (size_t)u * 4096 + rr * 64 + 8 * ks;
        *(f32x4*)so = (f32x4){S[0], S[1], S[2], S[3]}; *(f32x4*)(so + 4) = (f32x4){S[4], S[5], S[6], S[7]};
        if (seg == 7) break;
        __syncthreads();
        *(LAS f32x4*)(SL + rr * 64 + 8 * ks) = (f32x4){S[0], S[1], S[2], S[3]}; *(LAS f32x4*)(SL + rr * 64 + 8 * ks + 4) = (f32x4){S[4], S[5], S[6], S[7]};
        const float* ab = AB + (size_t)u * 8192;
        *(LAS f32x4*)(AL + tid * 8) = *(const f32x4*)(ab + tid * 8); *(LAS f32x4*)(AL + tid * 8 + 4) = *(const f32x4*)(ab + tid * 8 + 4);
        const f32x4 bb0 = *(const f32x4*)(ab + 4096 + rr * 64 + 8 * ks), bb1 = *(const f32x4*)(ab + 4096 + rr * 64 + 8 * ks + 4);
        __syncthreads();
#pragma unroll
        for (int j = 0; j < 4; ++j) { S[j] = bb0[j]; S[4 + j] = bb1[j]; }
#pragma nounroll
        for (int i = 0; i < 64; ++i) {
            const float s = SL[rr * 64 + i];
            const f32x4 a0 = *(const LAS f32x4*)(AL + i * 64 + 8 * ks), a1 = *(const LAS f32x4*)(AL + i * 64 + 8 * ks + 4);
#pragma unroll
            for (int j = 0; j < 4; ++j) { S[j] = fmaf(s, a0[j], S[j]); S[4 + j] = fmaf(s, a1[j], S[4 + j]); }
        }
    }
}
__device__ __forceinline__ void mixD3(Ctx C, const Params& P, int l) {
    OPQ(C);
    unsigned char* ws = P.ws;
    bf16* DR = PLP(ws, PL_DR); const bf16* DV = PLP(ws, PL_DV); const bf16* DZ = PLP(ws, PL_DZ);
    const bf16* OL = (const bf16*)(ws + WS_OL); const bf16* CCp = (const bf16*)(ws + WS_CC); const float* BON = (const float*)(ws + WS_DBON); const float* SS = (const float*)(ws + WS_DSS);
    const float* mu = P.in[6] + l * 896; const float* gn_g = P.in[14] + l * 256; const float* gn_b = P.in[15] + l * 256;
    const int lane = C.lane, wave = C.wave;
    for (int u = C.bid; u < 256; u += C.G) {
        const int b = u >> 5, h = (u >> 3) & 3, seg = u & 7, hc = h * 64 + lane;
        float S[64];
        {
            const f32x4* sp = (const f32x4*)(SS + (size_t)u * 4096 + lane * 64);
#pragma unroll
            for (int q = 0; q < 16; ++q) { const f32x4 x = sp[q]; S[4 * q] = x[0]; S[4 * q + 1] = x[1]; S[4 * q + 2] = x[2]; S[4 * q + 3] = x[3]; }
        }
        const float muv = mu[512 + hc], gg = gn_g[hc], gb = gn_b[hc];
        unsigned short ncv[8], nol[8], nvc[9], nzz[8]; float nbon[8];
#define D3_LOAD(T8) do { const int tl0_ = seg * 512 + wave * 64 + (T8); const size_t m0_ = ((size_t)b << 12) + tl0_; \
            nvc[0] = (tl0_ > 0) ? DV[(m0_ - 1) * 256 + hc] : (unsigned short)0; \
            _Pragma("unroll") for (int j = 0; j < 8; ++j) { const size_t m = m0_ + j; ncv[j] = CCp[m * 256 + hc]; nol[j] = OL[m * 256 + hc]; nbon[j] = BON[m * 4 + h]; nvc[j + 1] = DV[m * 256 + hc]; nzz[j] = DZ[m * 256 + hc]; } } while (0)
        D3_LOAD(0);
#pragma nounroll
        for (int t8 = 0; t8 < 64; t8 += 8) {
            const int tl0 = seg * 512 + wave * 64 + t8;
            const size_t m0 = ((size_t)b << 12) + tl0;
            float cv[8], ol[8], bon[8], vc[9], zz[8];
            vc[0] = bf2f(nvc[0]);
#pragma unroll
            for (int j = 0; j < 8; ++j) { cv[j] = bf2f(ncv[j]); ol[j] = bf2f(nol[j]); bon[j] = nbon[j]; vc[j + 1] = bf2f(nvc[j + 1]); zz[j] = bf2f(nzz[j]); }
            if (t8 + 8 < 64) D3_LOAD(t8 + 8);
#pragma unroll
            for (int j = 0; j < 8; ++j) {
                float o = ol[j];
#pragma unroll
                for (int i = 0; i < 64; ++i) o = fmaf(S[i], __builtin_bit_cast(float, __builtin_amdgcn_readlane(__builtin_bit_cast(int, cv[j]), i)), o);
                const float mean = wave_sum(o) * (1.f / 64.f); const float d = o - mean; const float var = wave_sum(d * d) * (1.f / 64.f);
                float y = d * __builtin_amdgcn_rsqf(var + 64e-5f) * gg + gb;
                y += bon[j] * (vc[j + 1] + muv * (vc[j] - vc[j + 1]));
                DR[(m0 + j) * 256 + hc] = (bf16)f2bf(y * zz[j] * fsig(zz[j]));
            }
        }
#undef D3_LOAD
    }
}

template <bool OUT>
__device__ __forceinline__ void mixB_chunks(Ctx C, unsigned char* ws, const float* normg, bf16* OUTP) {
    OPQ(C);
    const bf16* BQ = PLP(ws, PL_BQ); const bf16* BI = PLP(ws, PL_BI); const bf16* BZ = PLP(ws, PL_BZ); const float* BF = (const float*)(ws + WS_BF);
    float* BS = (float*)(ws + WS_BS); float* BG = (float*)(ws + WS_BG);
    LAS float* FT = (LAS float*)(C.lds + C.wave * 16384); LAS float* QT = FT + 1024; LAS float* IT = FT + 2048; LAS float* ZT = FT + 3072;
    const int lane = C.lane;
    const float gnorm = OUT ? normg[lane] : 0.f;
    for (int item = C.bid * 8 + C.wave; item < 2048; item += C.G * 8) {
        const int bh = item >> 6, c = item & 63, b = bh >> 2, h = bh & 3;
        const size_t m0 = ((size_t)b << 12) + c * 64;
        float S[64];
        if (OUT) {
            const float* sp = BS + (size_t)item * 4096 + lane;
#pragma unroll
            for (int d = 0; d < 64; ++d) S[d] = sp[d * 64];
        } else {
#pragma unroll
            for (int d = 0; d < 64; ++d) S[d] = 0.f;
        }
        float g = 1.f;
        float nf[16]; unsigned short ni[16], nq[16], nz[16];
#define B_LOADTILE(T0) do { _Pragma("unroll") for (int s = 0; s < 16; ++s) { const size_t m = m0 + (T0) + s; nf[s] = BF[m * 256 + h * 64 + lane]; ni[s] = BI[m * 256 + h * 64 + lane]; \
            if (OUT) { nq[s] = BQ[m * 256 + h * 64 + lane]; nz[s] = BZ[m * 256 + h * 64 + lane]; } } } while (0)
        B_LOADTILE(0);
        for (int t0 = 0; t0 < 64; t0 += 16) {
#pragma unroll
            for (int s = 0; s < 16; ++s) {
                FT[s * 64 + lane] = nf[s]; IT[s * 64 + lane] = bf2f(ni[s]);
                if (OUT) { QT[s * 64 + lane] = bf2f(nq[s]); ZT[s * 64 + lane] = bf2f(nz[s]); }
            }
            if (t0 + 16 < 64) B_LOADTILE(t0 + 16);
            LDS_WAIT(); asm volatile("" ::: "memory");
            if (!OUT) {
#pragma unroll
                for (int s = 0; s < 16; ++s) g *= FT[s * 64 + lane];
            }
#pragma nounroll
            for (int s = 0; s < 16; ++s) {
                const size_t m = m0 + t0 + s;
                const float iv = IT[s * 64 + lane];
                const LAS f32x4* fp = (const LAS f32x4*)(FT + s * 64); const LAS f32x4* qp = (const LAS f32x4*)(QT + s * 64);
                float o = 0.f;
#pragma unroll
                for (int q4 = 0; q4 < 16; ++q4) {
                    const f32x4 f4 = fp[q4];
#pragma unroll
                    for (int j = 0; j < 4; ++j) S[4 * q4 + j] = fmaf(f4[j], S[4 * q4 + j] - iv, iv);
                    if (OUT) { const f32x4 qv = qp[q4];
#pragma unroll
                        for (int j = 0; j < 4; ++j) o = fmaf(qv[j], S[4 * q4 + j], o); }
                }
                if (OUT) {
                    const float r = __builtin_amdgcn_rsqf(wave_sum(o * o) * (1.f / 64.f) + 1e-6f);
                    const float z = ZT[s * 64 + lane];
                    OUTP[m * 256 + h * 64 + lane] = (bf16)f2bf(o * r * gnorm * z * fsig(z));
                }
            }
            LDS_WAIT(); asm volatile("" ::: "memory");
        }
#undef B_LOADTILE
        if (!OUT) {
            float* sp = BS + (size_t)item * 4096 + lane;
#pragma unroll
            for (int d = 0; d < 64; ++d) sp[d * 64] = S[d];
            BG[item * 64 + lane] = g;
        }
    }
}
__device__ __forceinline__ void mixB_scan(Ctx C, unsigned char* ws) {
    OPQ(C);
    float* BS = (float*)(ws + WS_BS); const float* BG = (const float*)(ws + WS_BG);
    for (int e = C.bid * 512 + C.tid; e < 32 * 4096; e += C.G * 512) {
        const int bh = e >> 12, dv = e & 4095, d = dv >> 6;
        float S = 0.f;
#pragma unroll 8
        for (int c = 0; c < 64; ++c) {
            const size_t idx = ((size_t)(bh * 64 + c) << 12) + dv;
            const float sl = BS[idx], g = BG[(bh * 64 + c) * 64 + d];
            BS[idx] = S;
            S = fmaf(g, S, sl);
        }
    }
}

typedef float f32x16 __attribute__((ext_vector_type(16)));
__device__ __forceinline__ int crow_(int r, int hi) { return (r & 3) + 8 * (r >> 2) + 4 * hi; }
__device__ __forceinline__ void mixA_fast(Ctx C, unsigned char* ws, const float* bias, bf16* OUTP) {
    OPQ(C);
    const bf16* AQ = PLP(ws, PL_AQ); const bf16* AK = PLP(ws, PL_AK); const bf16* AVT = PLP(ws, PL_AV); const bf16* AZ = PLP(ws, PL_AZ);
    LAS float* BL = (LAS float*)C.lds;
    __syncthreads();
    for (int i = C.tid; i < 768; i += 512) BL[i] = bias[i] * 1.4426950408889634f;
    __syncthreads();
    const int lane = C.lane, q = lane & 31, hi = lane >> 5;
    for (int item = C.bid * 8 + C.wave; item < 2048; item += C.G * 8) {
        const int h = item & 3, c = (item >> 2) & 63, b = item >> 8;
        const size_t mq0 = ((size_t)b << 12) + c * 64;
        bf16x8_t qf[2][4];
#pragma unroll
        for (int qb = 0; qb < 2; ++qb)
#pragma unroll
            for (int s = 0; s < 4; ++s) qf[qb][s] = *(const bf16x8_t*)(AQ + (mq0 + 32 * qb + q) * 256 + h * 64 + 16 * s + 8 * hi);
        f32x16 O[2][2];
#pragma unroll
        for (int qb = 0; qb < 2; ++qb)
#pragma unroll
            for (int db = 0; db < 2; ++db)
#pragma unroll
                for (int r = 0; r < 16; ++r) O[qb][db][r] = 0.f;
        float mrun[2] = {-1e30f, -1e30f}, lrun[2] = {0.f, 0.f};
        const int klo = (c >= 8) ? (c - 8) * 64 : 0;
        const int nkb = (c * 64 + 64 - klo) >> 5;
        const LAS float* bh = BL + h * 192;
        bf16x8_t kfn[4], vtn[2][2];
#define A_LOADKV(KB) do { const size_t kb_ = (size_t)(b * 4 + h) * 128 + ((klo >> 5) + (KB)); _Pragma("unroll") for (int s = 0; s < 4; ++s) kfn[s] = *(const bf16x8_t*)(AK + ((kb_ * 4 + s) * 64 + lane) * 8); \
            _Pragma("unroll") for (int db = 0; db < 2; ++db) _Pragma("unroll") for (int s2 = 0; s2 < 2; ++s2) vtn[db][s2] = *(const bf16x8_t*)(AVT + (((kb_ * 2 + db) * 2 + s2) * 64 + lane) * 8); } while (0)
        A_LOADKV(0);
        for (int kb = 0; kb < nkb; ++kb) {
            const int kbase = klo + 32 * kb;
            bf16x8_t kf[4];
#pragma unroll
            for (int s = 0; s < 4; ++s) kf[s] = kfn[s];
            bf16x8_t vt[2][2];
#pragma unroll
            for (int db = 0; db < 2; ++db)
#pragma unroll
                for (int s2 = 0; s2 < 2; ++s2) vt[db][s2] = vtn[db][s2];
            if (kb + 1 < nkb) A_LOADKV(kb + 1);
#pragma unroll
            for (int qb = 0; qb < 2; ++qb) {
                f32x16 st;
#pragma unroll
                for (int r = 0; r < 16; ++r) st[r] = 0.f;
#pragma unroll
                for (int s = 0; s < 4; ++s) st = __builtin_amdgcn_mfma_f32_32x32x16_bf16(kf[s], qf[qb][s], st, 0, 0, 0);
                const int qpos = c * 64 + 32 * qb + q;
                float mx = -1e30f;
                if (qpos - (kbase + 31) >= 128) {
                    const float bc = bh[191];
#pragma unroll
                    for (int r = 0; r < 16; ++r) { st[r] = fmaf(st[r], 0.125f * 1.4426950408889634f, bc); mx = fmaxf(mx, st[r]); }
                } else {
#pragma unroll
                    for (int r = 0; r < 16; ++r) {
                        int rel = qpos - (kbase + crow_(r, hi)); rel = rel < -63 ? -63 : (rel > 128 ? 128 : rel);
                        st[r] = fmaf(st[r], 0.125f * 1.4426950408889634f, bh[rel + 63]);
                        mx = fmaxf(mx, st[r]);
                    }
                }
                mx = xh_max(mx);
                const float mn = fmaxf(mrun[qb], mx);
                float ps = 0.f;
#pragma unroll
                for (int r = 0; r < 16; ++r) { st[r] = __builtin_amdgcn_exp2f(st[r] - mn); ps += st[r]; }
                ps = xh_sum(ps);
                if (__builtin_amdgcn_ballot_w64(mn != mrun[qb]) != 0ull) {
                    const float al = __builtin_amdgcn_exp2f(mrun[qb] - mn);
                    lrun[qb] *= al;
#pragma unroll
                    for (int db = 0; db < 2; ++db)
#pragma unroll
                        for (int r = 0; r < 16; ++r) O[qb][db][r] *= al;
                }
                mrun[qb] = mn;
                lrun[qb] += ps;
                v4u p0, p1;
                p0.x = pk2(st[0], st[1]); p0.y = pk2(st[2], st[3]); p0.z = pk2(st[4], st[5]); p0.w = pk2(st[6], st[7]);
                p1.x = pk2(st[8], st[9]); p1.y = pk2(st[10], st[11]); p1.z = pk2(st[12], st[13]); p1.w = pk2(st[14], st[15]);
                const bf16x8_t pf0 = __builtin_bit_cast(bf16x8_t, p0), pf1 = __builtin_bit_cast(bf16x8_t, p1);
#pragma unroll
                for (int db = 0; db < 2; ++db) {
                    O[qb][db] = __builtin_amdgcn_mfma_f32_32x32x16_bf16(vt[db][0], pf0, O[qb][db], 0, 0, 0);
                    O[qb][db] = __builtin_amdgcn_mfma_f32_32x32x16_bf16(vt[db][1], pf1, O[qb][db], 0, 0, 0);
                }
            }
        }
#undef A_LOADKV
#pragma unroll
        for (int qb = 0; qb < 2; ++qb) {
            const float invl = 1.f / lrun[qb];
            const size_t mrow = (mq0 + 32 * qb + q) * 256 + h * 64;
#pragma unroll
            for (int db = 0; db < 2; ++db)
#pragma unroll
                for (int g = 0; g < 4; ++g) {
                    const int col = 32 * db + 8 * g + 4 * hi;
                    const v2u z = *(const v2u*)(AZ + mrow + col);
                    const float z0 = bflo(z.x), z1 = bfhi(z.x), z2 = bflo(z.y), z3 = bfhi(z.y);
                    v2u w;
                    w.x = pk2(O[qb][db][4 * g] * invl * z0 * fsig(z0), O[qb][db][4 * g + 1] * invl * z1 * fsig(z1));
                    w.y = pk2(O[qb][db][4 * g + 2] * invl * z2 * fsig(z2), O[qb][db][4 * g + 3] * invl * z3 * fsig(z3));
                    *(v2u*)(OUTP + mrow + col) = w;
                }
        }
    }
}

constexpr int C_NB = 256, C_CAP = 128;
constexpr int C_LDS_HIST = 0, C_LDS_QIF = 33792, C_LDS_BMP = 66560, C_LDS_QP = 99328, C_LDS_WQ = 101376, C_LDS_SCR = 102400;
enum { QP_LO = 0, QP_SC = 1, QP_CRIT = 2, QP_LO2 = 3, QP_SC2 = 4, QP_CRIT2 = 5, QP_KREM = 6, QP_CNT = 7, QP_LVL = 8, QP_CC = 9 };
__device__ __forceinline__ int c_bin(float s, float nlosc, float sc) { return (int)__builtin_amdgcn_fmed3f(fmaf(s, sc, nlosc), 0.f, (float)(C_NB - 1)); }
__device__ __forceinline__ float relu_asm(float x) { const int xi = __builtin_bit_cast(int, x); return __builtin_bit_cast(float, xi > 0 ? xi : 0); }
__device__ __forceinline__ void mixC_fast(Ctx C, unsigned char* ws, bf16* OUTP, const int parts = 3) {
    OPQ(C);
    const bf16* CQ = PLP(ws, PL_CQ); const bf16* CK = PLP(ws, PL_CK); const bf16* CVT = PLP(ws, PL_CV); const bf16* CZ = PLP(ws, PL_CZ);
    const bf16* QI0 = PLP(ws, PL_CQI0); const bf16* QI1 = PLP(ws, PL_CQI1); const bf16* KI = (const bf16*)(ws + WS_KI); const float* MS = (const float*)(ws + WS_MISC);
    LAS unsigned* HIST = (LAS unsigned*)(C.lds + C_LDS_HIST); LAS unsigned* BMP = (LAS unsigned*)(C.lds + C_LDS_BMP);
    LAS float* QPf = (LAS float*)(C.lds + C_LDS_QP); LAS int* QPi = (LAS int*)(C.lds + C_LDS_QP); LAS float* WQ = (LAS float*)(C.lds + C_LDS_WQ);
    LAS unsigned long long* LIST = (LAS unsigned long long*)(C.lds + C_LDS_HIST);
    LAS unsigned char* QIFL = C.lds + C_LDS_QIF;
    const int wave = C.wave;
    for (int pass2 = 0; pass2 < 2; ++pass2)
    for (int ui = C.bid; ui < 256; ui += C.G) {
        const int b = ui & 7, c = pass2 == 0 ? 63 - (ui >> 3) : (ui >> 3);
        const int n = 64 * (c + 1), nkb = n >> 5;
        const size_t mq0 = ((size_t)b << 12) + c * 64, mk0 = (size_t)b << 12;
        __syncthreads();
        unsigned long long tc0_ = (EXP >= 200) ? __builtin_amdgcn_s_memrealtime() : 0ull; unsigned long long tc1_ = tc0_;
#define TACC(slot) do { if (EXP >= 200 && wave == 0 && lane_id_fresh() == 0) { const unsigned long long tn_ = __builtin_amdgcn_s_memrealtime(); atomicAdd((unsigned*)(ws + WS_CTL) + 8192 + 16 * (slot) + 2, (unsigned)(tn_ - tc1_)); tc1_ = tn_; } } while (0)
        if (!(parts & 1)) {} else if (c <= 3) {
            const int tid0 = wave * 64 + lane_id_fresh();
            for (int i = tid0; i < 64 * 128; i += 512) BMP[i] = ((i & 127) < nkb) ? 0xFFFFFFFFu : 0u;
        } else {
          for (int qb = 0; qb < 2; ++qb) {
            {
                const int lane = lane_id_fresh();
#pragma nounroll
                for (int qq = 0; qq < 4; ++qq) {
                    const int qx = wave * 4 + qq; const size_t m = mq0 + 32 * qb + qx;
                    const int hh = lane >> 3;
                    const v4u w = *(const v4u*)((hh < 4 ? QI0 : QI1) + m * 256 + (hh & 3) * 64 + 8 * (lane & 7));
                    float ssq;
                    { const float a0 = bflo(w.x), a1 = bfhi(w.x), a2 = bflo(w.y), a3 = bfhi(w.y), a4 = bflo(w.z), a5 = bfhi(w.z), a6 = bflo(w.w), a7 = bfhi(w.w);
                      ssq = a0 * a0 + a1 * a1 + a2 * a2 + a3 * a3 + a4 * a4 + a5 * a5 + a6 * a6 + a7 * a7; }
                    ssq = red8(ssq);
                    const float wv = MS[m * 256 + 64 + hh] * (0.35355339059327373f * 0.125f);
                    float tm = 0.4f * wv * sqrtf(ssq), tv = 0.34f * wv * wv * ssq;
                    tm += dppf(tm, 4); tm += swz16f(tm); tm = xh_sum(tm);
                    tv += dppf(tv, 4); tv += swz16f(tv); tv = xh_sum(tv);
                    if ((lane & 7) == 0) WQ[qx * 8 + hh] = wv;
                    if (lane == 0) { const float sd = fmaxf(sqrtf(tv), 1e-20f);
                        { const float sc_ = (float)C_NB / (12.f * sd); QPf[qx * 16 + QP_SC] = sc_; QPf[qx * 16 + QP_LO] = -(tm - 4.f * sd) * sc_; }
                        QPi[qx * 16 + QP_KREM] = 256; QPi[qx * 16 + QP_CNT] = 0; QPi[qx * 16 + QP_LVL] = 0; QPi[qx * 16 + QP_CRIT] = -1; QPi[qx * 16 + QP_CRIT2] = -1; }
                }
                if (wave < 4) {
                    const int q = lane & 31, hi = lane >> 5;
#pragma unroll
                    for (int s = 0; s < 4; ++s) *(LAS bf16x8_t*)(QIFL + (wave * 4 + s) * 1024 + lane * 16) = *(const bf16x8_t*)(QI1 + (mq0 + 32 * qb + q) * 256 + wave * 64 + 16 * s + 8 * hi);
                }
            }
            TACC(6);
            int mode = 0;
            while (true) {
                {
                    const int lane = lane_id_fresh(), q = lane & 31, hi = lane >> 5;
                    if (mode < 2) { for (int i = wave * 64 + lane; i < 32 * 257; i += 512) HIST[i] = 0u; }
                    __syncthreads();
                    const float lo1 = QPf[q * 16 + QP_LO], sc1 = QPf[q * 16 + QP_SC]; const int crit1 = QPi[q * 16 + QP_CRIT]; const int lvl = QPi[q * 16 + QP_LVL];
                    bf16x8_t qif[4][4];
#pragma unroll
                    for (int hh = 0; hh < 4; ++hh)
#pragma unroll
                        for (int s = 0; s < 4; ++s) qif[hh][s] = *(const bf16x8_t*)(QI0 + (mq0 + 32 * qb + q) * 256 + hh * 64 + 16 * s + 8 * hi);
                    bf16x8_t kr0[4], kr1[4], kr2[4];
#define C_LOADKI(dst, KB) do { if ((KB) < nkb) { _Pragma("unroll") for (int s = 0; s < 4; ++s) dst[s] = *(const bf16x8_t*)(KI + ((((size_t)b * 128 + (KB)) * 4 + s) * 64 + lane) * 8); } } while (0)
                    C_LOADKI(kr0, wave); C_LOADKI(kr1, wave + 8); C_LOADKI(kr2, wave + 16);
                    for (int kb = wave; kb < nkb; kb += 8) {
                        const int kbase = 32 * kb;
                        bf16x8_t kif[4];
#pragma unroll
                        for (int s = 0; s < 4; ++s) { kif[s] = kr0[s]; kr0[s] = kr1[s]; kr1[s] = kr2[s]; }
                        C_LOADKI(kr2, kb + 24);
                        f32x16 I;
#pragma unroll
                        for (int r = 0; r < 16; ++r) I[r] = 0.f;
#pragma unroll
                        for (int hh = 0; hh < 8; ++hh) {
                            f32x16 D;
#pragma unroll
                            for (int r = 0; r < 16; ++r) D[r] = 0.f;
                            if (hh < 4) {
#pragma unroll
                                for (int s = 0; s < 4; ++s) D = __builtin_amdgcn_mfma_f32_32x32x16_bf16(kif[s], qif[hh][s], D, 0, 0, 0);
                            } else {
#pragma unroll
                                for (int s = 0; s < 4; ++s) D = __builtin_amdgcn_mfma_f32_32x32x16_bf16(kif[s], *(const LAS bf16x8_t*)(QIFL + ((hh - 4) * 4 + s) * 1024 + lane * 16), D, 0, 0, 0);
                            }
                            const float wqh = WQ[q * 8 + hh];
#pragma unroll
                            for (int r = 0; r < 16; ++r) I[r] = fmaf(relu_asm(D[r]), wqh, I[r]);
                            asm volatile("" : "+v"(kif[0]), "+v"(kif[1]), "+v"(kif[2]), "+v"(kif[3]), "+v"(I));
                        }
                        if (mode == 0) {
#pragma unroll
                            for (int r = 0; r < 16; ++r) { const int bn = c_bin(I[r], lo1, sc1); atomicAdd((unsigned*)&HIST[q * 257 + bn], 1u); }
                        } else if (mode == 1) {
                            if (lvl == 1) {
                                const float lo2 = QPf[q * 16 + QP_LO2], sc2 = QPf[q * 16 + QP_SC2];
#pragma unroll
                                for (int r = 0; r < 16; ++r) { if (c_bin(I[r], lo1, sc1) == crit1) { const int bn = c_bin(I[r], lo2, sc2); atomicAdd((unsigned*)&HIST[q * 257 + bn], 1u); } }
                            }
                        } else {
                            unsigned bits = 0u;
#pragma unroll
                            for (int r = 0; r < 16; ++r) {
                                const int b1 = c_bin(I[r], lo1, sc1);
                                bool sel = b1 > crit1, cand = (b1 == crit1);
                                if (cand && lvl == 1) { const int b2 = c_bin(I[r], QPf[q * 16 + QP_LO2], QPf[q * 16 + QP_SC2]); const int crit2 = QPi[q * 16 + QP_CRIT2]; sel = b2 > crit2; cand = (b2 == crit2); }
                                if (sel) bits |= 1u << ((r & 3) + 8 * (r >> 2));
                                if (cand) { const unsigned pos = atomicAdd((unsigned*)&QPi[q * 16 + QP_CNT], 1u);
                                    if (pos < (unsigned)C_CAP) LIST[q * C_CAP + pos] = ((unsigned long long)__float_as_uint(I[r]) << 32) | (unsigned)(kbase + crow_(r, hi)); }
                            }
                            bits <<= 4 * hi;
                            bits = xh_or(bits);
                            if (hi == 0) BMP[(32 * qb + q) * 128 + kb] = bits;
                        }
                    }
                }
#undef C_LOADKI
                __syncthreads();
                TACC(7);
                if (mode == 2) break;
                {
                    const int lane = lane_id_fresh();
                    LAS unsigned* SCR = (LAS unsigned*)(C.lds + C_LDS_SCR + wave * 256);
#pragma nounroll
                    for (int qq = 0; qq < 4; ++qq) {
                        const int qx = wave * 4 + qq;
                        const int lv = QPi[qx * 16 + QP_LVL];
                        if (mode == 1 && lv == 0) continue;
                        const int krem = QPi[qx * 16 + QP_KREM];
                        unsigned cnt[4]; unsigned s = 0u;
#pragma unroll
                        for (int j = 0; j < 4; ++j) { cnt[j] = HIST[qx * 257 + lane * 4 + j]; s += cnt[j]; }
                        SCR[lane] = s; LDS_WAIT(); asm volatile("" ::: "memory");
                        unsigned incl = 0u;
#pragma unroll 8
                        for (int l2 = 0; l2 < 64; ++l2) { const unsigned t = SCR[l2]; incl += (l2 >= lane) ? t : 0u; }
                        LDS_WAIT(); asm volatile("" ::: "memory");
                        unsigned run = incl - s;
                        int fcrit = -1; unsigned frun = 0u, fcnt = 0u;
#pragma unroll
                        for (int j = 3; j >= 0; --j) {
                            const bool hit = run < (unsigned)krem && run + cnt[j] >= (unsigned)krem;
                            fcrit = hit ? lane * 4 + j : fcrit; frun = hit ? run : frun; fcnt = hit ? cnt[j] : fcnt;
                            run += cnt[j];
                        }
                        if (fcrit >= 0) {
                            QPi[qx * 16 + QP_KREM] = krem - (int)frun; QPi[qx * 16 + QP_CC] = (int)fcnt;
                            if (mode == 0) { QPi[qx * 16 + QP_CRIT] = fcrit;
                                if (fcnt > (unsigned)C_CAP) { const float nlosc = QPf[qx * 16 + QP_LO], sc = QPf[qx * 16 + QP_SC];
                                    QPf[qx * 16 + QP_LO2] = (nlosc - (float)fcrit) * (float)C_NB; QPf[qx * 16 + QP_SC2] = sc * (float)C_NB; QPi[qx * 16 + QP_LVL] = 1; } }
                            else QPi[qx * 16 + QP_CRIT2] = fcrit;
                        }
                    }
                }
                __syncthreads();
                TACC(8);
                if (mode == 0) { bool need_l2 = false; for (int qx = 0; qx < 32; ++qx) need_l2 |= (QPi[qx * 16 + QP_LVL] == 1); mode = need_l2 ? 1 : 2; }
                else mode = 2;
                __syncthreads();
            }
            {
                const int lane = lane_id_fresh();
#pragma nounroll
                for (int qq = 0; qq < 4; ++qq) {
                    const int qx = wave * 4 + qq;
                    int cn = QPi[qx * 16 + QP_CNT]; cn = cn < C_CAP ? cn : C_CAP;
                    const int need = QPi[qx * 16 + QP_KREM];
                    for (int ci = lane; ci < cn; ci += 64) {
                        const unsigned long long me = LIST[qx * C_CAP + ci];
                        const float mv = __uint_as_float((unsigned)(me >> 32)); const unsigned mi = (unsigned)me;
                        int rank = 0;
                        for (int j = 0; j < cn; ++j) { const unsigned long long o = LIST[qx * C_CAP + j]; const float ov = __uint_as_float((unsigned)(o >> 32)); const unsigned oi = (unsigned)o;
                            rank += (ov > mv || (ov == mv && oi < mi)) ? 1 : 0; }
                        if (rank < need) atomicOr((unsigned*)&BMP[(32 * qb + qx) * 128 + (mi >> 5)], 1u << (mi & 31));
                    }
                }
            }
            __syncthreads();
            TACC(9);
          }
        }
        __syncthreads();
        if (EXP >= 200 && wave == 0 && lane_id_fresh() == 0) { const unsigned long long tn_ = __builtin_amdgcn_s_memrealtime(); atomicAdd((unsigned*)(ws + WS_CTL) + 8192 + 16 * 4 + 2, (unsigned)(tn_ - tc0_)); tc0_ = tn_; }
        if (parts & 2) {
            const int lane = lane_id_fresh(), q = lane & 31, hi = lane >> 5;
            const int qb = wave & 1, h = wave >> 1, ql = 32 * qb + q;
            bf16x8_t qf[4];
#pragma unroll
            for (int s = 0; s < 4; ++s) qf[s] = *(const bf16x8_t*)(CQ + (mq0 + ql) * 256 + h * 64 + 16 * s + 8 * hi);
            f32x16 O[2];
#pragma unroll
            for (int db = 0; db < 2; ++db)
#pragma unroll
                for (int r = 0; r < 16; ++r) O[db][r] = 0.f;
            float mrun = -1e30f, lrun = 0.f;
            bf16x8_t kfn[4], vtn[2][2];
#define C_LOADKV(KB) do { const size_t kb_ = (size_t)(b * 4 + h) * 128 + (KB); _Pragma("unroll") for (int s = 0; s < 4; ++s) kfn[s] = *(const bf16x8_t*)(CK + ((kb_ * 4 + s) * 64 + lane) * 8); \
                _Pragma("unroll") for (int db = 0; db < 2; ++db) _Pragma("unroll") for (int s2 = 0; s2 < 2; ++s2) vtn[db][s2] = *(const bf16x8_t*)(CVT + (((kb_ * 2 + db) * 2 + s2) * 64 + lane) * 8); } while (0)
            C_LOADKV(0);
            for (int kb = 0; kb < nkb; ++kb) {
                const unsigned word = BMP[ql * 128 + kb] >> (4 * hi);
                bf16x8_t kf[4];
#pragma unroll
                for (int s = 0; s < 4; ++s) kf[s] = kfn[s];
                bf16x8_t vt[2][2];
#pragma unroll
                for (int db = 0; db < 2; ++db)
#pragma unroll
                    for (int s2 = 0; s2 < 2; ++s2) vt[db][s2] = vtn[db][s2];
                if (kb + 1 < nkb) C_LOADKV(kb + 1);
                f32x16 st;
#pragma unroll
                for (int r = 0; r < 16; ++r) st[r] = 0.f;
#pragma unroll
                for (int s = 0; s < 4; ++s) st = __builtin_amdgcn_mfma_f32_32x32x16_bf16(kf[s], qf[s], st, 0, 0, 0);
                float mx = -INFINITY;
#pragma unroll
                for (int r = 0; r < 16; ++r) {
                    const bool on = (word >> ((r & 3) + 8 * (r >> 2))) & 1u;
                    st[r] = on ? st[r] : -INFINITY;
                    mx = fmaxf(mx, st[r]);
                }
                mx = xh_max(mx) * (0.125f * 1.4426950408889634f);
                const float mn = fmaxf(mrun, mx);
                float ps = 0.f;
#pragma unroll
                for (int r = 0; r < 16; ++r) { st[r] = __builtin_amdgcn_exp2f(fmaf(st[r], 0.125f * 1.4426950408889634f, -mn)); ps += st[r]; }
                ps = xh_sum(ps);
                if (__builtin_amdgcn_ballot_w64(mn != mrun) != 0ull) {
                    const float al = __builtin_amdgcn_exp2f(mrun - mn);
                    lrun *= al;
#pragma unroll
                    for (int db = 0; db < 2; ++db)
#pragma unroll
                        for (int r = 0; r < 16; ++r) O[db][r] *= al;
                }
                mrun = mn;
                lrun += ps;
                v4u p0, p1;
                p0.x = pk2(st[0], st[1]); p0.y = pk2(st[2], st[3]); p0.z = pk2(st[4], st[5]); p0.w = pk2(st[6], st[7]);
                p1.x = pk2(st[8], st[9]); p1.y = pk2(st[10], st[11]); p1.z = pk2(st[12], st[13]); p1.w = pk2(st[14], st[15]);
                const bf16x8_t pf0 = __builtin_bit_cast(bf16x8_t, p0), pf1 = __builtin_bit_cast(bf16x8_t, p1);
#pragma unroll
                for (int db = 0; db < 2; ++db) {
                    O[db] = __builtin_amdgcn_mfma_f32_32x32x16_bf16(vt[db][0], pf0, O[db], 0, 0, 0);
                    O[db] = __builtin_amdgcn_mfma_f32_32x32x16_bf16(vt[db][1], pf1, O[db], 0, 0, 0);
                }
            }
#undef C_LOADKV
            const float invl = 1.f / lrun;
            const size_t mrow = (mq0 + ql) * 256 + h * 64;
#pragma unroll
            for (int db = 0; db < 2; ++db)
#pragma unroll
                for (int g = 0; g < 4; ++g) {
                    const int col = 32 * db + 8 * g + 4 * hi;
                    const v2u z = *(const v2u*)(CZ + mrow + col);
                    const float z0 = bflo(z.x), z1 = bfhi(z.x), z2 = bflo(z.y), z3 = bfhi(z.y);
                    v2u w;
                    w.x = pk2(O[db][4 * g] * invl * z0 * fsig(z0), O[db][4 * g + 1] * invl * z1 * fsig(z1));
                    w.y = pk2(O[db][4 * g + 2] * invl * z2 * fsig(z2), O[db][4 * g + 3] * invl * z3 * fsig(z3));
                    *(v2u*)(OUTP + mrow + col) = w;
                }
        }
        if (EXP >= 200) { __syncthreads(); if (wave == 0 && lane_id_fresh() == 0) { const unsigned long long tn_ = __builtin_amdgcn_s_memrealtime(); atomicAdd((unsigned*)(ws + WS_CTL) + 8192 + 16 * 5 + 2, (unsigned)(tn_ - tc0_)); } }
    }
}
#define GRID_BAR() do { xcd_barrier(bar, C.wave == 0 && lane_id_fresh() == 0); if (EXP >= 100) { volatile LAS unsigned* TSW = (volatile LAS unsigned*)(C.lds + MISC_OFF) + 12; const unsigned k_ = TSW[0] + 1u; if (C.wave == 0 && lane_id_fresh() == 0) { TSW[0] = k_; TSW[k_] = (unsigned)__builtin_amdgcn_s_memrealtime(); } } } while (0)
#ifndef EXP
#define EXP 0
#endif
#define REP(k) for (int rep_ = 0; rep_ < ((EXP == (k)) ? 2 : 1); ++rep_)
template <int l>
__device__ __forceinline__ void layer_body(Ctx C, const Params& P, const XcdBarrier& bar) {
    unsigned char* ws = P.ws;
    const float* xin = (l == 0) ? P.in[0] : P.out;
    bf16* DRY = (bf16*)P.out;
    REP(1) {
        pg8::Gemm g{(const pg8::bf16_t*)(ws + WS_H), (const pg8::bf16_t*)(ws + WS_W1T), NTOK, NG1, 1024};
        pg8::StaticOrder S; S.init(NTOK, NG1, C.G, C.bid);
        EpiG1 E{ws, (const float*)(ws + WS_LB) + l * 256};
        pg8::gemm_phase<EpiG1, pg8::StaticOrder, true, true>(C.lds, g, S, E, C.wave);
    }
    GRID_BAR();
    REP(2) { mixD1(C, P, l); __syncthreads(); }
    REP(3) { mixB_chunks<false>(C, ws, nullptr, nullptr); __syncthreads(); }
    GRID_BAR();
    REP(16) { mixD2(C, ws); __syncthreads(); }
    mixB_scan(C, ws);
    GRID_BAR();
#define SUBT(k) do { if (EXP >= 200) { __syncthreads(); if (C.wave == 0 && lane_id_fresh() == 0) { const unsigned long long tn_ = __builtin_amdgcn_s_memrealtime(); const unsigned d_ = (unsigned)(tn_ - tsub_); tsub_ = tn_; \
        unsigned* cw_ = (unsigned*)(ws + WS_CTL) + 8192 + 16 * (k); atomicMax(cw_ + l, d_); atomicAdd(cw_ + 2, d_); } } } while (0)
    unsigned long long tsub_ = (EXP >= 200) ? __builtin_amdgcn_s_memrealtime() : 0ull;
    REP(4) { mixD3(C, P, l); __syncthreads(); }
    SUBT(0);
    if (EXP == 5 && l == 0) { mixB_chunks<true>(C, ws, P.in[5] + l * 64, DRY); __syncthreads(); }
    mixB_chunks<true>(C, ws, P.in[5] + l * 64, PLP(ws, PL_BQ));
    SUBT(1);
    if (EXP == 6 && l == 0) { mixA_fast(C, ws, P.in[3] + l * 4 * 192, DRY); }
    mixA_fast(C, ws, P.in[3] + l * 4 * 192, PLP(ws, PL_AQ));
    __syncthreads();
    SUBT(2);
    if (EXP == 7 && l == 0) { mixC_fast(C, ws, DRY); __syncthreads(); }
    if (EXP == 17 && l == 0) { mixC_fast(C, ws, DRY, 1); __syncthreads(); }
    if (EXP == 18 && l == 0) { mixC_fast(C, ws, DRY, 2); __syncthreads(); }
    mixC_fast(C, ws, PLP(ws, PL_CQ));
    SUBT(3);
    GRID_BAR();
    REP(8) {
#pragma nounroll
    for (int br = 0; br < 4; ++br) {
        pg8::Gemm g{(const pg8::bf16_t*)PLP(ws, br), (const pg8::bf16_t*)(ws + WS_WBT + (size_t)br * 1024 * 256 * 2), NTOK, 1024, 256};
        pg8::StaticOrder S; S.init(NTOK, 1024, C.G, C.bid);
        EpiBf E{(bf16*)(ws + WS_PB) + (size_t)br * NTOK * 1024, 1024};
        pg8::gemm_phase<EpiBf, pg8::StaticOrder, true, true>(C.lds, g, S, E, C.wave);
    }
    }
    GRID_BAR();
    REP(9) {
        pg8::Gemm g{(const pg8::bf16_t*)(ws + WS_H), (const pg8::bf16_t*)(ws + WS_WGT), NTOK, 4096, 1024};
        pg8::StaticOrder S; S.init(NTOK, 4096, C.G, C.bid);
        EpiGate E{(const bf16*)(ws + WS_PB), (bf16*)(ws + WS_Y)};
        pg8::gemm_phase<EpiGate, pg8::StaticOrder, true, true>(C.lds, g, S, E, C.wave);
    }
    GRID_BAR();
    for (int rep_ = 0; rep_ < ((EXP == 10 && l == 0) ? 3 : 1); ++rep_) {
        pg8::Gemm g{(const pg8::bf16_t*)(ws + WS_Y), (const pg8::bf16_t*)(ws + WS_WOT), NTOK, 1024, 1024};
        pg8::StaticOrder S; S.init(NTOK, 1024, C.G, C.bid);
        EpiRes E{xin, P.out};
        pg8::gemm_phase<EpiRes, pg8::StaticOrder, true, true>(C.lds, g, S, E, C.wave);
    }
    GRID_BAR();
    if (l == 0) { REP(11) { norm_rows_bf16(C, P.out, P.in[1] + 1024, (bf16*)(ws + WS_H)); convert_weights(C, P, 1); } GRID_BAR(); }
    else {
        OPQ(C); const int gw = C.bid * 8 + C.wave, NGW = C.G * 8;
        for (int m = gw; m < NTOK; m += NGW) rms_row(P.out + (size_t)m * 1024, P.in[18], nullptr, P.out + (size_t)m * 1024, C.lane);
    }
    if (EXP == 12) { for (int i = 0; i < 20; ++i) GRID_BAR(); }
}
__global__ void __launch_bounds__(512, 2) mega_fwd(Params P) {
    extern __shared__ __attribute__((aligned(16))) unsigned char lds_raw[];
    Ctx C; C.lds = (LAS unsigned char*)lds_raw; C.wave = __builtin_amdgcn_readfirstlane((int)threadIdx.x >> 6); C.G = gridDim.x; C.bid = blockIdx.x; OPQ(C);
    unsigned char* ws = P.ws;
    for (int u = C.tid; u < (LDS_BYTES - LDSCTL_OFF) / 4; u += 512) ((LAS unsigned*)(C.lds + LDSCTL_OFF))[u] = 0u;
    __syncthreads();
    volatile LAS unsigned* MISCW = (volatile LAS unsigned*)(C.lds + MISC_OFF);
    XcdBarrier bar = xcd_barrier_post((unsigned*)(ws + WS_CTL) + CW_BAR, MISCW + 8);
    if (EXP >= 100 && C.wave == 0 && lane_id_fresh() == 0) { volatile LAS unsigned* TSW = (volatile LAS unsigned*)(C.lds + MISC_OFF) + 12; TSW[0] = 1u; TSW[1] = (unsigned)__builtin_amdgcn_s_memrealtime(); }
    __syncthreads();
    for (int rep_ = 0; rep_ < ((EXP == 13) ? 2 : 1); ++rep_) { setup_tables(C, P); }
    for (int rep_ = 0; rep_ < ((EXP == 14) ? 2 : 1); ++rep_) { convert_weights(C, P, 0); }
    for (int rep_ = 0; rep_ < ((EXP == 15) ? 2 : 1); ++rep_) { norm_rows_bf16(C, P.in[0], P.in[1], (bf16*)(ws + WS_H)); }
    GRID_BAR();
    layer_body<0>(C, P, bar);
    layer_body<1>(C, P, bar);
    if (EXP >= 100) {
        GRID_BAR();
        if (C.bid == 0 && C.wave == 0 && lane_id_fresh() == 0) {
            volatile LAS unsigned* TSW = (volatile LAS unsigned*)(C.lds + MISC_OFF) + 12;
            const int j = EXP - 100; unsigned dt;
            if (j >= 100) { const unsigned* cw_ = (const unsigned*)(P.ws + WS_CTL) + 8192 + 16 * ((j - 100) % 10);
                dt = (j < 110) ? (__hip_atomic_load(cw_, __ATOMIC_RELAXED, __HIP_MEMORY_SCOPE_AGENT) + __hip_atomic_load(cw_ + 1, __ATOMIC_RELAXED, __HIP_MEMORY_SCOPE_AGENT)) : (__hip_atomic_load(cw_ + 2, __ATOMIC_RELAXED, __HIP_MEMORY_SCOPE_AGENT) / 256u); }
            else if (j == 0) dt = TSW[2] - TSW[1];
            else if (j <= 7) dt = (TSW[2 + j] - TSW[1 + j]) + (TSW[10 + j] - TSW[9 + j]);
            else if (j == 8) dt = (TSW[10] - TSW[9]);
            else dt = (TSW[18] - TSW[17]);
            const unsigned long long t0 = __builtin_amdgcn_s_memrealtime();
            while (__builtin_amdgcn_s_memrealtime() - t0 < 10ull * dt) __builtin_amdgcn_s_sleep(8);
        }
    }
}

extern "C" void kernel_launch(void* const* d_in, const int* in_sizes, int n_in, void* d_out, int out_size, void* d_ws, size_t ws_size, hipStream_t stream) {
    static int grid = 0;
    if (grid == 0) {
        if (n_in != 19 || ws_size < WS_END) { fprintf(stderr, "kernel_launch: need 19 inputs and %zu bytes of workspace (got %d, %zu)\n", (size_t)WS_END, n_in, ws_size); grid = -1; return; }
        int dev = 0, cus = 0, per_cu = 0;
        if (hipGetDevice(&dev) != hipSuccess || hipDeviceGetAttribute(&cus, hipDeviceAttributeMultiprocessorCount, dev) != hipSuccess) { grid = -1; return; }
        if (hipFuncSetAttribute((const void*)mega_fwd, hipFuncAttributeMaxDynamicSharedMemorySize, LDS_BYTES) != hipSuccess) { grid = -1; return; }
        (void)hipOccupancyMaxActiveBlocksPerMultiprocessor(&per_cu, (const void*)mega_fwd, 512, LDS_BYTES);
        (void)hipGetLastError();
        grid = cus;
    }
    if (grid < 0) return;
    if (hipMemsetAsync((char*)d_ws + WS_CTL, 0, CTL_ZERO_BYTES, stream) != hipSuccess) return;
    Params p{};
    for (int i = 0; i < 19; ++i) p.in[i] = (const float*)d_in[i];
    p.out = (float*)d_out; p.ws = (unsigned char*)d_ws;
    hipLaunchKernelGGL(mega_fwd, dim3(grid), dim3(512), LDS_BYTES, stream, p);
}
```

```cpp
#define EXP 0
#include <hip/hip_runtime.h>
#include <cstdio>
#include <cstdint>
#include <math.h>

#define DM 1024
#define SEQ 4096
#define NBATCH 8
#define NTOK (NBATCH * SEQ)
#define INC 8904
#define C_AQ 0
#define C_AK 256
#define C_AV 512
#define C_AZ 768
#define C_BQ 1024
#define C_BF 1280
#define C_BI 1536
#define C_BZ 1792
#define C_CQ 2048
#define C_CK 2304
#define C_CV 2560
#define C_CZ 2816
#define C_CQI 3072
#define C_CKI 3584
#define C_CWI 3648
#define C_PD 3656
#define C_DR 3656
#define C_DK 3912
#define C_DV 4168
#define C_DWD 4424
#define C_DAD 4488
#define C_DZ 4552
#define C_PG 4808
#define NG1 4864

namespace pg8 {
#define PG8_LAS __attribute__((address_space(3)))
typedef unsigned short bf16_t;
typedef short bf16x8 __attribute__((ext_vector_type(8)));
typedef float f32x4 __attribute__((ext_vector_type(4)));
typedef unsigned u32x4 __attribute__((ext_vector_type(4)));
constexpr int BM = 256, BK = 64, HALF = 128, HTB = HALF * BK * 2  , STAGE_BYTES = 8 * HTB, NXCD = 8, WGM = 8;

__host__ __device__ __forceinline__ int lds_byte(int r, int c) { const int st = (r >> 4) * 2 + (c >> 5), rr = r & 15, cc = c & 31, ob = rr * 64 + cc * 2; return st * 1024 + (ob ^ (((ob >> 9) & 1) << 5)); }
__host__ __device__ __forceinline__ void stage_rc(int b, int& R, int& C) { const int st = b / 1024, sb = b % 1024, swz = sb ^ (((sb >> 9) & 1) << 5); R = (st >> 1) * 16 + swz / 64; C = (st & 1) * 32 + (swz % 64) / 2; }
__host__ __device__ __forceinline__ int perm32(int rho) { const int n = rho >> 4, i = rho & 15; return 8 * (i >> 2) + 4 * n + (i & 3); }

struct Unit { int pm, pn; int grp; };
struct Gemm { const bf16_t* A; const bf16_t* Bt; int M, N, K; size_t a_grp = 0, b_grp = 0; };

struct StaticOrder {
    int nM, nN, nwg, G, c;
    __host__ __device__ void init(int M, int N, int G_, int c_) { nM = M / BM; nN = N / BM; nwg = nM * nN; G = G_; c = c_; }
    __host__ __device__ bool next(int i, Unit& u) const {
        const long L = (long)i * G + c; if (L >= nwg) return false;
        int wgid = (int)L; { const int q = nwg / NXCD, r = nwg % NXCD, xcd = wgid % NXCD, off = wgid / NXCD; wgid = (xcd < r ? xcd * (q + 1) : r * (q + 1) + (xcd - r) * q) + off; }
        const int nig = WGM * nN, gid = wgid / nig, fm = gid * WGM, gsz = (nM - fm) < WGM ? (nM - fm) : WGM;
        u.pm = fm + ((wgid % nig) % gsz); u.pn = (wgid % nig) / gsz; u.grp = 0; return true;
    }
    __device__ __forceinline__ void a_ready(const Unit&) const {}
    __device__ __forceinline__ void done(const Unit&) const {}
};
struct GroupedOrder {
    StaticOrder so; int ngrp;
    __host__ __device__ void init(int M, int N, int ngrp_, int G_, int c_) { so.init(M, N, G_, c_); ngrp = ngrp_; }
    __host__ __device__ bool next(int i, Unit& u) const {
        const long L = (long)i * so.G + so.c; if (L >= (long)ngrp * so.nwg) return false;
        const int grp = (int)(L / so.nwg), loc = (int)(L % so.nwg);
        StaticOrder t = so; t.c = loc; t.G = so.nwg;
        t.next(0, u); u.grp = grp; return true;
    }
    __device__ __forceinline__ void a_ready(const Unit&) const {}
    __device__ __forceinline__ void done(const Unit&) const {}
};

__device__ __forceinline__ unsigned cvt_pk_bf16(float lo, float hi) { unsigned r; asm volatile("v_cvt_pk_bf16_f32 %0, %1, %2" : "=v"(r) : "v"(lo), "v"(hi)); return r; }
template <class Epi, class Sched, bool ALIGN_EPI = false, bool SP2 = false>
__device__ __forceinline__ void gemm_phase(PG8_LAS unsigned char* lds, const Gemm g, const Sched& S, const Epi& E, const int wave_in) {
    int lane_; asm volatile("v_mbcnt_lo_u32_b32 %0, -1, 0\n\tv_mbcnt_hi_u32_b32 %0, -1, %0" : "=v"(lane_));
    const int wid = wave_in, lane = lane_, tid = wid * 64 + lane, wr = wid >> 2, wc = wid & 3, fr = lane & 15, fq = lane >> 4;
    const int K = g.K, nt = K / BK;
    unsigned voffA[2], voffB[2];
#pragma unroll
    for (int i = 0; i < 2; ++i) { int R, C; stage_rc(tid * 16 + i * 8192, R, C); const int Rb = Epi::PERM ? ((R & ~31) + perm32(R & 31)) : R;
        voffA[i] = (unsigned)(R * K + C) * 2u; voffB[i] = (unsigned)(Rb * K + C) * 2u; }
    const size_t kstep = (size_t)(BK * 2);
    const size_t hstep = (size_t)HALF * K * 2;
    const size_t tstep = 2 * hstep;
    const unsigned ldsw = (unsigned)wid * 1024u;
    const int aoff = lds_byte(wr * 64 + fr, fq * 8), boff = lds_byte(wc * 32 + fr, fq * 8);
#define PG8_SA(b, h) (((b) * 2 + (h)) * HTB)
#define PG8_SB(b, h) ((4 + (b) * 2 + (h)) * HTB)
#define PG8_STAGE(bufoff, gbase, voff) do { _Pragma("unroll") for (int _i = 0; _i < 2; ++_i) \
        __builtin_amdgcn_global_load_lds((const unsigned*)((const char*)(gbase) + (voff)[_i]), (PG8_LAS unsigned*)(lds + (bufoff) + ldsw + _i * 8192), 16, 0, 0); } while (0)
#define PG8_LDA(dst, b, h) do { _Pragma("unroll") for (int m = 0; m < 4; ++m) _Pragma("unroll") for (int k = 0; k < 2; ++k) dst[m][k] = *(const PG8_LAS bf16x8*)(lds + PG8_SA(b, h) + aoff + m * 2048 + k * 1024); } while (0)
#define PG8_LDB(dst, b, h) do { _Pragma("unroll") for (int n = 0; n < 2; ++n) _Pragma("unroll") for (int k = 0; k < 2; ++k) dst[n][k] = *(const PG8_LAS bf16x8*)(lds + PG8_SB(b, h) + boff + n * 2048 + k * 1024); } while (0)
#define PG8_MMA(ai, bj, At, Bt) do { __builtin_amdgcn_s_setprio(1); _Pragma("unroll") for (int m = 0; m < 4; ++m) _Pragma("unroll") for (int n = 0; n < 2; ++n) _Pragma("unroll") for (int k = 0; k < 2; ++k) \
        acc[ai][bj][m][n] = __builtin_amdgcn_mfma_f32_16x16x32_bf16(Bt[n][k], At[m][k], acc[ai][bj][m][n], 0, 0, 0); __builtin_amdgcn_s_setprio(0); } while (0)
#define PG8_WAIT_V(n) asm volatile("s_waitcnt vmcnt(" #n ")" ::: "memory")
#define PG8_WAIT_L(n) asm volatile("s_waitcnt lgkmcnt(" #n ")" ::: "memory")
#define PG8_BAR __builtin_amdgcn_s_barrier()
#define PG8_SCHED __builtin_amdgcn_sched_barrier(0)
    Unit cur, nxt; int ui = 0;
    if (!S.next(0, cur)) return;
    f32x4 acc[2][2][4][2];
#pragma unroll
    for (int a = 0; a < 2; ++a)
#pragma unroll
        for (int b = 0; b < 2; ++b)
#pragma unroll
            for (int m = 0; m < 4; ++m)
#pragma unroll
                for (int n = 0; n < 2; ++n) acc[a][b][m][n] = (f32x4){0.f, 0.f, 0.f, 0.f};
    bf16x8 At[4][2], B0[2][2], B1[2][2];
    const char* cA = (const char*)g.A + (size_t)cur.grp * g.a_grp + (size_t)cur.pm * tstep; const char* cB = (const char*)g.Bt + (size_t)cur.grp * g.b_grp + (size_t)cur.pn * tstep;
    S.a_ready(cur);
    if constexpr (SP2) {
        PG8_STAGE(PG8_SB(0, 0), cB, voffB); PG8_STAGE(PG8_SB(0, 1), cB + hstep, voffB); PG8_STAGE(PG8_SA(0, 0), cA, voffA); PG8_STAGE(PG8_SA(0, 1), cA + hstep, voffA);
        if (wr == 1) PG8_BAR;
        PG8_WAIT_V(2); PG8_BAR;
        PG8_STAGE(PG8_SB(1, 0), cB + kstep, voffB); PG8_STAGE(PG8_SA(1, 0), cA + kstep, voffA); PG8_STAGE(PG8_SB(1, 1), cB + hstep + kstep, voffB);
        PG8_WAIT_V(6); PG8_BAR;
    } else {
        PG8_STAGE(PG8_SB(0, 0), cB, voffB); PG8_STAGE(PG8_SA(0, 0), cA, voffA); PG8_STAGE(PG8_SB(0, 1), cB + hstep, voffB); PG8_STAGE(PG8_SA(0, 1), cA + hstep, voffA);
        if (wr == 1) PG8_BAR;
        PG8_WAIT_V(4); PG8_BAR;
        PG8_STAGE(PG8_SB(1, 0), cB + kstep, voffB); PG8_STAGE(PG8_SA(1, 0), cA + kstep, voffA); PG8_STAGE(PG8_SB(1, 1), cB + hstep + kstep, voffB);
        PG8_WAIT_V(6); PG8_BAR;
    }
    for (;;) {
        const bool has_next = S.next(ui + 1, nxt);
        const char* nA = has_next ? (const char*)g.A + (size_t)nxt.grp * g.a_grp + (size_t)nxt.pm * tstep : cA; const char* nB = has_next ? (const char*)g.Bt + (size_t)nxt.grp * g.b_grp + (size_t)nxt.pn * tstep : cB;
        for (int t = 0; t < nt; t += 2) {
            const bool last = (t == nt - 2);
            const char* a1 = cA + (size_t)(t + 1) * kstep;
            const char* a2 = last ? nA : cA + (size_t)(t + 2) * kstep; const char* b2 = last ? nB : cB + (size_t)(t + 2) * kstep;
            const char* a3 = a2 + kstep; const char* b3 = b2 + kstep;
            if (last && has_next) S.a_ready(nxt);
            if constexpr (SP2) {
            PG8_LDB(B0, 0, 0); PG8_LDB(B1, 0, 1); PG8_SCHED; PG8_LDA(At, 0, 0); PG8_STAGE(PG8_SA(1, 1), a1 + hstep, voffA);
            PG8_WAIT_V(8); PG8_WAIT_L(0); PG8_BAR; PG8_MMA(0, 0, At, B0); PG8_MMA(0, 1, At, B1); PG8_BAR; PG8_SCHED;
            PG8_LDA(At, 0, 1); PG8_STAGE(PG8_SB(0, 0), b2, voffB); PG8_STAGE(PG8_SB(0, 1), b2 + hstep, voffB); PG8_STAGE(PG8_SA(0, 0), a2, voffA);
            PG8_WAIT_V(8); PG8_WAIT_L(0); PG8_BAR; PG8_MMA(1, 0, At, B0); PG8_MMA(1, 1, At, B1); PG8_BAR; PG8_SCHED;
            PG8_LDB(B0, 1, 0); PG8_LDB(B1, 1, 1); PG8_SCHED; PG8_LDA(At, 1, 0); PG8_STAGE(PG8_SA(0, 1), a2 + hstep, voffA);
            PG8_WAIT_V(8); PG8_WAIT_L(0); PG8_BAR; PG8_MMA(0, 0, At, B0); PG8_MMA(0, 1, At, B1); PG8_BAR; PG8_SCHED;
            PG8_LDA(At, 1, 1); PG8_STAGE(PG8_SB(1, 0), b3, voffB); PG8_STAGE(PG8_SB(1, 1), b3 + hstep, voffB); PG8_STAGE(PG8_SA(1, 0), a3, voffA);
            PG8_WAIT_V(8); PG8_WAIT_L(0); PG8_BAR; PG8_MMA(1, 0, At, B0); PG8_MMA(1, 1, At, B1); PG8_BAR; PG8_SCHED;
            } else {
            PG8_LDB(B0, 0, 0); PG8_SCHED; PG8_LDA(At, 0, 0); PG8_STAGE(PG8_SA(1, 1), a1 + hstep, voffA);
            PG8_WAIT_L(8); PG8_BAR; PG8_WAIT_L(0); PG8_MMA(0, 0, At, B0); PG8_BAR; PG8_SCHED;
            PG8_LDB(B1, 0, 1); PG8_STAGE(PG8_SB(0, 0), b2, voffB);
            PG8_BAR; PG8_WAIT_L(0); PG8_MMA(0, 1, At, B1); PG8_BAR;
            PG8_LDA(At, 0, 1); PG8_STAGE(PG8_SA(0, 0), a2, voffA);
            PG8_BAR; PG8_WAIT_L(0); PG8_MMA(1, 0, At, B0); PG8_BAR; PG8_SCHED;
            PG8_STAGE(PG8_SB(0, 1), b2 + hstep, voffB);
            PG8_WAIT_V(6); PG8_BAR; PG8_MMA(1, 1, At, B1); PG8_BAR;
            PG8_LDB(B0, 1, 0); PG8_SCHED; PG8_LDA(At, 1, 0); PG8_STAGE(PG8_SA(0, 1), a2 + hstep, voffA);
            PG8_WAIT_L(8); PG8_BAR; PG8_WAIT_L(0); PG8_MMA(0, 0, At, B0); PG8_BAR; PG8_SCHED;
            PG8_LDB(B1, 1, 1); PG8_STAGE(PG8_SB(1, 0), b3, voffB);
            PG8_BAR; PG8_WAIT_L(0); PG8_MMA(0, 1, At, B1); PG8_BAR;
            PG8_LDA(At, 1, 1); PG8_STAGE(PG8_SA(1, 0), a3, voffA);
            PG8_BAR; PG8_WAIT_L(0); PG8_MMA(1, 0, At, B0); PG8_BAR; PG8_SCHED;
            PG8_STAGE(PG8_SB(1, 1), b3 + hstep, voffB);
            PG8_WAIT_V(6); PG8_BAR; PG8_MMA(1, 1, At, B1); PG8_BAR;
            }
        }
        if constexpr (ALIGN_EPI) { if (wr == 0) PG8_BAR; }
        if constexpr (!Epi::AFTER_DRAIN) { E(acc, cur, wr, wc, fr, fq); S.done(cur); }
        if (!has_next) break;
#pragma unroll
        for (int a = 0; a < 2; ++a)
#pragma unroll
            for (int b = 0; b < 2; ++b)
#pragma unroll
                for (int m = 0; m < 4; ++m)
#pragma unroll
                    for (int n = 0; n < 2; ++n) acc[a][b][m][n] = (f32x4){0.f, 0.f, 0.f, 0.f};
        cur = nxt; cA = nA; cB = nB; ++ui;
        if constexpr (ALIGN_EPI) { if (wr == 1) PG8_BAR; }
    }
    PG8_WAIT_V(0);
    if constexpr (!ALIGN_EPI) { if (wr == 0) PG8_BAR; }
    PG8_BAR;
    if constexpr (Epi::AFTER_DRAIN) { E.fused(acc, cur, wr, wc, fr, fq, lds, wid, lane); S.done(cur); }
#undef PG8_SA
#undef PG8_SB
#undef PG8_STAGE
#undef PG8_LDA
#undef PG8_LDB
#undef PG8_MMA
#undef PG8_WAIT_V
#undef PG8_WAIT_L
#undef PG8_BAR
#undef PG8_SCHED
}
}

#define GAS __attribute__((address_space(1)))
#define LAS __attribute__((address_space(3)))
typedef unsigned short bf16;
typedef unsigned v4u __attribute__((ext_vector_type(4)));
typedef unsigned v2u __attribute__((ext_vector_type(2)));
typedef float f32x4 __attribute__((ext_vector_type(4)));
typedef GAS unsigned gu32;
#define RLX_AGENT __ATOMIC_RELAXED, __HIP_MEMORY_SCOPE_AGENT
#define LDS_WAIT() asm volatile("s_waitcnt lgkmcnt(0)" ::: "memory")
#define VM_WAIT() asm volatile("s_waitcnt vmcnt(0)" ::: "memory")
__device__ __forceinline__ unsigned f2bf(float f) { unsigned u = __builtin_bit_cast(unsigned, f); return (u + 0x7fffu + ((u >> 16) & 1u)) >> 16; }
typedef float f32x2_t_ __attribute__((ext_vector_type(2))); typedef __bf16 bf16x2_t_ __attribute__((ext_vector_type(2)));
__device__ __forceinline__ unsigned pk2(float lo, float hi) { const f32x2_t_ v = {lo, hi}; const bf16x2_t_ b = __builtin_convertvector(v, bf16x2_t_); return __builtin_bit_cast(unsigned, b); }
__device__ __forceinline__ float bf2f(unsigned short b) { return __builtin_bit_cast(float, (unsigned)b << 16); }
__device__ __forceinline__ float bflo(unsigned w) { return __builtin_bit_cast(float, w << 16); }
__device__ __forceinline__ float bfhi(unsigned w) { return __builtin_bit_cast(float, w & 0xffff0000u); }
__device__ __forceinline__ float sigmoidf_(float x) { return 1.f / (1.f + expf(-x)); }
__device__ __forceinline__ float fsig(float x) { return __builtin_amdgcn_rcpf(1.f + __builtin_amdgcn_exp2f(-1.4426950408889634f * x)); }
__device__ __forceinline__ float siluf_(float x) { return x / (1.f + expf(-x)); }
__device__ __forceinline__ float dppf(float x, const int sel) {
    const int xi = __builtin_bit_cast(int, x); int r;
    if (sel == 0) r = __builtin_amdgcn_update_dpp(xi, xi, 0xB1, 0xF, 0xF, false);
    else if (sel == 1) r = __builtin_amdgcn_update_dpp(xi, xi, 0x4E, 0xF, 0xF, false);
    else if (sel == 2) r = __builtin_amdgcn_update_dpp(xi, xi, 0x141, 0xF, 0xF, false);
    else if (sel == 3) r = __builtin_amdgcn_update_dpp(xi, xi, 0x140, 0xF, 0xF, false);
    else r = __builtin_amdgcn_update_dpp(xi, xi, 0x128, 0xF, 0xF, false);
    return __builtin_bit_cast(float, r);
}
__device__ __forceinline__ float swz16f(float x) { return __builtin_bit_cast(float, __builtin_amdgcn_ds_swizzle(__builtin_bit_cast(int, x), 0x401F)); }
__device__ __forceinline__ float xh_sum(float x) { auto rr = __builtin_amdgcn_permlane32_swap(__float_as_uint(x), __float_as_uint(x), false, false); return __uint_as_float(rr[0]) + __uint_as_float(rr[1]); }
__device__ __forceinline__ float xh_max(float x) { auto rr = __builtin_amdgcn_permlane32_swap(__float_as_uint(x), __float_as_uint(x), false, false); return fmaxf(__uint_as_float(rr[0]), __uint_as_float(rr[1])); }
__device__ __forceinline__ unsigned xh_or(unsigned x) { auto rr = __builtin_amdgcn_permlane32_swap(x, x, false, false); return rr[0] | rr[1]; }
__device__ __forceinline__ float wave_sum(float v) {
    v += dppf(v, 0); v += dppf(v, 1); v += dppf(v, 2); v += dppf(v, 3); v += swz16f(v); return xh_sum(v);
}
__device__ __forceinline__ float wave_max(float v) {
    v = fmaxf(v, dppf(v, 0)); v = fmaxf(v, dppf(v, 1)); v = fmaxf(v, dppf(v, 2)); v = fmaxf(v, dppf(v, 3)); v = fmaxf(v, swz16f(v)); return xh_max(v);
}

constexpr size_t MiB = 1u << 20;
constexpr size_t WS_CTL = 0, CTL_ZERO_BYTES = 1 * MiB;
constexpr size_t WS_COS = 1 * MiB, WS_SIN = 1 * MiB + 512 * 1024;
constexpr size_t WS_LB = 2 * MiB;
constexpr size_t WS_DBON = 3 * MiB;
constexpr size_t WS_DAB = 4 * MiB;
constexpr size_t WS_DSS = 12 * MiB;
constexpr size_t WS_W1T = 16 * MiB;
constexpr size_t WS_WGT = 26 * MiB;
constexpr size_t WS_WBT = 34 * MiB;
constexpr size_t WS_WOT = 36 * MiB;
constexpr size_t WS_KI = 38 * MiB;
constexpr size_t WS_H = 42 * MiB;
constexpr size_t WS_PL = 106 * MiB;
constexpr size_t PLANE = 16 * MiB;
constexpr size_t WS_BF = WS_PL + 17 * PLANE;
constexpr size_t WS_MISC = WS_BF + 32 * MiB;
constexpr size_t WS_OL = WS_MISC + 32 * MiB;
constexpr size_t WS_CC = WS_OL + 16 * MiB;
constexpr size_t WS_BS = WS_CC + 16 * MiB;
constexpr size_t WS_BG = WS_BS + 32 * MiB;
constexpr size_t WS_END = WS_BG + 1 * MiB;
constexpr size_t WS_Y = WS_PL;
constexpr size_t WS_PB = WS_PL + 4 * PLANE;
static_assert(WS_PB + (size_t)4 * NTOK * 1024 * 2 <= WS_OL, "P_b overlay");
enum { PL_AQ = 0, PL_BQ = 1, PL_CQ = 2, PL_DR = 3, PL_AK = 4, PL_AV = 5, PL_AZ = 6, PL_BI = 7, PL_BZ = 8, PL_CK = 9, PL_CV = 10, PL_CZ = 11, PL_CQI0 = 12, PL_CQI1 = 13, PL_DK = 14, PL_DV = 15, PL_DZ = 16 };
#define PLP(ws, i) ((bf16*)((ws) + WS_PL + (size_t)(i) * PLANE))
constexpr int CW_BAR = 4096;

constexpr int RING_BYTES = 131072;
constexpr int LDSCTL_OFF = RING_BYTES, MISC_OFF = LDSCTL_OFF + 320;
constexpr int LDS_BYTES = 147456;

__device__ __forceinline__ int rope_j(int head, int dim) {
    const int bj = head >> 1, wc = ((head & 1) << 1) | ((dim >> 4) & 1), n = dim >> 5, fq = (dim >> 2) & 3, i = dim & 3;
    return 128 * bj + 32 * wc + 16 * n + 4 * fq + i;
}
__device__ __forceinline__ int win_dst_row(int c, int& which) {
    which = 0;
    if (c < 2048) return c;
    if (c < 2304) { const int l = c - 2048; return 8 * 256 + rope_j(l >> 6, l & 63); }
    if (c < 2560) { const int l = c - 2304; return 9 * 256 + rope_j(l >> 6, l & 63); }
    if (c < 3072) return c;
    if (c < 3584) { const int l = c - 3072; return (12 + (l >> 8)) * 256 + rope_j((l >> 6) & 3, l & 63); }
    if (c < 3648) return 14 * 256 + rope_j(0, c - 3584);
    if (c < 3656) return 14 * 256 + 64 + (c - 3648);
    if (c < 3912) return 15 * 256 + (c - 3656);
    if (c < 4168) return 16 * 256 + (c - 3912);
    if (c < 4424) return 17 * 256 + (c - 4168);
    if (c < 4488) return 14 * 256 + 72 + (c - 4424);
    if (c < 4552) return 14 * 256 + 136 + (c - 4488);
    if (c < 4808) return 18 * 256 + (c - 4552);
    which = 1;
    { const int g = c - 4808, br = g >> 10, y = g & 1023, pn = y >> 6, wc = (y >> 4) & 3, fq = (y >> 2) & 3, i = y & 3;
      return 256 * pn + 128 * (br >> 1) + 32 * wc + 16 * (br & 1) + 4 * fq + i; }
}

__device__ __forceinline__ size_t kfrag_off(int bh, int t, int d) { return ((((size_t)bh * 128 + (t >> 5)) * 4 + (d >> 4)) * 64 + ((t & 31) + 32 * ((d >> 3) & 1))) * 8 + (d & 7); }
__device__ __forceinline__ size_t vfrag_off(int bh, int t, int d) { const int kk = t & 31, r16 = kk & 15;
    return (((((size_t)bh * 128 + (t >> 5)) * 2 + (d >> 5)) * 2 + (kk >> 4)) * 64 + ((d & 31) + 32 * ((r16 >> 2) & 1))) * 8 + 4 * (r16 >> 3) + (r16 & 3); }

struct EpiG1 {
    static constexpr bool PERM = false, AFTER_DRAIN = false;
    unsigned char* ws; const float* lbl;
    __device__ __forceinline__ void operator()(const f32x4 (&acc)[2][2][4][2], const pg8::Unit& u, int wr, int wc, int fr, int fq) const {
        asm volatile("" : "+v"(fr), "+v"(fq));
        const int pn = u.pn;
        const int rbase = u.pm * 256 + wr * 64 + fr;
        const int cq = wc * 32 + 4 * fq;
        if (pn == 5) {
            float* BF = (float*)(ws + WS_BF);
#pragma unroll
            for (int bj = 0; bj < 2; ++bj)
#pragma unroll
                for (int n = 0; n < 2; ++n) {
                    const int col = cq + bj * 128 + n * 16;
                    const f32x4 l4 = *(const f32x4*)(lbl + col);
#pragma unroll
                    for (int ai = 0; ai < 2; ++ai)
#pragma unroll
                        for (int m = 0; m < 4; ++m) {
                            const f32x4 x = acc[ai][bj][m][n]; f32x4 o;
#pragma unroll
                            for (int i = 0; i < 4; ++i) o[i] = 1.f - (1.f - l4[i]) * fsig(-x[i]);
                            *(f32x4*)(BF + (size_t)(rbase + ai * 128 + m * 16) * 256 + col) = o;
                            asm volatile("" ::: "memory");
                        }
                }
        } else if (pn == 14) {
            float* MS = (float*)(ws + WS_MISC);
            const float* tcos = (const float*)(ws + WS_COS); const float* tsin = (const float*)(ws + WS_SIN);
#pragma unroll
            for (int bj = 0; bj < 2; ++bj) {
                if (bj == 0 && wc < 2) {
                    const int d0 = 16 * (wc & 1) + 4 * fq;
#pragma unroll
                    for (int ai = 0; ai < 2; ++ai)
#pragma unroll
                        for (int m = 0; m < 4; ++m) {
                            const int row = rbase + ai * 128 + m * 16, pos = row & (SEQ - 1);
                            const f32x4 c4 = *(const f32x4*)(tcos + pos * 32 + d0), s4 = *(const f32x4*)(tsin + pos * 32 + d0);
                            const f32x4 x1 = acc[ai][0][m][0], x2 = acc[ai][0][m][1];
                            const f32x4 y1 = x1 * c4 - x2 * s4, y2 = x2 * c4 + x1 * s4;
                            *(f32x4*)(MS + (size_t)row * 256 + d0) = y1;
                            *(f32x4*)(MS + (size_t)row * 256 + 32 + d0) = y2;
                            bf16* KIp = (bf16*)(ws + WS_KI);
                            v2u w1, w2; w1.x = pk2(y1[0], y1[1]); w1.y = pk2(y1[2], y1[3]); w2.x = pk2(y2[0], y2[1]); w2.y = pk2(y2[2], y2[3]);
                            *(v2u*)(KIp + kfrag_off(row >> 12, pos, d0)) = w1; *(v2u*)(KIp + kfrag_off(row >> 12, pos, 32 + d0)) = w2;
                            asm volatile("" ::: "memory");
                        }
                } else {
#pragma unroll
                    for (int n = 0; n < 2; ++n)
#pragma unroll
                        for (int ai = 0; ai < 2; ++ai)
#pragma unroll
                            for (int m = 0; m < 4; ++m)
                                *(f32x4*)(MS + (size_t)(rbase + ai * 128 + m * 16) * 256 + cq + bj * 128 + n * 16) = acc[ai][bj][m][n];
                }
            }
        } else {
            const unsigned long long lo = 0ull | (0ull << 0) | (4ull << 5) | (5ull << 10) | (6ull << 15) | (1ull << 20) | (0ull << 25) | (7ull << 30) | (8ull << 35) | (2ull << 40) | (9ull << 45) | (10ull << 50) | (11ull << 55);
            const unsigned long long hi = (12ull << 0) | (13ull << 5) | (0ull << 10) | (3ull << 15) | (14ull << 20) | (15ull << 25) | (16ull << 30);
            const int plane = (int)((pn < 12 ? (lo >> (5 * pn)) : (hi >> (5 * (pn - 12)))) & 31ull);
            bf16* PLN = PLP(ws, plane);
            if (pn == 8 || pn == 9 || pn == 12 || pn == 13) {
                const float* tcos = (const float*)(ws + WS_COS); const float* tsin = (const float*)(ws + WS_SIN);
                const int d0 = 16 * (wc & 1) + 4 * fq;
#pragma unroll
                for (int ai = 0; ai < 2; ++ai)
#pragma unroll
                    for (int m = 0; m < 4; ++m) {
                        const int row = rbase + ai * 128 + m * 16, pos = row & (SEQ - 1);
                        const f32x4 c4 = *(const f32x4*)(tcos + pos * 32 + d0), s4 = *(const f32x4*)(tsin + pos * 32 + d0);
#pragma unroll
                        for (int bj = 0; bj < 2; ++bj) {
                            const int head = 2 * bj + (wc >> 1);
                            const f32x4 x1 = acc[ai][bj][m][0], x2 = acc[ai][bj][m][1];
                            const f32x4 y1 = x1 * c4 - x2 * s4, y2 = x2 * c4 + x1 * s4;
                            v2u w1, w2; w1.x = pk2(y1[0], y1[1]); w1.y = pk2(y1[2], y1[3]); w2.x = pk2(y2[0], y2[1]); w2.y = pk2(y2[2], y2[3]);
                            if (pn == 9) {
                                const int bh = (row >> 12) * 4 + head;
                                *(v2u*)(PLN + kfrag_off(bh, pos, d0)) = w1; *(v2u*)(PLN + kfrag_off(bh, pos, 32 + d0)) = w2;
                            } else {
                                *(v2u*)(PLN + (size_t)row * 256 + head * 64 + d0) = w1;
                                *(v2u*)(PLN + (size_t)row * 256 + head * 64 + 32 + d0) = w2;
                            }
                        }
                        asm volatile("" ::: "memory");
                    }
            } else if (pn == 2 || pn == 10) {
#pragma unroll
                for (int ai = 0; ai < 2; ++ai)
#pragma unroll
                    for (int m = 0; m < 4; ++m) {
                        const int row = rbase + ai * 128 + m * 16, bb = row >> 12, tq = row & (SEQ - 1);
#pragma unroll
                        for (int bj = 0; bj < 2; ++bj)
#pragma unroll
                            for (int n = 0; n < 2; ++n) {
                                const f32x4 x = acc[ai][bj][m][n]; const int col = cq + bj * 128 + n * 16;
                                bf16* p = PLN + vfrag_off(bb * 4 + (col >> 6), tq, col & 63);
#pragma unroll
                                for (int i = 0; i < 4; ++i) p[8 * i] = (bf16)f2bf(x[i]);
                            }
                        asm volatile("" ::: "memory");
                    }
            } else if (pn == 1) {
#pragma unroll
                for (int ai = 0; ai < 2; ++ai)
#pragma unroll
                    for (int m = 0; m < 4; ++m) {
                        const int row = rbase + ai * 128 + m * 16, bb = row >> 12, tq = row & (SEQ - 1);
#pragma unroll
                        for (int bj = 0; bj < 2; ++bj)
#pragma unroll
                            for (int n = 0; n < 2; ++n) {
                                const f32x4 x = acc[ai][bj][m][n]; const int col = cq + bj * 128 + n * 16;
                                v2u w; w.x = pk2(x[0], x[1]); w.y = pk2(x[2], x[3]);
                                *(v2u*)(PLN + kfrag_off(bb * 4 + (col >> 6), tq, col & 63)) = w;
                            }
                        asm volatile("" ::: "memory");
                    }
            } else if (pn == 4) {
#pragma unroll
                for (int ai = 0; ai < 2; ++ai)
#pragma unroll
                    for (int m = 0; m < 4; ++m) {
                        bf16* rowp = PLN + (size_t)(rbase + ai * 128 + m * 16) * 256 + cq;
#pragma unroll
                        for (int bj = 0; bj < 2; ++bj)
#pragma unroll
                            for (int n = 0; n < 2; ++n) {
                                f32x4 x = acc[ai][bj][m][n];
#pragma unroll
                                for (int i = 0; i < 4; ++i) x[i] = x[i] * fsig(x[i]);
                                v2u w; w.x = pk2(x[0], x[1]); w.y = pk2(x[2], x[3]);
                                *(v2u*)(rowp + bj * 128 + n * 16) = w;
                            }
                        asm volatile("" ::: "memory");
                    }
            } else {
#pragma unroll
                for (int ai = 0; ai < 2; ++ai)
#pragma unroll
                    for (int m = 0; m < 4; ++m) {
                        bf16* rowp = PLN + (size_t)(rbase + ai * 128 + m * 16) * 256 + cq;
#pragma unroll
                        for (int bj = 0; bj < 2; ++bj)
#pragma unroll
                            for (int n = 0; n < 2; ++n) {
                                const f32x4 x = acc[ai][bj][m][n];
                                v2u w; w.x = pk2(x[0], x[1]); w.y = pk2(x[2], x[3]);
                                *(v2u*)(rowp + bj * 128 + n * 16) = w;
                            }
                        asm volatile("" ::: "memory");
                    }
            }
        }
    }
};
struct EpiBf {
    static constexpr bool PERM = false, AFTER_DRAIN = false;
    bf16* O; int ldc; size_t o_grp;
    __device__ __forceinline__ void operator()(const f32x4 (&acc)[2][2][4][2], const pg8::Unit& u, int wr, int wc, int fr, int fq) const {
        asm volatile("" : "+v"(fr), "+v"(fq));
        const int rbase = u.pm * 256 + wr * 64 + fr, cb = u.pn * 256 + wc * 32 + 4 * fq;
#pragma unroll
        for (int ai = 0; ai < 2; ++ai)
#pragma unroll
            for (int m = 0; m < 4; ++m) {
                bf16* rowp = O + (size_t)u.grp * o_grp + (size_t)(rbase + ai * 128 + m * 16) * ldc + cb;
#pragma unroll
                for (int bj = 0; bj < 2; ++bj)
#pragma unroll
                    for (int n = 0; n < 2; ++n) { const f32x4 x = acc[ai][bj][m][n]; v2u w; w.x = pk2(x[0], x[1]); w.y = pk2(x[2], x[3]); *(v2u*)(rowp + bj * 128 + n * 16) = w; }
            }
    }
};
struct EpiGate {
    static constexpr bool PERM = false, AFTER_DRAIN = false;
    const bf16* PB; bf16* Y;
    __device__ __forceinline__ void operator()(const f32x4 (&acc)[2][2][4][2], const pg8::Unit& u, int wr, int wc, int fr, int fq) const {
        asm volatile("" : "+v"(fr), "+v"(fq));
        const int rbase = u.pm * 256 + wr * 64 + fr, yc = u.pn * 64 + wc * 16 + 4 * fq;
#pragma unroll
        for (int ai = 0; ai < 2; ++ai)
#pragma unroll
            for (int m = 0; m < 4; ++m) {
                const size_t row = (size_t)(rbase + ai * 128 + m * 16);
                f32x4 y = (f32x4){0.f, 0.f, 0.f, 0.f};
#pragma unroll
                for (int br = 0; br < 4; ++br) {
                    const v2u pw = *(const v2u*)(PB + ((size_t)br * NTOK + row) * 1024 + yc);
                    const f32x4 g = acc[ai][br >> 1][m][br & 1];
                    y[0] += bflo(pw.x) * fsig(g[0]); y[1] += bfhi(pw.x) * fsig(g[1]);
                    y[2] += bflo(pw.y) * fsig(g[2]); y[3] += bfhi(pw.y) * fsig(g[3]);
                }
                v2u w; w.x = pk2(y[0], y[1]); w.y = pk2(y[2], y[3]);
                *(v2u*)(Y + row * 1024 + yc) = w;
                asm volatile("" ::: "memory");
            }
    }
};
struct EpiRes {
    static constexpr bool PERM = false, AFTER_DRAIN = false;
    const float* R; float* O;
    __device__ __forceinline__ void operator()(const f32x4 (&acc)[2][2][4][2], const pg8::Unit& u, int wr, int wc, int fr, int fq) const {
        asm volatile("" : "+v"(fr), "+v"(fq));
        const int rbase = u.pm * 256 + wr * 64 + fr, cb = u.pn * 256 + wc * 32 + 4 * fq;
#pragma unroll
        for (int ai = 0; ai < 2; ++ai)
#pragma unroll
            for (int m = 0; m < 4; ++m) {
                const size_t off = (size_t)(rbase + ai * 128 + m * 16) * 1024 + cb;
#pragma unroll
                for (int bj = 0; bj < 2; ++bj)
#pragma unroll
                    for (int n = 0; n < 2; ++n) { const f32x4 r = *(const f32x4*)(R + off + bj * 128 + n * 16); *(f32x4*)(O + off + bj * 128 + n * 16) = r + acc[ai][bj][m][n]; }
            }
    }
};
#define XB_TMO      128
#define XB_XCNT(j)  (256  + 64 * (j))
#define XB_XSUB(j)  (1280 + 64 * (j))
#define XB_XGEN(j)  (2304 + 64 * (j))
#define XB_TOP      3328
#define XB_TOPGEN   3392
#define XCD_BAR_WORDS 3456
#define XB_SPIN_CAP (1u << 18)

__device__ __forceinline__ unsigned xb_ld(unsigned* p)              { return __hip_atomic_load(p, __ATOMIC_RELAXED, __HIP_MEMORY_SCOPE_AGENT); }
__device__ __forceinline__ unsigned xb_add(unsigned* p, unsigned v) { return __hip_atomic_fetch_add(p, v, __ATOMIC_RELAXED, __HIP_MEMORY_SCOPE_AGENT); }
__device__ __forceinline__ unsigned xb_xcc_id() { return (unsigned)__builtin_amdgcn_s_getreg((3 << 11) | 20) & 0xFu; }
#define XB_SPIN(cond, bar) do { unsigned _sp = 0; while (cond) { __builtin_amdgcn_s_sleep(1); \
    if ((++_sp & 255u) == 0u) { if (xb_ld(&(bar)[XB_TMO])) break; if (_sp > XB_SPIN_CAP) { atomicAdd(&(bar)[XB_TMO], 1u); break; } } } } while (0)

struct XcdBarrier {
    unsigned* bar; unsigned x;
    volatile LAS unsigned* st;
};

__device__ __forceinline__ XcdBarrier xcd_barrier_post(unsigned* bar, volatile LAS unsigned* st) {
    XcdBarrier b; b.bar = bar; b.x = xb_xcc_id(); b.st = st;
    if (threadIdx.x == 0) (void)xb_add(&bar[XB_XCNT(b.x)], 1u);
    return b;
}
__device__ __forceinline__ void xcd_barrier_complete(unsigned* bar, unsigned x, unsigned& nloc, unsigned& nx) {
    const unsigned G = gridDim.x * gridDim.y * gridDim.z;
    unsigned sum, cnt, mine, sp = 0u;
    for (;;) {
        sum = 0u; cnt = 0u; mine = 0u;
#pragma unroll
        for (unsigned j = 0; j < 16; ++j) { const unsigned c = xb_ld(&bar[XB_XCNT(j)]); sum += c; cnt += (c > 0u) ? 1u : 0u; mine = (j == x) ? c : mine; }
        if (sum == G) break;
        __builtin_amdgcn_s_sleep(1);
        if ((++sp & 255u) == 0u) { if (xb_ld(&bar[XB_TMO])) break; if (sp > XB_SPIN_CAP) { atomicAdd(&bar[XB_TMO], 1u); break; } }
    }
    nloc = mine > 0u ? mine : 1u; nx = cnt > 0u ? cnt : 1u;
}

__device__ __forceinline__ void xcd_barrier(const XcdBarrier& b_in, const bool t0) {
    XcdBarrier b = b_in; asm volatile("" : "+s"(b.bar), "+s"(b.x));
    asm volatile("s_waitcnt vmcnt(0)" ::: "memory");
    __syncthreads();
    if (t0) {
        unsigned* bar = b.bar;
        __builtin_amdgcn_s_waitcnt(0);
        unsigned nloc = b.st[0], nx = b.st[1];
        if (nloc == 0u) { xcd_barrier_complete(bar, b.x, nloc, nx); b.st[0] = nloc; b.st[1] = nx; }
        const unsigned old = xb_add(&bar[XB_XSUB(b.x)], 1u);
        const unsigned gen = old / nloc;
        if (old + 1u == (gen + 1u) * nloc) {
            __builtin_amdgcn_fence(__ATOMIC_RELEASE, "agent");
            asm volatile("s_waitcnt vmcnt(0)" ::: "memory");
            const unsigned og = xb_add(&bar[XB_TOP], 1u);
            const unsigned tg = og / nx;
            if (og + 1u == (tg + 1u) * nx) xb_add(&bar[XB_TOPGEN], 1u);
            else XB_SPIN(xb_ld(&bar[XB_TOPGEN]) == tg, bar);
            __builtin_amdgcn_fence(__ATOMIC_ACQUIRE, "agent");
            xb_add(&bar[XB_XGEN(b.x)], 1u);
            asm volatile("s_waitcnt vmcnt(0)" ::: "memory");
        } else {
            XB_SPIN(xb_ld(&bar[XB_XGEN(b.x)]) == gen, bar);
            __builtin_amdgcn_fence(__ATOMIC_ACQUIRE, "agent");
            asm volatile("s_waitcnt vmcnt(0)" ::: "memory");
        }
    }
    __syncthreads();
}

struct Params { const float* in[19]; float* out; unsigned char* ws; };
struct Ctx {
    LAS unsigned char* lds; int tid, lane, wave, G, bid;
};
__device__ __forceinline__ int lane_id_fresh() { int l; asm volatile("v_mbcnt_lo_u32_b32 %0, -1, 0\n\tv_mbcnt_hi_u32_b32 %0, -1, %0" : "=v"(l)); return l; }
#define OPQ(C) do { (C).lane = lane_id_fresh(); (C).tid = (C).wave * 64 + (C).lane; } while (0)

template <class MapFn>
__device__ __forceinline__ void transpose_item(const float* W, int K, int N, LAS float* scr, int item, int lane, MapFn map) {
    const int nblk = (N + 31) / 32, kb = item / nblk, nb = item % nblk, k0 = 64 * kb, n0 = 32 * nb;
    const int ncol = n0 + (lane & 31);
#pragma unroll 8
    for (int i = 0; i < 32; ++i) { const int kk = 2 * i + (lane >> 5); scr[kk * 33 + (lane & 31)] = (ncol < N) ? W[(size_t)(k0 + kk) * N + ncol] : 0.f; }
    LDS_WAIT(); asm volatile("" ::: "memory");
    const int c = lane & 7;
#pragma unroll
    for (int j = 0; j < 4; ++j) {
        const int n = (lane >> 3) + 8 * j; const LAS float* s = scr + (8 * c) * 33 + n;
        v4u o; o.x = pk2(s[0 * 33], s[1 * 33]); o.y = pk2(s[2 * 33], s[3 * 33]); o.z = pk2(s[4 * 33], s[5 * 33]); o.w = pk2(s[6 * 33], s[7 * 33]);
        if (n0 + n < N) { bf16* dst = map(n0 + n); if (dst) *(v4u*)(dst + k0 + 8 * c) = o; }
    }
    LDS_WAIT(); asm volatile("" ::: "memory");
}
__device__ __forceinline__ void convert_weights(Ctx C, const Params& P, int l, const int parts) {
    OPQ(C);
    LAS float* scr = (LAS float*)(C.lds + C.wave * 16384);
    const int gw = C.bid * 8 + C.wave, NGW = C.G * 8;
    unsigned char* ws = P.ws;
    bf16* W1t = (bf16*)(ws + WS_W1T); bf16* Wgt = (bf16*)(ws + WS_WGT);
    bf16* Wbt = (bf16*)(ws + WS_WBT); bf16* Wot = (bf16*)(ws + WS_WOT);
    const float* w_in = P.in[2] + (size_t)l * 1024 * INC; const float* w_br = P.in[16] + (size_t)l * 4 * 256 * 1024; const float* w_out = P.in[17] + (size_t)l * 1024 * 1024;
    constexpr int NBLK = (INC + 31) / 32, NB1 = 151;
    if (parts & 1) {
        for (int it = gw; it < 16 * NB1; it += NGW) {
            const int item = (it / NB1) * NBLK + (it % NB1);
            transpose_item(w_in, 1024, INC, scr, item, C.lane, [&](int c) -> bf16* { int which; const int row = win_dst_row(c, which); return which ? (bf16*)nullptr : W1t + (size_t)row * 1024; });
        }
        for (int i = C.bid * 512 + C.tid; i < 56 * 1024 / 8; i += C.G * 512) *(v4u*)(W1t + (size_t)(14 * 256 + 200) * 1024 + (size_t)i * 8) = (v4u){0u, 0u, 0u, 0u};
    }
    if (parts & 2) {
        constexpr int NB2 = NBLK - 150, I_G = 16 * NB2, I_BR = 4 * 32, I_OUT = 16 * 32;
        for (int it = gw; it < I_G + 4 * I_BR + I_OUT; it += NGW) {
            int r = it;
            if (r < I_G) { const int item = (r / NB2) * NBLK + 150 + (r % NB2);
                transpose_item(w_in, 1024, INC, scr, item, C.lane, [&](int c) -> bf16* { int which; const int row = win_dst_row(c, which); return which ? Wgt + (size_t)row * 1024 : (bf16*)nullptr; }); continue; }
            r -= I_G;
            if (r < 4 * I_BR) { const int br = r / I_BR, ri = r % I_BR; transpose_item(w_br + (size_t)br * 256 * 1024, 256, 1024, scr, ri, C.lane, [&](int c) -> bf16* { return Wbt + ((size_t)br * 1024 + c) * 256; }); continue; }
            r -= 4 * I_BR;
            transpose_item(w_out, 1024, 1024, scr, r, C.lane, [&](int c) -> bf16* { return Wot + (size_t)c * 1024; });
        }
    }
}
__device__ __forceinline__ void rms_row(const float* xrow, const float* g, bf16* obf, float* of32, int lane) {
    const f32x4* xr = (const f32x4*)xrow + lane;
    f32x4 v[4]; float s = 0.f;
#pragma unroll
    for (int j = 0; j < 4; ++j) { v[j] = xr[64 * j]; s += (v[j].x * v[j].x + v[j].y * v[j].y) + (v[j].z * v[j].z + v[j].w * v[j].w); }
    const float inv = rsqrtf(wave_sum(s) * (1.f / 1024.f) + 1e-6f);
#pragma unroll
    for (int j = 0; j < 4; ++j) {
        const f32x4 gg = ((const f32x4*)g)[lane + 64 * j];
        const f32x4 o = v[j] * inv * gg;
        if (obf) { v2u w; w.x = pk2(o.x, o.y); w.y = pk2(o.z, o.w); ((v2u*)obf)[lane + 64 * j] = w; }
        else ((f32x4*)of32)[lane + 64 * j] = o;
    }
}
__device__ __forceinline__ void norm_rows_bf16(Ctx C, const float* x, const float* g, bf16* h) {
    OPQ(C);
    const int gw = C.bid * 8 + C.wave, NGW = C.G * 8;
    for (int m = gw; m < NTOK; m += NGW) rms_row(x + (size_t)m * 1024, g, h + (size_t)m * 1024, nullptr, C.lane);
}
__device__ __forceinline__ void setup_tables(Ctx C, const Params& P) {
    OPQ(C);
    float* tcos = (float*)(P.ws + WS_COS); float* tsin = (float*)(P.ws + WS_SIN); float* lb = (float*)(P.ws + WS_LB);
    for (int i = C.bid * 512 + C.tid; i < SEQ * 32; i += C.G * 512) {
        const int pos = i >> 5, j = i & 31;
        const float freq = (float)pow(10000.0, -(double)j / 32.0);
        const float ang = (float)pos * freq;
        tcos[i] = (float)cos((double)ang); tsin[i] = (float)sin((double)ang);
    }
    if (C.bid == 0 && C.tid < 256) {
        const float l0 = P.in[4][C.tid], l1 = P.in[4][256 + C.tid];
        lb[C.tid] = 0.f; lb[256 + C.tid] = 1.f / (1.f + expf(l0 - l1));
    }
}

__device__ __forceinline__ void mixA_simple(Ctx C, unsigned char* ws, const float* bias) {
    OPQ(C);
    bf16* AQ = PLP(ws, PL_AQ); const bf16* AK = PLP(ws, PL_AK); const bf16* AV = PLP(ws, PL_AV); const bf16* AZ = PLP(ws, PL_AZ);
    for (int it = C.bid * 512 + C.tid; it < 4 * NTOK; it += C.G * 512) {
        const int h = it / NTOK, m = it % NTOK, b = m >> 12, t = m & 4095, c = t >> 6, qi = t & 63;
        float q[64], o[64];
        {
            const v4u* qp = (const v4u*)(AQ + (size_t)m * 256 + h * 64);
#pragma unroll
            for (int j = 0; j < 8; ++j) { const v4u w = qp[j]; q[8 * j] = bflo(w.x); q[8 * j + 1] = bfhi(w.x); q[8 * j + 2] = bflo(w.y); q[8 * j + 3] = bfhi(w.y); q[8 * j + 4] = bflo(w.z); q[8 * j + 5] = bfhi(w.z); q[8 * j + 6] = bflo(w.w); q[8 * j + 7] = bfhi(w.w); }
        }
#pragma unroll
        for (int d = 0; d < 64; ++d) o[d] = 0.f;
        float mx = -INFINITY, l = 0.f;
        const float* bh = bias + h * 192;
        for (int kj = 0; kj < 576; ++kj) {
            const int kp = c * 64 - 512 + kj;
            if (kp < 0) continue;
            const size_t mk = ((size_t)b << 12) + kp;
            const v4u* kr = (const v4u*)(AK + mk * 256 + h * 64); const v4u* vr = (const v4u*)(AV + mk * 256 + h * 64);
            float s = 0.f;
#pragma unroll
            for (int j = 0; j < 8; ++j) { const v4u w = kr[j];
                s = fmaf(q[8 * j], bflo(w.x), s); s = fmaf(q[8 * j + 1], bfhi(w.x), s); s = fmaf(q[8 * j + 2], bflo(w.y), s); s = fmaf(q[8 * j + 3], bfhi(w.y), s);
                s = fmaf(q[8 * j + 4], bflo(w.z), s); s = fmaf(q[8 * j + 5], bfhi(w.z), s); s = fmaf(q[8 * j + 6], bflo(w.w), s); s = fmaf(q[8 * j + 7], bfhi(w.w), s); }
            int rel = qi + 512 - kj; rel = rel < -63 ? -63 : (rel > 128 ? 128 : rel);
            s = s * 0.125f + bh[rel + 63];
            const float mn = fmaxf(mx, s), al = expf(mx - mn), pe = expf(s - mn);
            l = l * al + pe; mx = mn;
#pragma unroll
            for (int j = 0; j < 8; ++j) { const v4u w = vr[j];
                o[8 * j] = fmaf(pe, bflo(w.x), o[8 * j] * al); o[8 * j + 1] = fmaf(pe, bfhi(w.x), o[8 * j + 1] * al); o[8 * j + 2] = fmaf(pe, bflo(w.y), o[8 * j + 2] * al); o[8 * j + 3] = fmaf(pe, bfhi(w.y), o[8 * j + 3] * al);
                o[8 * j + 4] = fmaf(pe, bflo(w.z), o[8 * j + 4] * al); o[8 * j + 5] = fmaf(pe, bfhi(w.z), o[8 * j + 5] * al); o[8 * j + 6] = fmaf(pe, bflo(w.w), o[8 * j + 6] * al); o[8 * j + 7] = fmaf(pe, bfhi(w.w), o[8 * j + 7] * al); }
        }
        const float invl = 1.f / l;
        const v4u* zp = (const v4u*)(AZ + (size_t)m * 256 + h * 64); v4u* op = (v4u*)(AQ + (size_t)m * 256 + h * 64);
#pragma unroll
        for (int j = 0; j < 8; ++j) { const v4u z = zp[j]; v4u w;
            w.x = pk2(o[8 * j] * invl * siluf_(bflo(z.x)), o[8 * j + 1] * invl * siluf_(bfhi(z.x))); w.y = pk2(o[8 * j + 2] * invl * siluf_(bflo(z.y)), o[8 * j + 3] * invl * siluf_(bfhi(z.y)));
            w.z = pk2(o[8 * j + 4] * invl * siluf_(bflo(z.z)), o[8 * j + 5] * invl * siluf_(bfhi(z.z))); w.w = pk2(o[8 * j + 6] * invl * siluf_(bflo(z.w)), o[8 * j + 7] * invl * siluf_(bfhi(z.w)));
            op[j] = w; }
    }
}
__device__ __forceinline__ void mixB_simple(Ctx C, unsigned char* ws, const float* normg) {
    OPQ(C);
    if (C.bid < 32 || C.bid >= 36) return;
    const int gw = (C.bid - 32) * 8 + C.wave;
    const int b = gw >> 2, h = gw & 3, v = C.lane;
    bf16* BQ = PLP(ws, PL_BQ); const bf16* BI = PLP(ws, PL_BI); const bf16* BZ = PLP(ws, PL_BZ); const float* BF = (const float*)(ws + WS_BF);
    float S[64];
#pragma unroll
    for (int d = 0; d < 64; ++d) S[d] = 0.f;
    const float g = normg[v];
    for (int t = 0; t < SEQ; ++t) {
        const size_t m = ((size_t)b << 12) + t;
        const float* fr = BF + m * 256 + h * 64; const bf16* qr = BQ + m * 256 + h * 64;
        const float iv = bf2f(BI[m * 256 + h * 64 + v]); const float z = bf2f(BZ[m * 256 + h * 64 + v]);
        float o = 0.f;
#pragma unroll
        for (int d = 0; d < 64; ++d) { S[d] = fmaf(fr[d], S[d] - iv, iv); o = fmaf(bf2f(qr[d]), S[d], o); }
        const float r = rsqrtf(wave_sum(o * o) * (1.f / 64.f) + 1e-6f);
        asm volatile("" ::: "memory");
        BQ[m * 256 + h * 64 + v] = (bf16)f2bf(o * r * g * siluf_(z));
    }
}
__device__ __forceinline__ void mixD_simple(Ctx C, unsigned char* ws, const Params& P, int l) {
    OPQ(C);
    if (C.bid >= 32) return;
    const int b = C.bid >> 2, h = C.bid & 3, tid = C.tid;
    bf16* DR = PLP(ws, PL_DR); const bf16* DK = PLP(ws, PL_DK); const bf16* DV = PLP(ws, PL_DV); const bf16* DZ = PLP(ws, PL_DZ); const float* MS = (const float*)(ws + WS_MISC);
    const float* mu = P.in[6] + l * 896; const float* w0 = P.in[7] + l * 256; const float* w_up = P.in[8] + (size_t)l * 64 * 256; const float* a0 = P.in[9] + l * 256;
    const float* a_up = P.in[10] + (size_t)l * 64 * 256; const float* k_k = P.in[11] + l * 256; const float* k_a = P.in[12] + l * 256; const float* r_k = P.in[13] + l * 256;
    const float* gn_g = P.in[14] + l * 256; const float* gn_b = P.in[15] + l * 256;
    LAS float* L = (LAS float*)C.lds;
    LAS float* twd = L; LAS float* ads = L + 64; LAS float* rs = L + 128; LAS float* kr = L + 192; LAS float* vs = L + 256;
    LAS float* wv = L + 320; LAS float* av = L + 384; LAS float* kkv = L + 448; LAS float* kfv = L + 512; LAS float* bv = L + 576; LAS float* ob = L + 640; LAS float* bon = L + 704;
    const int v = tid >> 3, ks = tid & 7;
    float S[8];
#pragma unroll
    for (int i = 0; i < 8; ++i) S[i] = 0.f;
    const int grp = tid >> 6, cc = tid & 63;
    float prev = 0.f, mucol = 0.f;
    if (grp == 0) mucol = mu[768 + cc]; else if (grp == 1) mucol = mu[832 + cc]; else if (grp == 2) mucol = mu[h * 64 + cc]; else if (grp == 3) mucol = mu[256 + h * 64 + cc]; else if (grp == 4) mucol = mu[512 + h * 64 + cc];
    for (int t = 0; t < SEQ; ++t) {
        const size_t m = ((size_t)b << 12) + t;
        if (grp < 5) {
            float cur;
            if (grp == 0) cur = MS[m * 256 + 72 + cc]; else if (grp == 1) cur = MS[m * 256 + 136 + cc];
            else if (grp == 2) cur = bf2f(DR[m * 256 + h * 64 + cc]); else if (grp == 3) cur = bf2f(DK[m * 256 + h * 64 + cc]); else cur = bf2f(DV[m * 256 + h * 64 + cc]);
            const float sh = cur + mucol * (prev - cur); prev = cur;
            if (grp == 0) twd[cc] = tanhf(sh); else if (grp == 1) ads[cc] = sh; else if (grp == 2) rs[cc] = sh; else if (grp == 3) kr[cc] = sh; else vs[cc] = sh;
        }
        __syncthreads();
        if (tid < 128) {
            const int c = tid & 63, hc = h * 64 + c;
            if (tid < 64) { float wl = w0[hc];
_Pragma("nounroll")
                for (int i = 0; i < 64; ++i) wl = fmaf(twd[i], w_up[i * 256 + hc], wl);
                const float x = -wl; const float sp = fmaxf(x, 0.f) + log1pf(expf(-fabsf(x))); wv[c] = expf(-expf(-sp - 0.5f)); }
            else { float al = a0[hc];
_Pragma("nounroll")
                for (int i = 0; i < 64; ++i) al = fmaf(ads[i], a_up[i * 256 + hc], al); av[c] = sigmoidf_(al); }
        }
        __syncthreads();
        if (tid < 64) {
            const int hc = h * 64 + tid; const float kx = kr[tid], a = av[tid];
            const float kkr = kx * k_k[hc]; const float nrm = sqrtf(wave_sum(kkr * kkr)); const float kk = kkr / fmaxf(nrm, 1e-12f);
            const float kf = kx * (1.f + (a - 1.f) * k_a[hc]);
            kkv[tid] = kk; kfv[tid] = kf; bv[tid] = kk * a;
            const float bsum = wave_sum(rs[tid] * kf * r_k[hc]); if (tid == 0) bon[0] = bsum;
        }
        __syncthreads();
        {
            float sa = 0.f;
#pragma unroll
            for (int i = 0; i < 8; ++i) sa = fmaf(S[i], kkv[8 * ks + i], sa);
            sa += __shfl_xor(sa, 1); sa += __shfl_xor(sa, 2); sa += __shfl_xor(sa, 4); sa = -sa;
            const float vv = vs[v]; float o = 0.f;
#pragma unroll
            for (int i = 0; i < 8; ++i) { S[i] = fmaf(S[i], wv[8 * ks + i], fmaf(sa, bv[8 * ks + i], vv * kfv[8 * ks + i])); o = fmaf(S[i], rs[8 * ks + i], o); }
            o += __shfl_xor(o, 1); o += __shfl_xor(o, 2); o += __shfl_xor(o, 4);
            if (ks == 0) ob[v] = o;
        }
        __syncthreads();
        if (tid < 64) {
            const int hc = h * 64 + tid; const float o = ob[tid];
            const float mean = wave_sum(o) * (1.f / 64.f); const float d = o - mean; const float var = wave_sum(d * d) * (1.f / 64.f);
            float y = d * rsqrtf(var + 64e-5f) * gn_g[hc] + gn_b[hc];
            y += bon[0] * vs[tid];
            const float z = bf2f(DZ[m * 256 + hc]);
            DR[m * 256 + hc] = (bf16)f2bf(y * siluf_(z));
        }
        __syncthreads();
    }
}
__device__ __forceinline__ void mixC_simple(Ctx C, unsigned char* ws) {
    OPQ(C);
    bf16* CQ = PLP(ws, PL_CQ); const bf16* CK = PLP(ws, PL_CK); const bf16* CV = PLP(ws, PL_CV); const bf16* CZ = PLP(ws, PL_CZ);
    const bf16* QI0 = PLP(ws, PL_CQI0); const bf16* QI1 = PLP(ws, PL_CQI1); const float* MS = (const float*)(ws + WS_MISC);
    LAS float* L = (LAS float*)C.lds;
    LAS float* qs = L;
    LAS float* q4 = L + 512;
    LAS float* wq = L + 768;
    LAS float* sc = L + 1024;
    LAS float* ps = L + 5120;
    LAS int* sel = (LAS int*)(L + 6144);
    LAS unsigned* hist = (LAS unsigned*)(L + 6400);
    LAS float* red = L + 6656;
    LAS unsigned* sw = (LAS unsigned*)(L + 6672);
    const int tid = C.tid;
    for (int m = C.bid; m < NTOK; m += C.G) {
        const int b = m >> 12, t = m & 4095, n = ((t >> 6) + 1) * 64;
        qs[tid] = bf2f(tid < 256 ? QI0[(size_t)m * 256 + tid] : QI1[(size_t)m * 256 + tid - 256]);
        if (tid < 256) q4[tid] = bf2f(CQ[(size_t)m * 256 + tid]);
        if (tid < 8) wq[tid] = MS[(size_t)m * 256 + 64 + tid] * 0.35355339059327373f;
        __syncthreads();
        for (int s = tid; s < n; s += 512) {
            const f32x4* kp = (const f32x4*)(MS + (((size_t)b << 12) + s) * 256);
            float kv[64];
#pragma unroll
            for (int j = 0; j < 16; ++j) { const f32x4 w = kp[j]; kv[4 * j] = w.x; kv[4 * j + 1] = w.y; kv[4 * j + 2] = w.z; kv[4 * j + 3] = w.w; }
            float acc = 0.f;
            for (int hh = 0; hh < 8; ++hh) {
                float d = 0.f;
#pragma unroll
                for (int c = 0; c < 64; ++c) d = fmaf(qs[hh * 64 + c], kv[c], d);
                d = fmaxf(d * 0.125f, 0.f);
                acc = fmaf(d, wq[hh], acc);
            }
            sc[s] = acc;
        }
        __syncthreads();
        int cnt;
        if (n <= 256) { if (tid < n) sel[tid] = tid; cnt = n; }
        else {
            unsigned key[8];
#pragma unroll
            for (int j = 0; j < 8; ++j) { const int idx = tid + 512 * j; unsigned kk = 0u; if (idx < n) { const unsigned u = __float_as_uint(sc[idx]); kk = (u & 0x80000000u) ? ~u : (u | 0x80000000u); } key[j] = kk; }
            if (tid == 0) { sw[0] = 0u; sw[1] = 256u; sw[3] = 0u; }
            unsigned mask = 0u;
            for (int pass = 3; pass >= 0; --pass) {
                const int shift = pass * 8;
                if (tid < 256) hist[tid] = 0u;
                __syncthreads();
                const unsigned prefix = sw[0];
#pragma unroll
                for (int j = 0; j < 8; ++j) { const int idx = tid + 512 * j; if (idx < n && (key[j] & mask) == prefix) atomicAdd((unsigned*)&hist[(key[j] >> shift) & 255u], 1u); }
                __syncthreads();
                if (tid == 0) { const unsigned k = sw[1]; unsigned c = 0u; int bb = 255; for (; bb > 0; --bb) { if (c + hist[bb] >= k) break; c += hist[bb]; }
                    sw[1] = k - c; sw[0] = prefix | ((unsigned)bb << shift); sw[2] = hist[bb]; }
                mask |= (0xFFu << shift);
                __syncthreads();
            }
            const unsigned thr = sw[0], need = sw[1], eqc = sw[2];
            if (tid == 0) { int cut = SEQ;
                if (eqc != need) { unsigned c = 0u; for (int i = 0; i < n; ++i) { const unsigned u = __float_as_uint(sc[i]); const unsigned kk = (u & 0x80000000u) ? ~u : (u | 0x80000000u); if (kk == thr) { ++c; if (c == need) { cut = i; break; } } } }
                sw[4] = (unsigned)cut; }
            __syncthreads();
            const int cut = (int)sw[4];
#pragma unroll
            for (int j = 0; j < 8; ++j) { const int idx = tid + 512 * j; if (idx < n && (key[j] > thr || (key[j] == thr && idx <= cut))) { const unsigned pos = atomicAdd((unsigned*)&sw[3], 1u); if (pos < 256u) sel[pos] = idx; } }
            cnt = 256;
        }
        __syncthreads();
        float s4[4] = {-INFINITY, -INFINITY, -INFINITY, -INFINITY};
        if (tid < cnt) {
            const v4u* kr = (const v4u*)(CK + (((size_t)b << 12) + sel[tid]) * 256);
#pragma unroll
            for (int hh = 0; hh < 4; ++hh) { float d = 0.f;
#pragma unroll
                for (int j = 0; j < 8; ++j) { const v4u w = kr[hh * 8 + j]; const LAS float* qq = q4 + hh * 64 + 8 * j;
                    d = fmaf(qq[0], bflo(w.x), d); d = fmaf(qq[1], bfhi(w.x), d); d = fmaf(qq[2], bflo(w.y), d); d = fmaf(qq[3], bfhi(w.y), d);
                    d = fmaf(qq[4], bflo(w.z), d); d = fmaf(qq[5], bfhi(w.z), d); d = fmaf(qq[6], bflo(w.w), d); d = fmaf(qq[7], bfhi(w.w), d); }
                s4[hh] = d * 0.125f; }
        }
        if (tid < 256) {
#pragma unroll
            for (int hh = 0; hh < 4; ++hh) { const float v = wave_max(s4[hh]); if (C.lane == 0) red[hh * 4 + C.wave] = v; }
        }
        __syncthreads();
        float mx[4];
#pragma unroll
        for (int hh = 0; hh < 4; ++hh) mx[hh] = fmaxf(fmaxf(red[hh * 4], red[hh * 4 + 1]), fmaxf(red[hh * 4 + 2], red[hh * 4 + 3]));
        __syncthreads();
        if (tid < 256) {
#pragma unroll
            for (int hh = 0; hh < 4; ++hh) { const float e = (tid < cnt) ? expf(s4[hh] - mx[hh]) : 0.f; ps[hh * 256 + tid] = e; const float v = wave_sum(e); if (C.lane == 0) red[hh * 4 + C.wave] = v; }
        }
        __syncthreads();
        if (tid < 256) {
            const int hh = tid >> 6;
            const float lsum = red[hh * 4] + red[hh * 4 + 1] + red[hh * 4 + 2] + red[hh * 4 + 3];
            float o = 0.f;
            for (int j = 0; j < cnt; ++j) o = fmaf(ps[hh * 256 + j], bf2f(CV[(((size_t)b << 12) + sel[j]) * 256 + tid]), o);
            const float z = bf2f(CZ[(size_t)m * 256 + tid]);
            CQ[(size_t)m * 256 + tid] = (bf16)f2bf(o / lsum * siluf_(z));
        }
        __syncthreads();
    }
}

typedef short bf16x8_t __attribute__((ext_vector_type(8)));
__device__ __forceinline__ float dpp_f(float x, const int ctrl_sel) {
    const int xi = __builtin_bit_cast(int, x); int r;
    if (ctrl_sel == 0) r = __builtin_amdgcn_update_dpp(xi, xi, 0xB1, 0xF, 0xF, false);
    else if (ctrl_sel == 1) r = __builtin_amdgcn_update_dpp(xi, xi, 0x4E, 0xF, 0xF, false);
    else r = __builtin_amdgcn_update_dpp(xi, xi, 0x141, 0xF, 0xF, false);
    return __builtin_bit_cast(float, r);
}
__device__ __forceinline__ float red8(float x) { x += dpp_f(x, 0); x += dpp_f(x, 1); x += dpp_f(x, 2); return x; }

constexpr int DSTEP_T = 320;
constexpr int D_LDS_STEP = 0, D_LDS_VS = 81920, D_LDS_TWD = 98304, D_LDS_ADS = 106496;
__device__ __forceinline__ void mixD1(Ctx C, const Params& P, int l) {
    OPQ(C);
    unsigned char* ws = P.ws;
    const bf16* DR = PLP(ws, PL_DR); const bf16* DK = PLP(ws, PL_DK); const bf16* DV = PLP(ws, PL_DV); const float* MS = (const float*)(ws + WS_MISC);
    const float* mu = P.in[6] + l * 896; const float* w0 = P.in[7] + l * 256; const float* w_up = P.in[8] + (size_t)l * 64 * 256; const float* a0 = P.in[9] + l * 256;
    const float* a_up = P.in[10] + (size_t)l * 64 * 256; const float* k_k = P.in[11] + l * 256; const float* k_a = P.in[12] + l * 256; const float* r_k = P.in[13] + l * 256;
    bf16* OL = (bf16*)(ws + WS_OL); bf16* CCp = (bf16*)(ws + WS_CC); float* BON = (float*)(ws + WS_DBON); float* AB = (float*)(ws + WS_DAB);
    LAS float* STEP = (LAS float*)(C.lds + D_LDS_STEP); LAS float* VS = (LAS float*)(C.lds + D_LDS_VS);
    LAS bf16* TWD = (LAS bf16*)(C.lds + D_LDS_TWD); LAS bf16* ADS = (LAS bf16*)(C.lds + D_LDS_ADS);
    const int tid = C.tid, lane = C.lane, wave = C.wave;
    const int tt = tid >> 3, c8 = tid & 7;
    for (int u = C.bid; u < 256; u += C.G) {
        const int b = u >> 5, h = (u >> 3) & 3, seg = u & 7, hc0 = h * 64;
        __syncthreads();
        {
            const int i = tid >> 3;
            const f32x4 wa = *(const f32x4*)(w_up + (size_t)i * 256 + hc0 + 8 * c8), wb = *(const f32x4*)(w_up + (size_t)i * 256 + hc0 + 8 * c8 + 4);
            const f32x4 aa = *(const f32x4*)(a_up + (size_t)i * 256 + hc0 + 8 * c8), ab = *(const f32x4*)(a_up + (size_t)i * 256 + hc0 + 8 * c8 + 4);
#pragma unroll
            for (int j = 0; j < 4; ++j) { TWD[(8 * c8 + j) * 64 + i] = (bf16)f2bf(wa[j]); TWD[(8 * c8 + 4 + j) * 64 + i] = (bf16)f2bf(wb[j]);
                                          ADS[(8 * c8 + j) * 64 + i] = (bf16)f2bf(aa[j]); ADS[(8 * c8 + 4 + j) * 64 + i] = (bf16)f2bf(ab[j]); }
        }
        __syncthreads();
        const int mat = wave >> 2, mt = wave & 3, fr = lane & 15, fq = lane >> 4;
        bf16x8_t bfrag[4][2];
#pragma unroll
        for (int nt = 0; nt < 4; ++nt)
#pragma unroll
            for (int k2 = 0; k2 < 2; ++k2) bfrag[nt][k2] = *(const LAS bf16x8_t*)((mat ? ADS : TWD) + (16 * nt + fr) * 64 + 32 * k2 + 8 * fq);
        float bias4[4];
#pragma unroll
        for (int nt = 0; nt < 4; ++nt) bias4[nt] = (mat ? a0 : w0)[hc0 + 16 * nt + fr];
        __syncthreads();
        float S[8], H[8];
#pragma unroll
        for (int j = 0; j < 8; ++j) { S[j] = 0.f; H[j] = (8 * c8 + j == tt) ? 1.f : 0.f; }
        v4u rc, kc, vc, rp, kp, vp; f32x4 wc0, wc1, ac0, ac1, wp0, wp1, ap0, ap1;
#define D1_LOADRAW(BLK) do { const int tl_ = seg * 512 + (BLK) * 64 + tt; const size_t m_ = ((size_t)b << 12) + tl_; const int ch_ = hc0 + 8 * c8; \
            rc = *(const v4u*)(DR + m_ * 256 + ch_); kc = *(const v4u*)(DK + m_ * 256 + ch_); vc = *(const v4u*)(DV + m_ * 256 + ch_); \
            wc0 = *(const f32x4*)(MS + m_ * 256 + 72 + 8 * c8); wc1 = *(const f32x4*)(MS + m_ * 256 + 76 + 8 * c8); ac0 = *(const f32x4*)(MS + m_ * 256 + 136 + 8 * c8); ac1 = *(const f32x4*)(MS + m_ * 256 + 140 + 8 * c8); \
            rp = (v4u){0u, 0u, 0u, 0u}; kp = rp; vp = rp; wp0 = (f32x4){0.f, 0.f, 0.f, 0.f}; wp1 = wp0; ap0 = wp0; ap1 = wp0; \
            if (tl_ > 0) { rp = *(const v4u*)(DR + (m_ - 1) * 256 + ch_); kp = *(const v4u*)(DK + (m_ - 1) * 256 + ch_); vp = *(const v4u*)(DV + (m_ - 1) * 256 + ch_); \
                wp0 = *(const f32x4*)(MS + (m_ - 1) * 256 + 72 + 8 * c8); wp1 = *(const f32x4*)(MS + (m_ - 1) * 256 + 76 + 8 * c8); ap0 = *(const f32x4*)(MS + (m_ - 1) * 256 + 136 + 8 * c8); ap1 = *(const f32x4*)(MS + (m_ - 1) * 256 + 140 + 8 * c8); } } while (0)
        D1_LOADRAW(0);
        for (int blk = 0; blk < 8; ++blk) {
            const int tloc0 = seg * 512 + blk * 64;
            const size_t m = ((size_t)b << 12) + tloc0 + tt;
            {
                const int ch = hc0 + 8 * c8;
                LAS float* st = STEP + tt * DSTEP_T + c8 * 40;
#pragma unroll
                for (int q = 0; q < 4; ++q) {
                    const unsigned rcw = rc[q], rpw = rp[q], kcw = kc[q], kpw = kp[q], vcw = vc[q], vpw = vp[q];
                    const float mr0 = mu[ch + 2 * q], mr1 = mu[ch + 2 * q + 1], mk0 = mu[256 + ch + 2 * q], mk1 = mu[256 + ch + 2 * q + 1], mv0 = mu[512 + ch + 2 * q], mv1 = mu[512 + ch + 2 * q + 1];
                    float c0 = bflo(rcw), c1 = bfhi(rcw);
                    st[32 + 2 * q] = c0 + mr0 * (bflo(rpw) - c0); st[32 + 2 * q + 1] = c1 + mr1 * (bfhi(rpw) - c1);
                    c0 = bflo(kcw); c1 = bfhi(kcw);
                    st[24 + 2 * q] = c0 + mk0 * (bflo(kpw) - c0); st[24 + 2 * q + 1] = c1 + mk1 * (bfhi(kpw) - c1);
                    c0 = bflo(vcw); c1 = bfhi(vcw);
                    VS[tt * 64 + 8 * c8 + 2 * q] = c0 + mv0 * (bflo(vpw) - c0); VS[tt * 64 + 8 * c8 + 2 * q + 1] = c1 + mv1 * (bfhi(vpw) - c1);
                }
                float tw[8], ad[8];
#pragma unroll
                for (int j = 0; j < 4; ++j) {
                    const float m0 = mu[768 + 8 * c8 + j], m1 = mu[768 + 8 * c8 + 4 + j], n0 = mu[832 + 8 * c8 + j], n1 = mu[832 + 8 * c8 + 4 + j];
                    tw[j] = tanhf(wc0[j] + m0 * (wp0[j] - wc0[j])); tw[4 + j] = tanhf(wc1[j] + m1 * (wp1[j] - wc1[j]));
                    ad[j] = ac0[j] + n0 * (ap0[j] - ac0[j]); ad[4 + j] = ac1[j] + n1 * (ap1[j] - ac1[j]);
                }
                v4u tv, av; tv.x = pk2(tw[0], tw[1]); tv.y = pk2(tw[2], tw[3]); tv.z = pk2(tw[4], tw[5]); tv.w = pk2(tw[6], tw[7]);
                av.x = pk2(ad[0], ad[1]); av.y = pk2(ad[2], ad[3]); av.z = pk2(ad[4], ad[5]); av.w = pk2(ad[6], ad[7]);
                *(LAS v4u*)(TWD + tt * 64 + 8 * c8) = tv; *(LAS v4u*)(ADS + tt * 64 + 8 * c8) = av;
            }
            __syncthreads();
            {
                const LAS bf16* Asrc = mat ? ADS : TWD;
                const bf16x8_t a0f = *(const LAS bf16x8_t*)(Asrc + (16 * mt + fr) * 64 + 8 * fq), a1f = *(const LAS bf16x8_t*)(Asrc + (16 * mt + fr) * 64 + 32 + 8 * fq);
#pragma unroll
                for (int nt = 0; nt < 4; ++nt) {
                    f32x4 acc = (f32x4){0.f, 0.f, 0.f, 0.f};
                    acc = __builtin_amdgcn_mfma_f32_16x16x32_bf16(a0f, bfrag[nt][0], acc, 0, 0, 0);
                    acc = __builtin_amdgcn_mfma_f32_16x16x32_bf16(a1f, bfrag[nt][1], acc, 0, 0, 0);
                    const int c = 16 * nt + fr;
#pragma unroll
                    for (int j = 0; j < 4; ++j) {
                        const int t = 16 * mt + 4 * fq + j; const float x = acc[j] + bias4[nt]; float val;
                        if (mat == 0) { const float nx = -x; const float sp = fmaxf(nx, 0.f) + log1pf(expf(-fabsf(nx))); val = expf(-expf(-sp - 0.5f)); }
                        else val = 1.f / (1.f + expf(-x));
                        STEP[t * DSTEP_T + (c >> 3) * 40 + (mat ? 16 : 8) + (c & 7)] = val;
                    }
                }
            }
            __syncthreads();
            {
                const int ch = hc0 + 8 * c8; LAS float* st = STEP + tt * DSTEP_T + c8 * 40;
                float kkr[8], ssq = 0.f, bon = 0.f;
#pragma unroll
                for (int j = 0; j < 8; ++j) { const float kx = st[24 + j], a = st[16 + j];
                    kkr[j] = kx * k_k[ch + j]; ssq = fmaf(kkr[j], kkr[j], ssq);
                    const float kf = kx * (1.f + (a - 1.f) * k_a[ch + j]); st[24 + j] = kf; bon = fmaf(st[32 + j] * kf, r_k[ch + j], bon); }
                ssq = red8(ssq); bon = red8(bon);
                const float inv = 1.f / fmaxf(sqrtf(ssq), 1e-12f);
#pragma unroll
                for (int j = 0; j < 8; ++j) { const float kk = kkr[j] * inv; st[j] = kk; st[16 + j] = kk * st[16 + j]; }
                if (c8 == 0) BON[m * 4 + h] = bon;
            }
            __syncthreads();
            if (blk + 1 < 8) D1_LOADRAW(blk + 1);
            for (int t = 0; t < 64; ++t) {
                const LAS f32x4* sp = (const LAS f32x4*)(STEP + t * DSTEP_T + c8 * 40);
                const f32x4 k0 = sp[0], k1 = sp[1], w0v = sp[2], w1v = sp[3], b0 = sp[4], b1 = sp[5], f0 = sp[6], f1 = sp[7], r0 = sp[8], r1 = sp[9];
                const float vv = VS[t * 64 + tt];
                float dS = 0.f, dH = 0.f;
#pragma unroll
                for (int j = 0; j < 4; ++j) { dS = fmaf(S[j], k0[j], dS); dH = fmaf(H[j], k0[j], dH); }
#pragma unroll
                for (int j = 0; j < 4; ++j) { dS = fmaf(S[4 + j], k1[j], dS); dH = fmaf(H[4 + j], k1[j], dH); }
                dS = -red8(dS); dH = -red8(dH);
                float oS = 0.f, oH = 0.f;
#pragma unroll
                for (int j = 0; j < 4; ++j) {
                    S[j] = fmaf(S[j], w0v[j], fmaf(dS, b0[j], vv * f0[j])); H[j] = fmaf(H[j], w0v[j], dH * b0[j]);
                    oS = fmaf(S[j], r0[j], oS); oH = fmaf(H[j], r0[j], oH);
                }
#pragma unroll
                for (int j = 0; j < 4; ++j) {
                    S[4 + j] = fmaf(S[4 + j], w1v[j], fmaf(dS, b1[j], vv * f1[j])); H[4 + j] = fmaf(H[4 + j], w1v[j], dH * b1[j]);
                    oS = fmaf(S[4 + j], r1[j], oS); oH = fmaf(H[4 + j], r1[j], oH);
                }
                oS = red8(oS); oH = red8(oH);
                if (c8 == 0) { const size_t mo = (((size_t)b << 12) + tloc0 + t) * 256 + hc0 + tt; OL[mo] = (bf16)f2bf(oS); CCp[mo] = (bf16)f2bf(oH); }
            }
            __syncthreads();
        }
#undef D1_LOADRAW
        {
            float* ab = AB + (size_t)u * 8192;
            *(f32x4*)(ab + tt * 64 + 8 * c8) = (f32x4){H[0], H[1], H[2], H[3]}; *(f32x4*)(ab + tt * 64 + 8 * c8 + 4) = (f32x4){H[4], H[5], H[6], H[7]};
            *(f32x4*)(ab + 4096 + tt * 64 + 8 * c8) = (f32x4){S[0], S[1], S[2], S[3]}; *(f32x4*)(ab + 4096 + tt * 64 + 8 * c8 + 4) = (f32x4){S[4], S[5], S[6], S[7]};
        }
    }
}
__device__ __forceinline__ void mixD1_ut(Ctx C, const Params& P, int l) {
    OPQ(C);
    unsigned char* ws = P.ws;
    const bf16* DR = PLP(ws, PL_DR); const bf16* DK = PLP(ws, PL_DK); const bf16* DV = PLP(ws, PL_DV); const float* MS = (const float*)(ws + WS_MISC);
    const float* mu = P.in[6] + l * 896; const float* w0 = P.in[7] + l * 256; const float* w_up = P.in[8] + (size_t)l * 64 * 256; const float* a0 = P.in[9] + l * 256;
    const float* a_up = P.in[10] + (size_t)l * 64 * 256; const float* k_k = P.in[11] + l * 256; const float* k_a = P.in[12] + l * 256; const float* r_k = P.in[13] + l * 256;
    bf16* OL = (bf16*)(ws + WS_OL); bf16* CCp = (bf16*)(ws + WS_CC); float* BON = (float*)(ws + WS_DBON); float* AB = (float*)(ws + WS_DAB);
    LAS float* STEP = (LAS float*)(C.lds + D_LDS_STEP); LAS bf16* VS16 = (LAS bf16*)(C.lds + D_LDS_VS);
    LAS bf16* BKR = (LAS bf16*)(C.lds + 90112); LAS bf16* BKT = (LAS bf16*)(C.lds + 94208); LAS bf16* XB = (LAS bf16*)(C.lds + 98304);
    LAS bf16* VA = (LAS bf16*)(C.lds + 114688); LAS float* RH = (LAS float*)(C.lds + 122880);
    LAS float* GAM = (LAS float*)(C.lds + 131584); LAS float* MN = (LAS float*)(C.lds + 135936); LAS bf16* KR = (LAS bf16*)(C.lds + 140032); LAS bf16* QP = (LAS bf16*)(C.lds + 144128);
    LAS bf16* TWD = (LAS bf16*)(C.lds + D_LDS_TWD); LAS bf16* ADS = (LAS bf16*)(C.lds + D_LDS_ADS);
    const int wave = C.wave;
    for (int u = C.bid; u < 256; u += C.G) {
        const int lane = lane_id_fresh(), tid = wave * 64 + lane;
        const int tt = tid >> 3, c8 = tid & 7;
        const int b = u >> 5, h = (u >> 3) & 3, seg = u & 7, hc0 = h * 64;
        __syncthreads();
        {
            const int i = tid >> 3;
            const f32x4 wa = *(const f32x4*)(w_up + (size_t)i * 256 + hc0 + 8 * c8), wb = *(const f32x4*)(w_up + (size_t)i * 256 + hc0 + 8 * c8 + 4);
            const f32x4 aa = *(const f32x4*)(a_up + (size_t)i * 256 + hc0 + 8 * c8), ab = *(const f32x4*)(a_up + (size_t)i * 256 + hc0 + 8 * c8 + 4);
#pragma unroll
            for (int j = 0; j < 4; ++j) { TWD[(8 * c8 + j) * 64 + i] = (bf16)f2bf(wa[j]); TWD[(8 * c8 + 4 + j) * 64 + i] = (bf16)f2bf(wb[j]);
                                          ADS[(8 * c8 + j) * 64 + i] = (bf16)f2bf(aa[j]); ADS[(8 * c8 + 4 + j) * 64 + i] = (bf16)f2bf(ab[j]); }
        }
        __syncthreads();
        const int mat = wave >> 2, mt = wave & 3, fr = lane & 15, fq = lane >> 4;
        bf16x8_t bfrag[4][2];
#pragma unroll
        for (int nt = 0; nt < 4; ++nt)
#pragma unroll
            for (int k2 = 0; k2 < 2; ++k2) bfrag[nt][k2] = *(const LAS bf16x8_t*)((mat ? ADS : TWD) + (16 * nt + fr) * 64 + 32 * k2 + 8 * fq);
        float bias4[4];
#pragma unroll
        for (int nt = 0; nt < 4; ++nt) bias4[nt] = (mat ? a0 : w0)[hc0 + 16 * nt + fr];
        __syncthreads();
        const int xc = lane & 15, xq = lane >> 4;
        f32x4 X[4];
#pragma unroll
        for (int kt = 0; kt < 4; ++kt)
#pragma unroll
            for (int j = 0; j < 4; ++j) X[kt][j] = (wave >= 4 && (16 * (wave - 4) + 4 * xq + j) == (16 * kt + xc)) ? 1.f : 0.f;
        for (int i = tid; i < 64 * 16; i += 512) VA[(64 + (i >> 4)) * 32 + (i & 15)] = (bf16)0;
        v4u rc, kc, vc, rp, kp, vp; f32x4 wc0, wc1, ac0, ac1, wp0, wp1, ap0, ap1;
#define D1_LOADRAW(BLK) do { const int tl_ = seg * 512 + (BLK) * 64 + tt; const size_t m_ = ((size_t)b << 12) + tl_; const int ch_ = hc0 + 8 * c8; \
            rc = *(const v4u*)(DR + m_ * 256 + ch_); kc = *(const v4u*)(DK + m_ * 256 + ch_); vc = *(const v4u*)(DV + m_ * 256 + ch_); \
            wc0 = *(const f32x4*)(MS + m_ * 256 + 72 + 8 * c8); wc1 = *(const f32x4*)(MS + m_ * 256 + 76 + 8 * c8); ac0 = *(const f32x4*)(MS + m_ * 256 + 136 + 8 * c8); ac1 = *(const f32x4*)(MS + m_ * 256 + 140 + 8 * c8); \
            rp = (v4u){0u, 0u, 0u, 0u}; kp = rp; vp = rp; wp0 = (f32x4){0.f, 0.f, 0.f, 0.f}; wp1 = wp0; ap0 = wp0; ap1 = wp0; \
            if (tl_ > 0) { rp = *(const v4u*)(DR + (m_ - 1) * 256 + ch_); kp = *(const v4u*)(DK + (m_ - 1) * 256 + ch_); vp = *(const v4u*)(DV + (m_ - 1) * 256 + ch_); \
                wp0 = *(const f32x4*)(MS + (m_ - 1) * 256 + 72 + 8 * c8); wp1 = *(const f32x4*)(MS + (m_ - 1) * 256 + 76 + 8 * c8); ap0 = *(const f32x4*)(MS + (m_ - 1) * 256 + 136 + 8 * c8); ap1 = *(const f32x4*)(MS + (m_ - 1) * 256 + 140 + 8 * c8); } } while (0)
        for (int blk = 0; blk < 8; ++blk) {
            D1_LOADRAW(blk);
            const int tloc0 = seg * 512 + blk * 64;
            const size_t m = ((size_t)b << 12) + tloc0 + tt;
            {
                const int ch = hc0 + 8 * c8;
                LAS float* st = STEP + tt * DSTEP_T + c8 * 40;
#pragma unroll
                for (int q = 0; q < 4; ++q) {
                    const unsigned rcw = rc[q], rpw = rp[q], kcw = kc[q], kpw = kp[q], vcw = vc[q], vpw = vp[q];
                    const float mr0 = mu[ch + 2 * q], mr1 = mu[ch + 2 * q + 1], mk0 = mu[256 + ch + 2 * q], mk1 = mu[256 + ch + 2 * q + 1], mv0 = mu[512 + ch + 2 * q], mv1 = mu[512 + ch + 2 * q + 1];
                    float c0 = bflo(rcw), c1 = bfhi(rcw);
                    st[32 + 2 * q] = c0 + mr0 * (bflo(rpw) - c0); st[32 + 2 * q + 1] = c1 + mr1 * (bfhi(rpw) - c1);
                    c0 = bflo(kcw); c1 = bfhi(kcw);
                    st[24 + 2 * q] = c0 + mk0 * (bflo(kpw) - c0); st[24 + 2 * q + 1] = c1 + mk1 * (bfhi(kpw) - c1);
                    c0 = bflo(vcw); c1 = bfhi(vcw);
                    VS16[tt * 64 + 8 * c8 + 2 * q] = (bf16)f2bf(c0 + mv0 * (bflo(vpw) - c0)); VS16[tt * 64 + 8 * c8 + 2 * q + 1] = (bf16)f2bf(c1 + mv1 * (bfhi(vpw) - c1));
                }
                float tw[8], ad[8];
#pragma unroll
                for (int j = 0; j < 4; ++j) {
                    const float m0 = mu[768 + 8 * c8 + j], m1 = mu[768 + 8 * c8 + 4 + j], n0 = mu[832 + 8 * c8 + j], n1 = mu[832 + 8 * c8 + 4 + j];
                    tw[j] = tanhf(wc0[j] + m0 * (wp0[j] - wc0[j])); tw[4 + j] = tanhf(wc1[j] + m1 * (wp1[j] - wc1[j]));
                    ad[j] = ac0[j] + n0 * (ap0[j] - ac0[j]); ad[4 + j] = ac1[j] + n1 * (ap1[j] - ac1[j]);
                }
                v4u tv, av; tv.x = pk2(tw[0], tw[1]); tv.y = pk2(tw[2], tw[3]); tv.z = pk2(tw[4], tw[5]); tv.w = pk2(tw[6], tw[7]);
                av.x = pk2(ad[0], ad[1]); av.y = pk2(ad[2], ad[3]); av.z = pk2(ad[4], ad[5]); av.w = pk2(ad[6], ad[7]);
                *(LAS v4u*)(TWD + tt * 64 + 8 * c8) = tv; *(LAS v4u*)(ADS + tt * 64 + 8 * c8) = av;
            }
            __syncthreads();
            {
                const LAS bf16* Asrc = mat ? ADS : TWD;
                const bf16x8_t a0f = *(const LAS bf16x8_t*)(Asrc + (16 * mt + fr) * 64 + 8 * fq), a1f = *(const LAS bf16x8_t*)(Asrc + (16 * mt + fr) * 64 + 32 + 8 * fq);
#pragma unroll
                for (int nt = 0; nt < 4; ++nt) {
                    f32x4 acc = (f32x4){0.f, 0.f, 0.f, 0.f};
                    acc = __builtin_amdgcn_mfma_f32_16x16x32_bf16(a0f, bfrag[nt][0], acc, 0, 0, 0);
                    acc = __builtin_amdgcn_mfma_f32_16x16x32_bf16(a1f, bfrag[nt][1], acc, 0, 0, 0);
                    const int c = 16 * nt + fr;
#pragma unroll
                    for (int j = 0; j < 4; ++j) {
                        const int t = 16 * mt + 4 * fq + j; const float x = acc[j] + bias4[nt]; float val;
                        if (mat == 0) { const float nx = -x; const float sp = fmaxf(nx, 0.f) + log1pf(expf(-fabsf(nx))); val = expf(-expf(-sp - 0.5f)); }
                        else val = 1.f / (1.f + expf(-x));
                        STEP[t * DSTEP_T + (c >> 3) * 40 + (mat ? 16 : 8) + (c & 7)] = val;
                    }
                }
            }
            __syncthreads();
            {
                const int ch = hc0 + 8 * c8; LAS float* st = STEP + tt * DSTEP_T + c8 * 40;
                float kkr[8], ssq = 0.f, bon = 0.f;
#pragma unroll
                for (int j = 0; j < 8; ++j) { const float kx = st[24 + j], a = st[16 + j];
                    kkr[j] = kx * k_k[ch + j]; ssq = fmaf(kkr[j], kkr[j], ssq);
                    const float kf = kx * (1.f + (a - 1.f) * k_a[ch + j]); st[24 + j] = kf; bon = fmaf(st[32 + j] * kf, r_k[ch + j], bon); }
                ssq = red8(ssq); bon = red8(bon);
                const float inv = 1.f / fmaxf(sqrtf(ssq), 1e-12f);
#pragma unroll
                for (int j = 0; j < 8; ++j) { const float kk = kkr[j] * inv; st[j] = kk; st[16 + j] = kk * st[16 + j]; }
                if (c8 == 0) BON[m * 4 + h] = bon;
            }
            __syncthreads();
            for (int sb = 0; sb < 4; ++sb) {
                const int tau = 16 * sb;
                int xcs = xc, xqs = xq, tids = tid; asm volatile("" : "+v"(xcs), "+v"(xqs), "+v"(tids));
#pragma unroll
                for (int kt = 0; kt < 4; ++kt)
#pragma unroll
                    for (int j = 0; j < 4; ++j) XB[(16 * wave + 4 * xqs + j) * 64 + 16 * kt + xcs] = (bf16)f2bf(X[kt][j]);
#pragma unroll
                for (int e = 0; e < 2; ++e) {
                    const int idx = tids + 512 * e, t2 = idx >> 6, k = idx & 63;
                    const LAS float* sw = STEP + tau * DSTEP_T + (k >> 3) * 40 + 8 + (k & 7);
                    float g0 = 1.f;
#pragma unroll
                    for (int u2 = 0; u2 < 15; ++u2) g0 *= (u2 < t2) ? sw[u2 * DSTEP_T] : 1.f;
                    const float g1 = g0 * sw[t2 * DSTEP_T];
                    if (t2 == 15) GAM[k] = g1;
                    const LAS float* st = STEP + (tau + t2) * DSTEP_T + (k >> 3) * 40 + (k & 7);
                    const float ig = __builtin_amdgcn_rcpf(g1);
                    const float kh = st[24] * ig, bh = st[16] * ig;
                    KR[t2 * 64 + k] = (bf16)f2bf(st[0] * g0); KR[(16 + t2) * 64 + k] = (bf16)f2bf(st[32] * g1);
                    BKR[t2 * 64 + k] = (bf16)f2bf(kh); BKR[(16 + t2) * 64 + k] = (bf16)f2bf(bh);
                    BKT[k * 32 + t2] = (bf16)f2bf(kh); BKT[k * 32 + 16 + t2] = (bf16)f2bf(-bh);
                    const int rho = idx & 63, s2 = idx >> 6;
                    VA[rho * 32 + s2] = VS16[(tau + s2) * 64 + rho];
                }
                __syncthreads();
                f32x4 dR;
                {
                    const bf16x8_t a0 = *(const LAS bf16x8_t*)(XB + (16 * wave + xcs) * 64 + 8 * xqs), a1 = *(const LAS bf16x8_t*)(XB + (16 * wave + xcs) * 64 + 32 + 8 * xqs);
                    const bf16x8_t bk0 = *(const LAS bf16x8_t*)(KR + xcs * 64 + 8 * xqs), bk1 = *(const LAS bf16x8_t*)(KR + xcs * 64 + 32 + 8 * xqs);
                    const bf16x8_t br0 = *(const LAS bf16x8_t*)(KR + (16 + xcs) * 64 + 8 * xqs), br1 = *(const LAS bf16x8_t*)(KR + (16 + xcs) * 64 + 32 + 8 * xqs);
                    f32x4 dK = (f32x4){0.f, 0.f, 0.f, 0.f}; dR = dK;
                    dK = __builtin_amdgcn_mfma_f32_16x16x32_bf16(a0, bk0, dK, 0, 0, 0); dK = __builtin_amdgcn_mfma_f32_16x16x32_bf16(a1, bk1, dK, 0, 0, 0);
                    dR = __builtin_amdgcn_mfma_f32_16x16x32_bf16(a0, br0, dR, 0, 0, 0); dR = __builtin_amdgcn_mfma_f32_16x16x32_bf16(a1, br1, dR, 0, 0, 0);
#pragma unroll
                    for (int j = 0; j < 4; ++j) RH[(16 * wave + 4 * xqs + j) * 16 + xcs] = dK[j];
                    if (wave == 7) {
#pragma unroll
                        for (int mt = 0; mt < 2; ++mt)
#pragma unroll
                            for (int nt = 0; nt < 2; ++nt) {
                                f32x4 acc = (f32x4){0.f, 0.f, 0.f, 0.f};
#pragma unroll
                                for (int ks = 0; ks < 2; ++ks)
                                    acc = __builtin_amdgcn_mfma_f32_16x16x32_bf16(*(const LAS bf16x8_t*)(BKR + (16 * mt + xcs) * 64 + 32 * ks + 8 * xqs), *(const LAS bf16x8_t*)(KR + (16 * nt + xcs) * 64 + 32 * ks + 8 * xqs), acc, 0, 0, 0);
#pragma unroll
                                for (int j = 0; j < 4; ++j) MN[(16 * mt + 4 * xqs + j) * 32 + 16 * nt + xcs] = acc[j];
                            }
                    }
                }
                __syncthreads();
                {
                    const int rho = tids >> 2, tq = tids & 3;
                    float rhs[4];
                    { const f32x4 x = *(const LAS f32x4*)(RH + rho * 16 + 4 * tq); rhs[0] = x[0]; rhs[1] = x[1]; rhs[2] = x[2]; rhs[3] = x[3]; }
                    float vv[16];
                    {
                        const v4u w0 = *(const LAS v4u*)(VA + rho * 32), w1 = *(const LAS v4u*)(VA + rho * 32 + 8);
                        vv[0] = bflo(w0.x); vv[1] = bfhi(w0.x); vv[2] = bflo(w0.y); vv[3] = bfhi(w0.y); vv[4] = bflo(w0.z); vv[5] = bfhi(w0.z); vv[6] = bflo(w0.w); vv[7] = bfhi(w0.w);
                        vv[8] = bflo(w1.x); vv[9] = bfhi(w1.x); vv[10] = bflo(w1.y); vv[11] = bfhi(w1.y); vv[12] = bflo(w1.z); vv[13] = bfhi(w1.z); vv[14] = bflo(w1.w); vv[15] = bfhi(w1.w);
                    }
#pragma unroll
                    for (int s2 = 0; s2 < 15; ++s2) {
                        const float mine = rhs[s2 & 3];
                        const float sa = __shfl(mine, (lane_id_fresh() & ~3) | (s2 >> 2));
                        const f32x4 n4 = *(const LAS f32x4*)(MN + s2 * 32 + 4 * tq), m4 = *(const LAS f32x4*)(MN + (16 + s2) * 32 + 4 * tq);
#pragma unroll
                        for (int i = 0; i < 4; ++i) { const float upd = fmaf(vv[s2], n4[i], fmaf(-sa, m4[i], rhs[i])); rhs[i] = (4 * tq + i > s2) ? upd : rhs[i]; }
                    }
                    v2u ow; ow.x = pk2(rhs[0], rhs[1]); ow.y = pk2(rhs[2], rhs[3]);
                    *(LAS v2u*)(VA + rho * 32 + 16 + 4 * tq) = ow;
                    if (wave == 2) {
#pragma unroll
                        for (int e = 0; e < 4; ++e) {
                            const int idx = (tids & 63) + 64 * e, t2 = idx >> 4, s2 = idx & 15;
                            const bool on = s2 <= t2;
                            QP[t2 * 32 + s2] = (bf16)f2bf(on ? MN[s2 * 32 + 16 + t2] : 0.f);
                            QP[t2 * 32 + 16 + s2] = (bf16)f2bf(on ? -MN[(16 + s2) * 32 + 16 + t2] : 0.f);
                        }
                    }
                }
                __syncthreads();
                {
                    const bf16x8_t aV = *(const LAS bf16x8_t*)(VA + (16 * wave + xcs) * 32 + 8 * xqs);
                    const bf16x8_t bQ = *(const LAS bf16x8_t*)(QP + xcs * 32 + 8 * xqs);
                    const f32x4 O = __builtin_amdgcn_mfma_f32_16x16x32_bf16(aV, bQ, dR, 0, 0, 0);
                    v2u ow; ow.x = pk2(O[0], O[1]); ow.y = pk2(O[2], O[3]);
                    const size_t mo = (((size_t)b << 12) + tloc0 + tau + xcs) * 256 + hc0 + 16 * (wave & 3) + 4 * xqs;
                    *(v2u*)((wave < 4 ? OL : CCp) + mo) = ow;
#pragma unroll
                    for (int kt = 0; kt < 4; ++kt) {
                        X[kt] = __builtin_amdgcn_mfma_f32_16x16x32_bf16(aV, *(const LAS bf16x8_t*)(BKT + (16 * kt + xcs) * 32 + 8 * xqs), X[kt], 0, 0, 0);
                        const float g16 = GAM[16 * kt + xcs];
#pragma unroll
                        for (int j = 0; j < 4; ++j) X[kt][j] *= g16;
                    }
                }
                __syncthreads();
            }
        }
#undef D1_LOADRAW
        {
            float* ab = AB + (size_t)u * 8192 + (wave < 4 ? 4096 : 0);
#pragma unroll
            for (int kt = 0; kt < 4; ++kt)
#pragma unroll
                for (int j = 0; j < 4; ++j) ab[(16 * (wave & 3) + 4 * xq + j) * 64 + 16 * kt + xc] = X[kt][j];
        }
    }
}
__device__ __forceinline__ void mixD2(Ctx C, unsigned char* ws) {
    OPQ(C);
    if (C.bid >= 32) return;
    const float* AB = (const float*)(ws + WS_DAB); float* SS = (float*)(ws + WS_DSS);
    LAS float* SL = (LAS float*)C.lds; LAS float* AL = SL + 4096;
    const int tid = C.tid, rr = tid >> 3, ks = tid & 7;
    float S[8];
#pragma unroll
    for (int j = 0; j < 8; ++j) S[j] = 0.f;
    f32x4 na0, na1, nb0, nb1;
#define D2_LOAD(U) do { const float* ab_ = AB + (size_t)(U) * 8192; na0 = *(const f32x4*)(ab_ + tid * 8); na1 = *(const f32x4*)(ab_ + tid * 8 + 4); \
        nb0 = *(const f32x4*)(ab_ + 4096 + rr * 64 + 8 * ks); nb1 = *(const f32x4*)(ab_ + 4096 + rr * 64 + 8 * ks + 4); } while (0)
    D2_LOAD(C.bid * 8);
    for (int seg = 0; seg < 8; ++seg) {
        const int u = C.bid * 8 + seg;
        float* so = SS + (size_t)u * 4096 + rr * 64 + 8 * ks;
        *(f32x4*)so = (f32x4){S[0], S[1], S[2], S[3]}; *(f32x4*)(so + 4) = (f32x4){S[4], S[5], S[6], S[7]};
        if (seg == 7) break;
        __syncthreads();
        *(LAS f32x4*)(SL + rr * 64 + 8 * ks) = (f32x4){S[0], S[1], S[2], S[3]}; *(LAS f32x4*)(SL + rr * 64 + 8 * ks + 4) = (f32x4){S[4], S[5], S[6], S[7]};
        *(LAS f32x4*)(AL + tid * 8) = na0; *(LAS f32x4*)(AL + tid * 8 + 4) = na1;
        const f32x4 bb0 = nb0, bb1 = nb1;
        if (seg + 1 < 7) D2_LOAD(u + 1);
        __syncthreads();
#pragma unroll
        for (int j = 0; j < 4; ++j) { S[j] = bb0[j]; S[4 + j] = bb1[j]; }
#pragma nounroll
        for (int i = 0; i < 64; ++i) {
            const float s = SL[rr * 64 + i];
            const f32x4 a0 = *(const LAS f32x4*)(AL + i * 64 + 8 * ks), a1 = *(const LAS f32x4*)(AL + i * 64 + 8 * ks + 4);
#pragma unroll
            for (int j = 0; j < 4; ++j) { S[j] = fmaf(s, a0[j], S[j]); S[4 + j] = fmaf(s, a1[j], S[4 + j]); }
        }
    }
#undef D2_LOAD
}
__device__ __forceinline__ void mixD3(Ctx C, const Params& P, int l) {
    OPQ(C);
    unsigned char* ws = P.ws;
    bf16* DR = PLP(ws, PL_DR); const bf16* DV = PLP(ws, PL_DV); const bf16* DZ = PLP(ws, PL_DZ);
    const bf16* OL = (const bf16*)(ws + WS_OL); const bf16* CCp = (const bf16*)(ws + WS_CC); const float* BON = (const float*)(ws + WS_DBON); const float* SS = (const float*)(ws + WS_DSS);
    const float* mu = P.in[6] + l * 896; const float* gn_g = P.in[14] + l * 256; const float* gn_b = P.in[15] + l * 256;
    const int lane = C.lane, wave = C.wave;
    for (int u = C.bid; u < 256; u += C.G) {
        const int b = u >> 5, h = (u >> 3) & 3, seg = u & 7, hc = h * 64 + lane;
        float S[64];
        {
            const f32x4* sp = (const f32x4*)(SS + (size_t)u * 4096 + lane * 64);
#pragma unroll
            for (int q = 0; q < 16; ++q) { const f32x4 x = sp[q]; S[4 * q] = x[0]; S[4 * q + 1] = x[1]; S[4 * q + 2] = x[2]; S[4 * q + 3] = x[3]; }
        }
        const float muv = mu[512 + hc], gg = gn_g[hc], gb = gn_b[hc];
        unsigned short ncv[8], nol[8], nvc[9], nzz[8]; float nbon[8];
#define D3_LOAD(T8) do { const int tl0_ = seg * 512 + wave * 64 + (T8); const size_t m0_ = ((size_t)b << 12) + tl0_; \
            nvc[0] = (tl0_ > 0) ? DV[(m0_ - 1) * 256 + hc] : (unsigned short)0; \
            _Pragma("unroll") for (int j = 0; j < 8; ++j) { const size_t m = m0_ + j; ncv[j] = CCp[m * 256 + hc]; nol[j] = OL[m * 256 + hc]; nbon[j] = BON[m * 4 + h]; nvc[j + 1] = DV[m * 256 + hc]; nzz[j] = DZ[m * 256 + hc]; } } while (0)
        D3_LOAD(0);
#pragma nounroll
        for (int t8 = 0; t8 < 64; t8 += 8) {
            const int tl0 = seg * 512 + wave * 64 + t8;
            const size_t m0 = ((size_t)b << 12) + tl0;
            float cv[8], ol[8], bon[8], vc[9], zz[8];
            vc[0] = bf2f(nvc[0]);
#pragma unroll
            for (int j = 0; j < 8; ++j) { cv[j] = bf2f(ncv[j]); ol[j] = bf2f(nol[j]); bon[j] = nbon[j]; vc[j + 1] = bf2f(nvc[j + 1]); zz[j] = bf2f(nzz[j]); }
            if (t8 + 8 < 64) D3_LOAD(t8 + 8);
#pragma unroll
            for (int j = 0; j < 8; ++j) {
                float o = ol[j];
#pragma unroll
                for (int i = 0; i < 64; ++i) o = fmaf(S[i], __builtin_bit_cast(float, __builtin_amdgcn_readlane(__builtin_bit_cast(int, cv[j]), i)), o);
                const float mean = wave_sum(o) * (1.f / 64.f); const float d = o - mean; const float var = wave_sum(d * d) * (1.f / 64.f);
                float y = d * __builtin_amdgcn_rsqf(var + 64e-5f) * gg + gb;
                y += bon[j] * (vc[j + 1] + muv * (vc[j] - vc[j + 1]));
                DR[(m0 + j) * 256 + hc] = (bf16)f2bf(y * zz[j] * fsig(zz[j]));
            }
        }
#undef D3_LOAD
    }
}

template <bool OUT>
__device__ __forceinline__ void mixB_chunks(Ctx C, unsigned char* ws, const float* normg, bf16* OUTP) {
    OPQ(C);
    const bf16* BQ = PLP(ws, PL_BQ); const bf16* BI = PLP(ws, PL_BI); const bf16* BZ = PLP(ws, PL_BZ); const float* BF = (const float*)(ws + WS_BF);
    float* BS = (float*)(ws + WS_BS); float* BG = (float*)(ws + WS_BG);
    LAS float* FT = (LAS float*)(C.lds + C.wave * 16384); LAS float* QT = FT + 1024; LAS float* IT = FT + 2048; LAS float* ZT = FT + 3072;
    const int lane = C.lane;
    const float gnorm = OUT ? normg[lane] : 0.f;
    for (int item = C.bid * 8 + C.wave; item < 2048; item += C.G * 8) {
        const int bh = item >> 6, c = item & 63, b = bh >> 2, h = bh & 3;
        const size_t m0 = ((size_t)b << 12) + c * 64;
        float S[64];
        if (OUT) {
            const float* sp = BS + (size_t)item * 4096 + lane;
#pragma unroll
            for (int d = 0; d < 64; ++d) S[d] = sp[d * 64];
        } else {
#pragma unroll
            for (int d = 0; d < 64; ++d) S[d] = 0.f;
        }
        float g = 1.f;
        float nf[16]; unsigned short ni[16], nq[16], nz[16];
#define B_LOADTILE(T0) do { _Pragma("unroll") for (int s = 0; s < 16; ++s) { const size_t m = m0 + (T0) + s; nf[s] = BF[m * 256 + h * 64 + lane]; ni[s] = BI[m * 256 + h * 64 + lane]; \
            if (OUT) { nq[s] = BQ[m * 256 + h * 64 + lane]; nz[s] = BZ[m * 256 + h * 64 + lane]; } } } while (0)
        B_LOADTILE(0);
        for (int t0 = 0; t0 < 64; t0 += 16) {
#pragma unroll
            for (int s = 0; s < 16; ++s) {
                FT[s * 64 + lane] = nf[s]; IT[s * 64 + lane] = bf2f(ni[s]);
                if (OUT) { QT[s * 64 + lane] = bf2f(nq[s]); ZT[s * 64 + lane] = bf2f(nz[s]); }
            }
            if (t0 + 16 < 64) B_LOADTILE(t0 + 16);
            LDS_WAIT(); asm volatile("" ::: "memory");
            if (!OUT) {
#pragma unroll
                for (int s = 0; s < 16; ++s) g *= FT[s * 64 + lane];
            }
#pragma nounroll
            for (int s = 0; s < 16; ++s) {
                const size_t m = m0 + t0 + s;
                const float iv = IT[s * 64 + lane];
                const LAS f32x4* fp = (const LAS f32x4*)(FT + s * 64); const LAS f32x4* qp = (const LAS f32x4*)(QT + s * 64);
                float o = 0.f;
#pragma unroll
                for (int q4 = 0; q4 < 16; ++q4) {
                    const f32x4 f4 = fp[q4];
#pragma unroll
                    for (int j = 0; j < 4; ++j) S[4 * q4 + j] = fmaf(f4[j], S[4 * q4 + j] - iv, iv);
                    if (OUT) { const f32x4 qv = qp[q4];
#pragma unroll
                        for (int j = 0; j < 4; ++j) o = fmaf(qv[j], S[4 * q4 + j], o); }
                }
                if (OUT) {
                    const float r = __builtin_amdgcn_rsqf(wave_sum(o * o) * (1.f / 64.f) + 1e-6f);
                    const float z = ZT[s * 64 + lane];
                    OUTP[m * 256 + h * 64 + lane] = (bf16)f2bf(o * r * gnorm * z * fsig(z));
                }
            }
            LDS_WAIT(); asm volatile("" ::: "memory");
        }
#undef B_LOADTILE
        if (!OUT) {
            float* sp = BS + (size_t)item * 4096 + lane;
#pragma unroll
            for (int d = 0; d < 64; ++d) sp[d * 64] = S[d];
            BG[item * 64 + lane] = g;
        }
    }
}
__device__ __forceinline__ void mixB_scan(Ctx C, unsigned char* ws) {
    OPQ(C);
    float* BS = (float*)(ws + WS_BS); const float* BG = (const float*)(ws + WS_BG);
    for (int e = C.bid * 512 + C.tid; e < 32 * 4096; e += C.G * 512) {
        const int bh = e >> 12, dv = e & 4095, d = dv >> 6;
        float S = 0.f;
#pragma unroll 8
        for (int c = 0; c < 64; ++c) {
            const size_t idx = ((size_t)(bh * 64 + c) << 12) + dv;
            const float sl = BS[idx], g = BG[(bh * 64 + c) * 64 + d];
            BS[idx] = S;
            S = fmaf(g, S, sl);
        }
    }
}

typedef float f32x16 __attribute__((ext_vector_type(16)));
__device__ __forceinline__ int crow_(int r, int hi) { return (r & 3) + 8 * (r >> 2) + 4 * hi; }
__device__ __forceinline__ void mixA_fast(Ctx C, unsigned char* ws, const float* bias, bf16* OUTP) {
    OPQ(C);
    const bf16* AQ = PLP(ws, PL_AQ); const bf16* AK = PLP(ws, PL_AK); const bf16* AVT = PLP(ws, PL_AV); const bf16* AZ = PLP(ws, PL_AZ);
    LAS float* BL = (LAS float*)C.lds;
    __syncthreads();
    for (int i = C.tid; i < 768; i += 512) BL[i] = bias[i] * 1.4426950408889634f;
    __syncthreads();
    const int lane = C.lane, q = lane & 31, hi = lane >> 5;
    for (int item = C.bid * 8 + C.wave; item < 2048; item += C.G * 8) {
        const int h = item & 3, c = (item >> 2) & 63, b = item >> 8;
        const size_t mq0 = ((size_t)b << 12) + c * 64;
        bf16x8_t qf[2][4];
#pragma unroll
        for (int qb = 0; qb < 2; ++qb)
#pragma unroll
            for (int s = 0; s < 4; ++s) qf[qb][s] = *(const bf16x8_t*)(AQ + (mq0 + 32 * qb + q) * 256 + h * 64 + 16 * s + 8 * hi);
        f32x16 O[2][2];
#pragma unroll
        for (int qb = 0; qb < 2; ++qb)
#pragma unroll
            for (int db = 0; db < 2; ++db)
#pragma unroll
                for (int r = 0; r < 16; ++r) O[qb][db][r] = 0.f;
        float mrun[2] = {-1e30f, -1e30f}, lrun[2] = {0.f, 0.f};
        const int klo = (c >= 8) ? (c - 8) * 64 : 0;
        const int nkb = (c * 64 + 64 - klo) >> 5;
        const LAS float* bh = BL + h * 192;
        bf16x8_t kfn[4], vtn[2][2];
#define A_LOADKV(KB) do { const size_t kb_ = (size_t)(b * 4 + h) * 128 + ((klo >> 5) + (KB)); _Pragma("unroll") for (int s = 0; s < 4; ++s) kfn[s] = *(const bf16x8_t*)(AK + ((kb_ * 4 + s) * 64 + lane) * 8); \
            _Pragma("unroll") for (int db = 0; db < 2; ++db) _Pragma("unroll") for (int s2 = 0; s2 < 2; ++s2) vtn[db][s2] = *(const bf16x8_t*)(AVT + (((kb_ * 2 + db) * 2 + s2) * 64 + lane) * 8); } while (0)
        A_LOADKV(0);
        for (int kb = 0; kb < nkb; ++kb) {
            const int kbase = klo + 32 * kb;
            bf16x8_t kf[4];
#pragma unroll
            for (int s = 0; s < 4; ++s) kf[s] = kfn[s];
            bf16x8_t vt[2][2];
#pragma unroll
            for (int db = 0; db < 2; ++db)
#pragma unroll
                for (int s2 = 0; s2 < 2; ++s2) vt[db][s2] = vtn[db][s2];
            if (kb + 1 < nkb) A_LOADKV(kb + 1);
#pragma unroll
            for (int qb = 0; qb < 2; ++qb) {
                f32x16 st;
#pragma unroll
                for (int r = 0; r < 16; ++r) st[r] = 0.f;
#pragma unroll
                for (int s = 0; s < 4; ++s) st = __builtin_amdgcn_mfma_f32_32x32x16_bf16(kf[s], qf[qb][s], st, 0, 0, 0);
                const int qpos = c * 64 + 32 * qb + q;
                float mx = -1e30f;
                if (qpos - (kbase + 31) >= 128) {
                    const float bc = bh[191];
#pragma unroll
                    for (int r = 0; r < 16; ++r) { st[r] = fmaf(st[r], 0.125f * 1.4426950408889634f, bc); mx = fmaxf(mx, st[r]); }
                } else {
#pragma unroll
                    for (int r = 0; r < 16; ++r) {
                        int rel = qpos - (kbase + crow_(r, hi)); rel = rel < -63 ? -63 : (rel > 128 ? 128 : rel);
                        st[r] = fmaf(st[r], 0.125f * 1.4426950408889634f, bh[rel + 63]);
                        mx = fmaxf(mx, st[r]);
                    }
                }
                mx = xh_max(mx);
                const float mn = fmaxf(mrun[qb], mx);
                float ps = 0.f;
#pragma unroll
                for (int r = 0; r < 16; ++r) { st[r] = __builtin_amdgcn_exp2f(st[r] - mn); ps += st[r]; }
                ps = xh_sum(ps);
                if (__builtin_amdgcn_ballot_w64(mn != mrun[qb]) != 0ull) {
                    const float al = __builtin_amdgcn_exp2f(mrun[qb] - mn);
                    lrun[qb] *= al;
#pragma unroll
                    for (int db = 0; db < 2; ++db)
#pragma unroll
                        for (int r = 0; r < 16; ++r) O[qb][db][r] *= al;
                }
                mrun[qb] = mn;
                lrun[qb] += ps;
                v4u p0, p1;
                p0.x = pk2(st[0], st[1]); p0.y = pk2(st[2], st[3]); p0.z = pk2(st[4], st[5]); p0.w = pk2(st[6], st[7]);
                p1.x = pk2(st[8], st[9]); p1.y = pk2(st[10], st[11]); p1.z = pk2(st[12], st[13]); p1.w = pk2(st[14], st[15]);
                const bf16x8_t pf0 = __builtin_bit_cast(bf16x8_t, p0), pf1 = __builtin_bit_cast(bf16x8_t, p1);
#pragma unroll
                for (int db = 0; db < 2; ++db) {
                    O[qb][db] = __builtin_amdgcn_mfma_f32_32x32x16_bf16(vt[db][0], pf0, O[qb][db], 0, 0, 0);
                    O[qb][db] = __builtin_amdgcn_mfma_f32_32x32x16_bf16(vt[db][1], pf1, O[qb][db], 0, 0, 0);
                }
            }
        }
#undef A_LOADKV
#pragma unroll
        for (int qb = 0; qb < 2; ++qb) {
            const float invl = 1.f / lrun[qb];
            const size_t mrow = (mq0 + 32 * qb + q) * 256 + h * 64;
#pragma unroll
            for (int db = 0; db < 2; ++db)
#pragma unroll
                for (int g = 0; g < 4; ++g) {
                    const int col = 32 * db + 8 * g + 4 * hi;
                    const v2u z = *(const v2u*)(AZ + mrow + col);
                    const float z0 = bflo(z.x), z1 = bfhi(z.x), z2 = bflo(z.y), z3 = bfhi(z.y);
                    v2u w;
                    w.x = pk2(O[qb][db][4 * g] * invl * z0 * fsig(z0), O[qb][db][4 * g + 1] * invl * z1 * fsig(z1));
                    w.y = pk2(O[qb][db][4 * g + 2] * invl * z2 * fsig(z2), O[qb][db][4 * g + 3] * invl * z3 * fsig(z3));
                    *(v2u*)(OUTP + mrow + col) = w;
                }
        }
    }
}

constexpr int C_NB = 256, C_CAP = 128;
constexpr int C_LDS_HIST = 0, C_LDS_QIF = 33792, C_LDS_BMP = 66560, C_LDS_QP = 99328, C_LDS_WQ = 101376, C_LDS_SCR = 102400;
enum { QP_LO = 0, QP_SC = 1, QP_CRIT = 2, QP_LO2 = 3, QP_SC2 = 4, QP_CRIT2 = 5, QP_KREM = 6, QP_CNT = 7, QP_LVL = 8, QP_CC = 9 };
__device__ __forceinline__ int c_bin(float s, float nlosc, float sc) { return (int)__builtin_amdgcn_fmed3f(fmaf(s, sc, nlosc), 0.f, (float)(C_NB - 1)); }
__device__ __forceinline__ float relu_asm(float x) { const int xi = __builtin_bit_cast(int, x); return __builtin_bit_cast(float, xi > 0 ? xi : 0); }
__device__ __forceinline__ void mixC_fast(Ctx C, unsigned char* ws, bf16* OUTP, const int parts = 3) {
    OPQ(C);
    const bf16* CQ = PLP(ws, PL_CQ); const bf16* CK = PLP(ws, PL_CK); const bf16* CVT = PLP(ws, PL_CV); const bf16* CZ = PLP(ws, PL_CZ);
    const bf16* QI0 = PLP(ws, PL_CQI0); const bf16* QI1 = PLP(ws, PL_CQI1); const bf16* KI = (const bf16*)(ws + WS_KI); const float* MS = (const float*)(ws + WS_MISC);
    LAS unsigned* HIST = (LAS unsigned*)(C.lds + C_LDS_HIST); LAS unsigned* BMP = (LAS unsigned*)(C.lds + C_LDS_BMP);
    LAS float* QPf = (LAS float*)(C.lds + C_LDS_QP); LAS int* QPi = (LAS int*)(C.lds + C_LDS_QP); LAS float* WQ = (LAS float*)(C.lds + C_LDS_WQ);
    LAS unsigned long long* LIST = (LAS unsigned long long*)(C.lds + C_LDS_HIST);
    LAS unsigned char* QIFL = C.lds + C_LDS_QIF;
    const int wave = C.wave;
    for (int pass2 = 0; pass2 < 2; ++pass2)
    for (int ui = C.bid; ui < 256; ui += C.G) {
        const int b = ui & 7, c = pass2 == 0 ? 63 - (ui >> 3) : (ui >> 3);
        const int n = 64 * (c + 1), nkb = n >> 5;
        const size_t mq0 = ((size_t)b << 12) + c * 64, mk0 = (size_t)b << 12;
        __syncthreads();
        unsigned long long tc0_ = (EXP >= 200) ? __builtin_amdgcn_s_memrealtime() : 0ull; unsigned long long tc1_ = tc0_;
#define TACC(slot) do { if (EXP >= 200 && wave == 0 && lane_id_fresh() == 0) { const unsigned long long tn_ = __builtin_amdgcn_s_memrealtime(); atomicAdd((unsigned*)(ws + WS_CTL) + 8192 + 16 * (slot) + 2, (unsigned)(tn_ - tc1_)); tc1_ = tn_; } } while (0)
        if (!(parts & 1)) {} else if (c <= 3) {
            const int tid0 = wave * 64 + lane_id_fresh();
            for (int i = tid0; i < 64 * 128; i += 512) BMP[i] = ((i & 127) < nkb) ? 0xFFFFFFFFu : 0u;
        } else {
          for (int qb = 0; qb < 2; ++qb) {
            {
                const int lane = lane_id_fresh();
#pragma nounroll
                for (int qq = 0; qq < 4; ++qq) {
                    const int qx = wave * 4 + qq; const size_t m = mq0 + 32 * qb + qx;
                    const int hh = lane >> 3;
                    const v4u w = *(const v4u*)((hh < 4 ? QI0 : QI1) + m * 256 + (hh & 3) * 64 + 8 * (lane & 7));
                    float ssq;
                    { const float a0 = bflo(w.x), a1 = bfhi(w.x), a2 = bflo(w.y), a3 = bfhi(w.y), a4 = bflo(w.z), a5 = bfhi(w.z), a6 = bflo(w.w), a7 = bfhi(w.w);
                      ssq = a0 * a0 + a1 * a1 + a2 * a2 + a3 * a3 + a4 * a4 + a5 * a5 + a6 * a6 + a7 * a7; }
                    ssq = red8(ssq);
                    const float wv = MS[m * 256 + 64 + hh] * (0.35355339059327373f * 0.125f);
                    float tm = 0.4f * wv * sqrtf(ssq), tv = 0.34f * wv * wv * ssq;
                    tm += dppf(tm, 4); tm += swz16f(tm); tm = xh_sum(tm);
                    tv += dppf(tv, 4); tv += swz16f(tv); tv = xh_sum(tv);
                    if ((lane & 7) == 0) WQ[qx * 8 + hh] = wv;
                    if (lane == 0) { const float sd = fmaxf(sqrtf(tv), 1e-20f);
                        { const float sc_ = (float)C_NB / (12.f * sd); QPf[qx * 16 + QP_SC] = sc_; QPf[qx * 16 + QP_LO] = -(tm - 4.f * sd) * sc_; }
                        QPi[qx * 16 + QP_KREM] = 256; QPi[qx * 16 + QP_CNT] = 0; QPi[qx * 16 + QP_LVL] = 0; QPi[qx * 16 + QP_CRIT] = -1; QPi[qx * 16 + QP_CRIT2] = -1; }
                }
                if (wave < 4) {
                    const int q = lane & 31, hi = lane >> 5;
#pragma unroll
                    for (int s = 0; s < 4; ++s) *(LAS bf16x8_t*)(QIFL + (wave * 4 + s) * 1024 + lane * 16) = *(const bf16x8_t*)(QI1 + (mq0 + 32 * qb + q) * 256 + wave * 64 + 16 * s + 8 * hi);
                }
            }
            TACC(6);
            int mode = 0;
            while (true) {
                {
                    const int lane = lane_id_fresh(), q = lane & 31, hi = lane >> 5;
                    if (mode < 2) { for (int i = wave * 64 + lane; i < 32 * 257; i += 512) HIST[i] = 0u; }
                    __syncthreads();
                    const float lo1 = QPf[q * 16 + QP_LO], sc1 = QPf[q * 16 + QP_SC]; const int crit1 = QPi[q * 16 + QP_CRIT]; const int lvl = QPi[q * 16 + QP_LVL];
                    bf16x8_t qif[4][4];
#pragma unroll
                    for (int hh = 0; hh < 4; ++hh)
#pragma unroll
                        for (int s = 0; s < 4; ++s) qif[hh][s] = *(const bf16x8_t*)(QI0 + (mq0 + 32 * qb + q) * 256 + hh * 64 + 16 * s + 8 * hi);
                    bf16x8_t kr0[4], kr1[4], kr2[4];
#define C_LOADKI(dst, KB) do { if ((KB) < nkb) { _Pragma("unroll") for (int s = 0; s < 4; ++s) dst[s] = *(const bf16x8_t*)(KI + ((((size_t)b * 128 + (KB)) * 4 + s) * 64 + lane) * 8); } } while (0)
                    C_LOADKI(kr0, wave); C_LOADKI(kr1, wave + 8); C_LOADKI(kr2, wave + 16);
                    for (int kb = wave; kb < nkb; kb += 8) {
                        const int kbase = 32 * kb;
                        bf16x8_t kif[4];
#pragma unroll
                        for (int s = 0; s < 4; ++s) { kif[s] = kr0[s]; kr0[s] = kr1[s]; kr1[s] = kr2[s]; }
                        C_LOADKI(kr2, kb + 24);
                        f32x16 I;
#pragma unroll
                        for (int r = 0; r < 16; ++r) I[r] = 0.f;
#pragma unroll
                        for (int hh = 0; hh < 8; ++hh) {
                            f32x16 D;
#pragma unroll
                            for (int r = 0; r < 16; ++r) D[r] = 0.f;
                            if (hh < 4) {
#pragma unroll
                                for (int s = 0; s < 4; ++s) D = __builtin_amdgcn_mfma_f32_32x32x16_bf16(kif[s], qif[hh][s], D, 0, 0, 0);
                            } else {
#pragma unroll
                                for (int s = 0; s < 4; ++s) D = __builtin_amdgcn_mfma_f32_32x32x16_bf16(kif[s], *(const LAS bf16x8_t*)(QIFL + ((hh - 4) * 4 + s) * 1024 + lane * 16), D, 0, 0, 0);
                            }
                            const float wqh = WQ[q * 8 + hh];
#pragma unroll
                            for (int r = 0; r < 16; ++r) I[r] = fmaf(relu_asm(D[r]), wqh, I[r]);
                            asm volatile("" : "+v"(kif[0]), "+v"(kif[1]), "+v"(kif[2]), "+v"(kif[3]), "+v"(I));
                        }
                        if (mode == 0) {
#pragma unroll
                            for (int r = 0; r < 16; ++r) { const int bn = c_bin(I[r], lo1, sc1); atomicAdd((unsigned*)&HIST[q * 257 + bn], 1u); }
                        } else if (mode == 1) {
                            if (lvl == 1) {
                                const float lo2 = QPf[q * 16 + QP_LO2], sc2 = QPf[q * 16 + QP_SC2];
#pragma unroll
                                for (int r = 0; r < 16; ++r) { if (c_bin(I[r], lo1, sc1) == crit1) { const int bn = c_bin(I[r], lo2, sc2); atomicAdd((unsigned*)&HIST[q * 257 + bn], 1u); } }
                            }
                        } else {
                            unsigned bits = 0u;
#pragma unroll
                            for (int r = 0; r < 16; ++r) {
                                const int b1 = c_bin(I[r], lo1, sc1);
                                bool sel = b1 > crit1, cand = (b1 == crit1);
                                if (cand && lvl == 1) { const int b2 = c_bin(I[r], QPf[q * 16 + QP_LO2], QPf[q * 16 + QP_SC2]); const int crit2 = QPi[q * 16 + QP_CRIT2]; sel = b2 > crit2; cand = (b2 == crit2); }
                                if (sel) bits |= 1u << ((r & 3) + 8 * (r >> 2));
                                if (cand) { const unsigned pos = atomicAdd((unsigned*)&QPi[q * 16 + QP_CNT], 1u);
                                    if (pos < (unsigned)C_CAP) LIST[q * C_CAP + pos] = ((unsigned long long)__float_as_uint(I[r]) << 32) | (unsigned)(kbase + crow_(r, hi)); }
                            }
                            bits <<= 4 * hi;
                            bits = xh_or(bits);
                            if (hi == 0) BMP[(32 * qb + q) * 128 + kb] = bits;
                        }
                    }
                }
#undef C_LOADKI
                __syncthreads();
                TACC(7);
                if (mode == 2) break;
                {
                    const int lane = lane_id_fresh();
                    LAS unsigned* SCR = (LAS unsigned*)(C.lds + C_LDS_SCR + wave * 256);
#pragma nounroll
                    for (int qq = 0; qq < 4; ++qq) {
                        const int qx = wave * 4 + qq;
                        const int lv = QPi[qx * 16 + QP_LVL];
                        if (mode == 1 && lv == 0) continue;
                        const int krem = QPi[qx * 16 + QP_KREM];
                        unsigned cnt[4]; unsigned s = 0u;
#pragma unroll
                        for (int j = 0; j < 4; ++j) { cnt[j] = HIST[qx * 257 + lane * 4 + j]; s += cnt[j]; }
                        SCR[lane] = s; LDS_WAIT(); asm volatile("" ::: "memory");
                        unsigned incl = 0u;
#pragma unroll 8
                        for (int l2 = 0; l2 < 64; ++l2) { const unsigned t = SCR[l2]; incl += (l2 >= lane) ? t : 0u; }
                        LDS_WAIT(); asm volatile("" ::: "memory");
                        unsigned run = incl - s;
                        int fcrit = -1; unsigned frun = 0u, fcnt = 0u;
#pragma unroll
                        for (int j = 3; j >= 0; --j) {
                            const bool hit = run < (unsigned)krem && run + cnt[j] >= (unsigned)krem;
                            fcrit = hit ? lane * 4 + j : fcrit; frun = hit ? run : frun; fcnt = hit ? cnt[j] : fcnt;
                            run += cnt[j];
                        }
                        if (fcrit >= 0) {
                            QPi[qx * 16 + QP_KREM] = krem - (int)frun; QPi[qx * 16 + QP_CC] = (int)fcnt;
                            if (mode == 0) { QPi[qx * 16 + QP_CRIT] = fcrit;
                                if (fcnt > (unsigned)C_CAP) { const float nlosc = QPf[qx * 16 + QP_LO], sc = QPf[qx * 16 + QP_SC];
                                    QPf[qx * 16 + QP_LO2] = (nlosc - (float)fcrit) * (float)C_NB; QPf[qx * 16 + QP_SC2] = sc * (float)C_NB; QPi[qx * 16 + QP_LVL] = 1; } }
                            else QPi[qx * 16 + QP_CRIT2] = fcrit;
                        }
                    }
                }
                __syncthreads();
                TACC(8);
                if (mode == 0) { bool need_l2 = false; for (int qx = 0; qx < 32; ++qx) need_l2 |= (QPi[qx * 16 + QP_LVL] == 1); mode = need_l2 ? 1 : 2; }
                else mode = 2;
                __syncthreads();
            }
            {
                const int lane = lane_id_fresh();
#pragma nounroll
                for (int qq = 0; qq < 4; ++qq) {
                    const int qx = wave * 4 + qq;
                    int cn = QPi[qx * 16 + QP_CNT]; cn = cn < C_CAP ? cn : C_CAP;
                    const int need = QPi[qx * 16 + QP_KREM];
                    for (int ci = lane; ci < cn; ci += 64) {
                        const unsigned long long me = LIST[qx * C_CAP + ci];
                        const float mv = __uint_as_float((unsigned)(me >> 32)); const unsigned mi = (unsigned)me;
                        int rank = 0;
                        for (int j = 0; j < cn; ++j) { const unsigned long long o = LIST[qx * C_CAP + j]; const float ov = __uint_as_float((unsigned)(o >> 32)); const unsigned oi = (unsigned)o;
                            rank += (ov > mv || (ov == mv && oi < mi)) ? 1 : 0; }
                        if (rank < need) atomicOr((unsigned*)&BMP[(32 * qb + qx) * 128 + (mi >> 5)], 1u << (mi & 31));
                    }
                }
            }
            __syncthreads();
            TACC(9);
          }
        }
        __syncthreads();
        if (EXP >= 200 && wave == 0 && lane_id_fresh() == 0) { const unsigned long long tn_ = __builtin_amdgcn_s_memrealtime(); atomicAdd((unsigned*)(ws + WS_CTL) + 8192 + 16 * 4 + 2, (unsigned)(tn_ - tc0_)); tc0_ = tn_; }
        if (parts & 2) {
            const int lane = lane_id_fresh(), q = lane & 31, hi = lane >> 5;
            const int qb = wave & 1, h = wave >> 1, ql = 32 * qb + q;
            bf16x8_t qf[4];
#pragma unroll
            for (int s = 0; s < 4; ++s) qf[s] = *(const bf16x8_t*)(CQ + (mq0 + ql) * 256 + h * 64 + 16 * s + 8 * hi);
            f32x16 O[2];
#pragma unroll
            for (int db = 0; db < 2; ++db)
#pragma unroll
                for (int r = 0; r < 16; ++r) O[db][r] = 0.f;
            float mrun = -1e30f, lrun = 0.f;
            bf16x8_t kfn[4], vtn[2][2];
#define C_LOADKV(KB) do { const size_t kb_ = (size_t)(b * 4 + h) * 128 + (KB); _Pragma("unroll") for (int s = 0; s < 4; ++s) kfn[s] = *(const bf16x8_t*)(CK + ((kb_ * 4 + s) * 64 + lane) * 8); \
                _Pragma("unroll") for (int db = 0; db < 2; ++db) _Pragma("unroll") for (int s2 = 0; s2 < 2; ++s2) vtn[db][s2] = *(const bf16x8_t*)(CVT + (((kb_ * 2 + db) * 2 + s2) * 64 + lane) * 8); } while (0)
            C_LOADKV(0);
            for (int kb = 0; kb < nkb; ++kb) {
                const unsigned word = BMP[ql * 128 + kb] >> (4 * hi);
                bf16x8_t kf[4];
#pragma unroll
                for (int s = 0; s < 4; ++s) kf[s] = kfn[s];
                bf16x8_t vt[2][2];
#pragma unroll
                for (int db = 0; db < 2; ++db)
#pragma unroll
                    for (int s2 = 0; s2 < 2; ++s2) vt[db][s2] = vtn[db][s2];
                if (kb + 1 < nkb) C_LOADKV(kb + 1);
                f32x16 st;
#pragma unroll
                for (int r = 0; r < 16; ++r) st[r] = 0.f;
#pragma unroll
                for (int s = 0; s < 4; ++s) st = __builtin_amdgcn_mfma_f32_32x32x16_bf16(kf[s], qf[s], st, 0, 0, 0);
                float mx = -INFINITY;
#pragma unroll
                for (int r = 0; r < 16; ++r) {
                    const bool on = (word >> ((r & 3) + 8 * (r >> 2))) & 1u;
                    st[r] = on ? st[r] : -INFINITY;
                    mx = fmaxf(mx, st[r]);
                }
                mx = xh_max(mx) * (0.125f * 1.4426950408889634f);
                const float mn = fmaxf(mrun, mx);
                float ps = 0.f;
#pragma unroll
                for (int r = 0; r < 16; ++r) { st[r] = __builtin_amdgcn_exp2f(fmaf(st[r], 0.125f * 1.4426950408889634f, -mn)); ps += st[r]; }
                ps = xh_sum(ps);
                if (__builtin_amdgcn_ballot_w64(mn != mrun) != 0ull) {
                    const float al = __builtin_amdgcn_exp2f(mrun - mn);
                    lrun *= al;
#pragma unroll
                    for (int db = 0; db < 2; ++db)
#pragma unroll
                        for (int r = 0; r < 16; ++r) O[db][r] *= al;
                }
                mrun = mn;
                lrun += ps;
                v4u p0, p1;
                p0.x = pk2(st[0], st[1]); p0.y = pk2(st[2], st[3]); p0.z = pk2(st[4], st[5]); p0.w = pk2(st[6], st[7]);
                p1.x = pk2(st[8], st[9]); p1.y = pk2(st[10], st[11]); p1.z = pk2(st[12], st[13]); p1.w = pk2(st[14], st[15]);
                const bf16x8_t pf0 = __builtin_bit_cast(bf16x8_t, p0), pf1 = __builtin_bit_cast(bf16x8_t, p1);
#pragma unroll
                for (int db = 0; db < 2; ++db) {
                    O[db] = __builtin_amdgcn_mfma_f32_32x32x16_bf16(vt[db][0], pf0, O[db], 0, 0, 0);
                    O[db] = __builtin_amdgcn_mfma_f32_32x32x16_bf16(vt[db][1], pf1, O[db], 0, 0, 0);
                }
            }
#undef C_LOADKV
            const float invl = 1.f / lrun;
            const size_t mrow = (mq0 + ql) * 256 + h * 64;
#pragma unroll
            for (int db = 0; db < 2; ++db)
#pragma unroll
                for (int g = 0; g < 4; ++g) {
                    const int col = 32 * db + 8 * g + 4 * hi;
                    const v2u z = *(const v2u*)(CZ + mrow + col);
                    const float z0 = bflo(z.x), z1 = bfhi(z.x), z2 = bflo(z.y), z3 = bfhi(z.y);
                    v2u w;
                    w.x = pk2(O[db][4 * g] * invl * z0 * fsig(z0), O[db][4 * g + 1] * invl * z1 * fsig(z1));
                    w.y = pk2(O[db][4 * g + 2] * invl * z2 * fsig(z2), O[db][4 * g + 3] * invl * z3 * fsig(z3));
                    *(v2u*)(OUTP + mrow + col) = w;
                }
        }
        if (EXP >= 200) { __syncthreads(); if (wave == 0 && lane_id_fresh() == 0) { const unsigned long long tn_ = __builtin_amdgcn_s_memrealtime(); atomicAdd((unsigned*)(ws + WS_CTL) + 8192 + 16 * 5 + 2, (unsigned)(tn_ - tc0_)); } }
    }
}
#define GRID_BAR() do { xcd_barrier(bar, C.wave == 0 && lane_id_fresh() == 0); if (EXP >= 100) { volatile LAS unsigned* TSW = (volatile LAS unsigned*)(C.lds + MISC_OFF) + 12; const unsigned k_ = TSW[0] + 1u; if (C.wave == 0 && lane_id_fresh() == 0) { TSW[0] = k_; TSW[k_] = (unsigned)__builtin_amdgcn_s_memrealtime(); } } } while (0)
#ifndef EXP
#define EXP 0
#endif
#define REP(k) for (int rep_ = 0; rep_ < ((EXP == (k)) ? 2 : 1); ++rep_)
template <int l>
__device__ __forceinline__ void layer_body(Ctx C, const Params& P, const XcdBarrier& bar) {
    unsigned char* ws = P.ws;
    const float* xin = (l == 0) ? P.in[0] : P.out;
    bf16* DRY = (bf16*)P.out;
    REP(1) {
        pg8::Gemm g{(const pg8::bf16_t*)(ws + WS_H), (const pg8::bf16_t*)(ws + WS_W1T), NTOK, NG1, 1024};
        pg8::StaticOrder S; S.init(NTOK, NG1, C.G, C.bid);
        EpiG1 E{ws, (const float*)(ws + WS_LB) + l * 256};
        pg8::gemm_phase<EpiG1, pg8::StaticOrder, true, true>(C.lds, g, S, E, C.wave);
    }
    GRID_BAR();
    REP(2) { mixD1_ut(C, P, l); __syncthreads(); }
    REP(3) { mixB_chunks<false>(C, ws, nullptr, nullptr); __syncthreads(); }
    GRID_BAR();
    REP(16) { mixD2(C, ws); __syncthreads(); }
    mixB_scan(C, ws);
    if (l == 0) { __syncthreads(); convert_weights(C, P, 1, 1); }
    GRID_BAR();
#define SUBT(k) do { if (EXP >= 200) { __syncthreads(); if (C.wave == 0 && lane_id_fresh() == 0) { const unsigned long long tn_ = __builtin_amdgcn_s_memrealtime(); const unsigned d_ = (unsigned)(tn_ - tsub_); tsub_ = tn_; \
        unsigned* cw_ = (unsigned*)(ws + WS_CTL) + 8192 + 16 * (k); atomicMax(cw_ + l, d_); atomicAdd(cw_ + 2, d_); } } } while (0)
    unsigned long long tsub_ = (EXP >= 200) ? __builtin_amdgcn_s_memrealtime() : 0ull;
    REP(4) { mixD3(C, P, l); __syncthreads(); }
    SUBT(0);
    if (EXP == 5 && l == 0) { mixB_chunks<true>(C, ws, P.in[5] + l * 64, DRY); __syncthreads(); }
    mixB_chunks<true>(C, ws, P.in[5] + l * 64, PLP(ws, PL_BQ));
    SUBT(1);
    if (EXP == 6 && l == 0) { mixA_fast(C, ws, P.in[3] + l * 4 * 192, DRY); }
    mixA_fast(C, ws, P.in[3] + l * 4 * 192, PLP(ws, PL_AQ));
    __syncthreads();
    SUBT(2);
    if (EXP == 7 && l == 0) { mixC_fast(C, ws, DRY); __syncthreads(); }
    if (EXP == 17 && l == 0) { mixC_fast(C, ws, DRY, 1); __syncthreads(); }
    if (EXP == 18 && l == 0) { mixC_fast(C, ws, DRY, 2); __syncthreads(); }
    mixC_fast(C, ws, PLP(ws, PL_CQ));
    SUBT(3);
    GRID_BAR();
    REP(8) {
        pg8::Gemm g{(const pg8::bf16_t*)PLP(ws, 0), (const pg8::bf16_t*)(ws + WS_WBT), NTOK, 1024, 256, (size_t)PLANE, (size_t)1024 * 256 * 2};
        pg8::GroupedOrder S; S.init(NTOK, 1024, 4, C.G, C.bid);
        EpiBf E{(bf16*)(ws + WS_PB), 1024, (size_t)NTOK * 1024};
        pg8::gemm_phase<EpiBf, pg8::GroupedOrder, true, true>(C.lds, g, S, E, C.wave);
    }
    GRID_BAR();
    REP(9) {
        pg8::Gemm g{(const pg8::bf16_t*)(ws + WS_H), (const pg8::bf16_t*)(ws + WS_WGT), NTOK, 4096, 1024};
        pg8::StaticOrder S; S.init(NTOK, 4096, C.G, C.bid);
        EpiGate E{(const bf16*)(ws + WS_PB), (bf16*)(ws + WS_Y)};
        pg8::gemm_phase<EpiGate, pg8::StaticOrder, true, true>(C.lds, g, S, E, C.wave);
    }
    GRID_BAR();
    for (int rep_ = 0; rep_ < ((EXP == 10 && l == 0) ? 3 : 1); ++rep_) {
        pg8::Gemm g{(const pg8::bf16_t*)(ws + WS_Y), (const pg8::bf16_t*)(ws + WS_WOT), NTOK, 1024, 1024};
        pg8::StaticOrder S; S.init(NTOK, 1024, C.G, C.bid);
        EpiRes E{xin, P.out};
        pg8::gemm_phase<EpiRes, pg8::StaticOrder, true, true>(C.lds, g, S, E, C.wave);
    }
    GRID_BAR();
    if (l == 0) { REP(11) { norm_rows_bf16(C, P.out, P.in[1] + 1024, (bf16*)(ws + WS_H)); convert_weights(C, P, 1, 2); } GRID_BAR(); }
    else {
        OPQ(C); const int gw = C.bid * 8 + C.wave, NGW = C.G * 8;
        for (int m = gw; m < NTOK; m += NGW) rms_row(P.out + (size_t)m * 1024, P.in[18], nullptr, P.out + (size_t)m * 1024, C.lane);
    }
    if (EXP == 12) { for (int i = 0; i < 20; ++i) GRID_BAR(); }
}
__global__ void __launch_bounds__(512, 2) mega_fwd(Params P) {
    extern __shared__ __attribute__((aligned(16))) unsigned char lds_raw[];
    Ctx C; C.lds = (LAS unsigned char*)lds_raw; C.wave = __builtin_amdgcn_readfirstlane((int)threadIdx.x >> 6); C.G = gridDim.x; C.bid = blockIdx.x; OPQ(C);
    unsigned char* ws = P.ws;
    for (int u = C.tid; u < (LDS_BYTES - LDSCTL_OFF) / 4; u += 512) ((LAS unsigned*)(C.lds + LDSCTL_OFF))[u] = 0u;
    __syncthreads();
    volatile LAS unsigned* MISCW = (volatile LAS unsigned*)(C.lds + MISC_OFF);
    XcdBarrier bar = xcd_barrier_post((unsigned*)(ws + WS_CTL) + CW_BAR, MISCW + 8);
    if (EXP >= 100 && C.wave == 0 && lane_id_fresh() == 0) { volatile LAS unsigned* TSW = (volatile LAS unsigned*)(C.lds + MISC_OFF) + 12; TSW[0] = 1u; TSW[1] = (unsigned)__builtin_amdgcn_s_memrealtime(); }
    __syncthreads();
    for (int rep_ = 0; rep_ < ((EXP == 13) ? 2 : 1); ++rep_) { setup_tables(C, P); }
    for (int rep_ = 0; rep_ < ((EXP == 14) ? 2 : 1); ++rep_) { convert_weights(C, P, 0, 3); }
    for (int rep_ = 0; rep_ < ((EXP == 15) ? 2 : 1); ++rep_) { norm_rows_bf16(C, P.in[0], P.in[1], (bf16*)(ws + WS_H)); }
    GRID_BAR();
    layer_body<0>(C, P, bar);
    layer_body<1>(C, P, bar);
    if (EXP >= 100) {
        GRID_BAR();
        if (C.bid == 0 && C.wave == 0 && lane_id_fresh() == 0) {
            volatile LAS unsigned* TSW = (volatile LAS unsigned*)(C.lds + MISC_OFF) + 12;
            const int j = EXP - 100; unsigned dt;
            if (j >= 100) { const unsigned* cw_ = (const unsigned*)(P.ws + WS_CTL) + 8192 + 16 * ((j - 100) % 10);
                dt = (j < 110) ? (__hip_atomic_load(cw_, __ATOMIC_RELAXED, __HIP_MEMORY_SCOPE_AGENT) + __hip_atomic_load(cw_ + 1, __ATOMIC_RELAXED, __HIP_MEMORY_SCOPE_AGENT)) : (__hip_atomic_load(cw_ + 2, __ATOMIC_RELAXED, __HIP_MEMORY_SCOPE_AGENT) / 256u); }
            else if (j == 0) dt = TSW[2] - TSW[1];
            else if (j <= 7) dt = (TSW[2 + j] - TSW[1 + j]) + (TSW[10 + j] - TSW[9 + j]);
            else if (j == 8) dt = (TSW[10] - TSW[9]);
            else dt = (TSW[18] - TSW[17]);
            const unsigned long long t0 = __builtin_amdgcn_s_memrealtime();
            while (__builtin_amdgcn_s_memrealtime() - t0 < 10ull * dt) __builtin_amdgcn_s_sleep(8);
        }
    }
}

extern "C" void kernel_launch(void* const* d_in, const int* in_sizes, int n_in, void* d_out, int out_size, void* d_ws, size_t ws_size, hipStream_t stream) {
    static int grid = 0;
    if (grid == 0) {
        if (n_in != 19 || ws_size < WS_END) { fprintf(stderr, "kernel_launch: need 19 inputs and %zu bytes of workspace (got %d, %zu)\n", (size_t)WS_END, n_in, ws_size); grid = -1; return; }
        int dev = 0, cus = 0, per_cu = 0;
        if (hipGetDevice(&dev) != hipSuccess || hipDeviceGetAttribute(&cus, hipDeviceAttributeMultiprocessorCount, dev) != hipSuccess) { grid = -1; return; }
        if (hipFuncSetAttribute((const void*)mega_fwd, hipFuncAttributeMaxDynamicSharedMemorySize, LDS_BYTES) != hipSuccess) { grid = -1; return; }
        (void)hipOccupancyMaxActiveBlocksPerMultiprocessor(&per_cu, (const void*)mega_fwd, 512, LDS_BYTES);
        (void)hipGetLastError();
        grid = cus;
    }
    if (grid < 0) return;
    if (hipMemsetAsync((char*)d_ws + WS_CTL, 0, CTL_ZERO_BYTES, stream) != hipSuccess) return;
    Params p{};
    for (int i = 0; i < 19; ++i) p.in[i] = (const float*)d_in[i];
    p.out = (float*)d_out; p.ws = (unsigned char*)d_ws;
    hipLaunchKernelGGL(mega_fwd, dim3(grid), dim3(512), LDS_BYTES, stream, p);
}
```

```cpp
#define EXP 0
#include <hip/hip_runtime.h>
#include <cstdio>
#include <cstdint>
#include <math.h>

#define DM 1024
#define SEQ 4096
#define NBATCH 8
#define NTOK (NBATCH * SEQ)
#define INC 8904
#define C_AQ 0
#define C_AK 256
#define C_AV 512
#define C_AZ 768
#define C_BQ 1024
#define C_BF 1280
#define C_BI 1536
#define C_BZ 1792
#define C_CQ 2048
#define C_CK 2304
#define C_CV 2560
#define C_CZ 2816
#define C_CQI 3072
#define C_CKI 3584
#define C_CWI 3648
#define C_PD 3656
#define C_DR 3656
#define C_DK 3912
#define C_DV 4168
#define C_DWD 4424
#define C_DAD 4488
#define C_DZ 4552
#define C_PG 4808
#define NG1 4864

namespace pg8 {
#define PG8_LAS __attribute__((address_space(3)))
typedef unsigned short bf16_t;
typedef short bf16x8 __attribute__((ext_vector_type(8)));
typedef float f32x4 __attribute__((ext_vector_type(4)));
typedef unsigned u32x4 __attribute__((ext_vector_type(4)));
constexpr int BM = 256, BK = 64, HALF = 128, HTB = HALF * BK * 2  , STAGE_BYTES = 8 * HTB, NXCD = 8, WGM = 8;

__host__ __device__ __forceinline__ int lds_byte(int r, int c) { const int st = (r >> 4) * 2 + (c >> 5), rr = r & 15, cc = c & 31, ob = rr * 64 + cc * 2; return st * 1024 + (ob ^ (((ob >> 9) & 1) << 5)); }
__host__ __device__ __forceinline__ void stage_rc(int b, int& R, int& C) { const int st = b / 1024, sb = b % 1024, swz = sb ^ (((sb >> 9) & 1) << 5); R = (st >> 1) * 16 + swz / 64; C = (st & 1) * 32 + (swz % 64) / 2; }
__host__ __device__ __forceinline__ int perm32(int rho) { const int n = rho >> 4, i = rho & 15; return 8 * (i >> 2) + 4 * n + (i & 3); }

struct Unit { int pm, pn; int grp; };
struct Gemm { const bf16_t* A; const bf16_t* Bt; int M, N, K; size_t a_grp = 0, b_grp = 0; };

struct StaticOrder {
    int nM, nN, nwg, G, c;
    __host__ __device__ void init(int M, int N, int G_, int c_) { nM = M / BM; nN = N / BM; nwg = nM * nN; G = G_; c = c_; }
    __host__ __device__ bool next(int i, Unit& u) const {
        const long L = (long)i * G + c; if (L >= nwg) return false;
        int wgid = (int)L; { const int q = nwg / NXCD, r = nwg % NXCD, xcd = wgid % NXCD, off = wgid / NXCD; wgid = (xcd < r ? xcd * (q + 1) : r * (q + 1) + (xcd - r) * q) + off; }
        const int nig = WGM * nN, gid = wgid / nig, fm = gid * WGM, gsz = (nM - fm) < WGM ? (nM - fm) : WGM;
        u.pm = fm + ((wgid % nig) % gsz); u.pn = (wgid % nig) / gsz; u.grp = 0; return true;
    }
    __device__ __forceinline__ void a_ready(const Unit&) const {}
    __device__ __forceinline__ void done(const Unit&) const {}
};
struct GroupedOrder {
    StaticOrder so; int ngrp;
    __host__ __device__ void init(int M, int N, int ngrp_, int G_, int c_) { so.init(M, N, G_, c_); ngrp = ngrp_; }
    __host__ __device__ bool next(int i, Unit& u) const {
        const long L = (long)i * so.G + so.c; if (L >= (long)ngrp * so.nwg) return false;
        const int grp = (int)(L / so.nwg), loc = (int)(L % so.nwg);
        StaticOrder t = so; t.c = loc; t.G = so.nwg;
        t.next(0, u); u.grp = grp; return true;
    }
    __device__ __forceinline__ void a_ready(const Unit&) const {}
    __device__ __forceinline__ void done(const Unit&) const {}
};

__device__ __forceinline__ unsigned cvt_pk_bf16(float lo, float hi) { unsigned r; asm volatile("v_cvt_pk_bf16_f32 %0, %1, %2" : "=v"(r) : "v"(lo), "v"(hi)); return r; }
template <class Epi, class Sched, bool ALIGN_EPI = false, bool SP2 = false>
__device__ __forceinline__ void gemm_phase(PG8_LAS unsigned char* lds, const Gemm g, const Sched& S, const Epi& E, const int wave_in) {
    int lane_; asm volatile("v_mbcnt_lo_u32_b32 %0, -1, 0\n\tv_mbcnt_hi_u32_b32 %0, -1, %0" : "=v"(lane_));
    const int wid = wave_in, lane = lane_, tid = wid * 64 + lane, wr = wid >> 2, wc = wid & 3, fr = lane & 15, fq = lane >> 4;
    const int K = g.K, nt = K / BK;
    unsigned voffA[2], voffB[2];
#pragma unroll
    for (int i = 0; i < 2; ++i) { int R, C; stage_rc(tid * 16 + i * 8192, R, C); const int Rb = Epi::PERM ? ((R & ~31) + perm32(R & 31)) : R;
        voffA[i] = (unsigned)(R * K + C) * 2u; voffB[i] = (unsigned)(Rb * K + C) * 2u; }
    const size_t kstep = (size_t)(BK * 2);
    const size_t hstep = (size_t)HALF * K * 2;
    const size_t tstep = 2 * hstep;
    const unsigned ldsw = (unsigned)wid * 1024u;
    const int aoff = lds_byte(wr * 64 + fr, fq * 8), boff = lds_byte(wc * 32 + fr, fq * 8);
#define PG8_SA(b, h) (((b) * 2 + (h)) * HTB)
#define PG8_SB(b, h) ((4 + (b) * 2 + (h)) * HTB)
#define PG8_STAGE(bufoff, gbase, voff) do { _Pragma("unroll") for (int _i = 0; _i < 2; ++_i) \
        __builtin_amdgcn_global_load_lds((const unsigned*)((const char*)(gbase) + (voff)[_i]), (PG8_LAS unsigned*)(lds + (bufoff) + ldsw + _i * 8192), 16, 0, 0); } while (0)
#define PG8_LDA(dst, b, h) do { _Pragma("unroll") for (int m = 0; m < 4; ++m) _Pragma("unroll") for (int k = 0; k < 2; ++k) dst[m][k] = *(const PG8_LAS bf16x8*)(lds + PG8_SA(b, h) + aoff + m * 2048 + k * 1024); } while (0)
#define PG8_LDB(dst, b, h) do { _Pragma("unroll") for (int n = 0; n < 2; ++n) _Pragma("unroll") for (int k = 0; k < 2; ++k) dst[n][k] = *(const PG8_LAS bf16x8*)(lds + PG8_SB(b, h) + boff + n * 2048 + k * 1024); } while (0)
#define PG8_MMA(ai, bj, At, Bt) do { __builtin_amdgcn_s_setprio(1); _Pragma("unroll") for (int m = 0; m < 4; ++m) _Pragma("unroll") for (int n = 0; n < 2; ++n) _Pragma("unroll") for (int k = 0; k < 2; ++k) \
        acc[ai][bj][m][n] = __builtin_amdgcn_mfma_f32_16x16x32_bf16(Bt[n][k], At[m][k], acc[ai][bj][m][n], 0, 0, 0); __builtin_amdgcn_s_setprio(0); } while (0)
#define PG8_WAIT_V(n) asm volatile("s_waitcnt vmcnt(" #n ")" ::: "memory")
#define PG8_WAIT_L(n) asm volatile("s_waitcnt lgkmcnt(" #n ")" ::: "memory")
#define PG8_BAR __builtin_amdgcn_s_barrier()
#define PG8_SCHED __builtin_amdgcn_sched_barrier(0)
    Unit cur, nxt; int ui = 0;
    if (!S.next(0, cur)) return;
    f32x4 acc[2][2][4][2];
#pragma unroll
    for (int a = 0; a < 2; ++a)
#pragma unroll
        for (int b = 0; b < 2; ++b)
#pragma unroll
            for (int m = 0; m < 4; ++m)
#pragma unroll
                for (int n = 0; n < 2; ++n) acc[a][b][m][n] = (f32x4){0.f, 0.f, 0.f, 0.f};
    bf16x8 At[4][2], B0[2][2], B1[2][2];
    const char* cA = (const char*)g.A + (size_t)cur.grp * g.a_grp + (size_t)cur.pm * tstep; const char* cB = (const char*)g.Bt + (size_t)cur.grp * g.b_grp + (size_t)cur.pn * tstep;
    S.a_ready(cur);
    if constexpr (SP2) {
        PG8_STAGE(PG8_SB(0, 0), cB, voffB); PG8_STAGE(PG8_SB(0, 1), cB + hstep, voffB); PG8_STAGE(PG8_SA(0, 0), cA, voffA); PG8_STAGE(PG8_SA(0, 1), cA + hstep, voffA);
        if (wr == 1) PG8_BAR;
        PG8_WAIT_V(2); PG8_BAR;
        PG8_STAGE(PG8_SB(1, 0), cB + kstep, voffB); PG8_STAGE(PG8_SA(1, 0), cA + kstep, voffA); PG8_STAGE(PG8_SB(1, 1), cB + hstep + kstep, voffB);
        PG8_WAIT_V(6); PG8_BAR;
    } else {
        PG8_STAGE(PG8_SB(0, 0), cB, voffB); PG8_STAGE(PG8_SA(0, 0), cA, voffA); PG8_STAGE(PG8_SB(0, 1), cB + hstep, voffB); PG8_STAGE(PG8_SA(0, 1), cA + hstep, voffA);
        if (wr == 1) PG8_BAR;
        PG8_WAIT_V(4); PG8_BAR;
        PG8_STAGE(PG8_SB(1, 0), cB + kstep, voffB); PG8_STAGE(PG8_SA(1, 0), cA + kstep, voffA); PG8_STAGE(PG8_SB(1, 1), cB + hstep + kstep, voffB);
        PG8_WAIT_V(6); PG8_BAR;
    }
    for (;;) {
        const bool has_next = S.next(ui + 1, nxt);
        const char* nA = has_next ? (const char*)g.A + (size_t)nxt.grp * g.a_grp + (size_t)nxt.pm * tstep : cA; const char* nB = has_next ? (const char*)g.Bt + (size_t)nxt.grp * g.b_grp + (size_t)nxt.pn * tstep : cB;
        for (int t = 0; t < nt; t += 2) {
            const bool last = (t == nt - 2);
            const char* a1 = cA + (size_t)(t + 1) * kstep;
            const char* a2 = last ? nA : cA + (size_t)(t + 2) * kstep; const char* b2 = last ? nB : cB + (size_t)(t + 2) * kstep;
            const char* a3 = a2 + kstep; const char* b3 = b2 + kstep;
            if (last && has_next) S.a_ready(nxt);
            if constexpr (SP2) {
            PG8_LDB(B0, 0, 0); PG8_LDB(B1, 0, 1); PG8_SCHED; PG8_LDA(At, 0, 0); PG8_STAGE(PG8_SA(1, 1), a1 + hstep, voffA);
            PG8_WAIT_V(8); PG8_WAIT_L(0); PG8_BAR; PG8_MMA(0, 0, At, B0); PG8_MMA(0, 1, At, B1); PG8_BAR; PG8_SCHED;
            PG8_LDA(At, 0, 1); PG8_STAGE(PG8_SB(0, 0), b2, voffB); PG8_STAGE(PG8_SB(0, 1), b2 + hstep, voffB); PG8_STAGE(PG8_SA(0, 0), a2, voffA);
            PG8_WAIT_V(8); PG8_WAIT_L(0); PG8_BAR; PG8_MMA(1, 0, At, B0); PG8_MMA(1, 1, At, B1); PG8_BAR; PG8_SCHED;
            PG8_LDB(B0, 1, 0); PG8_LDB(B1, 1, 1); PG8_SCHED; PG8_LDA(At, 1, 0); PG8_STAGE(PG8_SA(0, 1), a2 + hstep, voffA);
            PG8_WAIT_V(8); PG8_WAIT_L(0); PG8_BAR; PG8_MMA(0, 0, At, B0); PG8_MMA(0, 1, At, B1); PG8_BAR; PG8_SCHED;
            PG8_LDA(At, 1, 1); PG8_STAGE(PG8_SB(1, 0), b3, voffB); PG8_STAGE(PG8_SB(1, 1), b3 + hstep, voffB); PG8_STAGE(PG8_SA(1, 0), a3, voffA);
            PG8_WAIT_V(8); PG8_WAIT_L(0); PG8_BAR; PG8_MMA(1, 0, At, B0); PG8_MMA(1, 1, At, B1); PG8_BAR; PG8_SCHED;
            } else {
            PG8_LDB(B0, 0, 0); PG8_SCHED; PG8_LDA(At, 0, 0); PG8_STAGE(PG8_SA(1, 1), a1 + hstep, voffA);
            PG8_WAIT_L(8); PG8_BAR; PG8_WAIT_L(0); PG8_MMA(0, 0, At, B0); PG8_BAR; PG8_SCHED;
            PG8_LDB(B1, 0, 1); PG8_STAGE(PG8_SB(0, 0), b2, voffB);
            PG8_BAR; PG8_WAIT_L(0); PG8_MMA(0, 1, At, B1); PG8_BAR;
            PG8_LDA(At, 0, 1); PG8_STAGE(PG8_SA(0, 0), a2, voffA);
            PG8_BAR; PG8_WAIT_L(0); PG8_MMA(1, 0, At, B0); PG8_BAR; PG8_SCHED;
            PG8_STAGE(PG8_SB(0, 1), b2 + hstep, voffB);
            PG8_WAIT_V(6); PG8_BAR; PG8_MMA(1, 1, At, B1); PG8_BAR;
            PG8_LDB(B0, 1, 0); PG8_SCHED; PG8_LDA(At, 1, 0); PG8_STAGE(PG8_SA(0, 1), a2 + hstep, voffA);
            PG8_WAIT_L(8); PG8_BAR; PG8_WAIT_L(0); PG8_MMA(0, 0, At, B0); PG8_BAR; PG8_SCHED;
            PG8_LDB(B1, 1, 1); PG8_STAGE(PG8_SB(1, 0), b3, voffB);
            PG8_BAR; PG8_WAIT_L(0); PG8_MMA(0, 1, At, B1); PG8_BAR;
            PG8_LDA(At, 1, 1); PG8_STAGE(PG8_SA(1, 0), a3, voffA);
            PG8_BAR; PG8_WAIT_L(0); PG8_MMA(1, 0, At, B0); PG8_BAR; PG8_SCHED;
            PG8_STAGE(PG8_SB(1, 1), b3 + hstep, voffB);
            PG8_WAIT_V(6); PG8_BAR; PG8_MMA(1, 1, At, B1); PG8_BAR;
            }
        }
        if constexpr (ALIGN_EPI) { if (wr == 0) PG8_BAR; }
        if constexpr (!Epi::AFTER_DRAIN) { E(acc, cur, wr, wc, fr, fq); S.done(cur); }
        if (!has_next) break;
#pragma unroll
        for (int a = 0; a < 2; ++a)
#pragma unroll
            for (int b = 0; b < 2; ++b)
#pragma unroll
                for (int m = 0; m < 4; ++m)
#pragma unroll
                    for (int n = 0; n < 2; ++n) acc[a][b][m][n] = (f32x4){0.f, 0.f, 0.f, 0.f};
        cur = nxt; cA = nA; cB = nB; ++ui;
        if constexpr (ALIGN_EPI) { if (wr == 1) PG8_BAR; }
    }
    PG8_WAIT_V(0);
    if constexpr (!ALIGN_EPI) { if (wr == 0) PG8_BAR; }
    PG8_BAR;
    if constexpr (Epi::AFTER_DRAIN) { E.fused(acc, cur, wr, wc, fr, fq, lds, wid, lane); S.done(cur); }
#undef PG8_SA
#undef PG8_SB
#undef PG8_STAGE
#undef PG8_LDA
#undef PG8_LDB
#undef PG8_MMA
#undef PG8_WAIT_V
#undef PG8_WAIT_L
#undef PG8_BAR
#undef PG8_SCHED
}
}

#define GAS __attribute__((address_space(1)))
#define LAS __attribute__((address_space(3)))
typedef unsigned short bf16;
typedef unsigned v4u __attribute__((ext_vector_type(4)));
typedef unsigned v2u __attribute__((ext_vector_type(2)));
typedef float f32x4 __attribute__((ext_vector_type(4)));
typedef GAS unsigned gu32;
#define RLX_AGENT __ATOMIC_RELAXED, __HIP_MEMORY_SCOPE_AGENT
#define LDS_WAIT() asm volatile("s_waitcnt lgkmcnt(0)" ::: "memory")
#define VM_WAIT() asm volatile("s_waitcnt vmcnt(0)" ::: "memory")
__device__ __forceinline__ unsigned f2bf(float f) { unsigned u = __builtin_bit_cast(unsigned, f); return (u + 0x7fffu + ((u >> 16) & 1u)) >> 16; }
typedef float f32x2_t_ __attribute__((ext_vector_type(2))); typedef __bf16 bf16x2_t_ __attribute__((ext_vector_type(2)));
__device__ __forceinline__ unsigned pk2(float lo, float hi) { const f32x2_t_ v = {lo, hi}; const bf16x2_t_ b = __builtin_convertvector(v, bf16x2_t_); return __builtin_bit_cast(unsigned, b); }
__device__ __forceinline__ float bf2f(unsigned short b) { return __builtin_bit_cast(float, (unsigned)b << 16); }
__device__ __forceinline__ float bflo(unsigned w) { return __builtin_bit_cast(float, w << 16); }
__device__ __forceinline__ float bfhi(unsigned w) { return __builtin_bit_cast(float, w & 0xffff0000u); }
__device__ __forceinline__ float sigmoidf_(float x) { return 1.f / (1.f + expf(-x)); }
__device__ __forceinline__ float fsig(float x) { return __builtin_amdgcn_rcpf(1.f + __builtin_amdgcn_exp2f(-1.4426950408889634f * x)); }
__device__ __forceinline__ float siluf_(float x) { return x / (1.f + expf(-x)); }
__device__ __forceinline__ float dppf(float x, const int sel) {
    const int xi = __builtin_bit_cast(int, x); int r;
    if (sel == 0) r = __builtin_amdgcn_update_dpp(xi, xi, 0xB1, 0xF, 0xF, false);
    else if (sel == 1) r = __builtin_amdgcn_update_dpp(xi, xi, 0x4E, 0xF, 0xF, false);
    else if (sel == 2) r = __builtin_amdgcn_update_dpp(xi, xi, 0x141, 0xF, 0xF, false);
    else if (sel == 3) r = __builtin_amdgcn_update_dpp(xi, xi, 0x140, 0xF, 0xF, false);
    else r = __builtin_amdgcn_update_dpp(xi, xi, 0x128, 0xF, 0xF, false);
    return __builtin_bit_cast(float, r);
}
__device__ __forceinline__ float swz16f(float x) { return __builtin_bit_cast(float, __builtin_amdgcn_ds_swizzle(__builtin_bit_cast(int, x), 0x401F)); }
__device__ __forceinline__ float xh_sum(float x) { auto rr = __builtin_amdgcn_permlane32_swap(__float_as_uint(x), __float_as_uint(x), false, false); return __uint_as_float(rr[0]) + __uint_as_float(rr[1]); }
__device__ __forceinline__ float xh_max(float x) { auto rr = __builtin_amdgcn_permlane32_swap(__float_as_uint(x), __float_as_uint(x), false, false); return fmaxf(__uint_as_float(rr[0]), __uint_as_float(rr[1])); }
__device__ __forceinline__ unsigned xh_or(unsigned x) { auto rr = __builtin_amdgcn_permlane32_swap(x, x, false, false); return rr[0] | rr[1]; }
__device__ __forceinline__ float wave_sum(float v) {
    v += dppf(v, 0); v += dppf(v, 1); v += dppf(v, 2); v += dppf(v, 3); v += swz16f(v); return xh_sum(v);
}
__device__ __forceinline__ float wave_max(float v) {
    v = fmaxf(v, dppf(v, 0)); v = fmaxf(v, dppf(v, 1)); v = fmaxf(v, dppf(v, 2)); v = fmaxf(v, dppf(v, 3)); v = fmaxf(v, swz16f(v)); return xh_max(v);
}

constexpr size_t MiB = 1u << 20;
constexpr size_t WS_CTL = 0, CTL_ZERO_BYTES = 1 * MiB;
constexpr size_t WS_COS = 1 * MiB, WS_SIN = 1 * MiB + 512 * 1024;
constexpr size_t WS_LB = 2 * MiB;
constexpr size_t WS_DBON = 3 * MiB;
constexpr size_t WS_DAB = 4 * MiB;
constexpr size_t WS_DSS = 12 * MiB;
constexpr size_t WS_W1T = 16 * MiB;
constexpr size_t WS_WGT = 26 * MiB;
constexpr size_t WS_WBT = 34 * MiB;
constexpr size_t WS_WOT = 36 * MiB;
constexpr size_t WS_KI = 38 * MiB;
constexpr size_t WS_H = 42 * MiB;
constexpr size_t WS_PL = 106 * MiB;
constexpr size_t PLANE = 16 * MiB;
constexpr size_t WS_BF = WS_PL + 17 * PLANE;
constexpr size_t WS_MISC = WS_BF + 32 * MiB;
constexpr size_t WS_OL = WS_MISC + 32 * MiB;
constexpr size_t WS_CC = WS_OL + 16 * MiB;
constexpr size_t WS_BS = WS_CC + 16 * MiB;
constexpr size_t WS_BG = WS_BS + 32 * MiB;
constexpr size_t WS_END = WS_BG + 1 * MiB;
constexpr size_t WS_Y = WS_PL;
constexpr size_t WS_PB = WS_PL + 4 * PLANE;
static_assert(WS_PB + (size_t)4 * NTOK * 1024 * 2 <= WS_OL, "P_b overlay");
enum { PL_AQ = 0, PL_BQ = 1, PL_CQ = 2, PL_DR = 3, PL_AK = 4, PL_AV = 5, PL_AZ = 6, PL_BI = 7, PL_BZ = 8, PL_CK = 9, PL_CV = 10, PL_CZ = 11, PL_CQI0 = 12, PL_CQI1 = 13, PL_DK = 14, PL_DV = 15, PL_DZ = 16 };
#define PLP(ws, i) ((bf16*)((ws) + WS_PL + (size_t)(i) * PLANE))
constexpr int CW_BAR = 4096;

constexpr int RING_BYTES = 131072;
constexpr int LDSCTL_OFF = RING_BYTES, MISC_OFF = LDSCTL_OFF + 320;
constexpr int LDS_BYTES = 147456;

__device__ __forceinline__ int rope_j(int head, int dim) {
    const int bj = head >> 1, wc = ((head & 1) << 1) | ((dim >> 4) & 1), n = dim >> 5, fq = (dim >> 2) & 3, i = dim & 3;
    return 128 * bj + 32 * wc + 16 * n + 4 * fq + i;
}
__device__ __forceinline__ int win_dst_row(int c, int& which) {
    which = 0;
    if (c < 2048) return c;
    if (c < 2304) { const int l = c - 2048; return 8 * 256 + rope_j(l >> 6, l & 63); }
    if (c < 2560) { const int l = c - 2304; return 9 * 256 + rope_j(l >> 6, l & 63); }
    if (c < 3072) return c;
    if (c < 3584) { const int l = c - 3072; return (12 + (l >> 8)) * 256 + rope_j((l >> 6) & 3, l & 63); }
    if (c < 3648) return 14 * 256 + rope_j(0, c - 3584);
    if (c < 3656) return 14 * 256 + 64 + (c - 3648);
    if (c < 3912) return 15 * 256 + (c - 3656);
    if (c < 4168) return 16 * 256 + (c - 3912);
    if (c < 4424) return 17 * 256 + (c - 4168);
    if (c < 4488) return 14 * 256 + 72 + (c - 4424);
    if (c < 4552) return 14 * 256 + 136 + (c - 4488);
    if (c < 4808) return 18 * 256 + (c - 4552);
    which = 1;
    { const int g = c - 4808, br = g >> 10, y = g & 1023, pn = y >> 6, wc = (y >> 4) & 3, fq = (y >> 2) & 3, i = y & 3;
      return 256 * pn + 128 * (br >> 1) + 32 * wc + 16 * (br & 1) + 4 * fq + i; }
}

__device__ __forceinline__ size_t kfrag_off(int bh, int t, int d) { return ((((size_t)bh * 128 + (t >> 5)) * 4 + (d >> 4)) * 64 + ((t & 31) + 32 * ((d >> 3) & 1))) * 8 + (d & 7); }
__device__ __forceinline__ size_t vfrag_off(int bh, int t, int d) { const int kk = t & 31, r16 = kk & 15;
    return (((((size_t)bh * 128 + (t >> 5)) * 2 + (d >> 5)) * 2 + (kk >> 4)) * 64 + ((d & 31) + 32 * ((r16 >> 2) & 1))) * 8 + 4 * (r16 >> 3) + (r16 & 3); }

struct EpiG1 {
    static constexpr bool PERM = false, AFTER_DRAIN = false;
    unsigned char* ws; const float* lbl;
    __device__ __forceinline__ void operator()(const f32x4 (&acc)[2][2][4][2], const pg8::Unit& u, int wr, int wc, int fr, int fq) const {
        asm volatile("" : "+v"(fr), "+v"(fq));
        const int pn = u.pn;
        const int rbase = u.pm * 256 + wr * 64 + fr;
        const int cq = wc * 32 + 4 * fq;
        if (pn == 5) {
            float* BF = (float*)(ws + WS_BF);
#pragma unroll
            for (int bj = 0; bj < 2; ++bj)
#pragma unroll
                for (int n = 0; n < 2; ++n) {
                    const int col = cq + bj * 128 + n * 16;
                    const f32x4 l4 = *(const f32x4*)(lbl + col);
#pragma unroll
                    for (int ai = 0; ai < 2; ++ai)
#pragma unroll
                        for (int m = 0; m < 4; ++m) {
                            const f32x4 x = acc[ai][bj][m][n]; f32x4 o;
#pragma unroll
                            for (int i = 0; i < 4; ++i) o[i] = 1.f - (1.f - l4[i]) * fsig(-x[i]);
                            *(f32x4*)(BF + (size_t)(rbase + ai * 128 + m * 16) * 256 + col) = o;
                            asm volatile("" ::: "memory");
                        }
                }
        } else if (pn == 14) {
            float* MS = (float*)(ws + WS_MISC);
            const float* tcos = (const float*)(ws + WS_COS); const float* tsin = (const float*)(ws + WS_SIN);
#pragma unroll
            for (int bj = 0; bj < 2; ++bj) {
                if (bj == 0 && wc < 2) {
                    const int d0 = 16 * (wc & 1) + 4 * fq;
#pragma unroll
                    for (int ai = 0; ai < 2; ++ai)
#pragma unroll
                        for (int m = 0; m < 4; ++m) {
                            const int row = rbase + ai * 128 + m * 16, pos = row & (SEQ - 1);
                            const f32x4 c4 = *(const f32x4*)(tcos + pos * 32 + d0), s4 = *(const f32x4*)(tsin + pos * 32 + d0);
                            const f32x4 x1 = acc[ai][0][m][0], x2 = acc[ai][0][m][1];
                            const f32x4 y1 = x1 * c4 - x2 * s4, y2 = x2 * c4 + x1 * s4;
                            *(f32x4*)(MS + (size_t)row * 256 + d0) = y1;
                            *(f32x4*)(MS + (size_t)row * 256 + 32 + d0) = y2;
                            bf16* KIp = (bf16*)(ws + WS_KI);
                            v2u w1, w2; w1.x = pk2(y1[0], y1[1]); w1.y = pk2(y1[2], y1[3]); w2.x = pk2(y2[0], y2[1]); w2.y = pk2(y2[2], y2[3]);
                            *(v2u*)(KIp + kfrag_off(row >> 12, pos, d0)) = w1; *(v2u*)(KIp + kfrag_off(row >> 12, pos, 32 + d0)) = w2;
                            asm volatile("" ::: "memory");
                        }
                } else {
#pragma unroll
                    for (int n = 0; n < 2; ++n)
#pragma unroll
                        for (int ai = 0; ai < 2; ++ai)
#pragma unroll
                            for (int m = 0; m < 4; ++m)
                                *(f32x4*)(MS + (size_t)(rbase + ai * 128 + m * 16) * 256 + cq + bj * 128 + n * 16) = acc[ai][bj][m][n];
                }
            }
        } else {
            const unsigned long long lo = 0ull | (0ull << 0) | (4ull << 5) | (5ull << 10) | (6ull << 15) | (1ull << 20) | (0ull << 25) | (7ull << 30) | (8ull << 35) | (2ull << 40) | (9ull << 45) | (10ull << 50) | (11ull << 55);
            const unsigned long long hi = (12ull << 0) | (13ull << 5) | (0ull << 10) | (3ull << 15) | (14ull << 20) | (15ull << 25) | (16ull << 30);
            const int plane = (int)((pn < 12 ? (lo >> (5 * pn)) : (hi >> (5 * (pn - 12)))) & 31ull);
            bf16* PLN = PLP(ws, plane);
            if (pn == 8 || pn == 9 || pn == 12 || pn == 13) {
                const float* tcos = (const float*)(ws + WS_COS); const float* tsin = (const float*)(ws + WS_SIN);
                const int d0 = 16 * (wc & 1) + 4 * fq;
#pragma unroll
                for (int ai = 0; ai < 2; ++ai)
#pragma unroll
                    for (int m = 0; m < 4; ++m) {
                        const int row = rbase + ai * 128 + m * 16, pos = row & (SEQ - 1);
                        const f32x4 c4 = *(const f32x4*)(tcos + pos * 32 + d0), s4 = *(const f32x4*)(tsin + pos * 32 + d0);
#pragma unroll
                        for (int bj = 0; bj < 2; ++bj) {
                            const int head = 2 * bj + (wc >> 1);
                            const f32x4 x1 = acc[ai][bj][m][0], x2 = acc[ai][bj][m][1];
                            const f32x4 y1 = x1 * c4 - x2 * s4, y2 = x2 * c4 + x1 * s4;
                            v2u w1, w2; w1.x = pk2(y1[0], y1[1]); w1.y = pk2(y1[2], y1[3]); w2.x = pk2(y2[0], y2[1]); w2.y = pk2(y2[2], y2[3]);
                            if (pn == 9) {
                                const int bh = (row >> 12) * 4 + head;
                                *(v2u*)(PLN + kfrag_off(bh, pos, d0)) = w1; *(v2u*)(PLN + kfrag_off(bh, pos, 32 + d0)) = w2;
                            } else {
                                *(v2u*)(PLN + (size_t)row * 256 + head * 64 + d0) = w1;
                                *(v2u*)(PLN + (size_t)row * 256 + head * 64 + 32 + d0) = w2;
                            }
                        }
                        asm volatile("" ::: "memory");
                    }
            } else if (pn == 2 || pn == 10) {
#pragma unroll
                for (int ai = 0; ai < 2; ++ai)
#pragma unroll
                    for (int m = 0; m < 4; ++m) {
                        const int row = rbase + ai * 128 + m * 16, bb = row >> 12, tq = row & (SEQ - 1);
#pragma unroll
                        for (int bj = 0; bj < 2; ++bj)
#pragma unroll
                            for (int n = 0; n < 2; ++n) {
                                const f32x4 x = acc[ai][bj][m][n]; const int col = cq + bj * 128 + n * 16;
                                bf16* p = PLN + vfrag_off(bb * 4 + (col >> 6), tq, col & 63);
#pragma unroll
                                for (int i = 0; i < 4; ++i) p[8 * i] = (bf16)f2bf(x[i]);
                            }
                        asm volatile("" ::: "memory");
                    }
            } else if (pn == 1) {
#pragma unroll
                for (int ai = 0; ai < 2; ++ai)
#pragma unroll
                    for (int m = 0; m < 4; ++m) {
                        const int row = rbase + ai * 128 + m * 16, bb = row >> 12, tq = row & (SEQ - 1);
#pragma unroll
                        for (int bj = 0; bj < 2; ++bj)
#pragma unroll
                            for (int n = 0; n < 2; ++n) {
                                const f32x4 x = acc[ai][bj][m][n]; const int col = cq + bj * 128 + n * 16;
                                v2u w; w.x = pk2(x[0], x[1]); w.y = pk2(x[2], x[3]);
                                *(v2u*)(PLN + kfrag_off(bb * 4 + (col >> 6), tq, col & 63)) = w;
                            }
                        asm volatile("" ::: "memory");
                    }
            } else if (pn == 4) {
#pragma unroll
                for (int ai = 0; ai < 2; ++ai)
#pragma unroll
                    for (int m = 0; m < 4; ++m) {
                        bf16* rowp = PLN + (size_t)(rbase + ai * 128 + m * 16) * 256 + cq;
#pragma unroll
                        for (int bj = 0; bj < 2; ++bj)
#pragma unroll
                            for (int n = 0; n < 2; ++n) {
                                f32x4 x = acc[ai][bj][m][n];
#pragma unroll
                                for (int i = 0; i < 4; ++i) x[i] = x[i] * fsig(x[i]);
                                v2u w; w.x = pk2(x[0], x[1]); w.y = pk2(x[2], x[3]);
                                *(v2u*)(rowp + bj * 128 + n * 16) = w;
                            }
                        asm volatile("" ::: "memory");
                    }
            } else {
#pragma unroll
                for (int ai = 0; ai < 2; ++ai)
#pragma unroll
                    for (int m = 0; m < 4; ++m) {
                        bf16* rowp = PLN + (size_t)(rbase + ai * 128 + m * 16) * 256 + cq;
#pragma unroll
                        for (int bj = 0; bj < 2; ++bj)
#pragma unroll
                            for (int n = 0; n < 2; ++n) {
                                const f32x4 x = acc[ai][bj][m][n];
                                v2u w; w.x = pk2(x[0], x[1]); w.y = pk2(x[2], x[3]);
                                *(v2u*)(rowp + bj * 128 + n * 16) = w;
                            }
                        asm volatile("" ::: "memory");
                    }
            }
        }
    }
};
struct EpiBf {
    static constexpr bool PERM = false, AFTER_DRAIN = false;
    bf16* O; int ldc; size_t o_grp;
    __device__ __forceinline__ void operator()(const f32x4 (&acc)[2][2][4][2], const pg8::Unit& u, int wr, int wc, int fr, int fq) const {
        asm volatile("" : "+v"(fr), "+v"(fq));
        const int rbase = u.pm * 256 + wr * 64 + fr, cb = u.pn * 256 + wc * 32 + 4 * fq;
#pragma unroll
        for (int ai = 0; ai < 2; ++ai)
#pragma unroll
            for (int m = 0; m < 4; ++m) {
                bf16* rowp = O + (size_t)u.grp * o_grp + (size_t)(rbase + ai * 128 + m * 16) * ldc + cb;
#pragma unroll
                for (int bj = 0; bj < 2; ++bj)
#pragma unroll
                    for (int n = 0; n < 2; ++n) { const f32x4 x = acc[ai][bj][m][n]; v2u w; w.x = pk2(x[0], x[1]); w.y = pk2(x[2], x[3]); *(v2u*)(rowp + bj * 128 + n * 16) = w; }
            }
    }
};
struct EpiGate {
    static constexpr bool PERM = false, AFTER_DRAIN = false;
    const bf16* PB; bf16* Y;
    __device__ __forceinline__ void operator()(const f32x4 (&acc)[2][2][4][2], const pg8::Unit& u, int wr, int wc, int fr, int fq) const {
        asm volatile("" : "+v"(fr), "+v"(fq));
        const int rbase = u.pm * 256 + wr * 64 + fr, yc = u.pn * 64 + wc * 16 + 4 * fq;
#pragma unroll
        for (int ai = 0; ai < 2; ++ai)
#pragma unroll
            for (int m = 0; m < 4; ++m) {
                const size_t row = (size_t)(rbase + ai * 128 + m * 16);
                f32x4 y = (f32x4){0.f, 0.f, 0.f, 0.f};
#pragma unroll
                for (int br = 0; br < 4; ++br) {
                    const v2u pw = *(const v2u*)(PB + ((size_t)br * NTOK + row) * 1024 + yc);
                    const f32x4 g = acc[ai][br >> 1][m][br & 1];
                    y[0] += bflo(pw.x) * fsig(g[0]); y[1] += bfhi(pw.x) * fsig(g[1]);
                    y[2] += bflo(pw.y) * fsig(g[2]); y[3] += bfhi(pw.y) * fsig(g[3]);
                }
                v2u w; w.x = pk2(y[0], y[1]); w.y = pk2(y[2], y[3]);
                *(v2u*)(Y + row * 1024 + yc) = w;
                asm volatile("" ::: "memory");
            }
    }
};
struct EpiRes {
    static constexpr bool PERM = false, AFTER_DRAIN = false;
    const float* R; float* O;
    __device__ __forceinline__ void operator()(const f32x4 (&acc)[2][2][4][2], const pg8::Unit& u, int wr, int wc, int fr, int fq) const {
        asm volatile("" : "+v"(fr), "+v"(fq));
        const int rbase = u.pm * 256 + wr * 64 + fr, cb = u.pn * 256 + wc * 32 + 4 * fq;
#pragma unroll
        for (int ai = 0; ai < 2; ++ai)
#pragma unroll
            for (int m = 0; m < 4; ++m) {
                const size_t off = (size_t)(rbase + ai * 128 + m * 16) * 1024 + cb;
#pragma unroll
                for (int bj = 0; bj < 2; ++bj)
#pragma unroll
                    for (int n = 0; n < 2; ++n) { const f32x4 r = *(const f32x4*)(R + off + bj * 128 + n * 16); *(f32x4*)(O + off + bj * 128 + n * 16) = r + acc[ai][bj][m][n]; }
            }
    }
};
#define XB_TMO      128
#define XB_XCNT(j)  (256  + 64 * (j))
#define XB_XSUB(j)  (1280 + 64 * (j))
#define XB_XGEN(j)  (2304 + 64 * (j))
#define XB_TOP      3328
#define XB_TOPGEN   3392
#define XCD_BAR_WORDS 3456
#define XB_SPIN_CAP (1u << 18)

__device__ __forceinline__ unsigned xb_ld(unsigned* p)              { return __hip_atomic_load(p, __ATOMIC_RELAXED, __HIP_MEMORY_SCOPE_AGENT); }
__device__ __forceinline__ unsigned xb_add(unsigned* p, unsigned v) { return __hip_atomic_fetch_add(p, v, __ATOMIC_RELAXED, __HIP_MEMORY_SCOPE_AGENT); }
__device__ __forceinline__ unsigned xb_xcc_id() { return (unsigned)__builtin_amdgcn_s_getreg((3 << 11) | 20) & 0xFu; }
#define XB_SPIN(cond, bar) do { unsigned _sp = 0; while (cond) { __builtin_amdgcn_s_sleep(1); \
    if ((++_sp & 255u) == 0u) { if (xb_ld(&(bar)[XB_TMO])) break; if (_sp > XB_SPIN_CAP) { atomicAdd(&(bar)[XB_TMO], 1u); break; } } } } while (0)

struct XcdBarrier {
    unsigned* bar; unsigned x;
    volatile LAS unsigned* st;
};

__device__ __forceinline__ XcdBarrier xcd_barrier_post(unsigned* bar, volatile LAS unsigned* st) {
    XcdBarrier b; b.bar = bar; b.x = xb_xcc_id(); b.st = st;
    if (threadIdx.x == 0) (void)xb_add(&bar[XB_XCNT(b.x)], 1u);
    return b;
}
__device__ __forceinline__ void xcd_barrier_complete(unsigned* bar, unsigned x, unsigned& nloc, unsigned& nx) {
    const unsigned G = gridDim.x * gridDim.y * gridDim.z;
    unsigned sum, cnt, mine, sp = 0u;
    for (;;) {
        sum = 0u; cnt = 0u; mine = 0u;
#pragma unroll
        for (unsigned j = 0; j < 16; ++j) { const unsigned c = xb_ld(&bar[XB_XCNT(j)]); sum += c; cnt += (c > 0u) ? 1u : 0u; mine = (j == x) ? c : mine; }
        if (sum == G) break;
        __builtin_amdgcn_s_sleep(1);
        if ((++sp & 255u) == 0u) { if (xb_ld(&bar[XB_TMO])) break; if (sp > XB_SPIN_CAP) { atomicAdd(&bar[XB_TMO], 1u); break; } }
    }
    nloc = mine > 0u ? mine : 1u; nx = cnt > 0u ? cnt : 1u;
}

__device__ __forceinline__ void xcd_barrier(const XcdBarrier& b_in, const bool t0) {
    XcdBarrier b = b_in; asm volatile("" : "+s"(b.bar), "+s"(b.x));
    asm volatile("s_waitcnt vmcnt(0)" ::: "memory");
    __syncthreads();
    if (t0) {
        unsigned* bar = b.bar;
        __builtin_amdgcn_s_waitcnt(0);
        unsigned nloc = b.st[0], nx = b.st[1];
        if (nloc == 0u) { xcd_barrier_complete(bar, b.x, nloc, nx); b.st[0] = nloc; b.st[1] = nx; }
        const unsigned old = xb_add(&bar[XB_XSUB(b.x)], 1u);
        const unsigned gen = old / nloc;
        if (old + 1u == (gen + 1u) * nloc) {
            __builtin_amdgcn_fence(__ATOMIC_RELEASE, "agent");
            asm volatile("s_waitcnt vmcnt(0)" ::: "memory");
            const unsigned og = xb_add(&bar[XB_TOP], 1u);
            const unsigned tg = og / nx;
            if (og + 1u == (tg + 1u) * nx) xb_add(&bar[XB_TOPGEN], 1u);
            else XB_SPIN(xb_ld(&bar[XB_TOPGEN]) == tg, bar);
            __builtin_amdgcn_fence(__ATOMIC_ACQUIRE, "agent");
            xb_add(&bar[XB_XGEN(b.x)], 1u);
            asm volatile("s_waitcnt vmcnt(0)" ::: "memory");
        } else {
            XB_SPIN(xb_ld(&bar[XB_XGEN(b.x)]) == gen, bar);
            __builtin_amdgcn_fence(__ATOMIC_ACQUIRE, "agent");
            asm volatile("s_waitcnt vmcnt(0)" ::: "memory");
        }
    }
    __syncthreads();
}

struct Params { const float* in[19]; float* out; unsigned char* ws; };
struct Ctx {
    LAS unsigned char* lds; int tid, lane, wave, G, bid;
};
__device__ __forceinline__ int lane_id_fresh() { int l; asm volatile("v_mbcnt_lo_u32_b32 %0, -1, 0\n\tv_mbcnt_hi_u32_b32 %0, -1, %0" : "=v"(l)); return l; }
#define OPQ(C) do { (C).lane = lane_id_fresh(); (C).tid = (C).wave * 64 + (C).lane; } while (0)

template <class MapFn>
__device__ __forceinline__ void transpose_item(const float* W, int K, int N, LAS float* scr, int item, int lane, MapFn map) {
    const int nblk = (N + 31) / 32, kb = item / nblk, nb = item % nblk, k0 = 64 * kb, n0 = 32 * nb;
    const int ncol = n0 + (lane & 31);
#pragma unroll 8
    for (int i = 0; i < 32; ++i) { const int kk = 2 * i + (lane >> 5); scr[kk * 33 + (lane & 31)] = (ncol < N) ? W[(size_t)(k0 + kk) * N + ncol] : 0.f; }
    LDS_WAIT(); asm volatile("" ::: "memory");
    const int c = lane & 7;
#pragma unroll
    for (int j = 0; j < 4; ++j) {
        const int n = (lane >> 3) + 8 * j; const LAS float* s = scr + (8 * c) * 33 + n;
        v4u o; o.x = pk2(s[0 * 33], s[1 * 33]); o.y = pk2(s[2 * 33], s[3 * 33]); o.z = pk2(s[4 * 33], s[5 * 33]); o.w = pk2(s[6 * 33], s[7 * 33]);
        if (n0 + n < N) { bf16* dst = map(n0 + n); if (dst) *(v4u*)(dst + k0 + 8 * c) = o; }
    }
    LDS_WAIT(); asm volatile("" ::: "memory");
}
__device__ __forceinline__ void convert_weights(Ctx C, const Params& P, int l, const int parts) {
    OPQ(C);
    LAS float* scr = (LAS float*)(C.lds + C.wave * 16384);
    const int gw = C.bid * 8 + C.wave, NGW = C.G * 8;
    unsigned char* ws = P.ws;
    bf16* W1t = (bf16*)(ws + WS_W1T); bf16* Wgt = (bf16*)(ws + WS_WGT);
    bf16* Wbt = (bf16*)(ws + WS_WBT); bf16* Wot = (bf16*)(ws + WS_WOT);
    const float* w_in = P.in[2] + (size_t)l * 1024 * INC; const float* w_br = P.in[16] + (size_t)l * 4 * 256 * 1024; const float* w_out = P.in[17] + (size_t)l * 1024 * 1024;
    constexpr int NBLK = (INC + 31) / 32, NB1 = 151;
    if (parts & 1) {
        for (int it = gw; it < 16 * NB1; it += NGW) {
            const int item = (it / NB1) * NBLK + (it % NB1);
            transpose_item(w_in, 1024, INC, scr, item, C.lane, [&](int c) -> bf16* { int which; const int row = win_dst_row(c, which); return which ? (bf16*)nullptr : W1t + (size_t)row * 1024; });
        }
        for (int i = C.bid * 512 + C.tid; i < 56 * 1024 / 8; i += C.G * 512) *(v4u*)(W1t + (size_t)(14 * 256 + 200) * 1024 + (size_t)i * 8) = (v4u){0u, 0u, 0u, 0u};
    }
    if (parts & 2) {
        constexpr int NB2 = NBLK - 150, I_G = 16 * NB2, I_BR = 4 * 32, I_OUT = 16 * 32;
        for (int it = gw; it < I_G + 4 * I_BR + I_OUT; it += NGW) {
            int r = it;
            if (r < I_G) { const int item = (r / NB2) * NBLK + 150 + (r % NB2);
                transpose_item(w_in, 1024, INC, scr, item, C.lane, [&](int c) -> bf16* { int which; const int row = win_dst_row(c, which); return which ? Wgt + (size_t)row * 1024 : (bf16*)nullptr; }); continue; }
            r -= I_G;
            if (r < 4 * I_BR) { const int br = r / I_BR, ri = r % I_BR; transpose_item(w_br + (size_t)br * 256 * 1024, 256, 1024, scr, ri, C.lane, [&](int c) -> bf16* { return Wbt + ((size_t)br * 1024 + c) * 256; }); continue; }
            r -= 4 * I_BR;
            transpose_item(w_out, 1024, 1024, scr, r, C.lane, [&](int c) -> bf16* { return Wot + (size_t)c * 1024; });
        }
    }
}
__device__ __forceinline__ void rms_row(const float* xrow, const float* g, bf16* obf, float* of32, int lane) {
    const f32x4* xr = (const f32x4*)xrow + lane;
    f32x4 v[4]; float s = 0.f;
#pragma unroll
    for (int j = 0; j < 4; ++j) { v[j] = xr[64 * j]; s += (v[j].x * v[j].x + v[j].y * v[j].y) + (v[j].z * v[j].z + v[j].w * v[j].w); }
    const float inv = rsqrtf(wave_sum(s) * (1.f / 1024.f) + 1e-6f);
#pragma unroll
    for (int j = 0; j < 4; ++j) {
        const f32x4 gg = ((const f32x4*)g)[lane + 64 * j];
        const f32x4 o = v[j] * inv * gg;
        if (obf) { v2u w; w.x = pk2(o.x, o.y); w.y = pk2(o.z, o.w); ((v2u*)obf)[lane + 64 * j] = w; }
        else ((f32x4*)of32)[lane + 64 * j] = o;
    }
}
__device__ __forceinline__ void norm_rows_bf16(Ctx C, const float* x, const float* g, bf16* h) {
    OPQ(C);
    const int gw = C.bid * 8 + C.wave, NGW = C.G * 8;
    for (int m = gw; m < NTOK; m += NGW) rms_row(x + (size_t)m * 1024, g, h + (size_t)m * 1024, nullptr, C.lane);
}
__device__ __forceinline__ void setup_tables(Ctx C, const Params& P) {
    OPQ(C);
    float* tcos = (float*)(P.ws + WS_COS); float* tsin = (float*)(P.ws + WS_SIN); float* lb = (float*)(P.ws + WS_LB);
    for (int i = C.bid * 512 + C.tid; i < SEQ * 32; i += C.G * 512) {
        const int pos = i >> 5, j = i & 31;
        const float freq = (float)pow(10000.0, -(double)j / 32.0);
        const float ang = (float)pos * freq;
        tcos[i] = (float)cos((double)ang); tsin[i] = (float)sin((double)ang);
    }
    if (C.bid == 0 && C.tid < 256) {
        const float l0 = P.in[4][C.tid], l1 = P.in[4][256 + C.tid];
        lb[C.tid] = 0.f; lb[256 + C.tid] = 1.f / (1.f + expf(l0 - l1));
    }
}

__device__ __forceinline__ void mixA_simple(Ctx C, unsigned char* ws, const float* bias) {
    OPQ(C);
    bf16* AQ = PLP(ws, PL_AQ); const bf16* AK = PLP(ws, PL_AK); const bf16* AV = PLP(ws, PL_AV); const bf16* AZ = PLP(ws, PL_AZ);
    for (int it = C.bid * 512 + C.tid; it < 4 * NTOK; it += C.G * 512) {
        const int h = it / NTOK, m = it % NTOK, b = m >> 12, t = m & 4095, c = t >> 6, qi = t & 63;
        float q[64], o[64];
        {
            const v4u* qp = (const v4u*)(AQ + (size_t)m * 256 + h * 64);
#pragma unroll
            for (int j = 0; j < 8; ++j) { const v4u w = qp[j]; q[8 * j] = bflo(w.x); q[8 * j + 1] = bfhi(w.x); q[8 * j + 2] = bflo(w.y); q[8 * j + 3] = bfhi(w.y); q[8 * j + 4] = bflo(w.z); q[8 * j + 5] = bfhi(w.z); q[8 * j + 6] = bflo(w.w); q[8 * j + 7] = bfhi(w.w); }
        }
#pragma unroll
        for (int d = 0; d < 64; ++d) o[d] = 0.f;
        float mx = -INFINITY, l = 0.f;
        const float* bh = bias + h * 192;
        for (int kj = 0; kj < 576; ++kj) {
            const int kp = c * 64 - 512 + kj;
            if (kp < 0) continue;
            const size_t mk = ((size_t)b << 12) + kp;
            const v4u* kr = (const v4u*)(AK + mk * 256 + h * 64); const v4u* vr = (const v4u*)(AV + mk * 256 + h * 64);
            float s = 0.f;
#pragma unroll
            for (int j = 0; j < 8; ++j) { const v4u w = kr[j];
                s = fmaf(q[8 * j], bflo(w.x), s); s = fmaf(q[8 * j + 1], bfhi(w.x), s); s = fmaf(q[8 * j + 2], bflo(w.y), s); s = fmaf(q[8 * j + 3], bfhi(w.y), s);
                s = fmaf(q[8 * j + 4], bflo(w.z), s); s = fmaf(q[8 * j + 5], bfhi(w.z), s); s = fmaf(q[8 * j + 6], bflo(w.w), s); s = fmaf(q[8 * j + 7], bfhi(w.w), s); }
            int rel = qi + 512 - kj; rel = rel < -63 ? -63 : (rel > 128 ? 128 : rel);
            s = s * 0.125f + bh[rel + 63];
            const float mn = fmaxf(mx, s), al = expf(mx - mn), pe = expf(s - mn);
            l = l * al + pe; mx = mn;
#pragma unroll
            for (int j = 0; j < 8; ++j) { const v4u w = vr[j];
                o[8 * j] = fmaf(pe, bflo(w.x), o[8 * j] * al); o[8 * j + 1] = fmaf(pe, bfhi(w.x), o[8 * j + 1] * al); o[8 * j + 2] = fmaf(pe, bflo(w.y), o[8 * j + 2] * al); o[8 * j + 3] = fmaf(pe, bfhi(w.y), o[8 * j + 3] * al);
                o[8 * j + 4] = fmaf(pe, bflo(w.z), o[8 * j + 4] * al); o[8 * j + 5] = fmaf(pe, bfhi(w.z), o[8 * j + 5] * al); o[8 * j + 6] = fmaf(pe, bflo(w.w), o[8 * j + 6] * al); o[8 * j + 7] = fmaf(pe, bfhi(w.w), o[8 * j + 7] * al); }
        }
        const float invl = 1.f / l;
        const v4u* zp = (const v4u*)(AZ + (size_t)m * 256 + h * 64); v4u* op = (v4u*)(AQ + (size_t)m * 256 + h * 64);
#pragma unroll
        for (int j = 0; j < 8; ++j) { const v4u z = zp[j]; v4u w;
            w.x = pk2(o[8 * j] * invl * siluf_(bflo(z.x)), o[8 * j + 1] * invl * siluf_(bfhi(z.x))); w.y = pk2(o[8 * j + 2] * invl * siluf_(bflo(z.y)), o[8 * j + 3] * invl * siluf_(bfhi(z.y)));
            w.z = pk2(o[8 * j + 4] * invl * siluf_(bflo(z.z)), o[8 * j + 5] * invl * siluf_(bfhi(z.z))); w.w = pk2(o[8 * j + 6] * invl * siluf_(bflo(z.w)), o[8 * j + 7] * invl * siluf_(bfhi(z.w)));
            op[j] = w; }
    }
}
__device__ __forceinline__ void mixB_simple(Ctx C, unsigned char* ws, const float* normg) {
    OPQ(C);
    if (C.bid < 32 || C.bid >= 36) return;
    const int gw = (C.bid - 32) * 8 + C.wave;
    const int b = gw >> 2, h = gw & 3, v = C.lane;
    bf16* BQ = PLP(ws, PL_BQ); const bf16* BI = PLP(ws, PL_BI); const bf16* BZ = PLP(ws, PL_BZ); const float* BF = (const float*)(ws + WS_BF);
    float S[64];
#pragma unroll
    for (int d = 0; d < 64; ++d) S[d] = 0.f;
    const float g = normg[v];
    for (int t = 0; t < SEQ; ++t) {
        const size_t m = ((size_t)b << 12) + t;
        const float* fr = BF + m * 256 + h * 64; const bf16* qr = BQ + m * 256 + h * 64;
        const float iv = bf2f(BI[m * 256 + h * 64 + v]); const float z = bf2f(BZ[m * 256 + h * 64 + v]);
        float o = 0.f;
#pragma unroll
        for (int d = 0; d < 64; ++d) { S[d] = fmaf(fr[d], S[d] - iv, iv); o = fmaf(bf2f(qr[d]), S[d], o); }
        const float r = rsqrtf(wave_sum(o * o) * (1.f / 64.f) + 1e-6f);
        asm volatile("" ::: "memory");
        BQ[m * 256 + h * 64 + v] = (bf16)f2bf(o * r * g * siluf_(z));
    }
}
__device__ __forceinline__ void mixD_simple(Ctx C, unsigned char* ws, const Params& P, int l) {
    OPQ(C);
    if (C.bid >= 32) return;
    const int b = C.bid >> 2, h = C.bid & 3, tid = C.tid;
    bf16* DR = PLP(ws, PL_DR); const bf16* DK = PLP(ws, PL_DK); const bf16* DV = PLP(ws, PL_DV); const bf16* DZ = PLP(ws, PL_DZ); const float* MS = (const float*)(ws + WS_MISC);
    const float* mu = P.in[6] + l * 896; const float* w0 = P.in[7] + l * 256; const float* w_up = P.in[8] + (size_t)l * 64 * 256; const float* a0 = P.in[9] + l * 256;
    const float* a_up = P.in[10] + (size_t)l * 64 * 256; const float* k_k = P.in[11] + l * 256; const float* k_a = P.in[12] + l * 256; const float* r_k = P.in[13] + l * 256;
    const float* gn_g = P.in[14] + l * 256; const float* gn_b = P.in[15] + l * 256;
    LAS float* L = (LAS float*)C.lds;
    LAS float* twd = L; LAS float* ads = L + 64; LAS float* rs = L + 128; LAS float* kr = L + 192; LAS float* vs = L + 256;
    LAS float* wv = L + 320; LAS float* av = L + 384; LAS float* kkv = L + 448; LAS float* kfv = L + 512; LAS float* bv = L + 576; LAS float* ob = L + 640; LAS float* bon = L + 704;
    const int v = tid >> 3, ks = tid & 7;
    float S[8];
#pragma unroll
    for (int i = 0; i < 8; ++i) S[i] = 0.f;
    const int grp = tid >> 6, cc = tid & 63;
    float prev = 0.f, mucol = 0.f;
    if (grp == 0) mucol = mu[768 + cc]; else if (grp == 1) mucol = mu[832 + cc]; else if (grp == 2) mucol = mu[h * 64 + cc]; else if (grp == 3) mucol = mu[256 + h * 64 + cc]; else if (grp == 4) mucol = mu[512 + h * 64 + cc];
    for (int t = 0; t < SEQ; ++t) {
        const size_t m = ((size_t)b << 12) + t;
        if (grp < 5) {
            float cur;
            if (grp == 0) cur = MS[m * 256 + 72 + cc]; else if (grp == 1) cur = MS[m * 256 + 136 + cc];
            else if (grp == 2) cur = bf2f(DR[m * 256 + h * 64 + cc]); else if (grp == 3) cur = bf2f(DK[m * 256 + h * 64 + cc]); else cur = bf2f(DV[m * 256 + h * 64 + cc]);
            const float sh = cur + mucol * (prev - cur); prev = cur;
            if (grp == 0) twd[cc] = tanhf(sh); else if (grp == 1) ads[cc] = sh; else if (grp == 2) rs[cc] = sh; else if (grp == 3) kr[cc] = sh; else vs[cc] = sh;
        }
        __syncthreads();
        if (tid < 128) {
            const int c = tid & 63, hc = h * 64 + c;
            if (tid < 64) { float wl = w0[hc];
_Pragma("nounroll")
                for (int i = 0; i < 64; ++i) wl = fmaf(twd[i], w_up[i * 256 + hc], wl);
                const float x = -wl; const float sp = fmaxf(x, 0.f) + log1pf(expf(-fabsf(x))); wv[c] = expf(-expf(-sp - 0.5f)); }
            else { float al = a0[hc];
_Pragma("nounroll")
                for (int i = 0; i < 64; ++i) al = fmaf(ads[i], a_up[i * 256 + hc], al); av[c] = sigmoidf_(al); }
        }
        __syncthreads();
        if (tid < 64) {
            const int hc = h * 64 + tid; const float kx = kr[tid], a = av[tid];
            const float kkr = kx * k_k[hc]; const float nrm = sqrtf(wave_sum(kkr * kkr)); const float kk = kkr / fmaxf(nrm, 1e-12f);
            const float kf = kx * (1.f + (a - 1.f) * k_a[hc]);
            kkv[tid] = kk; kfv[tid] = kf; bv[tid] = kk * a;
            const float bsum = wave_sum(rs[tid] * kf * r_k[hc]); if (tid == 0) bon[0] = bsum;
        }
        __syncthreads();
        {
            float sa = 0.f;
#pragma unroll
            for (int i = 0; i < 8; ++i) sa = fmaf(S[i], kkv[8 * ks + i], sa);
            sa += __shfl_xor(sa, 1); sa += __shfl_xor(sa, 2); sa += __shfl_xor(sa, 4); sa = -sa;
            const float vv = vs[v]; float o = 0.f;
#pragma unroll
            for (int i = 0; i < 8; ++i) { S[i] = fmaf(S[i], wv[8 * ks + i], fmaf(sa, bv[8 * ks + i], vv * kfv[8 * ks + i])); o = fmaf(S[i], rs[8 * ks + i], o); }
            o += __shfl_xor(o, 1); o += __shfl_xor(o, 2); o += __shfl_xor(o, 4);
            if (ks == 0) ob[v] = o;
        }
        __syncthreads();
        if (tid < 64) {
            const int hc = h * 64 + tid; const float o = ob[tid];
            const float mean = wave_sum(o) * (1.f / 64.f); const float d = o - mean; const float var = wave_sum(d * d) * (1.f / 64.f);
            float y = d * rsqrtf(var + 64e-5f) * gn_g[hc] + gn_b[hc];
            y += bon[0] * vs[tid];
            const float z = bf2f(DZ[m * 256 + hc]);
            DR[m * 256 + hc] = (bf16)f2bf(y * siluf_(z));
        }
        __syncthreads();
    }
}
__device__ __forceinline__ void mixC_simple(Ctx C, unsigned char* ws) {
    OPQ(C);
    bf16* CQ = PLP(ws, PL_CQ); const bf16* CK = PLP(ws, PL_CK); const bf16* CV = PLP(ws, PL_CV); const bf16* CZ = PLP(ws, PL_CZ);
    const bf16* QI0 = PLP(ws, PL_CQI0); const bf16* QI1 = PLP(ws, PL_CQI1); const float* MS = (const float*)(ws + WS_MISC);
    LAS float* L = (LAS float*)C.lds;
    LAS float* qs = L;
    LAS float* q4 = L + 512;
    LAS float* wq = L + 768;
    LAS float* sc = L + 1024;
    LAS float* ps = L + 5120;
    LAS int* sel = (LAS int*)(L + 6144);
    LAS unsigned* hist = (LAS unsigned*)(L + 6400);
    LAS float* red = L + 6656;
    LAS unsigned* sw = (LAS unsigned*)(L + 6672);
    const int tid = C.tid;
    for (int m = C.bid; m < NTOK; m += C.G) {
        const int b = m >> 12, t = m & 4095, n = ((t >> 6) + 1) * 64;
        qs[tid] = bf2f(tid < 256 ? QI0[(size_t)m * 256 + tid] : QI1[(size_t)m * 256 + tid - 256]);
        if (tid < 256) q4[tid] = bf2f(CQ[(size_t)m * 256 + tid]);
        if (tid < 8) wq[tid] = MS[(size_t)m * 256 + 64 + tid] * 0.35355339059327373f;
        __syncthreads();
        for (int s = tid; s < n; s += 512) {
            const f32x4* kp = (const f32x4*)(MS + (((size_t)b << 12) + s) * 256);
            float kv[64];
#pragma unroll
            for (int j = 0; j < 16; ++j) { const f32x4 w = kp[j]; kv[4 * j] = w.x; kv[4 * j + 1] = w.y; kv[4 * j + 2] = w.z; kv[4 * j + 3] = w.w; }
            float acc = 0.f;
            for (int hh = 0; hh < 8; ++hh) {
                float d = 0.f;
#pragma unroll
                for (int c = 0; c < 64; ++c) d = fmaf(qs[hh * 64 + c], kv[c], d);
                d = fmaxf(d * 0.125f, 0.f);
                acc = fmaf(d, wq[hh], acc);
            }
            sc[s] = acc;
        }
        __syncthreads();
        int cnt;
        if (n <= 256) { if (tid < n) sel[tid] = tid; cnt = n; }
        else {
            unsigned key[8];
#pragma unroll
            for (int j = 0; j < 8; ++j) { const int idx = tid + 512 * j; unsigned kk = 0u; if (idx < n) { const unsigned u = __float_as_uint(sc[idx]); kk = (u & 0x80000000u) ? ~u : (u | 0x80000000u); } key[j] = kk; }
            if (tid == 0) { sw[0] = 0u; sw[1] = 256u; sw[3] = 0u; }
            unsigned mask = 0u;
            for (int pass = 3; pass >= 0; --pass) {
                const int shift = pass * 8;
                if (tid < 256) hist[tid] = 0u;
                __syncthreads();
                const unsigned prefix = sw[0];
#pragma unroll
                for (int j = 0; j < 8; ++j) { const int idx = tid + 512 * j; if (idx < n && (key[j] & mask) == prefix) atomicAdd((unsigned*)&hist[(key[j] >> shift) & 255u], 1u); }
                __syncthreads();
                if (tid == 0) { const unsigned k = sw[1]; unsigned c = 0u; int bb = 255; for (; bb > 0; --bb) { if (c + hist[bb] >= k) break; c += hist[bb]; }
                    sw[1] = k - c; sw[0] = prefix | ((unsigned)bb << shift); sw[2] = hist[bb]; }
                mask |= (0xFFu << shift);
                __syncthreads();
            }
            const unsigned thr = sw[0], need = sw[1], eqc = sw[2];
            if (tid == 0) { int cut = SEQ;
                if (eqc != need) { unsigned c = 0u; for (int i = 0; i < n; ++i) { const unsigned u = __float_as_uint(sc[i]); const unsigned kk = (u & 0x80000000u) ? ~u : (u | 0x80000000u); if (kk == thr) { ++c; if (c == need) { cut = i; break; } } } }
                sw[4] = (unsigned)cut; }
            __syncthreads();
            const int cut = (int)sw[4];
#pragma unroll
            for (int j = 0; j < 8; ++j) { const int idx = tid + 512 * j; if (idx < n && (key[j] > thr || (key[j] == thr && idx <= cut))) { const unsigned pos = atomicAdd((unsigned*)&sw[3], 1u); if (pos < 256u) sel[pos] = idx; } }
            cnt = 256;
        }
        __syncthreads();
        float s4[4] = {-INFINITY, -INFINITY, -INFINITY, -INFINITY};
        if (tid < cnt) {
            const v4u* kr = (const v4u*)(CK + (((size_t)b << 12) + sel[tid]) * 256);
#pragma unroll
            for (int hh = 0; hh < 4; ++hh) { float d = 0.f;
#pragma unroll
                for (int j = 0; j < 8; ++j) { const v4u w = kr[hh * 8 + j]; const LAS float* qq = q4 + hh * 64 + 8 * j;
                    d = fmaf(qq[0], bflo(w.x), d); d = fmaf(qq[1], bfhi(w.x), d); d = fmaf(qq[2], bflo(w.y), d); d = fmaf(qq[3], bfhi(w.y), d);
                    d = fmaf(qq[4], bflo(w.z), d); d = fmaf(qq[5], bfhi(w.z), d); d = fmaf(qq[6], bflo(w.w), d); d = fmaf(qq[7], bfhi(w.w), d); }
                s4[hh] = d * 0.125f; }
        }
        if (tid < 256) {
#pragma unroll
            for (int hh = 0; hh < 4; ++hh) { const float v = wave_max(s4[hh]); if (C.lane == 0) red[hh * 4 + C.wave] = v; }
        }
        __syncthreads();
        float mx[4];
#pragma unroll
        for (int hh = 0; hh < 4; ++hh) mx[hh] = fmaxf(fmaxf(red[hh * 4], red[hh * 4 + 1]), fmaxf(red[hh * 4 + 2], red[hh * 4 + 3]));
        __syncthreads();
        if (tid < 256) {
#pragma unroll
            for (int hh = 0; hh < 4; ++hh) { const float e = (tid < cnt) ? expf(s4[hh] - mx[hh]) : 0.f; ps[hh * 256 + tid] = e; const float v = wave_sum(e); if (C.lane == 0) red[hh * 4 + C.wave] = v; }
        }
        __syncthreads();
        if (tid < 256) {
            const int hh = tid >> 6;
            const float lsum = red[hh * 4] + red[hh * 4 + 1] + red[hh * 4 + 2] + red[hh * 4 + 3];
            float o = 0.f;
            for (int j = 0; j < cnt; ++j) o = fmaf(ps[hh * 256 + j], bf2f(CV[(((size_t)b << 12) + sel[j]) * 256 + tid]), o);
            const float z = bf2f(CZ[(size_t)m * 256 + tid]);
            CQ[(size_t)m * 256 + tid] = (bf16)f2bf(o / lsum * siluf_(z));
        }
        __syncthreads();
    }
}

typedef short bf16x8_t __attribute__((ext_vector_type(8)));
__device__ __forceinline__ float dpp_f(float x, const int ctrl_sel) {
    const int xi = __builtin_bit_cast(int, x); int r;
    if (ctrl_sel == 0) r = __builtin_amdgcn_update_dpp(xi, xi, 0xB1, 0xF, 0xF, false);
    else if (ctrl_sel == 1) r = __builtin_amdgcn_update_dpp(xi, xi, 0x4E, 0xF, 0xF, false);
    else r = __builtin_amdgcn_update_dpp(xi, xi, 0x141, 0xF, 0xF, false);
    return __builtin_bit_cast(float, r);
}
__device__ __forceinline__ float red8(float x) { x += dpp_f(x, 0); x += dpp_f(x, 1); x += dpp_f(x, 2); return x; }

constexpr int DSTEP_T = 320;
constexpr int D_LDS_STEP = 0, D_LDS_VS = 81920, D_LDS_TWD = 98304, D_LDS_ADS = 106496;
__device__ __forceinline__ void mixD1(Ctx C, const Params& P, int l) {
    OPQ(C);
    unsigned char* ws = P.ws;
    const bf16* DR = PLP(ws, PL_DR); const bf16* DK = PLP(ws, PL_DK); const bf16* DV = PLP(ws, PL_DV); const float* MS = (const float*)(ws + WS_MISC);
    const float* mu = P.in[6] + l * 896; const float* w0 = P.in[7] + l * 256; const float* w_up = P.in[8] + (size_t)l * 64 * 256; const float* a0 = P.in[9] + l * 256;
    const float* a_up = P.in[10] + (size_t)l * 64 * 256; const float* k_k = P.in[11] + l * 256; const float* k_a = P.in[12] + l * 256; const float* r_k = P.in[13] + l * 256;
    bf16* OL = (bf16*)(ws + WS_OL); bf16* CCp = (bf16*)(ws + WS_CC); float* BON = (float*)(ws + WS_DBON); float* AB = (float*)(ws + WS_DAB);
    LAS float* STEP = (LAS float*)(C.lds + D_LDS_STEP); LAS float* VS = (LAS float*)(C.lds + D_LDS_VS);
    LAS bf16* TWD = (LAS bf16*)(C.lds + D_LDS_TWD); LAS bf16* ADS = (LAS bf16*)(C.lds + D_LDS_ADS);
    const int tid = C.tid, lane = C.lane, wave = C.wave;
    const int tt = tid >> 3, c8 = tid & 7;
    for (int u = C.bid; u < 256; u += C.G) {
        const int b = u >> 5, h = (u >> 3) & 3, seg = u & 7, hc0 = h * 64;
        __syncthreads();
        {
            const int i = tid >> 3;
            const f32x4 wa = *(const f32x4*)(w_up + (size_t)i * 256 + hc0 + 8 * c8), wb = *(const f32x4*)(w_up + (size_t)i * 256 + hc0 + 8 * c8 + 4);
            const f32x4 aa = *(const f32x4*)(a_up + (size_t)i * 256 + hc0 + 8 * c8), ab = *(const f32x4*)(a_up + (size_t)i * 256 + hc0 + 8 * c8 + 4);
#pragma unroll
            for (int j = 0; j < 4; ++j) { TWD[(8 * c8 + j) * 64 + i] = (bf16)f2bf(wa[j]); TWD[(8 * c8 + 4 + j) * 64 + i] = (bf16)f2bf(wb[j]);
                                          ADS[(8 * c8 + j) * 64 + i] = (bf16)f2bf(aa[j]); ADS[(8 * c8 + 4 + j) * 64 + i] = (bf16)f2bf(ab[j]); }
        }
        __syncthreads();
        const int mat = wave >> 2, mt = wave & 3, fr = lane & 15, fq = lane >> 4;
        bf16x8_t bfrag[4][2];
#pragma unroll
        for (int nt = 0; nt < 4; ++nt)
#pragma unroll
            for (int k2 = 0; k2 < 2; ++k2) bfrag[nt][k2] = *(const LAS bf16x8_t*)((mat ? ADS : TWD) + (16 * nt + fr) * 64 + 32 * k2 + 8 * fq);
        float bias4[4];
#pragma unroll
        for (int nt = 0; nt < 4; ++nt) bias4[nt] = (mat ? a0 : w0)[hc0 + 16 * nt + fr];
        __syncthreads();
        float S[8], H[8];
#pragma unroll
        for (int j = 0; j < 8; ++j) { S[j] = 0.f; H[j] = (8 * c8 + j == tt) ? 1.f : 0.f; }
        v4u rc, kc, vc, rp, kp, vp; f32x4 wc0, wc1, ac0, ac1, wp0, wp1, ap0, ap1;
#define D1_LOADRAW(BLK) do { const int tl_ = seg * 512 + (BLK) * 64 + tt; const size_t m_ = ((size_t)b << 12) + tl_; const int ch_ = hc0 + 8 * c8; \
            rc = *(const v4u*)(DR + m_ * 256 + ch_); kc = *(const v4u*)(DK + m_ * 256 + ch_); vc = *(const v4u*)(DV + m_ * 256 + ch_); \
            wc0 = *(const f32x4*)(MS + m_ * 256 + 72 + 8 * c8); wc1 = *(const f32x4*)(MS + m_ * 256 + 76 + 8 * c8); ac0 = *(const f32x4*)(MS + m_ * 256 + 136 + 8 * c8); ac1 = *(const f32x4*)(MS + m_ * 256 + 140 + 8 * c8); \
            rp = (v4u){0u, 0u, 0u, 0u}; kp = rp; vp = rp; wp0 = (f32x4){0.f, 0.f, 0.f, 0.f}; wp1 = wp0; ap0 = wp0; ap1 = wp0; \
            if (tl_ > 0) { rp = *(const v4u*)(DR + (m_ - 1) * 256 + ch_); kp = *(const v4u*)(DK + (m_ - 1) * 256 + ch_); vp = *(const v4u*)(DV + (m_ - 1) * 256 + ch_); \
                wp0 = *(const f32x4*)(MS + (m_ - 1) * 256 + 72 + 8 * c8); wp1 = *(const f32x4*)(MS + (m_ - 1) * 256 + 76 + 8 * c8); ap0 = *(const f32x4*)(MS + (m_ - 1) * 256 + 136 + 8 * c8); ap1 = *(const f32x4*)(MS + (m_ - 1) * 256 + 140 + 8 * c8); } } while (0)
        D1_LOADRAW(0);
        for (int blk = 0; blk < 8; ++blk) {
            const int tloc0 = seg * 512 + blk * 64;
            const size_t m = ((size_t)b << 12) + tloc0 + tt;
            {
                const int ch = hc0 + 8 * c8;
                LAS float* st = STEP + tt * DSTEP_T + c8 * 40;
#pragma unroll
                for (int q = 0; q < 4; ++q) {
                    const unsigned rcw = rc[q], rpw = rp[q], kcw = kc[q], kpw = kp[q], vcw = vc[q], vpw = vp[q];
                    const float mr0 = mu[ch + 2 * q], mr1 = mu[ch + 2 * q + 1], mk0 = mu[256 + ch + 2 * q], mk1 = mu[256 + ch + 2 * q + 1], mv0 = mu[512 + ch + 2 * q], mv1 = mu[512 + ch + 2 * q + 1];
                    float c0 = bflo(rcw), c1 = bfhi(rcw);
                    st[32 + 2 * q] = c0 + mr0 * (bflo(rpw) - c0); st[32 + 2 * q + 1] = c1 + mr1 * (bfhi(rpw) - c1);
                    c0 = bflo(kcw); c1 = bfhi(kcw);
                    st[24 + 2 * q] = c0 + mk0 * (bflo(kpw) - c0); st[24 + 2 * q + 1] = c1 + mk1 * (bfhi(kpw) - c1);
                    c0 = bflo(vcw); c1 = bfhi(vcw);
                    VS[tt * 64 + 8 * c8 + 2 * q] = c0 + mv0 * (bflo(vpw) - c0); VS[tt * 64 + 8 * c8 + 2 * q + 1] = c1 + mv1 * (bfhi(vpw) - c1);
                }
                float tw[8], ad[8];
#pragma unroll
                for (int j = 0; j < 4; ++j) {
                    const float m0 = mu[768 + 8 * c8 + j], m1 = mu[768 + 8 * c8 + 4 + j], n0 = mu[832 + 8 * c8 + j], n1 = mu[832 + 8 * c8 + 4 + j];
                    tw[j] = tanhf(wc0[j] + m0 * (wp0[j] - wc0[j])); tw[4 + j] = tanhf(wc1[j] + m1 * (wp1[j] - wc1[j]));
                    ad[j] = ac0[j] + n0 * (ap0[j] - ac0[j]); ad[4 + j] = ac1[j] + n1 * (ap1[j] - ac1[j]);
                }
                v4u tv, av; tv.x = pk2(tw[0], tw[1]); tv.y = pk2(tw[2], tw[3]); tv.z = pk2(tw[4], tw[5]); tv.w = pk2(tw[6], tw[7]);
                av.x = pk2(ad[0], ad[1]); av.y = pk2(ad[2], ad[3]); av.z = pk2(ad[4], ad[5]); av.w = pk2(ad[6], ad[7]);
                *(LAS v4u*)(TWD + tt * 64 + 8 * c8) = tv; *(LAS v4u*)(ADS + tt * 64 + 8 * c8) = av;
            }
            __syncthreads();
            {
                const LAS bf16* Asrc = mat ? ADS : TWD;
                const bf16x8_t a0f = *(const LAS bf16x8_t*)(Asrc + (16 * mt + fr) * 64 + 8 * fq), a1f = *(const LAS bf16x8_t*)(Asrc + (16 * mt + fr) * 64 + 32 + 8 * fq);
#pragma unroll
                for (int nt = 0; nt < 4; ++nt) {
                    f32x4 acc = (f32x4){0.f, 0.f, 0.f, 0.f};
                    acc = __builtin_amdgcn_mfma_f32_16x16x32_bf16(a0f, bfrag[nt][0], acc, 0, 0, 0);
                    acc = __builtin_amdgcn_mfma_f32_16x16x32_bf16(a1f, bfrag[nt][1], acc, 0, 0, 0);
                    const int c = 16 * nt + fr;
#pragma unroll
                    for (int j = 0; j < 4; ++j) {
                        const int t = 16 * mt + 4 * fq + j; const float x = acc[j] + bias4[nt]; float val;
                        if (mat == 0) { const float nx = -x; const float sp = fmaxf(nx, 0.f) + log1pf(expf(-fabsf(nx))); val = expf(-expf(-sp - 0.5f)); }
                        else val = 1.f / (1.f + expf(-x));
                        STEP[t * DSTEP_T + (c >> 3) * 40 + (mat ? 16 : 8) + (c & 7)] = val;
                    }
                }
            }
            __syncthreads();
            {
                const int ch = hc0 + 8 * c8; LAS float* st = STEP + tt * DSTEP_T + c8 * 40;
                float kkr[8], ssq = 0.f, bon = 0.f;
#pragma unroll
                for (int j = 0; j < 8; ++j) { const float kx = st[24 + j], a = st[16 + j];
                    kkr[j] = kx * k_k[ch + j]; ssq = fmaf(kkr[j], kkr[j], ssq);
                    const float kf = kx * (1.f + (a - 1.f) * k_a[ch + j]); st[24 + j] = kf; bon = fmaf(st[32 + j] * kf, r_k[ch + j], bon); }
                ssq = red8(ssq); bon = red8(bon);
                const float inv = 1.f / fmaxf(sqrtf(ssq), 1e-12f);
#pragma unroll
                for (int j = 0; j < 8; ++j) { const float kk = kkr[j] * inv; st[j] = kk; st[16 + j] = kk * st[16 + j]; }
                if (c8 == 0) BON[m * 4 + h] = bon;
            }
            __syncthreads();
            if (blk + 1 < 8) D1_LOADRAW(blk + 1);
            for (int t = 0; t < 64; ++t) {
                const LAS f32x4* sp = (const LAS f32x4*)(STEP + t * DSTEP_T + c8 * 40);
                const f32x4 k0 = sp[0], k1 = sp[1], w0v = sp[2], w1v = sp[3], b0 = sp[4], b1 = sp[5], f0 = sp[6], f1 = sp[7], r0 = sp[8], r1 = sp[9];
                const float vv = VS[t * 64 + tt];
                float dS = 0.f, dH = 0.f;
#pragma unroll
                for (int j = 0; j < 4; ++j) { dS = fmaf(S[j], k0[j], dS); dH = fmaf(H[j], k0[j], dH); }
#pragma unroll
                for (int j = 0; j < 4; ++j) { dS = fmaf(S[4 + j], k1[j], dS); dH = fmaf(H[4 + j], k1[j], dH); }
                dS = -red8(dS); dH = -red8(dH);
                float oS = 0.f, oH = 0.f;
#pragma unroll
                for (int j = 0; j < 4; ++j) {
                    S[j] = fmaf(S[j], w0v[j], fmaf(dS, b0[j], vv * f0[j])); H[j] = fmaf(H[j], w0v[j], dH * b0[j]);
                    oS = fmaf(S[j], r0[j], oS); oH = fmaf(H[j], r0[j], oH);
                }
#pragma unroll
                for (int j = 0; j < 4; ++j) {
                    S[4 + j] = fmaf(S[4 + j], w1v[j], fmaf(dS, b1[j], vv * f1[j])); H[4 + j] = fmaf(H[4 + j], w1v[j], dH * b1[j]);
                    oS = fmaf(S[4 + j], r1[j], oS); oH = fmaf(H[4 + j], r1[j], oH);
                }
                oS = red8(oS); oH = red8(oH);
                if (c8 == 0) { const size_t mo = (((size_t)b << 12) + tloc0 + t) * 256 + hc0 + tt; OL[mo] = (bf16)f2bf(oS); CCp[mo] = (bf16)f2bf(oH); }
            }
            __syncthreads();
        }
#undef D1_LOADRAW
        {
            float* ab = AB + (size_t)u * 8192;
            *(f32x4*)(ab + tt * 64 + 8 * c8) = (f32x4){H[0], H[1], H[2], H[3]}; *(f32x4*)(ab + tt * 64 + 8 * c8 + 4) = (f32x4){H[4], H[5], H[6], H[7]};
            *(f32x4*)(ab + 4096 + tt * 64 + 8 * c8) = (f32x4){S[0], S[1], S[2], S[3]}; *(f32x4*)(ab + 4096 + tt * 64 + 8 * c8 + 4) = (f32x4){S[4], S[5], S[6], S[7]};
        }
    }
}
__device__ __forceinline__ void mixD1_ut(Ctx C, const Params& P, int l) {
    OPQ(C);
    unsigned char* ws = P.ws;
    const bf16* DR = PLP(ws, PL_DR); const bf16* DK = PLP(ws, PL_DK); const bf16* DV = PLP(ws, PL_DV); const float* MS = (const float*)(ws + WS_MISC);
    const float* mu = P.in[6] + l * 896; const float* w0 = P.in[7] + l * 256; const float* w_up = P.in[8] + (size_t)l * 64 * 256; const float* a0 = P.in[9] + l * 256;
    const float* a_up = P.in[10] + (size_t)l * 64 * 256; const float* k_k = P.in[11] + l * 256; const float* k_a = P.in[12] + l * 256; const float* r_k = P.in[13] + l * 256;
    bf16* OL = (bf16*)(ws + WS_OL); bf16* CCp = (bf16*)(ws + WS_CC); float* BON = (float*)(ws + WS_DBON); float* AB = (float*)(ws + WS_DAB);
    LAS float* STEP = (LAS float*)(C.lds + D_LDS_STEP); LAS bf16* VS16 = (LAS bf16*)(C.lds + D_LDS_VS);
    LAS bf16* BKR = (LAS bf16*)(C.lds + 90112); LAS bf16* BKT = (LAS bf16*)(C.lds + 94208); LAS bf16* XB = (LAS bf16*)(C.lds + 98304);
    LAS bf16* VA = (LAS bf16*)(C.lds + 114688); LAS float* RH = (LAS float*)(C.lds + 122880);
    LAS float* GAM = (LAS float*)(C.lds + 131584); LAS float* MN = (LAS float*)(C.lds + 135936); LAS bf16* KR = (LAS bf16*)(C.lds + 140032); LAS bf16* QP = (LAS bf16*)(C.lds + 144128);
    LAS bf16* TWD = (LAS bf16*)(C.lds + D_LDS_TWD); LAS bf16* ADS = (LAS bf16*)(C.lds + D_LDS_ADS);
    const int wave = C.wave;
    for (int u = C.bid; u < 256; u += C.G) {
        const int lane = lane_id_fresh(), tid = wave * 64 + lane;
        const int tt = tid >> 3, c8 = tid & 7;
        const int b = u >> 5, h = (u >> 3) & 3, seg = u & 7, hc0 = h * 64;
        __syncthreads();
        {
            const int i = tid >> 3;
            const f32x4 wa = *(const f32x4*)(w_up + (size_t)i * 256 + hc0 + 8 * c8), wb = *(const f32x4*)(w_up + (size_t)i * 256 + hc0 + 8 * c8 + 4);
            const f32x4 aa = *(const f32x4*)(a_up + (size_t)i * 256 + hc0 + 8 * c8), ab = *(const f32x4*)(a_up + (size_t)i * 256 + hc0 + 8 * c8 + 4);
#pragma unroll
            for (int j = 0; j < 4; ++j) { TWD[(8 * c8 + j) * 64 + i] = (bf16)f2bf(wa[j]); TWD[(8 * c8 + 4 + j) * 64 + i] = (bf16)f2bf(wb[j]);
                                          ADS[(8 * c8 + j) * 64 + i] = (bf16)f2bf(aa[j]); ADS[(8 * c8 + 4 + j) * 64 + i] = (bf16)f2bf(ab[j]); }
        }
        __syncthreads();
        const int mat = wave >> 2, mt = wave & 3, fr = lane & 15, fq = lane >> 4;
        bf16x8_t bfrag[4][2];
#pragma unroll
        for (int nt = 0; nt < 4; ++nt)
#pragma unroll
            for (int k2 = 0; k2 < 2; ++k2) bfrag[nt][k2] = *(const LAS bf16x8_t*)((mat ? ADS : TWD) + (16 * nt + fr) * 64 + 32 * k2 + 8 * fq);
        float bias4[4];
#pragma unroll
        for (int nt = 0; nt < 4; ++nt) bias4[nt] = (mat ? a0 : w0)[hc0 + 16 * nt + fr];
        __syncthreads();
        const int xc = lane & 15, xq = lane >> 4;
        f32x4 X[4];
#pragma unroll
        for (int kt = 0; kt < 4; ++kt)
#pragma unroll
            for (int j = 0; j < 4; ++j) X[kt][j] = (wave >= 4 && (16 * (wave - 4) + 4 * xq + j) == (16 * kt + xc)) ? 1.f : 0.f;
        for (int i = tid; i < 64 * 16; i += 512) VA[(64 + (i >> 4)) * 32 + (i & 15)] = (bf16)0;
        v4u rc, kc, vc, rp, kp, vp; f32x4 wc0, wc1, ac0, ac1, wp0, wp1, ap0, ap1;
#define D1_LOADRAW(BLK) do { const int tl_ = seg * 512 + (BLK) * 64 + tt; const size_t m_ = ((size_t)b << 12) + tl_; const int ch_ = hc0 + 8 * c8; \
            rc = *(const v4u*)(DR + m_ * 256 + ch_); kc = *(const v4u*)(DK + m_ * 256 + ch_); vc = *(const v4u*)(DV + m_ * 256 + ch_); \
            wc0 = *(const f32x4*)(MS + m_ * 256 + 72 + 8 * c8); wc1 = *(const f32x4*)(MS + m_ * 256 + 76 + 8 * c8); ac0 = *(const f32x4*)(MS + m_ * 256 + 136 + 8 * c8); ac1 = *(const f32x4*)(MS + m_ * 256 + 140 + 8 * c8); \
            rp = (v4u){0u, 0u, 0u, 0u}; kp = rp; vp = rp; wp0 = (f32x4){0.f, 0.f, 0.f, 0.f}; wp1 = wp0; ap0 = wp0; ap1 = wp0; \
            if (tl_ > 0) { rp = *(const v4u*)(DR + (m_ - 1) * 256 + ch_); kp = *(const v4u*)(DK + (m_ - 1) * 256 + ch_); vp = *(const v4u*)(DV + (m_ - 1) * 256 + ch_); \
                wp0 = *(const f32x4*)(MS + (m_ - 1) * 256 + 72 + 8 * c8); wp1 = *(const f32x4*)(MS + (m_ - 1) * 256 + 76 + 8 * c8); ap0 = *(const f32x4*)(MS + (m_ - 1) * 256 + 136 + 8 * c8); ap1 = *(const f32x4*)(MS + (m_ - 1) * 256 + 140 + 8 * c8); } } while (0)
        for (int blk = 0; blk < 8; ++blk) {
            D1_LOADRAW(blk);
            const int tloc0 = seg * 512 + blk * 64;
            const size_t m = ((size_t)b << 12) + tloc0 + tt;
            {
                const int ch = hc0 + 8 * c8;
                LAS float* st = STEP + tt * DSTEP_T + c8 * 40;
#pragma unroll
                for (int q = 0; q < 4; ++q) {
                    const unsigned rcw = rc[q], rpw = rp[q], kcw = kc[q], kpw = kp[q], vcw = vc[q], vpw = vp[q];
                    const float mr0 = mu[ch + 2 * q], mr1 = mu[ch + 2 * q + 1], mk0 = mu[256 + ch + 2 * q], mk1 = mu[256 + ch + 2 * q + 1], mv0 = mu[512 + ch + 2 * q], mv1 = mu[512 + ch + 2 * q + 1];
                    float c0 = bflo(rcw), c1 = bfhi(rcw);
                    st[32 + 2 * q] = c0 + mr0 * (bflo(rpw) - c0); st[32 + 2 * q + 1] = c1 + mr1 * (bfhi(rpw) - c1);
                    c0 = bflo(kcw); c1 = bfhi(kcw);
                    st[24 + 2 * q] = c0 + mk0 * (bflo(kpw) - c0); st[24 + 2 * q + 1] = c1 + mk1 * (bfhi(kpw) - c1);
                    c0 = bflo(vcw); c1 = bfhi(vcw);
                    VS16[tt * 64 + 8 * c8 + 2 * q] = (bf16)f2bf(c0 + mv0 * (bflo(vpw) - c0)); VS16[tt * 64 + 8 * c8 + 2 * q + 1] = (bf16)f2bf(c1 + mv1 * (bfhi(vpw) - c1));
                }
                float tw[8], ad[8];
#pragma unroll
                for (int j = 0; j < 4; ++j) {
                    const float m0 = mu[768 + 8 * c8 + j], m1 = mu[768 + 8 * c8 + 4 + j], n0 = mu[832 + 8 * c8 + j], n1 = mu[832 + 8 * c8 + 4 + j];
                    tw[j] = tanhf(wc0[j] + m0 * (wp0[j] - wc0[j])); tw[4 + j] = tanhf(wc1[j] + m1 * (wp1[j] - wc1[j]));
                    ad[j] = ac0[j] + n0 * (ap0[j] - ac0[j]); ad[4 + j] = ac1[j] + n1 * (ap1[j] - ac1[j]);
                }
                v4u tv, av; tv.x = pk2(tw[0], tw[1]); tv.y = pk2(tw[2], tw[3]); tv.z = pk2(tw[4], tw[5]); tv.w = pk2(tw[6], tw[7]);
                av.x = pk2(ad[0], ad[1]); av.y = pk2(ad[2], ad[3]); av.z = pk2(ad[4], ad[5]); av.w = pk2(ad[6], ad[7]);
                *(LAS v4u*)(TWD + tt * 64 + 8 * c8) = tv; *(LAS v4u*)(ADS + tt * 64 + 8 * c8) = av;
            }
            __syncthreads();
            {
                const LAS bf16* Asrc = mat ? ADS : TWD;
                const bf16x8_t a0f = *(const LAS bf16x8_t*)(Asrc + (16 * mt + fr) * 64 + 8 * fq), a1f = *(const LAS bf16x8_t*)(Asrc + (16 * mt + fr) * 64 + 32 + 8 * fq);
#pragma unroll
                for (int nt = 0; nt < 4; ++nt) {
                    f32x4 acc = (f32x4){0.f, 0.f, 0.f, 0.f};
                    acc = __builtin_amdgcn_mfma_f32_16x16x32_bf16(a0f, bfrag[nt][0], acc, 0, 0, 0);
                    acc = __builtin_amdgcn_mfma_f32_16x16x32_bf16(a1f, bfrag[nt][1], acc, 0, 0, 0);
                    const int c = 16 * nt + fr;
#pragma unroll
                    for (int j = 0; j < 4; ++j) {
                        const int t = 16 * mt + 4 * fq + j; const float x = acc[j] + bias4[nt]; float val;
                        if (mat == 0) { const float nx = -x; const float sp = fmaxf(nx, 0.f) + log1pf(expf(-fabsf(nx))); val = expf(-expf(-sp - 0.5f)); }
                        else val = 1.f / (1.f + expf(-x));
                        STEP[t * DSTEP_T + (c >> 3) * 40 + (mat ? 16 : 8) + (c & 7)] = val;
                    }
                }
            }
            __syncthreads();
            {
                const int ch = hc0 + 8 * c8; LAS float* st = STEP + tt * DSTEP_T + c8 * 40;
                float kkr[8], ssq = 0.f, bon = 0.f;
#pragma unroll
                for (int j = 0; j < 8; ++j) { const float kx = st[24 + j], a = st[16 + j];
                    kkr[j] = kx * k_k[ch + j]; ssq = fmaf(kkr[j], kkr[j], ssq);
                    const float kf = kx * (1.f + (a - 1.f) * k_a[ch + j]); st[24 + j] = kf; bon = fmaf(st[32 + j] * kf, r_k[ch + j], bon); }
                ssq = red8(ssq); bon = red8(bon);
                const float inv = 1.f / fmaxf(sqrtf(ssq), 1e-12f);
#pragma unroll
                for (int j = 0; j < 8; ++j) { const float kk = kkr[j] * inv; st[j] = kk; st[16 + j] = kk * st[16 + j]; }
                if (c8 == 0) BON[m * 4 + h] = bon;
            }
            __syncthreads();
            for (int sb = 0; sb < 4; ++sb) {
                const int tau = 16 * sb;
                int xcs = xc, xqs = xq, tids = tid; asm volatile("" : "+v"(xcs), "+v"(xqs), "+v"(tids));
#pragma unroll
                for (int kt = 0; kt < 4; ++kt)
#pragma unroll
                    for (int j = 0; j < 4; ++j) XB[(16 * wave + 4 * xqs + j) * 64 + 16 * kt + xcs] = (bf16)f2bf(X[kt][j]);
#pragma unroll
                for (int e = 0; e < 2; ++e) {
                    const int idx = tids + 512 * e, t2 = idx >> 6, k = idx & 63;
                    const LAS float* sw = STEP + tau * DSTEP_T + (k >> 3) * 40 + 8 + (k & 7);
                    float g0 = 1.f;
#pragma unroll
                    for (int u2 = 0; u2 < 15; ++u2) g0 *= (u2 < t2) ? sw[u2 * DSTEP_T] : 1.f;
                    const float g1 = g0 * sw[t2 * DSTEP_T];
                    if (t2 == 15) GAM[k] = g1;
                    const LAS float* st = STEP + (tau + t2) * DSTEP_T + (k >> 3) * 40 + (k & 7);
                    const float ig = __builtin_amdgcn_rcpf(g1);
                    const float kh = st[24] * ig, bh = st[16] * ig;
                    KR[t2 * 64 + k] = (bf16)f2bf(st[0] * g0); KR[(16 + t2) * 64 + k] = (bf16)f2bf(st[32] * g1);
                    BKR[t2 * 64 + k] = (bf16)f2bf(kh); BKR[(16 + t2) * 64 + k] = (bf16)f2bf(bh);
                    BKT[k * 32 + t2] = (bf16)f2bf(kh); BKT[k * 32 + 16 + t2] = (bf16)f2bf(-bh);
                    const int rho = idx & 63, s2 = idx >> 6;
                    VA[rho * 32 + s2] = VS16[(tau + s2) * 64 + rho];
                }
                __syncthreads();
                f32x4 dR;
                {
                    const bf16x8_t a0 = *(const LAS bf16x8_t*)(XB + (16 * wave + xcs) * 64 + 8 * xqs), a1 = *(const LAS bf16x8_t*)(XB + (16 * wave + xcs) * 64 + 32 + 8 * xqs);
                    const bf16x8_t bk0 = *(const LAS bf16x8_t*)(KR + xcs * 64 + 8 * xqs), bk1 = *(const LAS bf16x8_t*)(KR + xcs * 64 + 32 + 8 * xqs);
                    const bf16x8_t br0 = *(const LAS bf16x8_t*)(KR + (16 + xcs) * 64 + 8 * xqs), br1 = *(const LAS bf16x8_t*)(KR + (16 + xcs) * 64 + 32 + 8 * xqs);
                    f32x4 dK = (f32x4){0.f, 0.f, 0.f, 0.f}; dR = dK;
                    dK = __builtin_amdgcn_mfma_f32_16x16x32_bf16(a0, bk0, dK, 0, 0, 0); dK = __builtin_amdgcn_mfma_f32_16x16x32_bf16(a1, bk1, dK, 0, 0, 0);
                    dR = __builtin_amdgcn_mfma_f32_16x16x32_bf16(a0, br0, dR, 0, 0, 0); dR = __builtin_amdgcn_mfma_f32_16x16x32_bf16(a1, br1, dR, 0, 0, 0);
#pragma unroll
                    for (int j = 0; j < 4; ++j) RH[(16 * wave + 4 * xqs + j) * 16 + xcs] = dK[j];
                    if (wave == 7) {
#pragma unroll
                        for (int mt = 0; mt < 2; ++mt)
#pragma unroll
                            for (int nt = 0; nt < 2; ++nt) {
                                f32x4 acc = (f32x4){0.f, 0.f, 0.f, 0.f};
#pragma unroll
                                for (int ks = 0; ks < 2; ++ks)
                                    acc = __builtin_amdgcn_mfma_f32_16x16x32_bf16(*(const LAS bf16x8_t*)(BKR + (16 * mt + xcs) * 64 + 32 * ks + 8 * xqs), *(const LAS bf16x8_t*)(KR + (16 * nt + xcs) * 64 + 32 * ks + 8 * xqs), acc, 0, 0, 0);
#pragma unroll
                                for (int j = 0; j < 4; ++j) MN[(16 * mt + 4 * xqs + j) * 32 + 16 * nt + xcs] = acc[j];
                            }
                    }
                }
                __syncthreads();
                {
                    const int rho = tids >> 2, tq = tids & 3;
                    float rhs[4];
                    { const f32x4 x = *(const LAS f32x4*)(RH + rho * 16 + 4 * tq); rhs[0] = x[0]; rhs[1] = x[1]; rhs[2] = x[2]; rhs[3] = x[3]; }
                    float vv[16];
                    {
                        const v4u w0 = *(const LAS v4u*)(VA + rho * 32), w1 = *(const LAS v4u*)(VA + rho * 32 + 8);
                        vv[0] = bflo(w0.x); vv[1] = bfhi(w0.x); vv[2] = bflo(w0.y); vv[3] = bfhi(w0.y); vv[4] = bflo(w0.z); vv[5] = bfhi(w0.z); vv[6] = bflo(w0.w); vv[7] = bfhi(w0.w);
                        vv[8] = bflo(w1.x); vv[9] = bfhi(w1.x); vv[10] = bflo(w1.y); vv[11] = bfhi(w1.y); vv[12] = bflo(w1.z); vv[13] = bfhi(w1.z); vv[14] = bflo(w1.w); vv[15] = bfhi(w1.w);
                    }
#pragma unroll
                    for (int s2 = 0; s2 < 15; ++s2) {
                        const float mine = rhs[s2 & 3];
                        const float sa = __shfl(mine, (lane_id_fresh() & ~3) | (s2 >> 2));
                        const f32x4 n4 = *(const LAS f32x4*)(MN + s2 * 32 + 4 * tq), m4 = *(const LAS f32x4*)(MN + (16 + s2) * 32 + 4 * tq);
#pragma unroll
                        for (int i = 0; i < 4; ++i) { const float upd = fmaf(vv[s2], n4[i], fmaf(-sa, m4[i], rhs[i])); rhs[i] = (4 * tq + i > s2) ? upd : rhs[i]; }
                    }
                    v2u ow; ow.x = pk2(rhs[0], rhs[1]); ow.y = pk2(rhs[2], rhs[3]);
                    *(LAS v2u*)(VA + rho * 32 + 16 + 4 * tq) = ow;
                    if (wave == 2) {
#pragma unroll
                        for (int e = 0; e < 4; ++e) {
                            const int idx = (tids & 63) + 64 * e, t2 = idx >> 4, s2 = idx & 15;
                            const bool on = s2 <= t2;
                            QP[t2 * 32 + s2] = (bf16)f2bf(on ? MN[s2 * 32 + 16 + t2] : 0.f);
                            QP[t2 * 32 + 16 + s2] = (bf16)f2bf(on ? -MN[(16 + s2) * 32 + 16 + t2] : 0.f);
                        }
                    }
                }
                __syncthreads();
                {
                    const bf16x8_t aV = *(const LAS bf16x8_t*)(VA + (16 * wave + xcs) * 32 + 8 * xqs);
                    const bf16x8_t bQ = *(const LAS bf16x8_t*)(QP + xcs * 32 + 8 * xqs);
                    const f32x4 O = __builtin_amdgcn_mfma_f32_16x16x32_bf16(aV, bQ, dR, 0, 0, 0);
                    v2u ow; ow.x = pk2(O[0], O[1]); ow.y = pk2(O[2], O[3]);
                    const size_t mo = (((size_t)b << 12) + tloc0 + tau + xcs) * 256 + hc0 + 16 * (wave & 3) + 4 * xqs;
                    *(v2u*)((wave < 4 ? OL : CCp) + mo) = ow;
#pragma unroll
                    for (int kt = 0; kt < 4; ++kt) {
                        X[kt] = __builtin_amdgcn_mfma_f32_16x16x32_bf16(aV, *(const LAS bf16x8_t*)(BKT + (16 * kt + xcs) * 32 + 8 * xqs), X[kt], 0, 0, 0);
                        const float g16 = GAM[16 * kt + xcs];
#pragma unroll
                        for (int j = 0; j < 4; ++j) X[kt][j] *= g16;
                    }
                }
                __syncthreads();
            }
        }
#undef D1_LOADRAW
        {
            float* ab = AB + (size_t)u * 8192 + (wave < 4 ? 4096 : 0);
#pragma unroll
            for (int kt = 0; kt < 4; ++kt)
#pragma unroll
                for (int j = 0; j < 4; ++j) ab[(16 * (wave & 3) + 4 * xq + j) * 64 + 16 * kt + xc] = X[kt][j];
        }
    }
}
__device__ __forceinline__ void mixD2(Ctx C, unsigned char* ws) {
    OPQ(C);
    if (C.bid >= 32) return;
    const float* AB = (const float*)(ws + WS_DAB); float* SS = (float*)(ws + WS_DSS);
    LAS float* SL = (LAS float*)C.lds; LAS float* AL = SL + 4096;
    const int tid = C.tid, rr = tid >> 3, ks = tid & 7;
    float S[8];
#pragma unroll
    for (int j = 0; j < 8; ++j) S[j] = 0.f;
    f32x4 na0, na1, nb0, nb1;
#define D2_LOAD(U) do { const float* ab_ = AB + (size_t)(U) * 8192; na0 = *(const f32x4*)(ab_ + tid * 8); na1 = *(const f32x4*)(ab_ + tid * 8 + 4); \
        nb0 = *(const f32x4*)(ab_ + 4096 + rr * 64 + 8 * ks); nb1 = *(const f32x4*)(ab_ + 4096 + rr * 64 + 8 * ks + 4); } while (0)
    D2_LOAD(C.bid * 8);
    for (int seg = 0; seg < 8; ++seg) {
        const int u = C.bid * 8 + seg;
        float* so = SS + (size_t)u * 4096 + rr * 64 + 8 * ks;
        *(f32x4*)so = (f32x4){S[0], S[1], S[2], S[3]}; *(f32x4*)(so + 4) = (f32x4){S[4], S[5], S[6], S[7]};
        if (seg == 7) break;
        __syncthreads();
        *(LAS f32x4*)(SL + rr * 64 + 8 * ks) = (f32x4){S[0], S[1], S[2], S[3]}; *(LAS f32x4*)(SL + rr * 64 + 8 * ks + 4) = (f32x4){S[4], S[5], S[6], S[7]};
        *(LAS f32x4*)(AL + tid * 8) = na0; *(LAS f32x4*)(AL + tid * 8 + 4) = na1;
        const f32x4 bb0 = nb0, bb1 = nb1;
        if (seg + 1 < 7) D2_LOAD(u + 1);
        __syncthreads();
#pragma unroll
        for (int j = 0; j < 4; ++j) { S[j] = bb0[j]; S[4 + j] = bb1[j]; }
#pragma nounroll
        for (int i = 0; i < 64; ++i) {
            const float s = SL[rr * 64 + i];
            const f32x4 a0 = *(const LAS f32x4*)(AL + i * 64 + 8 * ks), a1 = *(const LAS f32x4*)(AL + i * 64 + 8 * ks + 4);
#pragma unroll
            for (int j = 0; j < 4; ++j) { S[j] = fmaf(s, a0[j], S[j]); S[4 + j] = fmaf(s, a1[j], S[4 + j]); }
        }
    }
#undef D2_LOAD
}
__device__ __forceinline__ void mixD3(Ctx C, const Params& P, int l) {
    OPQ(C);
    unsigned char* ws = P.ws;
    bf16* DR = PLP(ws, PL_DR); const bf16* DV = PLP(ws, PL_DV); const bf16* DZ = PLP(ws, PL_DZ);
    const bf16* OL = (const bf16*)(ws + WS_OL); const bf16* CCp = (const bf16*)(ws + WS_CC); const float* BON = (const float*)(ws + WS_DBON); const float* SS = (const float*)(ws + WS_DSS);
    const float* mu = P.in[6] + l * 896; const float* gn_g = P.in[14] + l * 256; const float* gn_b = P.in[15] + l * 256;
    const int lane = C.lane, wave = C.wave;
    for (int u = C.bid; u < 256; u += C.G) {
        const int b = u >> 5, h = (u >> 3) & 3, seg = u & 7, hc = h * 64 + lane;
        float S[64];
        {
            const f32x4* sp = (const f32x4*)(SS + (size_t)u * 4096 + lane * 64);
#pragma unroll
            for (int q = 0; q < 16; ++q) { const f32x4 x = sp[q]; S[4 * q] = x[0]; S[4 * q + 1] = x[1]; S[4 * q + 2] = x[2]; S[4 * q + 3] = x[3]; }
        }
        const float muv = mu[512 + hc], gg = gn_g[hc], gb = gn_b[hc];
        unsigned short ncv[8], nol[8], nvc[9], nzz[8]; float nbon[8];
#define D3_LOAD(T8) do { const int tl0_ = seg * 512 + wave * 64 + (T8); const size_t m0_ = ((size_t)b << 12) + tl0_; \
            nvc[0] = (tl0_ > 0) ? DV[(m0_ - 1) * 256 + hc] : (unsigned short)0; \
            _Pragma("unroll") for (int j = 0; j < 8; ++j) { const size_t m = m0_ + j; ncv[j] = CCp[m * 256 + hc]; nol[j] = OL[m * 256 + hc]; nbon[j] = BON[m * 4 + h]; nvc[j + 1] = DV[m * 256 + hc]; nzz[j] = DZ[m * 256 + hc]; } } while (0)
        D3_LOAD(0);
#pragma nounroll
        for (int t8 = 0; t8 < 64; t8 += 8) {
            const int tl0 = seg * 512 + wave * 64 + t8;
            const size_t m0 = ((size_t)b << 12) + tl0;
            float cv[8], ol[8], bon[8], vc[9], zz[8];
            vc[0] = bf2f(nvc[0]);
#pragma unroll
            for (int j = 0; j < 8; ++j) { cv[j] = bf2f(ncv[j]); ol[j] = bf2f(nol[j]); bon[j] = nbon[j]; vc[j + 1] = bf2f(nvc[j + 1]); zz[j] = bf2f(nzz[j]); }
            if (t8 + 8 < 64) D3_LOAD(t8 + 8);
#pragma unroll
            for (int j = 0; j < 8; ++j) {
                float o = ol[j];
#pragma unroll
                for (int i = 0; i < 64; ++i) o = fmaf(S[i], __builtin_bit_cast(float, __builtin_amdgcn_readlane(__builtin_bit_cast(int, cv[j]), i)), o);
                const float mean = wave_sum(o) * (1.f / 64.f); const float d = o - mean; const float var = wave_sum(d * d) * (1.f / 64.f);
                float y = d * __builtin_amdgcn_rsqf(var + 64e-5f) * gg + gb;
                y += bon[j] * (vc[j + 1] + muv * (vc[j] - vc[j + 1]));
                DR[(m0 + j) * 256 + hc] = (bf16)f2bf(y * zz[j] * fsig(zz[j]));
            }
        }
#undef D3_LOAD
    }
}

template <bool OUT>
__device__ __forceinline__ void mixB_chunks(Ctx C, unsigned char* ws, const float* normg, bf16* OUTP) {
    OPQ(C);
    const bf16* BQ = PLP(ws, PL_BQ); const bf16* BI = PLP(ws, PL_BI); const bf16* BZ = PLP(ws, PL_BZ); const float* BF = (const float*)(ws + WS_BF);
    float* BS = (float*)(ws + WS_BS); float* BG = (float*)(ws + WS_BG);
    LAS float* FT = (LAS float*)(C.lds + C.wave * 16384); LAS float* QT = FT + 1024; LAS float* IT = FT + 2048; LAS float* ZT = FT + 3072;
    const int lane = C.lane;
    const float gnorm = OUT ? normg[lane] : 0.f;
    for (int item = C.bid * 8 + C.wave; item < 2048; item += C.G * 8) {
        const int bh = item >> 6, c = item & 63, b = bh >> 2, h = bh & 3;
        const size_t m0 = ((size_t)b << 12) + c * 64;
        float S[64];
        if (OUT) {
            const float* sp = BS + (size_t)item * 4096 + lane;
#pragma unroll
            for (int d = 0; d < 64; ++d) S[d] = sp[d * 64];
        } else {
#pragma unroll
            for (int d = 0; d < 64; ++d) S[d] = 0.f;
        }
        float g = 1.f;
        float nf[16]; unsigned short ni[16], nq[16], nz[16];
#define B_LOADTILE(T0) do { _Pragma("unroll") for (int s = 0; s < 16; ++s) { const size_t m = m0 + (T0) + s; nf[s] = BF[m * 256 + h * 64 + lane]; ni[s] = BI[m * 256 + h * 64 + lane]; \
            if (OUT) { nq[s] = BQ[m * 256 + h * 64 + lane]; nz[s] = BZ[m * 256 + h * 64 + lane]; } } } while (0)
        B_LOADTILE(0);
        for (int t0 = 0; t0 < 64; t0 += 16) {
#pragma unroll
            for (int s = 0; s < 16; ++s) {
                FT[s * 64 + lane] = nf[s]; IT[s * 64 + lane] = bf2f(ni[s]);
                if (OUT) { QT[s * 64 + lane] = bf2f(nq[s]); ZT[s * 64 + lane] = bf2f(nz[s]); }
            }
            if (t0 + 16 < 64) B_LOADTILE(t0 + 16);
            LDS_WAIT(); asm volatile("" ::: "memory");
            if (!OUT) {
#pragma unroll
                for (int s = 0; s < 16; ++s) g *= FT[s * 64 + lane];
            }
#pragma nounroll
            for (int s = 0; s < 16; ++s) {
                const size_t m = m0 + t0 + s;
                const float iv = IT[s * 64 + lane];
                const LAS f32x4* fp = (const LAS f32x4*)(FT + s * 64); const LAS f32x4* qp = (const LAS f32x4*)(QT + s * 64);
                float o = 0.f;
#pragma unroll
                for (int q4 = 0; q4 < 16; ++q4) {
                    const f32x4 f4 = fp[q4];
#pragma unroll
                    for (int j = 0; j < 4; ++j) S[4 * q4 + j] = fmaf(f4[j], S[4 * q4 + j] - iv, iv);
                    if (OUT) { const f32x4 qv = qp[q4];
#pragma unroll
                        for (int j = 0; j < 4; ++j) o = fmaf(qv[j], S[4 * q4 + j], o); }
                }
                if (OUT) {
                    const float r = __builtin_amdgcn_rsqf(wave_sum(o * o) * (1.f / 64.f) + 1e-6f);
                    const float z = ZT[s * 64 + lane];
                    OUTP[m * 256 + h * 64 + lane] = (bf16)f2bf(o * r * gnorm * z * fsig(z));
                }
            }
            LDS_WAIT(); asm volatile("" ::: "memory");
        }
#undef B_LOADTILE
        if (!OUT) {
            float* sp = BS + (size_t)item * 4096 + lane;
#pragma unroll
            for (int d = 0; d < 64; ++d) sp[d * 64] = S[d];
            BG[item * 64 + lane] = g;
        }
    }
}
__device__ __forceinline__ void mixB_scan(Ctx C, unsigned char* ws) {
    OPQ(C);
    float* BS = (float*)(ws + WS_BS); const float* BG = (const float*)(ws + WS_BG);
    for (int e = C.bid * 512 + C.tid; e < 32 * 4096; e += C.G * 512) {
        const int bh = e >> 12, dv = e & 4095, d = dv >> 6;
        float S = 0.f;
#pragma unroll 8
        for (int c = 0; c < 64; ++c) {
            const size_t idx = ((size_t)(bh * 64 + c) << 12) + dv;
            const float sl = BS[idx], g = BG[(bh * 64 + c) * 64 + d];
            BS[idx] = S;
            S = fmaf(g, S, sl);
        }
    }
}

typedef float f32x16 __attribute__((ext_vector_type(16)));
__device__ __forceinline__ int crow_(int r, int hi) { return (r & 3) + 8 * (r >> 2) + 4 * hi; }
__device__ __forceinline__ void mixA_fast(Ctx C, unsigned char* ws, const float* bias, bf16* OUTP) {
    OPQ(C);
    const bf16* AQ = PLP(ws, PL_AQ); const bf16* AK = PLP(ws, PL_AK); const bf16* AVT = PLP(ws, PL_AV); const bf16* AZ = PLP(ws, PL_AZ);
    LAS float* BL = (LAS float*)C.lds;
    __syncthreads();
    for (int i = C.tid; i < 768; i += 512) BL[i] = bias[i] * 1.4426950408889634f;
    __syncthreads();
    const int lane = C.lane, q = lane & 31, hi = lane >> 5;
    for (int item = C.bid * 8 + C.wave; item < 2048; item += C.G * 8) {
        const int h = item & 3, c = (item >> 2) & 63, b = item >> 8;
        const size_t mq0 = ((size_t)b << 12) + c * 64;
        bf16x8_t qf[2][4];
#pragma unroll
        for (int qb = 0; qb < 2; ++qb)
#pragma unroll
            for (int s = 0; s < 4; ++s) qf[qb][s] = *(const bf16x8_t*)(AQ + (mq0 + 32 * qb + q) * 256 + h * 64 + 16 * s + 8 * hi);
        f32x16 O[2][2];
#pragma unroll
        for (int qb = 0; qb < 2; ++qb)
#pragma unroll
            for (int db = 0; db < 2; ++db)
#pragma unroll
                for (int r = 0; r < 16; ++r) O[qb][db][r] = 0.f;
        float mrun[2] = {-1e30f, -1e30f}, lrun[2] = {0.f, 0.f};
        const int klo = (c >= 8) ? (c - 8) * 64 : 0;
        const int nkb = (c * 64 + 64 - klo) >> 5;
        const LAS float* bh = BL + h * 192;
        bf16x8_t kfn[4], vtn[2][2];
#define A_LOADKV(KB) do { const size_t kb_ = (size_t)(b * 4 + h) * 128 + ((klo >> 5) + (KB)); _Pragma("unroll") for (int s = 0; s < 4; ++s) kfn[s] = *(const bf16x8_t*)(AK + ((kb_ * 4 + s) * 64 + lane) * 8); \
            _Pragma("unroll") for (int db = 0; db < 2; ++db) _Pragma("unroll") for (int s2 = 0; s2 < 2; ++s2) vtn[db][s2] = *(const bf16x8_t*)(AVT + (((kb_ * 2 + db) * 2 + s2) * 64 + lane) * 8); } while (0)
        A_LOADKV(0);
        for (int kb = 0; kb < nkb; ++kb) {
            const int kbase = klo + 32 * kb;
            bf16x8_t kf[4];
#pragma unroll
            for (int s = 0; s < 4; ++s) kf[s] = kfn[s];
            bf16x8_t vt[2][2];
#pragma unroll
            for (int db = 0; db < 2; ++db)
#pragma unroll
                for (int s2 = 0; s2 < 2; ++s2) vt[db][s2] = vtn[db][s2];
            if (kb + 1 < nkb) A_LOADKV(kb + 1);
#pragma unroll
            for (int qb = 0; qb < 2; ++qb) {
                f32x16 st;
#pragma unroll
                for (int r = 0; r < 16; ++r) st[r] = 0.f;
#pragma unroll
                for (int s = 0; s < 4; ++s) st = __builtin_amdgcn_mfma_f32_32x32x16_bf16(kf[s], qf[qb][s], st, 0, 0, 0);
                const int qpos = c * 64 + 32 * qb + q;
                float mx = -1e30f;
                if (qpos - (kbase + 31) >= 128) {
                    const float bc = bh[191];
#pragma unroll
                    for (int r = 0; r < 16; ++r) { st[r] = fmaf(st[r], 0.125f * 1.4426950408889634f, bc); mx = fmaxf(mx, st[r]); }
                } else {
#pragma unroll
                    for (int r = 0; r < 16; ++r) {
                        int rel = qpos - (kbase + crow_(r, hi)); rel = rel < -63 ? -63 : (rel > 128 ? 128 : rel);
                        st[r] = fmaf(st[r], 0.125f * 1.4426950408889634f, bh[rel + 63]);
                        mx = fmaxf(mx, st[r]);
                    }
                }
                mx = xh_max(mx);
                const float mn = fmaxf(mrun[qb], mx);
                float ps = 0.f;
#pragma unroll
                for (int r = 0; r < 16; ++r) { st[r] = __builtin_amdgcn_exp2f(st[r] - mn); ps += st[r]; }
                ps = xh_sum(ps);
                if (__builtin_amdgcn_ballot_w64(mn != mrun[qb]) != 0ull) {
                    const float al = __builtin_amdgcn_exp2f(mrun[qb] - mn);
                    lrun[qb] *= al;
#pragma unroll
                    for (int db = 0; db < 2; ++db)
#pragma unroll
                        for (int r = 0; r < 16; ++r) O[qb][db][r] *= al;
                }
                mrun[qb] = mn;
                lrun[qb] += ps;
                v4u p0, p1;
                p0.x = pk2(st[0], st[1]); p0.y = pk2(st[2], st[3]); p0.z = pk2(st[4], st[5]); p0.w = pk2(st[6], st[7]);
                p1.x = pk2(st[8], st[9]); p1.y = pk2(st[10], st[11]); p1.z = pk2(st[12], st[13]); p1.w = pk2(st[14], st[15]);
                const bf16x8_t pf0 = __builtin_bit_cast(bf16x8_t, p0), pf1 = __builtin_bit_cast(bf16x8_t, p1);
#pragma unroll
                for (int db = 0; db < 2; ++db) {
                    O[qb][db] = __builtin_amdgcn_mfma_f32_32x32x16_bf16(vt[db][0], pf0, O[qb][db], 0, 0, 0);
                    O[qb][db] = __builtin_amdgcn_mfma_f32_32x32x16_bf16(vt[db][1], pf1, O[qb][db], 0, 0, 0);
                }
            }
        }
#undef A_LOADKV
#pragma unroll
        for (int qb = 0; qb < 2; ++qb) {
            const float invl = 1.f / lrun[qb];
            const size_t mrow = (mq0 + 32 * qb + q) * 256 + h * 64;
#pragma unroll
            for (int db = 0; db < 2; ++db)
#pragma unroll
                for (int g = 0; g < 4; ++g) {
                    const int col = 32 * db + 8 * g + 4 * hi;
                    const v2u z = *(const v2u*)(AZ + mrow + col);
                    const float z0 = bflo(z.x), z1 = bfhi(z.x), z2 = bflo(z.y), z3 = bfhi(z.y);
                    v2u w;
                    w.x = pk2(O[qb][db][4 * g] * invl * z0 * fsig(z0), O[qb][db][4 * g + 1] * invl * z1 * fsig(z1));
                    w.y = pk2(O[qb][db][4 * g + 2] * invl * z2 * fsig(z2), O[qb][db][4 * g + 3] * invl * z3 * fsig(z3));
                    *(v2u*)(OUTP + mrow + col) = w;
                }
        }
    }
}

typedef __bf16 bf2_t __attribute__((ext_vector_type(2)));
__device__ __forceinline__ float dot2u(unsigned a, unsigned b, float c) { return __builtin_amdgcn_fdot2_f32_bf16(__builtin_bit_cast(bf2_t, a), __builtin_bit_cast(bf2_t, b), c, false); }
__device__ __forceinline__ float fma_s(float a, float b, float c) { float d; asm("v_fma_f32 %0, %1, %2, %3" : "=v"(d) : "v"(a), "v"(b), "v"(c)); return d; }
__device__ __forceinline__ float add_s(float a, float b) { float d; asm("v_add_f32_e32 %0, %1, %2" : "=v"(d) : "v"(a), "v"(b)); return d; }
__device__ __forceinline__ float mul_s(float a, float b) { float d; asm("v_mul_f32_e32 %0, %1, %2" : "=v"(d) : "v"(a), "v"(b)); return d; }
constexpr int C_NB = 256, C_CAP = 128;
constexpr int C_LDS_HIST = 0, C_LDS_QIF = 33792, C_LDS_BMP = 66560, C_LDS_QP = 99328, C_LDS_WQ = 101376, C_LDS_SCR = 102400;
enum { QP_LO = 0, QP_SC = 1, QP_CRIT = 2, QP_LO2 = 3, QP_SC2 = 4, QP_CRIT2 = 5, QP_KREM = 6, QP_CNT = 7, QP_LVL = 8, QP_CC = 9 };
__device__ __forceinline__ int c_bin(float s, float nlosc, float sc) { return (int)__builtin_amdgcn_fmed3f(fma_s(s, sc, nlosc), 0.f, (float)(C_NB - 1)); }
__device__ __forceinline__ float relu_asm(float x) { const int xi = __builtin_bit_cast(int, x); return __builtin_bit_cast(float, xi > 0 ? xi : 0); }
__device__ __forceinline__ void mixC_fast(Ctx C, unsigned char* ws, bf16* OUTP, const int parts = 3) {
    OPQ(C);
    const bf16* CQ = PLP(ws, PL_CQ); const bf16* CK = PLP(ws, PL_CK); const bf16* CVT = PLP(ws, PL_CV); const bf16* CZ = PLP(ws, PL_CZ);
    const bf16* QI0 = PLP(ws, PL_CQI0); const bf16* QI1 = PLP(ws, PL_CQI1); const bf16* KI = (const bf16*)(ws + WS_KI); const float* MS = (const float*)(ws + WS_MISC);
    LAS unsigned* HIST = (LAS unsigned*)(C.lds + C_LDS_HIST); LAS unsigned* BMP = (LAS unsigned*)(C.lds + C_LDS_BMP);
    LAS float* QPf = (LAS float*)(C.lds + C_LDS_QP); LAS int* QPi = (LAS int*)(C.lds + C_LDS_QP); LAS float* WQ = (LAS float*)(C.lds + C_LDS_WQ);
    LAS unsigned long long* LIST = (LAS unsigned long long*)(C.lds + C_LDS_HIST);
    LAS unsigned char* QIFL = C.lds + C_LDS_QIF;
    v4u* BINS = (v4u*)PLP(ws, PL_AK) + (size_t)C.bid * (128 * 64);
    const int wave = C.wave;
    if (wave & 4) __builtin_amdgcn_s_setprio(0); else __builtin_amdgcn_s_setprio(2);
    for (int pass2 = 0; pass2 < 2; ++pass2)
    for (int ui = C.bid; ui < 256; ui += C.G) {
        const int b = ui & 7, c = pass2 == 0 ? 63 - (ui >> 3) : (ui >> 3);
        const int n = 64 * (c + 1), nkb = n >> 5;
        const size_t mq0 = ((size_t)b << 12) + c * 64, mk0 = (size_t)b << 12;
        __syncthreads();
        unsigned long long tc0_ = (EXP >= 200) ? __builtin_amdgcn_s_memrealtime() : 0ull; unsigned long long tc1_ = tc0_;
#define TACC(slot) do { if (EXP >= 200 && wave == 0 && lane_id_fresh() == 0) { const unsigned long long tn_ = __builtin_amdgcn_s_memrealtime(); atomicAdd((unsigned*)(ws + WS_CTL) + 8192 + 16 * (slot) + 2, (unsigned)(tn_ - tc1_)); tc1_ = tn_; } } while (0)
        if (!(parts & 1)) {} else if (c <= 3) {
            const int tid0 = wave * 64 + lane_id_fresh();
            for (int i = tid0; i < 64 * 128; i += 512) BMP[i] = ((i & 127) < nkb) ? 0xFFFFFFFFu : 0u;
        } else {
          for (int qb = 0; qb < 2; ++qb) {
            {
                const int lane = lane_id_fresh();
#pragma nounroll
                for (int qq = 0; qq < 4; ++qq) {
                    const int qx = wave * 4 + qq; const size_t m = mq0 + 32 * qb + qx;
                    const int hh = lane >> 3;
                    const v4u w = *(const v4u*)((hh < 4 ? QI0 : QI1) + m * 256 + (hh & 3) * 64 + 8 * (lane & 7));
                    float ssq;
                    { const float a0 = bflo(w.x), a1 = bfhi(w.x), a2 = bflo(w.y), a3 = bfhi(w.y), a4 = bflo(w.z), a5 = bfhi(w.z), a6 = bflo(w.w), a7 = bfhi(w.w);
                      ssq = a0 * a0 + a1 * a1 + a2 * a2 + a3 * a3 + a4 * a4 + a5 * a5 + a6 * a6 + a7 * a7; }
                    ssq = red8(ssq);
                    const float wv = MS[m * 256 + 64 + hh] * (0.35355339059327373f * 0.125f);
                    float tm = 0.4f * wv * sqrtf(ssq), tv = 0.34f * wv * wv * ssq;
                    tm += dppf(tm, 4); tm += swz16f(tm); tm = xh_sum(tm);
                    tv += dppf(tv, 4); tv += swz16f(tv); tv = xh_sum(tv);
                    if ((lane & 7) == 0) WQ[qx * 8 + hh] = wv;
                    if (lane == 0) { const float sd = fmaxf(sqrtf(tv), 1e-20f);
                        { const float sc_ = (float)C_NB / (12.f * sd); QPf[qx * 16 + QP_SC] = sc_; QPf[qx * 16 + QP_LO] = -(tm - 4.f * sd) * sc_; }
                        QPi[qx * 16 + QP_KREM] = 256; QPi[qx * 16 + QP_CNT] = 0; QPi[qx * 16 + QP_LVL] = 0; QPi[qx * 16 + QP_CRIT] = -1; QPi[qx * 16 + QP_CRIT2] = -1; }
                }
                {
                    const int q = lane & 31, hi = lane >> 5;
#pragma unroll
                    for (int s = 0; s < 4; ++s) *(LAS bf16x8_t*)(QIFL + (wave * 4 + s) * 1024 + lane * 16) = *(const bf16x8_t*)((wave < 4 ? QI0 : QI1) + (mq0 + 32 * qb + q) * 256 + (wave & 3) * 64 + 16 * s + 8 * hi);
                }
            }
            TACC(6);
            int mode = 0; bool fastv = false;
            while (true) {
                if (mode == 3) {
                    const int lane = lane_id_fresh(), q = lane & 31, hi = lane >> 5;
                    const int crit1 = QPi[q * 16 + QP_CRIT];
                    v4u wr[16];
#pragma unroll
                    for (int i = 0; i < 16; ++i) { const int kb = wave + 8 * i; wr[i] = BINS[(kb < nkb ? kb : wave) * 64 + lane]; }
#pragma unroll
                    for (int i = 0; i < 16; ++i) {
                        const int kb = wave + 8 * i;
                        if (kb < nkb) {
                            unsigned bits = 0u;
#pragma unroll
                            for (int r = 0; r < 16; ++r) {
                                const int b1 = (int)((wr[i][r >> 2] >> (8 * (r & 3))) & 255u);
                                if (b1 > crit1) bits |= 1u << ((r & 3) + 8 * (r >> 2));
                                if (b1 == crit1) { const unsigned pos = atomicAdd((unsigned*)&QPi[q * 16 + QP_CNT], 1u);
                                    if (pos < (unsigned)C_CAP) LIST[q * C_CAP + pos] = (unsigned long long)(unsigned)(32 * kb + crow_(r, hi)); }
                            }
                            bits <<= 4 * hi;
                            bits = xh_or(bits);
                            if (hi == 0) BMP[(32 * qb + q) * 128 + kb] = bits;
                        }
                    }
                    fastv = true;
                    __syncthreads();
                    TACC(7);
                    break;
                }
                {
                    const int lane = lane_id_fresh(), q = lane & 31, hi = lane >> 5;
                    if (mode < 2) { for (int i = wave * 64 + lane; i < 32 * 257; i += 512) HIST[i] = 0u; }
                    __syncthreads();
                    const float lo1 = QPf[q * 16 + QP_LO], sc1 = QPf[q * 16 + QP_SC]; const int crit1 = QPi[q * 16 + QP_CRIT]; const int lvl = QPi[q * 16 + QP_LVL];
                    bf16x8_t qif[4][4];
#pragma unroll
                    for (int hh = 0; hh < 4; ++hh)
#pragma unroll
                        for (int s = 0; s < 4; ++s) qif[hh][s] = *(const LAS bf16x8_t*)(QIFL + (hh * 4 + s) * 1024 + lane * 16);
                    bf16x8_t kr0[4], kr1[4], kr2[4];
#define C_LOADKI(dst, KB) do { if ((KB) < nkb) { _Pragma("unroll") for (int s = 0; s < 4; ++s) dst[s] = *(const bf16x8_t*)(KI + ((((size_t)b * 128 + (KB)) * 4 + s) * 64 + lane) * 8); } } while (0)
                    C_LOADKI(kr0, wave); C_LOADKI(kr1, wave + 8); C_LOADKI(kr2, wave + 16);
                    for (int kb = wave; kb < nkb; kb += 8) {
                        const int kbase = 32 * kb;
                        bf16x8_t kif[4];
#pragma unroll
                        for (int s = 0; s < 4; ++s) { kif[s] = kr0[s]; kr0[s] = kr1[s]; kr1[s] = kr2[s]; }
                        C_LOADKI(kr2, kb + 24);
                        f32x16 I;
#pragma unroll
                        for (int r = 0; r < 16; ++r) I[r] = 0.f;
#pragma unroll
                        for (int hh = 0; hh < 8; ++hh) {
                            f32x16 D;
#pragma unroll
                            for (int r = 0; r < 16; ++r) D[r] = 0.f;
                            if (hh < 4) {
#pragma unroll
                                for (int s = 0; s < 4; ++s) D = __builtin_amdgcn_mfma_f32_32x32x16_bf16(kif[s], qif[hh][s], D, 0, 0, 0);
                            } else {
#pragma unroll
                                for (int s = 0; s < 4; ++s) D = __builtin_amdgcn_mfma_f32_32x32x16_bf16(kif[s], *(const LAS bf16x8_t*)(QIFL + (hh * 4 + s) * 1024 + lane * 16), D, 0, 0, 0);
                            }
                            const float wqh = WQ[q * 8 + hh];
#pragma unroll
                            for (int r = 0; r < 16; ++r) I[r] = fma_s(relu_asm(D[r]), wqh, I[r]);
                            asm volatile("" : "+v"(kif[0]), "+v"(kif[1]), "+v"(kif[2]), "+v"(kif[3]), "+v"(I));
                        }
                        if (mode == 0) {
                            v4u rec; rec.x = 0u; rec.y = 0u; rec.z = 0u; rec.w = 0u;
#pragma unroll
                            for (int r = 0; r < 16; ++r) { const int bn = c_bin(I[r], lo1, sc1); atomicAdd((unsigned*)&HIST[q * 257 + bn], 1u); rec[r >> 2] |= (unsigned)bn << (8 * (r & 3)); }
                            BINS[kb * 64 + lane] = rec;
                        } else if (mode == 1) {
                            if (lvl == 1) {
                                const float lo2 = QPf[q * 16 + QP_LO2], sc2 = QPf[q * 16 + QP_SC2];
#pragma unroll
                                for (int r = 0; r < 16; ++r) { if (c_bin(I[r], lo1, sc1) == crit1) { const int bn = c_bin(I[r], lo2, sc2); atomicAdd((unsigned*)&HIST[q * 257 + bn], 1u); } }
                            }
                        } else {
                            unsigned bits = 0u;
#pragma unroll
                            for (int r = 0; r < 16; ++r) {
                                const int b1 = c_bin(I[r], lo1, sc1);
                                bool sel = b1 > crit1, cand = (b1 == crit1);
                                if (cand && lvl == 1) { const int b2 = c_bin(I[r], QPf[q * 16 + QP_LO2], QPf[q * 16 + QP_SC2]); const int crit2 = QPi[q * 16 + QP_CRIT2]; sel = b2 > crit2; cand = (b2 == crit2); }
                                if (sel) bits |= 1u << ((r & 3) + 8 * (r >> 2));
                                if (cand) { const unsigned pos = atomicAdd((unsigned*)&QPi[q * 16 + QP_CNT], 1u);
                                    if (pos < (unsigned)C_CAP) LIST[q * C_CAP + pos] = ((unsigned long long)__float_as_uint(I[r]) << 32) | (unsigned)(kbase + crow_(r, hi)); }
                            }
                            bits <<= 4 * hi;
                            bits = xh_or(bits);
                            if (hi == 0) BMP[(32 * qb + q) * 128 + kb] = bits;
                        }
                    }
                }
#undef C_LOADKI
                __syncthreads();
                TACC(7);
                if (mode == 2) break;
                {
                    const int lane = lane_id_fresh();
                    LAS unsigned* SCR = (LAS unsigned*)(C.lds + C_LDS_SCR + wave * 256);
#pragma nounroll
                    for (int qq = 0; qq < 4; ++qq) {
                        const int qx = wave * 4 + qq;
                        const int lv = QPi[qx * 16 + QP_LVL];
                        if (mode == 1 && lv == 0) continue;
                        const int krem = QPi[qx * 16 + QP_KREM];
                        unsigned cnt[4]; unsigned s = 0u;
#pragma unroll
                        for (int j = 0; j < 4; ++j) { cnt[j] = HIST[qx * 257 + lane * 4 + j]; s += cnt[j]; }
                        SCR[lane] = s; LDS_WAIT(); asm volatile("" ::: "memory");
                        unsigned incl = 0u;
#pragma unroll 8
                        for (int l2 = 0; l2 < 64; ++l2) { const unsigned t = SCR[l2]; incl += (l2 >= lane) ? t : 0u; }
                        LDS_WAIT(); asm volatile("" ::: "memory");
                        unsigned run = incl - s;
                        int fcrit = -1; unsigned frun = 0u, fcnt = 0u;
#pragma unroll
                        for (int j = 3; j >= 0; --j) {
                            const bool hit = run < (unsigned)krem && run + cnt[j] >= (unsigned)krem;
                            fcrit = hit ? lane * 4 + j : fcrit; frun = hit ? run : frun; fcnt = hit ? cnt[j] : fcnt;
                            run += cnt[j];
                        }
                        if (fcrit >= 0) {
                            QPi[qx * 16 + QP_KREM] = krem - (int)frun; QPi[qx * 16 + QP_CC] = (int)fcnt;
                            if (mode == 0) { QPi[qx * 16 + QP_CRIT] = fcrit;
                                if (fcnt > (unsigned)C_CAP) { const float nlosc = QPf[qx * 16 + QP_LO], sc = QPf[qx * 16 + QP_SC];
                                    QPf[qx * 16 + QP_LO2] = (nlosc - (float)fcrit) * (float)C_NB; QPf[qx * 16 + QP_SC2] = sc * (float)C_NB; QPi[qx * 16 + QP_LVL] = 1; } }
                            else QPi[qx * 16 + QP_CRIT2] = fcrit;
                        }
                    }
                }
                __syncthreads();
                TACC(8);
                if (mode == 0) { bool need_l2 = false; for (int qx = 0; qx < 32; ++qx) need_l2 |= (QPi[qx * 16 + QP_LVL] == 1); mode = need_l2 ? 1 : ((EXP == 31 || EXP == 33) ? 2 : 3); }
                else mode = 2;
                __syncthreads();
            }
            if (EXP == 33) fastv = true;
            {
                const int lane = lane_id_fresh();
                if (fastv) {
                    int o1 = QPi[(wave * 4 + 0) * 16 + QP_CNT], o2 = QPi[(wave * 4 + 1) * 16 + QP_CNT], o3 = QPi[(wave * 4 + 2) * 16 + QP_CNT], o4 = QPi[(wave * 4 + 3) * 16 + QP_CNT];
                    o1 = o1 < C_CAP ? o1 : C_CAP; o2 = o1 + (o2 < C_CAP ? o2 : C_CAP); o3 = o2 + (o3 < C_CAP ? o3 : C_CAP); o4 = o3 + (o4 < C_CAP ? o4 : C_CAP);
                    for (int g = lane; g < o4; g += 64) {
                        const int qq = (g >= o1 ? 1 : 0) + (g >= o2 ? 1 : 0) + (g >= o3 ? 1 : 0);
                        const int ci = g - (qq == 0 ? 0 : (qq == 1 ? o1 : (qq == 2 ? o2 : o3)));
                        const int qx = wave * 4 + qq;
                        const unsigned idx = (unsigned)LIST[qx * C_CAP + ci];
                        const bf16* kp = KI + ((size_t)(b * 128 + (int)(idx >> 5)) * 4 * 64 + (idx & 31u)) * 8;
                        v4u kk[8];
#pragma unroll
                        for (int s = 0; s < 4; ++s)
#pragma unroll
                            for (int h2 = 0; h2 < 2; ++h2) kk[s * 2 + h2] = *(const v4u*)(kp + (s * 64 + h2 * 32) * 8);
                        float Iv = 0.f;
#pragma unroll
                        for (int hh = 0; hh < 8; ++hh) {
                            float d = 0.f;
#pragma unroll
                            for (int s = 0; s < 4; ++s)
#pragma unroll
                                for (int h2 = 0; h2 < 2; ++h2) {
                                    const v4u qv = *(const LAS v4u*)(QIFL + (hh * 4 + s) * 1024 + (h2 * 32 + qx) * 16);
                                    const v4u kv = kk[s * 2 + h2];
                                    d = dot2u(kv.x, qv.x, d); d = dot2u(kv.y, qv.y, d); d = dot2u(kv.z, qv.z, d); d = dot2u(kv.w, qv.w, d);
                                }
                            Iv = fmaf(fmaxf(d, 0.f), WQ[qx * 8 + hh], Iv);
                        }
                        LIST[qx * C_CAP + ci] = ((unsigned long long)__float_as_uint(Iv) << 32) | idx;
                    }
                    LDS_WAIT(); asm volatile("" ::: "memory");
                }
#pragma nounroll
                for (int qq = 0; qq < 4; ++qq) {
                    const int qx = wave * 4 + qq;
                    int cn = QPi[qx * 16 + QP_CNT]; cn = cn < C_CAP ? cn : C_CAP;
                    const int need = QPi[qx * 16 + QP_KREM];
                    for (int ci = lane; ci < cn; ci += 64) {
                        const unsigned long long me = LIST[qx * C_CAP + ci];
                        const float mv = __uint_as_float((unsigned)(me >> 32)); const unsigned mi = (unsigned)me;
                        int rank = 0;
                        for (int j = 0; j < cn; ++j) { const unsigned long long o = LIST[qx * C_CAP + j]; const float ov = __uint_as_float((unsigned)(o >> 32)); const unsigned oi = (unsigned)o;
                            rank += (ov > mv || (ov == mv && oi < mi)) ? 1 : 0; }
                        if (rank < need) atomicOr((unsigned*)&BMP[(32 * qb + qx) * 128 + (mi >> 5)], 1u << (mi & 31));
                    }
                }
            }
            __syncthreads();
            TACC(9);
          }
        }
        __syncthreads();
        if (EXP >= 200 && wave == 0 && lane_id_fresh() == 0) { const unsigned long long tn_ = __builtin_amdgcn_s_memrealtime(); atomicAdd((unsigned*)(ws + WS_CTL) + 8192 + 16 * 4 + 2, (unsigned)(tn_ - tc0_)); tc0_ = tn_; }
        if (parts & 2) {
            const int lane = lane_id_fresh(), q = lane & 31, hi = lane >> 5;
            const int qb = wave & 1, h = wave >> 1, ql = 32 * qb + q;
            bf16x8_t qf[4];
#pragma unroll
            for (int s = 0; s < 4; ++s) qf[s] = *(const bf16x8_t*)(CQ + (mq0 + ql) * 256 + h * 64 + 16 * s + 8 * hi);
            f32x16 O[2];
#pragma unroll
            for (int db = 0; db < 2; ++db)
#pragma unroll
                for (int r = 0; r < 16; ++r) O[db][r] = 0.f;
            float mrun = -1e30f, lrun = 0.f;
            bf16x8_t kfn[4], vtn[2][2];
#define C_LOADKV(KB) do { const size_t kb_ = (size_t)(b * 4 + h) * 128 + (KB); _Pragma("unroll") for (int s = 0; s < 4; ++s) kfn[s] = *(const bf16x8_t*)(CK + ((kb_ * 4 + s) * 64 + lane) * 8); \
                _Pragma("unroll") for (int db = 0; db < 2; ++db) _Pragma("unroll") for (int s2 = 0; s2 < 2; ++s2) vtn[db][s2] = *(const bf16x8_t*)(CVT + (((kb_ * 2 + db) * 2 + s2) * 64 + lane) * 8); } while (0)
            C_LOADKV(0);
            for (int kb = 0; kb < nkb; ++kb) {
                const unsigned word = BMP[ql * 128 + kb] >> (4 * hi);
                bf16x8_t kf[4];
#pragma unroll
                for (int s = 0; s < 4; ++s) kf[s] = kfn[s];
                bf16x8_t vt[2][2];
#pragma unroll
                for (int db = 0; db < 2; ++db)
#pragma unroll
                    for (int s2 = 0; s2 < 2; ++s2) vt[db][s2] = vtn[db][s2];
                if (kb + 1 < nkb) C_LOADKV(kb + 1);
                f32x16 st;
#pragma unroll
                for (int r = 0; r < 16; ++r) st[r] = 0.f;
#pragma unroll
                for (int s = 0; s < 4; ++s) st = __builtin_amdgcn_mfma_f32_32x32x16_bf16(kf[s], qf[s], st, 0, 0, 0);
                float mx = -INFINITY;
#pragma unroll
                for (int r = 0; r < 16; ++r) {
                    const bool on = (word >> ((r & 3) + 8 * (r >> 2))) & 1u;
                    st[r] = on ? st[r] : -INFINITY;
                    mx = fmaxf(mx, st[r]);
                }
                mx = xh_max(mx) * (0.125f * 1.4426950408889634f);
                const float mn = fmaxf(mrun, mx);
                float ps = 0.f;
#pragma unroll
                for (int r = 0; r < 16; ++r) { st[r] = __builtin_amdgcn_exp2f(fmaf(st[r], 0.125f * 1.4426950408889634f, -mn)); ps += st[r]; }
                ps = xh_sum(ps);
                if (__builtin_amdgcn_ballot_w64(mn != mrun) != 0ull) {
                    const float al = __builtin_amdgcn_exp2f(mrun - mn);
                    lrun *= al;
#pragma unroll
                    for (int db = 0; db < 2; ++db)
#pragma unroll
                        for (int r = 0; r < 16; ++r) O[db][r] *= al;
                }
                mrun = mn;
                lrun += ps;
                v4u p0, p1;
                p0.x = pk2(st[0], st[1]); p0.y = pk2(st[2], st[3]); p0.z = pk2(st[4], st[5]); p0.w = pk2(st[6], st[7]);
                p1.x = pk2(st[8], st[9]); p1.y = pk2(st[10], st[11]); p1.z = pk2(st[12], st[13]); p1.w = pk2(st[14], st[15]);
                const bf16x8_t pf0 = __builtin_bit_cast(bf16x8_t, p0), pf1 = __builtin_bit_cast(bf16x8_t, p1);
#pragma unroll
                for (int db = 0; db < 2; ++db) {
                    O[db] = __builtin_amdgcn_mfma_f32_32x32x16_bf16(vt[db][0], pf0, O[db], 0, 0, 0);
                    O[db] = __builtin_amdgcn_mfma_f32_32x32x16_bf16(vt[db][1], pf1, O[db], 0, 0, 0);
                }
            }
#undef C_LOADKV
            const float invl = 1.f / lrun;
            const size_t mrow = (mq0 + ql) * 256 + h * 64;
#pragma unroll
            for (int db = 0; db < 2; ++db)
#pragma unroll
                for (int g = 0; g < 4; ++g) {
                    const int col = 32 * db + 8 * g + 4 * hi;
                    const v2u z = *(const v2u*)(CZ + mrow + col);
                    const float z0 = bflo(z.x), z1 = bfhi(z.x), z2 = bflo(z.y), z3 = bfhi(z.y);
                    v2u w;
                    w.x = pk2(O[db][4 * g] * invl * z0 * fsig(z0), O[db][4 * g + 1] * invl * z1 * fsig(z1));
                    w.y = pk2(O[db][4 * g + 2] * invl * z2 * fsig(z2), O[db][4 * g + 3] * invl * z3 * fsig(z3));
                    *(v2u*)(OUTP + mrow + col) = w;
                }
        }
        if (EXP >= 200) { __syncthreads(); if (wave == 0 && lane_id_fresh() == 0) { const unsigned long long tn_ = __builtin_amdgcn_s_memrealtime(); atomicAdd((unsigned*)(ws + WS_CTL) + 8192 + 16 * 5 + 2, (unsigned)(tn_ - tc0_)); } }
    }
    __builtin_amdgcn_s_setprio(0);
}
#define GRID_BAR() do { xcd_barrier(bar, C.wave == 0 && lane_id_fresh() == 0); if (EXP >= 100) { volatile LAS unsigned* TSW = (volatile LAS unsigned*)(C.lds + MISC_OFF) + 12; const unsigned k_ = TSW[0] + 1u; if (C.wave == 0 && lane_id_fresh() == 0) { TSW[0] = k_; TSW[k_] = (unsigned)__builtin_amdgcn_s_memrealtime(); } } } while (0)
#ifndef EXP
#define EXP 0
#endif
#define REP(k) for (int rep_ = 0; rep_ < ((EXP == (k)) ? 2 : 1); ++rep_)
template <int l>
__device__ __forceinline__ void layer_body(Ctx C, const Params& P, const XcdBarrier& bar) {
    unsigned char* ws = P.ws;
    const float* xin = (l == 0) ? P.in[0] : P.out;
    bf16* DRY = (bf16*)P.out;
    REP(1) {
        pg8::Gemm g{(const pg8::bf16_t*)(ws + WS_H), (const pg8::bf16_t*)(ws + WS_W1T), NTOK, NG1, 1024};
        pg8::StaticOrder S; S.init(NTOK, NG1, C.G, C.bid);
        EpiG1 E{ws, (const float*)(ws + WS_LB) + l * 256};
        pg8::gemm_phase<EpiG1, pg8::StaticOrder, true, true>(C.lds, g, S, E, C.wave);
    }
    GRID_BAR();
    REP(2) { mixD1_ut(C, P, l); __syncthreads(); }
    REP(3) { mixB_chunks<false>(C, ws, nullptr, nullptr); __syncthreads(); }
    GRID_BAR();
    REP(16) { mixD2(C, ws); __syncthreads(); }
    mixB_scan(C, ws);
    if (l == 0) { __syncthreads(); convert_weights(C, P, 1, 1); }
    __syncthreads();
    mixA_fast(C, ws, P.in[3] + l * 4 * 192, PLP(ws, PL_AQ));
    __syncthreads();
    GRID_BAR();
#define SUBT(k) do { if (EXP >= 200) { __syncthreads(); if (C.wave == 0 && lane_id_fresh() == 0) { const unsigned long long tn_ = __builtin_amdgcn_s_memrealtime(); const unsigned d_ = (unsigned)(tn_ - tsub_); tsub_ = tn_; \
        unsigned* cw_ = (unsigned*)(ws + WS_CTL) + 8192 + 16 * (k); atomicMax(cw_ + l, d_); atomicAdd(cw_ + 2, d_); } } } while (0)
    unsigned long long tsub_ = (EXP >= 200) ? __builtin_amdgcn_s_memrealtime() : 0ull;
    REP(4) { mixD3(C, P, l); __syncthreads(); }
    SUBT(0);
    if (EXP == 5 && l == 0) { mixB_chunks<true>(C, ws, P.in[5] + l * 64, DRY); __syncthreads(); }
    mixB_chunks<true>(C, ws, P.in[5] + l * 64, PLP(ws, PL_BQ));
    SUBT(1);
    SUBT(2);
    if (EXP == 7 && l == 0) { mixC_fast(C, ws, DRY); __syncthreads(); }
    if (EXP == 17 && l == 0) { mixC_fast(C, ws, DRY, 1); __syncthreads(); }
    if (EXP == 18 && l == 0) { mixC_fast(C, ws, DRY, 2); __syncthreads(); }
    mixC_fast(C, ws, PLP(ws, PL_CQ));
    SUBT(3);
    GRID_BAR();
    REP(8) {
        pg8::Gemm g{(const pg8::bf16_t*)PLP(ws, 0), (const pg8::bf16_t*)(ws + WS_WBT), NTOK, 1024, 256, (size_t)PLANE, (size_t)1024 * 256 * 2};
        pg8::GroupedOrder S; S.init(NTOK, 1024, 4, C.G, C.bid);
        EpiBf E{(bf16*)(ws + WS_PB), 1024, (size_t)NTOK * 1024};
        pg8::gemm_phase<EpiBf, pg8::GroupedOrder, true, true>(C.lds, g, S, E, C.wave);
    }
    GRID_BAR();
    REP(9) {
        pg8::Gemm g{(const pg8::bf16_t*)(ws + WS_H), (const pg8::bf16_t*)(ws + WS_WGT), NTOK, 4096, 1024};
        pg8::StaticOrder S; S.init(NTOK, 4096, C.G, C.bid);
        EpiGate E{(const bf16*)(ws + WS_PB), (bf16*)(ws + WS_Y)};
        pg8::gemm_phase<EpiGate, pg8::StaticOrder, true, true>(C.lds, g, S, E, C.wave);
    }
    GRID_BAR();
    for (int rep_ = 0; rep_ < ((EXP == 10 && l == 0) ? 3 : 1); ++rep_) {
        pg8::Gemm g{(const pg8::bf16_t*)(ws + WS_Y), (const pg8::bf16_t*)(ws + WS_WOT), NTOK, 1024, 1024};
        pg8::StaticOrder S; S.init(NTOK, 1024, C.G, C.bid);
        EpiRes E{xin, P.out};
        pg8::gemm_phase<EpiRes, pg8::StaticOrder, true, true>(C.lds, g, S, E, C.wave);
    }
    GRID_BAR();
    if (l == 0) { REP(11) { norm_rows_bf16(C, P.out, P.in[1] + 1024, (bf16*)(ws + WS_H)); convert_weights(C, P, 1, 2); } GRID_BAR(); }
    else {
        OPQ(C); const int gw = C.bid * 8 + C.wave, NGW = C.G * 8;
        for (int m = gw; m < NTOK; m += NGW) rms_row(P.out + (size_t)m * 1024, P.in[18], nullptr, P.out + (size_t)m * 1024, C.lane);
    }
    if (EXP == 12) { for (int i = 0; i < 20; ++i) GRID_BAR(); }
}
__global__ void __launch_bounds__(512, 2) mega_fwd(Params P) {
    extern __shared__ __attribute__((aligned(16))) unsigned char lds_raw[];
    Ctx C; C.lds = (LAS unsigned char*)lds_raw; C.wave = __builtin_amdgcn_readfirstlane((int)threadIdx.x >> 6); C.G = gridDim.x; C.bid = blockIdx.x; OPQ(C);
    unsigned char* ws = P.ws;
    for (int u = C.tid; u < (LDS_BYTES - LDSCTL_OFF) / 4; u += 512) ((LAS unsigned*)(C.lds + LDSCTL_OFF))[u] = 0u;
    __syncthreads();
    volatile LAS unsigned* MISCW = (volatile LAS unsigned*)(C.lds + MISC_OFF);
    XcdBarrier bar = xcd_barrier_post((unsigned*)(ws + WS_CTL) + CW_BAR, MISCW + 8);
    if (EXP >= 100 && C.wave == 0 && lane_id_fresh() == 0) { volatile LAS unsigned* TSW = (volatile LAS unsigned*)(C.lds + MISC_OFF) + 12; TSW[0] = 1u; TSW[1] = (unsigned)__builtin_amdgcn_s_memrealtime(); }
    __syncthreads();
    for (int rep_ = 0; rep_ < ((EXP == 13) ? 2 : 1); ++rep_) { setup_tables(C, P); }
    for (int rep_ = 0; rep_ < ((EXP == 14) ? 2 : 1); ++rep_) { convert_weights(C, P, 0, 3); }
    for (int rep_ = 0; rep_ < ((EXP == 15) ? 2 : 1); ++rep_) { norm_rows_bf16(C, P.in[0], P.in[1], (bf16*)(ws + WS_H)); }
    GRID_BAR();
    layer_body<0>(C, P, bar);
    layer_body<1>(C, P, bar);
    if (EXP >= 100) {
        GRID_BAR();
        if (C.bid == 0 && C.wave == 0 && lane_id_fresh() == 0) {
            volatile LAS unsigned* TSW = (volatile LAS unsigned*)(C.lds + MISC_OFF) + 12;
            const int j = EXP - 100; unsigned dt;
            if (j >= 100) { const unsigned* cw_ = (const unsigned*)(P.ws + WS_CTL) + 8192 + 16 * ((j - 100) % 10);
                dt = (j < 110) ? (__hip_atomic_load(cw_, __ATOMIC_RELAXED, __HIP_MEMORY_SCOPE_AGENT) + __hip_atomic_load(cw_ + 1, __ATOMIC_RELAXED, __HIP_MEMORY_SCOPE_AGENT)) : (__hip_atomic_load(cw_ + 2, __ATOMIC_RELAXED, __HIP_MEMORY_SCOPE_AGENT) / 256u); }
            else if (j == 0) dt = TSW[2] - TSW[1];
            else if (j <= 7) dt = (TSW[2 + j] - TSW[1 + j]) + (TSW[10 + j] - TSW[9 + j]);
            else if (j == 8) dt = (TSW[10] - TSW[9]);
            else dt = (TSW[18] - TSW[17]);
            const unsigned long long t0 = __builtin_amdgcn_s_memrealtime();
            while (__builtin_amdgcn_s_memrealtime() - t0 < 10ull * dt) __builtin_amdgcn_s_sleep(8);
        }
    }
}

extern "C" void kernel_launch(void* const* d_in, const int* in_sizes, int n_in, void* d_out, int out_size, void* d_ws, size_t ws_size, hipStream_t stream) {
    static int grid = 0;
    if (grid == 0) {
        if (n_in != 19 || ws_size < WS_END) { fprintf(stderr, "kernel_launch: need 19 inputs and %zu bytes of workspace (got %d, %zu)\n", (size_t)WS_END, n_in, ws_size); grid = -1; return; }
        int dev = 0, cus = 0, per_cu = 0;
        if (hipGetDevice(&dev) != hipSuccess || hipDeviceGetAttribute(&cus, hipDeviceAttributeMultiprocessorCount, dev) != hipSuccess) { grid = -1; return; }
        if (hipFuncSetAttribute((const void*)mega_fwd, hipFuncAttributeMaxDynamicSharedMemorySize, LDS_BYTES) != hipSuccess) { grid = -1; return; }
        (void)hipOccupancyMaxActiveBlocksPerMultiprocessor(&per_cu, (const void*)mega_fwd, 512, LDS_BYTES);
        (void)hipGetLastError();
        grid = cus;
    }
    if (grid < 0) return;
    if (hipMemsetAsync((char*)d_ws + WS_CTL, 0, CTL_ZERO_BYTES, stream) != hipSuccess) return;
    Params p{};
    for (int i = 0; i < 19; ++i) p.in[i] = (const float*)d_in[i];
    p.out = (float*)d_out; p.ws = (unsigned char*)d_ws;
    hipLaunchKernelGGL(mega_fwd, dim3(grid), dim3(512), LDS_BYTES, stream, p);
}
```

```cpp
#define EXP 0
#include <hip/hip_runtime.h>
#include <cstdio>
#include <cstdint>
#include <math.h>

#define DM 1024
#define SEQ 4096
#define NBATCH 8
#define NTOK (NBATCH * SEQ)
#define INC 8904
#define C_AQ 0
#define C_AK 256
#define C_AV 512
#define C_AZ 768
#define C_BQ 1024
#define C_BF 1280
#define C_BI 1536
#define C_BZ 1792
#define C_CQ 2048
#define C_CK 2304
#define C_CV 2560
#define C_CZ 2816
#define C_CQI 3072
#define C_CKI 3584
#define C_CWI 3648
#define C_PD 3656
#define C_DR 3656
#define C_DK 3912
#define C_DV 4168
#define C_DWD 4424
#define C_DAD 4488
#define C_DZ 4552
#define C_PG 4808
#define NG1 4864

namespace pg8 {
#define PG8_LAS __attribute__((address_space(3)))
typedef unsigned short bf16_t;
typedef short bf16x8 __attribute__((ext_vector_type(8)));
typedef float f32x4 __attribute__((ext_vector_type(4)));
typedef unsigned u32x4 __attribute__((ext_vector_type(4)));
constexpr int BM = 256, BK = 64, HALF = 128, HTB = HALF * BK * 2  , STAGE_BYTES = 8 * HTB, NXCD = 8, WGM = 8;

__host__ __device__ __forceinline__ int lds_byte(int r, int c) { const int st = (r >> 4) * 2 + (c >> 5), rr = r & 15, cc = c & 31, ob = rr * 64 + cc * 2; return st * 1024 + (ob ^ (((ob >> 9) & 1) << 5)); }
__host__ __device__ __forceinline__ void stage_rc(int b, int& R, int& C) { const int st = b / 1024, sb = b % 1024, swz = sb ^ (((sb >> 9) & 1) << 5); R = (st >> 1) * 16 + swz / 64; C = (st & 1) * 32 + (swz % 64) / 2; }
__host__ __device__ __forceinline__ int perm32(int rho) { const int n = rho >> 4, i = rho & 15; return 8 * (i >> 2) + 4 * n + (i & 3); }

struct Unit { int pm, pn; int grp; };
struct Gemm { const bf16_t* A; const bf16_t* Bt; int M, N, K; size_t a_grp = 0, b_grp = 0; };

struct StaticOrder {
    int nM, nN, nwg, G, c;
    __host__ __device__ void init(int M, int N, int G_, int c_) { nM = M / BM; nN = N / BM; nwg = nM * nN; G = G_; c = c_; }
    __host__ __device__ bool next(int i, Unit& u) const {
        const long L = (long)i * G + c; if (L >= nwg) return false;
        int wgid = (int)L; { const int q = nwg / NXCD, r = nwg % NXCD, xcd = wgid % NXCD, off = wgid / NXCD; wgid = (xcd < r ? xcd * (q + 1) : r * (q + 1) + (xcd - r) * q) + off; }
        const int nig = WGM * nN, gid = wgid / nig, fm = gid * WGM, gsz = (nM - fm) < WGM ? (nM - fm) : WGM;
        u.pm = fm + ((wgid % nig) % gsz); u.pn = (wgid % nig) / gsz; u.grp = 0; return true;
    }
    __device__ __forceinline__ void a_ready(const Unit&) const {}
    __device__ __forceinline__ void done(const Unit&) const {}
};
struct GroupedOrder {
    StaticOrder so; int ngrp;
    __host__ __device__ void init(int M, int N, int ngrp_, int G_, int c_) { so.init(M, N, G_, c_); ngrp = ngrp_; }
    __host__ __device__ bool next(int i, Unit& u) const {
        const long L = (long)i * so.G + so.c; if (L >= (long)ngrp * so.nwg) return false;
        const int grp = (int)(L / so.nwg), loc = (int)(L % so.nwg);
        StaticOrder t = so; t.c = loc; t.G = so.nwg;
        t.next(0, u); u.grp = grp; return true;
    }
    __device__ __forceinline__ void a_ready(const Unit&) const {}
    __device__ __forceinline__ void done(const Unit&) const {}
};

__device__ __forceinline__ unsigned cvt_pk_bf16(float lo, float hi) { unsigned r; asm volatile("v_cvt_pk_bf16_f32 %0, %1, %2" : "=v"(r) : "v"(lo), "v"(hi)); return r; }
template <class Epi, class Sched, bool ALIGN_EPI = false, bool SP2 = false>
__device__ __forceinline__ void gemm_phase(PG8_LAS unsigned char* lds, const Gemm g, const Sched& S, const Epi& E, const int wave_in) {
    int lane_; asm volatile("v_mbcnt_lo_u32_b32 %0, -1, 0\n\tv_mbcnt_hi_u32_b32 %0, -1, %0" : "=v"(lane_));
    const int wid = wave_in, lane = lane_, tid = wid * 64 + lane, wr = wid >> 2, wc = wid & 3, fr = lane & 15, fq = lane >> 4;
    const int K = g.K, nt = K / BK;
    unsigned voffA[2], voffB[2];
#pragma unroll
    for (int i = 0; i < 2; ++i) { int R, C; stage_rc(tid * 16 + i * 8192, R, C); const int Rb = Epi::PERM ? ((R & ~31) + perm32(R & 31)) : R;
        voffA[i] = (unsigned)(R * K + C) * 2u; voffB[i] = (unsigned)(Rb * K + C) * 2u; }
    const size_t kstep = (size_t)(BK * 2);
    const size_t hstep = (size_t)HALF * K * 2;
    const size_t tstep = 2 * hstep;
    const unsigned ldsw = (unsigned)wid * 1024u;
    const int aoff = lds_byte(wr * 64 + fr, fq * 8), boff = lds_byte(wc * 32 + fr, fq * 8);
#define PG8_SA(b, h) (((b) * 2 + (h)) * HTB)
#define PG8_SB(b, h) ((4 + (b) * 2 + (h)) * HTB)
#define PG8_STAGE(bufoff, gbase, voff) do { _Pragma("unroll") for (int _i = 0; _i < 2; ++_i) \
        __builtin_amdgcn_global_load_lds((const unsigned*)((const char*)(gbase) + (voff)[_i]), (PG8_LAS unsigned*)(lds + (bufoff) + ldsw + _i * 8192), 16, 0, 0); } while (0)
#define PG8_LDA(dst, b, h) do { _Pragma("unroll") for (int m = 0; m < 4; ++m) _Pragma("unroll") for (int k = 0; k < 2; ++k) dst[m][k] = *(const PG8_LAS bf16x8*)(lds + PG8_SA(b, h) + aoff + m * 2048 + k * 1024); } while (0)
#define PG8_LDB(dst, b, h) do { _Pragma("unroll") for (int n = 0; n < 2; ++n) _Pragma("unroll") for (int k = 0; k < 2; ++k) dst[n][k] = *(const PG8_LAS bf16x8*)(lds + PG8_SB(b, h) + boff + n * 2048 + k * 1024); } while (0)
#define PG8_MMA(ai, bj, At, Bt) do { __builtin_amdgcn_s_setprio(1); _Pragma("unroll") for (int m = 0; m < 4; ++m) _Pragma("unroll") for (int n = 0; n < 2; ++n) _Pragma("unroll") for (int k = 0; k < 2; ++k) \
        acc[ai][bj][m][n] = __builtin_amdgcn_mfma_f32_16x16x32_bf16(Bt[n][k], At[m][k], acc[ai][bj][m][n], 0, 0, 0); __builtin_amdgcn_s_setprio(0); } while (0)
#define PG8_WAIT_V(n) asm volatile("s_waitcnt vmcnt(" #n ")" ::: "memory")
#define PG8_WAIT_L(n) asm volatile("s_waitcnt lgkmcnt(" #n ")" ::: "memory")
#define PG8_BAR __builtin_amdgcn_s_barrier()
#define PG8_SCHED __builtin_amdgcn_sched_barrier(0)
    Unit cur, nxt; int ui = 0;
    if (!S.next(0, cur)) return;
    f32x4 acc[2][2][4][2];
#pragma unroll
    for (int a = 0; a < 2; ++a)
#pragma unroll
        for (int b = 0; b < 2; ++b)
#pragma unroll
            for (int m = 0; m < 4; ++m)
#pragma unroll
                for (int n = 0; n < 2; ++n) acc[a][b][m][n] = (f32x4){0.f, 0.f, 0.f, 0.f};
    bf16x8 At[4][2], B0[2][2], B1[2][2];
    const char* cA = (const char*)g.A + (size_t)cur.grp * g.a_grp + (size_t)cur.pm * tstep; const char* cB = (const char*)g.Bt + (size_t)cur.grp * g.b_grp + (size_t)cur.pn * tstep;
    S.a_ready(cur);
    if constexpr (SP2) {
        PG8_STAGE(PG8_SB(0, 0), cB, voffB); PG8_STAGE(PG8_SB(0, 1), cB + hstep, voffB); PG8_STAGE(PG8_SA(0, 0), cA, voffA); PG8_STAGE(PG8_SA(0, 1), cA + hstep, voffA);
        if (wr == 1) PG8_BAR;
        PG8_WAIT_V(2); PG8_BAR;
        PG8_STAGE(PG8_SB(1, 0), cB + kstep, voffB); PG8_STAGE(PG8_SA(1, 0), cA + kstep, voffA); PG8_STAGE(PG8_SB(1, 1), cB + hstep + kstep, voffB);
        PG8_WAIT_V(6); PG8_BAR;
    } else {
        PG8_STAGE(PG8_SB(0, 0), cB, voffB); PG8_STAGE(PG8_SA(0, 0), cA, voffA); PG8_STAGE(PG8_SB(0, 1), cB + hstep, voffB); PG8_STAGE(PG8_SA(0, 1), cA + hstep, voffA);
        if (wr == 1) PG8_BAR;
        PG8_WAIT_V(4); PG8_BAR;
        PG8_STAGE(PG8_SB(1, 0), cB + kstep, voffB); PG8_STAGE(PG8_SA(1, 0), cA + kstep, voffA); PG8_STAGE(PG8_SB(1, 1), cB + hstep + kstep, voffB);
        PG8_WAIT_V(6); PG8_BAR;
    }
    for (;;) {
        const bool has_next = S.next(ui + 1, nxt);
        const char* nA = has_next ? (const char*)g.A + (size_t)nxt.grp * g.a_grp + (size_t)nxt.pm * tstep : cA; const char* nB = has_next ? (const char*)g.Bt + (size_t)nxt.grp * g.b_grp + (size_t)nxt.pn * tstep : cB;
        for (int t = 0; t < nt; t += 2) {
            const bool last = (t == nt - 2);
            const char* a1 = cA + (size_t)(t + 1) * kstep;
            const char* a2 = last ? nA : cA + (size_t)(t + 2) * kstep; const char* b2 = last ? nB : cB + (size_t)(t + 2) * kstep;
            const char* a3 = a2 + kstep; const char* b3 = b2 + kstep;
            if (last && has_next) S.a_ready(nxt);
            if constexpr (SP2) {
            PG8_LDB(B0, 0, 0); PG8_LDB(B1, 0, 1); PG8_SCHED; PG8_LDA(At, 0, 0); PG8_STAGE(PG8_SA(1, 1), a1 + hstep, voffA);
            PG8_WAIT_V(8); PG8_WAIT_L(0); PG8_BAR; PG8_MMA(0, 0, At, B0); PG8_MMA(0, 1, At, B1); PG8_BAR; PG8_SCHED;
            PG8_LDA(At, 0, 1); PG8_STAGE(PG8_SB(0, 0), b2, voffB); PG8_STAGE(PG8_SB(0, 1), b2 + hstep, voffB); PG8_STAGE(PG8_SA(0, 0), a2, voffA);
            PG8_WAIT_V(8); PG8_WAIT_L(0); PG8_BAR; PG8_MMA(1, 0, At, B0); PG8_MMA(1, 1, At, B1); PG8_BAR; PG8_SCHED;
            PG8_LDB(B0, 1, 0); PG8_LDB(B1, 1, 1); PG8_SCHED; PG8_LDA(At, 1, 0); PG8_STAGE(PG8_SA(0, 1), a2 + hstep, voffA);
            PG8_WAIT_V(8); PG8_WAIT_L(0); PG8_BAR; PG8_MMA(0, 0, At, B0); PG8_MMA(0, 1, At, B1); PG8_BAR; PG8_SCHED;
            PG8_LDA(At, 1, 1); PG8_STAGE(PG8_SB(1, 0), b3, voffB); PG8_STAGE(PG8_SB(1, 1), b3 + hstep, voffB); PG8_STAGE(PG8_SA(1, 0), a3, voffA);
            PG8_WAIT_V(8); PG8_WAIT_L(0); PG8_BAR; PG8_MMA(1, 0, At, B0); PG8_MMA(1, 1, At, B1); PG8_BAR; PG8_SCHED;
            } else {
            PG8_LDB(B0, 0, 0); PG8_SCHED; PG8_LDA(At, 0, 0); PG8_STAGE(PG8_SA(1, 1), a1 + hstep, voffA);
            PG8_WAIT_L(8); PG8_BAR; PG8_WAIT_L(0); PG8_MMA(0, 0, At, B0); PG8_BAR; PG8_SCHED;
            PG8_LDB(B1, 0, 1); PG8_STAGE(PG8_SB(0, 0), b2, voffB);
            PG8_BAR; PG8_WAIT_L(0); PG8_MMA(0, 1, At, B1); PG8_BAR;
            PG8_LDA(At, 0, 1); PG8_STAGE(PG8_SA(0, 0), a2, voffA);
            PG8_BAR; PG8_WAIT_L(0); PG8_MMA(1, 0, At, B0); PG8_BAR; PG8_SCHED;
            PG8_STAGE(PG8_SB(0, 1), b2 + hstep, voffB);
            PG8_WAIT_V(6); PG8_BAR; PG8_MMA(1, 1, At, B1); PG8_BAR;
            PG8_LDB(B0, 1, 0); PG8_SCHED; PG8_LDA(At, 1, 0); PG8_STAGE(PG8_SA(0, 1), a2 + hstep, voffA);
            PG8_WAIT_L(8); PG8_BAR; PG8_WAIT_L(0); PG8_MMA(0, 0, At, B0); PG8_BAR; PG8_SCHED;
            PG8_LDB(B1, 1, 1); PG8_STAGE(PG8_SB(1, 0), b3, voffB);
            PG8_BAR; PG8_WAIT_L(0); PG8_MMA(0, 1, At, B1); PG8_BAR;
            PG8_LDA(At, 1, 1); PG8_STAGE(PG8_SA(1, 0), a3, voffA);
            PG8_BAR; PG8_WAIT_L(0); PG8_MMA(1, 0, At, B0); PG8_BAR; PG8_SCHED;
            PG8_STAGE(PG8_SB(1, 1), b3 + hstep, voffB);
            PG8_WAIT_V(6); PG8_BAR; PG8_MMA(1, 1, At, B1); PG8_BAR;
            }
        }
        if constexpr (ALIGN_EPI) { if (wr == 0) PG8_BAR; }
        if constexpr (!Epi::AFTER_DRAIN) { E(acc, cur, wr, wc, fr, fq); S.done(cur); }
        if (!has_next) break;
#pragma unroll
        for (int a = 0; a < 2; ++a)
#pragma unroll
            for (int b = 0; b < 2; ++b)
#pragma unroll
                for (int m = 0; m < 4; ++m)
#pragma unroll
                    for (int n = 0; n < 2; ++n) acc[a][b][m][n] = (f32x4){0.f, 0.f, 0.f, 0.f};
        cur = nxt; cA = nA; cB = nB; ++ui;
        if constexpr (ALIGN_EPI) { if (wr == 1) PG8_BAR; }
    }
    PG8_WAIT_V(0);
    if constexpr (!ALIGN_EPI) { if (wr == 0) PG8_BAR; }
    PG8_BAR;
    if constexpr (Epi::AFTER_DRAIN) { E.fused(acc, cur, wr, wc, fr, fq, lds, wid, lane); S.done(cur); }
#undef PG8_SA
#undef PG8_SB
#undef PG8_STAGE
#undef PG8_LDA
#undef PG8_LDB
#undef PG8_MMA
#undef PG8_WAIT_V
#undef PG8_WAIT_L
#undef PG8_BAR
#undef PG8_SCHED
}
}

#define GAS __attribute__((address_space(1)))
#define LAS __attribute__((address_space(3)))
typedef unsigned short bf16;
typedef unsigned v4u __attribute__((ext_vector_type(4)));
typedef unsigned v2u __attribute__((ext_vector_type(2)));
typedef float f32x4 __attribute__((ext_vector_type(4)));
typedef GAS unsigned gu32;
#define RLX_AGENT __ATOMIC_RELAXED, __HIP_MEMORY_SCOPE_AGENT
#define LDS_WAIT() asm volatile("s_waitcnt lgkmcnt(0)" ::: "memory")
#define VM_WAIT() asm volatile("s_waitcnt vmcnt(0)" ::: "memory")
__device__ __forceinline__ unsigned f2bf(float f) { unsigned u = __builtin_bit_cast(unsigned, f); return (u + 0x7fffu + ((u >> 16) & 1u)) >> 16; }
typedef float f32x2_t_ __attribute__((ext_vector_type(2))); typedef __bf16 bf16x2_t_ __attribute__((ext_vector_type(2)));
__device__ __forceinline__ unsigned pk2(float lo, float hi) { const f32x2_t_ v = {lo, hi}; const bf16x2_t_ b = __builtin_convertvector(v, bf16x2_t_); return __builtin_bit_cast(unsigned, b); }
__device__ __forceinline__ float bf2f(unsigned short b) { return __builtin_bit_cast(float, (unsigned)b << 16); }
__device__ __forceinline__ float bflo(unsigned w) { return __builtin_bit_cast(float, w << 16); }
__device__ __forceinline__ float bfhi(unsigned w) { return __builtin_bit_cast(float, w & 0xffff0000u); }
__device__ __forceinline__ float sigmoidf_(float x) { return 1.f / (1.f + expf(-x)); }
__device__ __forceinline__ float fsig(float x) { return __builtin_amdgcn_rcpf(1.f + __builtin_amdgcn_exp2f(-1.4426950408889634f * x)); }
__device__ __forceinline__ float siluf_(float x) { return x / (1.f + expf(-x)); }
__device__ __forceinline__ float dppf(float x, const int sel) {
    const int xi = __builtin_bit_cast(int, x); int r;
    if (sel == 0) r = __builtin_amdgcn_update_dpp(xi, xi, 0xB1, 0xF, 0xF, false);
    else if (sel == 1) r = __builtin_amdgcn_update_dpp(xi, xi, 0x4E, 0xF, 0xF, false);
    else if (sel == 2) r = __builtin_amdgcn_update_dpp(xi, xi, 0x141, 0xF, 0xF, false);
    else if (sel == 3) r = __builtin_amdgcn_update_dpp(xi, xi, 0x140, 0xF, 0xF, false);
    else r = __builtin_amdgcn_update_dpp(xi, xi, 0x128, 0xF, 0xF, false);
    return __builtin_bit_cast(float, r);
}
__device__ __forceinline__ float swz16f(float x) { return __builtin_bit_cast(float, __builtin_amdgcn_ds_swizzle(__builtin_bit_cast(int, x), 0x401F)); }
__device__ __forceinline__ float xh_sum(float x) { auto rr = __builtin_amdgcn_permlane32_swap(__float_as_uint(x), __float_as_uint(x), false, false); return __uint_as_float(rr[0]) + __uint_as_float(rr[1]); }
__device__ __forceinline__ float xh_max(float x) { auto rr = __builtin_amdgcn_permlane32_swap(__float_as_uint(x), __float_as_uint(x), false, false); return fmaxf(__uint_as_float(rr[0]), __uint_as_float(rr[1])); }
__device__ __forceinline__ unsigned xh_or(unsigned x) { auto rr = __builtin_amdgcn_permlane32_swap(x, x, false, false); return rr[0] | rr[1]; }
__device__ __forceinline__ float wave_sum(float v) {
    v += dppf(v, 0); v += dppf(v, 1); v += dppf(v, 2); v += dppf(v, 3); v += swz16f(v); return xh_sum(v);
}
__device__ __forceinline__ float wave_max(float v) {
    v = fmaxf(v, dppf(v, 0)); v = fmaxf(v, dppf(v, 1)); v = fmaxf(v, dppf(v, 2)); v = fmaxf(v, dppf(v, 3)); v = fmaxf(v, swz16f(v)); return xh_max(v);
}

constexpr size_t MiB = 1u << 20;
constexpr size_t WS_CTL = 0, CTL_ZERO_BYTES = 1 * MiB;
constexpr size_t WS_COS = 1 * MiB, WS_SIN = 1 * MiB + 512 * 1024;
constexpr size_t WS_LB = 2 * MiB;
constexpr size_t WS_DBON = 3 * MiB;
constexpr size_t WS_DAB = 4 * MiB;
constexpr size_t WS_DSS = 12 * MiB;
constexpr size_t WS_W1T = 16 * MiB;
constexpr size_t WS_WGT = 26 * MiB;
constexpr size_t WS_WBT = 34 * MiB;
constexpr size_t WS_WOT = 36 * MiB;
constexpr size_t WS_KI = 38 * MiB;
constexpr size_t WS_H = 42 * MiB;
constexpr size_t WS_PL = 106 * MiB;
constexpr size_t PLANE = 16 * MiB;
constexpr size_t WS_BF = WS_PL + 17 * PLANE;
constexpr size_t WS_MISC = WS_BF + 32 * MiB;
constexpr size_t WS_OL = WS_MISC + 32 * MiB;
constexpr size_t WS_CC = WS_OL + 16 * MiB;
constexpr size_t WS_BS = WS_CC + 16 * MiB;
constexpr size_t WS_BG = WS_BS + 32 * MiB;
constexpr size_t WS_END = WS_BG + 1 * MiB;
constexpr size_t WS_Y = WS_PL;
constexpr size_t WS_PB = WS_PL + 4 * PLANE;
static_assert(WS_PB + (size_t)4 * NTOK * 1024 * 2 <= WS_OL, "P_b overlay");
enum { PL_AQ = 0, PL_BQ = 1, PL_CQ = 2, PL_DR = 3, PL_AK = 4, PL_AV = 5, PL_AZ = 6, PL_BI = 7, PL_BZ = 8, PL_CK = 9, PL_CV = 10, PL_CZ = 11, PL_CQI0 = 12, PL_CQI1 = 13, PL_DK = 14, PL_DV = 15, PL_DZ = 16 };
#define PLP(ws, i) ((bf16*)((ws) + WS_PL + (size_t)(i) * PLANE))
constexpr int CW_BAR = 4096;

constexpr int RING_BYTES = 131072;
constexpr int LDSCTL_OFF = RING_BYTES, MISC_OFF = LDSCTL_OFF + 320;
constexpr int LDS_BYTES = 147456;

__device__ __forceinline__ int rope_j(int head, int dim) {
    const int bj = head >> 1, wc = ((head & 1) << 1) | ((dim >> 4) & 1), n = dim >> 5, fq = (dim >> 2) & 3, i = dim & 3;
    return 128 * bj + 32 * wc + 16 * n + 4 * fq + i;
}
__device__ __forceinline__ int win_dst_row(int c, int& which) {
    which = 0;
    if (c < 2048) return c;
    if (c < 2304) { const int l = c - 2048; return 8 * 256 + rope_j(l >> 6, l & 63); }
    if (c < 2560) { const int l = c - 2304; return 9 * 256 + rope_j(l >> 6, l & 63); }
    if (c < 3072) return c;
    if (c < 3584) { const int l = c - 3072; return (12 + (l >> 8)) * 256 + rope_j((l >> 6) & 3, l & 63); }
    if (c < 3648) return 14 * 256 + rope_j(0, c - 3584);
    if (c < 3656) return 14 * 256 + 64 + (c - 3648);
    if (c < 3912) return 15 * 256 + (c - 3656);
    if (c < 4168) return 16 * 256 + (c - 3912);
    if (c < 4424) return 17 * 256 + (c - 4168);
    if (c < 4488) return 14 * 256 + 72 + (c - 4424);
    if (c < 4552) return 14 * 256 + 136 + (c - 4488);
    if (c < 4808) return 18 * 256 + (c - 4552);
    which = 1;
    { const int g = c - 4808, br = g >> 10, y = g & 1023, pn = y >> 6, wc = (y >> 4) & 3, fq = (y >> 2) & 3, i = y & 3;
      return 256 * pn + 128 * (br >> 1) + 32 * wc + 16 * (br & 1) + 4 * fq + i; }
}

__device__ __forceinline__ size_t kfrag_off(int bh, int t, int d) { return ((((size_t)bh * 128 + (t >> 5)) * 4 + (d >> 4)) * 64 + ((t & 31) + 32 * ((d >> 3) & 1))) * 8 + (d & 7); }
__device__ __forceinline__ size_t vfrag_off(int bh, int t, int d) { const int kk = t & 31, r16 = kk & 15;
    return (((((size_t)bh * 128 + (t >> 5)) * 2 + (d >> 5)) * 2 + (kk >> 4)) * 64 + ((d & 31) + 32 * ((r16 >> 2) & 1))) * 8 + 4 * (r16 >> 3) + (r16 & 3); }

struct EpiG1 {
    static constexpr bool PERM = false, AFTER_DRAIN = false;
    unsigned char* ws; const float* lbl;
    __device__ __forceinline__ void operator()(const f32x4 (&acc)[2][2][4][2], const pg8::Unit& u, int wr, int wc, int fr, int fq) const {
        asm volatile("" : "+v"(fr), "+v"(fq));
        const int pn = u.pn;
        const int rbase = u.pm * 256 + wr * 64 + fr;
        const int cq = wc * 32 + 4 * fq;
        if (pn == 5) {
            float* BF = (float*)(ws + WS_BF);
#pragma unroll
            for (int bj = 0; bj < 2; ++bj)
#pragma unroll
                for (int n = 0; n < 2; ++n) {
                    const int col = cq + bj * 128 + n * 16;
                    const f32x4 l4 = *(const f32x4*)(lbl + col);
#pragma unroll
                    for (int ai = 0; ai < 2; ++ai)
#pragma unroll
                        for (int m = 0; m < 4; ++m) {
                            const f32x4 x = acc[ai][bj][m][n]; f32x4 o;
#pragma unroll
                            for (int i = 0; i < 4; ++i) o[i] = 1.f - (1.f - l4[i]) * fsig(-x[i]);
                            *(f32x4*)(BF + (size_t)(rbase + ai * 128 + m * 16) * 256 + col) = o;
                            asm volatile("" ::: "memory");
                        }
                }
        } else if (pn == 14) {
            float* MS = (float*)(ws + WS_MISC);
            const float* tcos = (const float*)(ws + WS_COS); const float* tsin = (const float*)(ws + WS_SIN);
#pragma unroll
            for (int bj = 0; bj < 2; ++bj) {
                if (bj == 0 && wc < 2) {
                    const int d0 = 16 * (wc & 1) + 4 * fq;
#pragma unroll
                    for (int ai = 0; ai < 2; ++ai)
#pragma unroll
                        for (int m = 0; m < 4; ++m) {
                            const int row = rbase + ai * 128 + m * 16, pos = row & (SEQ - 1);
                            const f32x4 c4 = *(const f32x4*)(tcos + pos * 32 + d0), s4 = *(const f32x4*)(tsin + pos * 32 + d0);
                            const f32x4 x1 = acc[ai][0][m][0], x2 = acc[ai][0][m][1];
                            const f32x4 y1 = x1 * c4 - x2 * s4, y2 = x2 * c4 + x1 * s4;
                            *(f32x4*)(MS + (size_t)row * 256 + d0) = y1;
                            *(f32x4*)(MS + (size_t)row * 256 + 32 + d0) = y2;
                            bf16* KIp = (bf16*)(ws + WS_KI);
                            v2u w1, w2; w1.x = pk2(y1[0], y1[1]); w1.y = pk2(y1[2], y1[3]); w2.x = pk2(y2[0], y2[1]); w2.y = pk2(y2[2], y2[3]);
                            *(v2u*)(KIp + kfrag_off(row >> 12, pos, d0)) = w1; *(v2u*)(KIp + kfrag_off(row >> 12, pos, 32 + d0)) = w2;
                            asm volatile("" ::: "memory");
                        }
                } else {
#pragma unroll
                    for (int n = 0; n < 2; ++n)
#pragma unroll
                        for (int ai = 0; ai < 2; ++ai)
#pragma unroll
                            for (int m = 0; m < 4; ++m)
                                *(f32x4*)(MS + (size_t)(rbase + ai * 128 + m * 16) * 256 + cq + bj * 128 + n * 16) = acc[ai][bj][m][n];
                }
            }
        } else {
            const unsigned long long lo = 0ull | (0ull << 0) | (4ull << 5) | (5ull << 10) | (6ull << 15) | (1ull << 20) | (0ull << 25) | (7ull << 30) | (8ull << 35) | (2ull << 40) | (9ull << 45) | (10ull << 50) | (11ull << 55);
            const unsigned long long hi = (12ull << 0) | (13ull << 5) | (0ull << 10) | (3ull << 15) | (14ull << 20) | (15ull << 25) | (16ull << 30);
            const int plane = (int)((pn < 12 ? (lo >> (5 * pn)) : (hi >> (5 * (pn - 12)))) & 31ull);
            bf16* PLN = PLP(ws, plane);
            if (pn == 8 || pn == 9 || pn == 12 || pn == 13) {
                const float* tcos = (const float*)(ws + WS_COS); const float* tsin = (const float*)(ws + WS_SIN);
                const int d0 = 16 * (wc & 1) + 4 * fq;
#pragma unroll
                for (int ai = 0; ai < 2; ++ai)
#pragma unroll
                    for (int m = 0; m < 4; ++m) {
                        const int row = rbase + ai * 128 + m * 16, pos = row & (SEQ - 1);
                        const f32x4 c4 = *(const f32x4*)(tcos + pos * 32 + d0), s4 = *(const f32x4*)(tsin + pos * 32 + d0);
#pragma unroll
                        for (int bj = 0; bj < 2; ++bj) {
                            const int head = 2 * bj + (wc >> 1);
                            const f32x4 x1 = acc[ai][bj][m][0], x2 = acc[ai][bj][m][1];
                            const f32x4 y1 = x1 * c4 - x2 * s4, y2 = x2 * c4 + x1 * s4;
                            v2u w1, w2; w1.x = pk2(y1[0], y1[1]); w1.y = pk2(y1[2], y1[3]); w2.x = pk2(y2[0], y2[1]); w2.y = pk2(y2[2], y2[3]);
                            if (pn == 9) {
                                const int bh = (row >> 12) * 4 + head;
                                *(v2u*)(PLN + kfrag_off(bh, pos, d0)) = w1; *(v2u*)(PLN + kfrag_off(bh, pos, 32 + d0)) = w2;
                            } else {
                                *(v2u*)(PLN + (size_t)row * 256 + head * 64 + d0) = w1;
                                *(v2u*)(PLN + (size_t)row * 256 + head * 64 + 32 + d0) = w2;
                            }
                        }
                        asm volatile("" ::: "memory");
                    }
            } else if (pn == 2 || pn == 10) {
#pragma unroll
                for (int ai = 0; ai < 2; ++ai)
#pragma unroll
                    for (int m = 0; m < 4; ++m) {
                        const int row = rbase + ai * 128 + m * 16, bb = row >> 12, tq = row & (SEQ - 1);
#pragma unroll
                        for (int bj = 0; bj < 2; ++bj)
#pragma unroll
                            for (int n = 0; n < 2; ++n) {
                                const f32x4 x = acc[ai][bj][m][n]; const int col = cq + bj * 128 + n * 16;
                                bf16* p = PLN + vfrag_off(bb * 4 + (col >> 6), tq, col & 63);
#pragma unroll
                                for (int i = 0; i < 4; ++i) p[8 * i] = (bf16)f2bf(x[i]);
                            }
                        asm volatile("" ::: "memory");
                    }
            } else if (pn == 1) {
#pragma unroll
                for (int ai = 0; ai < 2; ++ai)
#pragma unroll
                    for (int m = 0; m < 4; ++m) {
                        const int row = rbase + ai * 128 + m * 16, bb = row >> 12, tq = row & (SEQ - 1);
#pragma unroll
                        for (int bj = 0; bj < 2; ++bj)
#pragma unroll
                            for (int n = 0; n < 2; ++n) {
                                const f32x4 x = acc[ai][bj][m][n]; const int col = cq + bj * 128 + n * 16;
                                v2u w; w.x = pk2(x[0], x[1]); w.y = pk2(x[2], x[3]);
                                *(v2u*)(PLN + kfrag_off(bb * 4 + (col >> 6), tq, col & 63)) = w;
                            }
                        asm volatile("" ::: "memory");
                    }
            } else if (pn == 4) {
#pragma unroll
                for (int ai = 0; ai < 2; ++ai)
#pragma unroll
                    for (int m = 0; m < 4; ++m) {
                        bf16* rowp = PLN + (size_t)(rbase + ai * 128 + m * 16) * 256 + cq;
#pragma unroll
                        for (int bj = 0; bj < 2; ++bj)
#pragma unroll
                            for (int n = 0; n < 2; ++n) {
                                f32x4 x = acc[ai][bj][m][n];
#pragma unroll
                                for (int i = 0; i < 4; ++i) x[i] = x[i] * fsig(x[i]);
                                v2u w; w.x = pk2(x[0], x[1]); w.y = pk2(x[2], x[3]);
                                *(v2u*)(rowp + bj * 128 + n * 16) = w;
                            }
                        asm volatile("" ::: "memory");
                    }
            } else {
#pragma unroll
                for (int ai = 0; ai < 2; ++ai)
#pragma unroll
                    for (int m = 0; m < 4; ++m) {
                        bf16* rowp = PLN + (size_t)(rbase + ai * 128 + m * 16) * 256 + cq;
#pragma unroll
                        for (int bj = 0; bj < 2; ++bj)
#pragma unroll
                            for (int n = 0; n < 2; ++n) {
                                const f32x4 x = acc[ai][bj][m][n];
                                v2u w; w.x = pk2(x[0], x[1]); w.y = pk2(x[2], x[3]);
                                *(v2u*)(rowp + bj * 128 + n * 16) = w;
                            }
                        asm volatile("" ::: "memory");
                    }
            }
        }
    }
};
struct EpiBf {
    static constexpr bool PERM = false, AFTER_DRAIN = false;
    bf16* O; int ldc; size_t o_grp;
    __device__ __forceinline__ void operator()(const f32x4 (&acc)[2][2][4][2], const pg8::Unit& u, int wr, int wc, int fr, int fq) const {
        asm volatile("" : "+v"(fr), "+v"(fq));
        const int rbase = u.pm * 256 + wr * 64 + fr, cb = u.pn * 256 + wc * 32 + 4 * fq;
#pragma unroll
        for (int ai = 0; ai < 2; ++ai)
#pragma unroll
            for (int m = 0; m < 4; ++m) {
                bf16* rowp = O + (size_t)u.grp * o_grp + (size_t)(rbase + ai * 128 + m * 16) * ldc + cb;
#pragma unroll
                for (int bj = 0; bj < 2; ++bj)
#pragma unroll
                    for (int n = 0; n < 2; ++n) { const f32x4 x = acc[ai][bj][m][n]; v2u w; w.x = pk2(x[0], x[1]); w.y = pk2(x[2], x[3]); *(v2u*)(rowp + bj * 128 + n * 16) = w; }
            }
    }
};
struct EpiGate {
    static constexpr bool PERM = false, AFTER_DRAIN = false;
    const bf16* PB; bf16* Y;
    __device__ __forceinline__ void operator()(const f32x4 (&acc)[2][2][4][2], const pg8::Unit& u, int wr, int wc, int fr, int fq) const {
        asm volatile("" : "+v"(fr), "+v"(fq));
        const int rbase = u.pm * 256 + wr * 64 + fr, yc = u.pn * 64 + wc * 16 + 4 * fq;
#pragma unroll
        for (int ai = 0; ai < 2; ++ai)
#pragma unroll
            for (int m = 0; m < 4; ++m) {
                const size_t row = (size_t)(rbase + ai * 128 + m * 16);
                f32x4 y = (f32x4){0.f, 0.f, 0.f, 0.f};
#pragma unroll
                for (int br = 0; br < 4; ++br) {
                    const v2u pw = *(const v2u*)(PB + ((size_t)br * NTOK + row) * 1024 + yc);
                    const f32x4 g = acc[ai][br >> 1][m][br & 1];
                    y[0] += bflo(pw.x) * fsig(g[0]); y[1] += bfhi(pw.x) * fsig(g[1]);
                    y[2] += bflo(pw.y) * fsig(g[2]); y[3] += bfhi(pw.y) * fsig(g[3]);
                }
                v2u w; w.x = pk2(y[0], y[1]); w.y = pk2(y[2], y[3]);
                *(v2u*)(Y + row * 1024 + yc) = w;
                asm volatile("" ::: "memory");
            }
    }
};
struct EpiRes {
    static constexpr bool PERM = false, AFTER_DRAIN = false;
    const float* R; float* O;
    __device__ __forceinline__ void operator()(const f32x4 (&acc)[2][2][4][2], const pg8::Unit& u, int wr, int wc, int fr, int fq) const {
        asm volatile("" : "+v"(fr), "+v"(fq));
        const int rbase = u.pm * 256 + wr * 64 + fr, cb = u.pn * 256 + wc * 32 + 4 * fq;
#pragma unroll
        for (int ai = 0; ai < 2; ++ai)
#pragma unroll
            for (int m = 0; m < 4; ++m) {
                const size_t off = (size_t)(rbase + ai * 128 + m * 16) * 1024 + cb;
#pragma unroll
                for (int bj = 0; bj < 2; ++bj)
#pragma unroll
                    for (int n = 0; n < 2; ++n) { const f32x4 r = *(const f32x4*)(R + off + bj * 128 + n * 16); *(f32x4*)(O + off + bj * 128 + n * 16) = r + acc[ai][bj][m][n]; }
            }
    }
};
#define XB_TMO      128
#define XB_XCNT(j)  (256  + 64 * (j))
#define XB_XSUB(j)  (1280 + 64 * (j))
#define XB_XGEN(j)  (2304 + 64 * (j))
#define XB_TOP      3328
#define XB_TOPGEN   3392
#define XCD_BAR_WORDS 3456
#define XB_SPIN_CAP (1u << 18)

__device__ __forceinline__ unsigned xb_ld(unsigned* p)              { return __hip_atomic_load(p, __ATOMIC_RELAXED, __HIP_MEMORY_SCOPE_AGENT); }
__device__ __forceinline__ unsigned xb_add(unsigned* p, unsigned v) { return __hip_atomic_fetch_add(p, v, __ATOMIC_RELAXED, __HIP_MEMORY_SCOPE_AGENT); }
__device__ __forceinline__ unsigned xb_xcc_id() { return (unsigned)__builtin_amdgcn_s_getreg((3 << 11) | 20) & 0xFu; }
#define XB_SPIN(cond, bar) do { unsigned _sp = 0; while (cond) { __builtin_amdgcn_s_sleep(1); \
    if ((++_sp & 255u) == 0u) { if (xb_ld(&(bar)[XB_TMO])) break; if (_sp > XB_SPIN_CAP) { atomicAdd(&(bar)[XB_TMO], 1u); break; } } } } while (0)

struct XcdBarrier {
    unsigned* bar; unsigned x;
    volatile LAS unsigned* st;
};

__device__ __forceinline__ XcdBarrier xcd_barrier_post(unsigned* bar, volatile LAS unsigned* st) {
    XcdBarrier b; b.bar = bar; b.x = xb_xcc_id(); b.st = st;
    if (threadIdx.x == 0) (void)xb_add(&bar[XB_XCNT(b.x)], 1u);
    return b;
}
__device__ __forceinline__ void xcd_barrier_complete(unsigned* bar, unsigned x, unsigned& nloc, unsigned& nx) {
    const unsigned G = gridDim.x * gridDim.y * gridDim.z;
    unsigned sum, cnt, mine, sp = 0u;
    for (;;) {
        sum = 0u; cnt = 0u; mine = 0u;
#pragma unroll
        for (unsigned j = 0; j < 16; ++j) { const unsigned c = xb_ld(&bar[XB_XCNT(j)]); sum += c; cnt += (c > 0u) ? 1u : 0u; mine = (j == x) ? c : mine; }
        if (sum == G) break;
        __builtin_amdgcn_s_sleep(1);
        if ((++sp & 255u) == 0u) { if (xb_ld(&bar[XB_TMO])) break; if (sp > XB_SPIN_CAP) { atomicAdd(&bar[XB_TMO], 1u); break; } }
    }
    nloc = mine > 0u ? mine : 1u; nx = cnt > 0u ? cnt : 1u;
}

__device__ __forceinline__ void xcd_barrier(const XcdBarrier& b_in, const bool t0) {
    XcdBarrier b = b_in; asm volatile("" : "+s"(b.bar), "+s"(b.x));
    asm volatile("s_waitcnt vmcnt(0)" ::: "memory");
    __syncthreads();
    if (t0) {
        unsigned* bar = b.bar;
        __builtin_amdgcn_s_waitcnt(0);
        unsigned nloc = b.st[0], nx = b.st[1];
        if (nloc == 0u) { xcd_barrier_complete(bar, b.x, nloc, nx); b.st[0] = nloc; b.st[1] = nx; }
        const unsigned old = xb_add(&bar[XB_XSUB(b.x)], 1u);
        const unsigned gen = old / nloc;
        if (old + 1u == (gen + 1u) * nloc) {
            __builtin_amdgcn_fence(__ATOMIC_RELEASE, "agent");
            asm volatile("s_waitcnt vmcnt(0)" ::: "memory");
            const unsigned og = xb_add(&bar[XB_TOP], 1u);
            const unsigned tg = og / nx;
            if (og + 1u == (tg + 1u) * nx) xb_add(&bar[XB_TOPGEN], 1u);
            else XB_SPIN(xb_ld(&bar[XB_TOPGEN]) == tg, bar);
            __builtin_amdgcn_fence(__ATOMIC_ACQUIRE, "agent");
            xb_add(&bar[XB_XGEN(b.x)], 1u);
            asm volatile("s_waitcnt vmcnt(0)" ::: "memory");
        } else {
            XB_SPIN(xb_ld(&bar[XB_XGEN(b.x)]) == gen, bar);
            __builtin_amdgcn_fence(__ATOMIC_ACQUIRE, "agent");
            asm volatile("s_waitcnt vmcnt(0)" ::: "memory");
        }
    }
    __syncthreads();
}

struct Params { const float* in[19]; float* out; unsigned char* ws; };
struct Ctx {
    LAS unsigned char* lds; int tid, lane, wave, G, bid;
};
__device__ __forceinline__ int lane_id_fresh() { int l; asm volatile("v_mbcnt_lo_u32_b32 %0, -1, 0\n\tv_mbcnt_hi_u32_b32 %0, -1, %0" : "=v"(l)); return l; }
#define OPQ(C) do { (C).lane = lane_id_fresh(); (C).tid = (C).wave * 64 + (C).lane; } while (0)

template <class MapFn>
__device__ __forceinline__ void transpose_item(const float* W, int K, int N, LAS float* scr, int item, int lane, MapFn map) {
    const int nblk = (N + 31) / 32, kb = item / nblk, nb = item % nblk, k0 = 64 * kb, n0 = 32 * nb;
    const int ncol = n0 + (lane & 31);
    float wv[32];
#pragma unroll
    for (int i = 0; i < 32; ++i) { const int kk = 2 * i + (lane >> 5); wv[i] = (ncol < N) ? W[(size_t)(k0 + kk) * N + ncol] : 0.f; }
#pragma unroll
    for (int i = 0; i < 32; ++i) { const int kk = 2 * i + (lane >> 5); scr[kk * 33 + (lane & 31)] = wv[i]; }
    LDS_WAIT(); asm volatile("" ::: "memory");
    const int c = lane & 7;
#pragma unroll
    for (int j = 0; j < 4; ++j) {
        const int n = (lane >> 3) + 8 * j; const LAS float* s = scr + (8 * c) * 33 + n;
        v4u o; o.x = pk2(s[0 * 33], s[1 * 33]); o.y = pk2(s[2 * 33], s[3 * 33]); o.z = pk2(s[4 * 33], s[5 * 33]); o.w = pk2(s[6 * 33], s[7 * 33]);
        if (n0 + n < N) { bf16* dst = map(n0 + n); if (dst) *(v4u*)(dst + k0 + 8 * c) = o; }
    }
    LDS_WAIT(); asm volatile("" ::: "memory");
}
__device__ __forceinline__ void convert_weights(Ctx C, const Params& P, int l, const int parts, const int bid0 = 0) {
    OPQ(C);
    if (C.bid < bid0) return;
    LAS float* scr = (LAS float*)(C.lds + C.wave * 16384);
    const int gw = (C.bid - bid0) * 8 + C.wave, NGW = (C.G - bid0) * 8;
    unsigned char* ws = P.ws;
    bf16* W1t = (bf16*)(ws + WS_W1T); bf16* Wgt = (bf16*)(ws + WS_WGT);
    bf16* Wbt = (bf16*)(ws + WS_WBT); bf16* Wot = (bf16*)(ws + WS_WOT);
    const float* w_in = P.in[2] + (size_t)l * 1024 * INC; const float* w_br = P.in[16] + (size_t)l * 4 * 256 * 1024; const float* w_out = P.in[17] + (size_t)l * 1024 * 1024;
    constexpr int NBLK = (INC + 31) / 32, NB1 = 151;
    if (parts & 1) {
        for (int it = gw; it < 16 * NB1; it += NGW) {
            const int item = (it / NB1) * NBLK + (it % NB1);
            transpose_item(w_in, 1024, INC, scr, item, C.lane, [&](int c) -> bf16* { int which; const int row = win_dst_row(c, which); return which ? (bf16*)nullptr : W1t + (size_t)row * 1024; });
        }
        for (int i = (C.bid - bid0) * 512 + C.tid; i < 56 * 1024 / 8; i += (C.G - bid0) * 512) *(v4u*)(W1t + (size_t)(14 * 256 + 200) * 1024 + (size_t)i * 8) = (v4u){0u, 0u, 0u, 0u};
    }
    if (parts & 2) {
        constexpr int NB2 = NBLK - 150, I_G = 16 * NB2, I_BR = 4 * 32, I_OUT = 16 * 32;
        for (int it = gw; it < I_G + 4 * I_BR + I_OUT; it += NGW) {
            int r = it;
            if (r < I_G) { const int item = (r / NB2) * NBLK + 150 + (r % NB2);
                transpose_item(w_in, 1024, INC, scr, item, C.lane, [&](int c) -> bf16* { int which; const int row = win_dst_row(c, which); return which ? Wgt + (size_t)row * 1024 : (bf16*)nullptr; }); continue; }
            r -= I_G;
            if (r < 4 * I_BR) { const int br = r / I_BR, ri = r % I_BR; transpose_item(w_br + (size_t)br * 256 * 1024, 256, 1024, scr, ri, C.lane, [&](int c) -> bf16* { return Wbt + ((size_t)br * 1024 + c) * 256; }); continue; }
            r -= 4 * I_BR;
            transpose_item(w_out, 1024, 1024, scr, r, C.lane, [&](int c) -> bf16* { return Wot + (size_t)c * 1024; });
        }
    }
}
__device__ __forceinline__ void rms_row(const float* xrow, const float* g, bf16* obf, float* of32, int lane) {
    const f32x4* xr = (const f32x4*)xrow + lane;
    f32x4 v[4]; float s = 0.f;
#pragma unroll
    for (int j = 0; j < 4; ++j) { v[j] = xr[64 * j]; s += (v[j].x * v[j].x + v[j].y * v[j].y) + (v[j].z * v[j].z + v[j].w * v[j].w); }
    const float inv = rsqrtf(wave_sum(s) * (1.f / 1024.f) + 1e-6f);
#pragma unroll
    for (int j = 0; j < 4; ++j) {
        const f32x4 gg = ((const f32x4*)g)[lane + 64 * j];
        const f32x4 o = v[j] * inv * gg;
        if (obf) { v2u w; w.x = pk2(o.x, o.y); w.y = pk2(o.z, o.w); ((v2u*)obf)[lane + 64 * j] = w; }
        else ((f32x4*)of32)[lane + 64 * j] = o;
    }
}
__device__ __forceinline__ void norm_rows_bf16(Ctx C, const float* x, const float* g, bf16* h) {
    OPQ(C);
    const int gw = C.bid * 8 + C.wave, NGW = C.G * 8;
    for (int m = gw; m < NTOK; m += NGW) rms_row(x + (size_t)m * 1024, g, h + (size_t)m * 1024, nullptr, C.lane);
}
__device__ __forceinline__ void setup_tables(Ctx C, const Params& P) {
    OPQ(C);
    float* tcos = (float*)(P.ws + WS_COS); float* tsin = (float*)(P.ws + WS_SIN); float* lb = (float*)(P.ws + WS_LB);
    for (int i = C.bid * 512 + C.tid; i < SEQ * 32; i += C.G * 512) {
        const int pos = i >> 5, j = i & 31;
        const float freq = (float)pow(10000.0, -(double)j / 32.0);
        const float ang = (float)pos * freq;
        tcos[i] = (float)cos((double)ang); tsin[i] = (float)sin((double)ang);
    }
    if (C.bid == 0 && C.tid < 256) {
        const float l0 = P.in[4][C.tid], l1 = P.in[4][256 + C.tid];
        lb[C.tid] = 0.f; lb[256 + C.tid] = 1.f / (1.f + expf(l0 - l1));
    }
}

__device__ __forceinline__ void mixA_simple(Ctx C, unsigned char* ws, const float* bias) {
    OPQ(C);
    bf16* AQ = PLP(ws, PL_AQ); const bf16* AK = PLP(ws, PL_AK); const bf16* AV = PLP(ws, PL_AV); const bf16* AZ = PLP(ws, PL_AZ);
    for (int it = C.bid * 512 + C.tid; it < 4 * NTOK; it += C.G * 512) {
        const int h = it / NTOK, m = it % NTOK, b = m >> 12, t = m & 4095, c = t >> 6, qi = t & 63;
        float q[64], o[64];
        {
            const v4u* qp = (const v4u*)(AQ + (size_t)m * 256 + h * 64);
#pragma unroll
            for (int j = 0; j < 8; ++j) { const v4u w = qp[j]; q[8 * j] = bflo(w.x); q[8 * j + 1] = bfhi(w.x); q[8 * j + 2] = bflo(w.y); q[8 * j + 3] = bfhi(w.y); q[8 * j + 4] = bflo(w.z); q[8 * j + 5] = bfhi(w.z); q[8 * j + 6] = bflo(w.w); q[8 * j + 7] = bfhi(w.w); }
        }
#pragma unroll
        for (int d = 0; d < 64; ++d) o[d] = 0.f;
        float mx = -INFINITY, l = 0.f;
        const float* bh = bias + h * 192;
        for (int kj = 0; kj < 576; ++kj) {
            const int kp = c * 64 - 512 + kj;
            if (kp < 0) continue;
            const size_t mk = ((size_t)b << 12) + kp;
            const v4u* kr = (const v4u*)(AK + mk * 256 + h * 64); const v4u* vr = (const v4u*)(AV + mk * 256 + h * 64);
            float s = 0.f;
#pragma unroll
            for (int j = 0; j < 8; ++j) { const v4u w = kr[j];
                s = fmaf(q[8 * j], bflo(w.x), s); s = fmaf(q[8 * j + 1], bfhi(w.x), s); s = fmaf(q[8 * j + 2], bflo(w.y), s); s = fmaf(q[8 * j + 3], bfhi(w.y), s);
                s = fmaf(q[8 * j + 4], bflo(w.z), s); s = fmaf(q[8 * j + 5], bfhi(w.z), s); s = fmaf(q[8 * j + 6], bflo(w.w), s); s = fmaf(q[8 * j + 7], bfhi(w.w), s); }
            int rel = qi + 512 - kj; rel = rel < -63 ? -63 : (rel > 128 ? 128 : rel);
            s = s * 0.125f + bh[rel + 63];
            const float mn = fmaxf(mx, s), al = expf(mx - mn), pe = expf(s - mn);
            l = l * al + pe; mx = mn;
#pragma unroll
            for (int j = 0; j < 8; ++j) { const v4u w = vr[j];
                o[8 * j] = fmaf(pe, bflo(w.x), o[8 * j] * al); o[8 * j + 1] = fmaf(pe, bfhi(w.x), o[8 * j + 1] * al); o[8 * j + 2] = fmaf(pe, bflo(w.y), o[8 * j + 2] * al); o[8 * j + 3] = fmaf(pe, bfhi(w.y), o[8 * j + 3] * al);
                o[8 * j + 4] = fmaf(pe, bflo(w.z), o[8 * j + 4] * al); o[8 * j + 5] = fmaf(pe, bfhi(w.z), o[8 * j + 5] * al); o[8 * j + 6] = fmaf(pe, bflo(w.w), o[8 * j + 6] * al); o[8 * j + 7] = fmaf(pe, bfhi(w.w), o[8 * j + 7] * al); }
        }
        const float invl = 1.f / l;
        const v4u* zp = (const v4u*)(AZ + (size_t)m * 256 + h * 64); v4u* op = (v4u*)(AQ + (size_t)m * 256 + h * 64);
#pragma unroll
        for (int j = 0; j < 8; ++j) { const v4u z = zp[j]; v4u w;
            w.x = pk2(o[8 * j] * invl * siluf_(bflo(z.x)), o[8 * j + 1] * invl * siluf_(bfhi(z.x))); w.y = pk2(o[8 * j + 2] * invl * siluf_(bflo(z.y)), o[8 * j + 3] * invl * siluf_(bfhi(z.y)));
            w.z = pk2(o[8 * j + 4] * invl * siluf_(bflo(z.z)), o[8 * j + 5] * invl * siluf_(bfhi(z.z))); w.w = pk2(o[8 * j + 6] * invl * siluf_(bflo(z.w)), o[8 * j + 7] * invl * siluf_(bfhi(z.w)));
            op[j] = w; }
    }
}
__device__ __forceinline__ void mixB_simple(Ctx C, unsigned char* ws, const float* normg) {
    OPQ(C);
    if (C.bid < 32 || C.bid >= 36) return;
    const int gw = (C.bid - 32) * 8 + C.wave;
    const int b = gw >> 2, h = gw & 3, v = C.lane;
    bf16* BQ = PLP(ws, PL_BQ); const bf16* BI = PLP(ws, PL_BI); const bf16* BZ = PLP(ws, PL_BZ); const float* BF = (const float*)(ws + WS_BF);
    float S[64];
#pragma unroll
    for (int d = 0; d < 64; ++d) S[d] = 0.f;
    const float g = normg[v];
    for (int t = 0; t < SEQ; ++t) {
        const size_t m = ((size_t)b << 12) + t;
        const float* fr = BF + m * 256 + h * 64; const bf16* qr = BQ + m * 256 + h * 64;
        const float iv = bf2f(BI[m * 256 + h * 64 + v]); const float z = bf2f(BZ[m * 256 + h * 64 + v]);
        float o = 0.f;
#pragma unroll
        for (int d = 0; d < 64; ++d) { S[d] = fmaf(fr[d], S[d] - iv, iv); o = fmaf(bf2f(qr[d]), S[d], o); }
        const float r = rsqrtf(wave_sum(o * o) * (1.f / 64.f) + 1e-6f);
        asm volatile("" ::: "memory");
        BQ[m * 256 + h * 64 + v] = (bf16)f2bf(o * r * g * siluf_(z));
    }
}
__device__ __forceinline__ void mixD_simple(Ctx C, unsigned char* ws, const Params& P, int l) {
    OPQ(C);
    if (C.bid >= 32) return;
    const int b = C.bid >> 2, h = C.bid & 3, tid = C.tid;
    bf16* DR = PLP(ws, PL_DR); const bf16* DK = PLP(ws, PL_DK); const bf16* DV = PLP(ws, PL_DV); const bf16* DZ = PLP(ws, PL_DZ); const float* MS = (const float*)(ws + WS_MISC);
    const float* mu = P.in[6] + l * 896; const float* w0 = P.in[7] + l * 256; const float* w_up = P.in[8] + (size_t)l * 64 * 256; const float* a0 = P.in[9] + l * 256;
    const float* a_up = P.in[10] + (size_t)l * 64 * 256; const float* k_k = P.in[11] + l * 256; const float* k_a = P.in[12] + l * 256; const float* r_k = P.in[13] + l * 256;
    const float* gn_g = P.in[14] + l * 256; const float* gn_b = P.in[15] + l * 256;
    LAS float* L = (LAS float*)C.lds;
    LAS float* twd = L; LAS float* ads = L + 64; LAS float* rs = L + 128; LAS float* kr = L + 192; LAS float* vs = L + 256;
    LAS float* wv = L + 320; LAS float* av = L + 384; LAS float* kkv = L + 448; LAS float* kfv = L + 512; LAS float* bv = L + 576; LAS float* ob = L + 640; LAS float* bon = L + 704;
    const int v = tid >> 3, ks = tid & 7;
    float S[8];
#pragma unroll
    for (int i = 0; i < 8; ++i) S[i] = 0.f;
    const int grp = tid >> 6, cc = tid & 63;
    float prev = 0.f, mucol = 0.f;
    if (grp == 0) mucol = mu[768 + cc]; else if (grp == 1) mucol = mu[832 + cc]; else if (grp == 2) mucol = mu[h * 64 + cc]; else if (grp == 3) mucol = mu[256 + h * 64 + cc]; else if (grp == 4) mucol = mu[512 + h * 64 + cc];
    for (int t = 0; t < SEQ; ++t) {
        const size_t m = ((size_t)b << 12) + t;
        if (grp < 5) {
            float cur;
            if (grp == 0) cur = MS[m * 256 + 72 + cc]; else if (grp == 1) cur = MS[m * 256 + 136 + cc];
            else if (grp == 2) cur = bf2f(DR[m * 256 + h * 64 + cc]); else if (grp == 3) cur = bf2f(DK[m * 256 + h * 64 + cc]); else cur = bf2f(DV[m * 256 + h * 64 + cc]);
            const float sh = cur + mucol * (prev - cur); prev = cur;
            if (grp == 0) twd[cc] = tanhf(sh); else if (grp == 1) ads[cc] = sh; else if (grp == 2) rs[cc] = sh; else if (grp == 3) kr[cc] = sh; else vs[cc] = sh;
        }
        __syncthreads();
        if (tid < 128) {
            const int c = tid & 63, hc = h * 64 + c;
            if (tid < 64) { float wl = w0[hc];
_Pragma("nounroll")
                for (int i = 0; i < 64; ++i) wl = fmaf(twd[i], w_up[i * 256 + hc], wl);
                const float x = -wl; const float sp = fmaxf(x, 0.f) + log1pf(expf(-fabsf(x))); wv[c] = expf(-expf(-sp - 0.5f)); }
            else { float al = a0[hc];
_Pragma("nounroll")
                for (int i = 0; i < 64; ++i) al = fmaf(ads[i], a_up[i * 256 + hc], al); av[c] = sigmoidf_(al); }
        }
        __syncthreads();
        if (tid < 64) {
            const int hc = h * 64 + tid; const float kx = kr[tid], a = av[tid];
            const float kkr = kx * k_k[hc]; const float nrm = sqrtf(wave_sum(kkr * kkr)); const float kk = kkr / fmaxf(nrm, 1e-12f);
            const float kf = kx * (1.f + (a - 1.f) * k_a[hc]);
            kkv[tid] = kk; kfv[tid] = kf; bv[tid] = kk * a;
            const float bsum = wave_sum(rs[tid] * kf * r_k[hc]); if (tid == 0) bon[0] = bsum;
        }
        __syncthreads();
        {
            float sa = 0.f;
#pragma unroll
            for (int i = 0; i < 8; ++i) sa = fmaf(S[i], kkv[8 * ks + i], sa);
            sa += __shfl_xor(sa, 1); sa += __shfl_xor(sa, 2); sa += __shfl_xor(sa, 4); sa = -sa;
            const float vv = vs[v]; float o = 0.f;
#pragma unroll
            for (int i = 0; i < 8; ++i) { S[i] = fmaf(S[i], wv[8 * ks + i], fmaf(sa, bv[8 * ks + i], vv * kfv[8 * ks + i])); o = fmaf(S[i], rs[8 * ks + i], o); }
            o += __shfl_xor(o, 1); o += __shfl_xor(o, 2); o += __shfl_xor(o, 4);
            if (ks == 0) ob[v] = o;
        }
        __syncthreads();
        if (tid < 64) {
            const int hc = h * 64 + tid; const float o = ob[tid];
            const float mean = wave_sum(o) * (1.f / 64.f); const float d = o - mean; const float var = wave_sum(d * d) * (1.f / 64.f);
            float y = d * rsqrtf(var + 64e-5f) * gn_g[hc] + gn_b[hc];
            y += bon[0] * vs[tid];
            const float z = bf2f(DZ[m * 256 + hc]);
            DR[m * 256 + hc] = (bf16)f2bf(y * siluf_(z));
        }
        __syncthreads();
    }
}
__device__ __forceinline__ void mixC_simple(Ctx C, unsigned char* ws) {
    OPQ(C);
    bf16* CQ = PLP(ws, PL_CQ); const bf16* CK = PLP(ws, PL_CK); const bf16* CV = PLP(ws, PL_CV); const bf16* CZ = PLP(ws, PL_CZ);
    const bf16* QI0 = PLP(ws, PL_CQI0); const bf16* QI1 = PLP(ws, PL_CQI1); const float* MS = (const float*)(ws + WS_MISC);
    LAS float* L = (LAS float*)C.lds;
    LAS float* qs = L;
    LAS float* q4 = L + 512;
    LAS float* wq = L + 768;
    LAS float* sc = L + 1024;
    LAS float* ps = L + 5120;
    LAS int* sel = (LAS int*)(L + 6144);
    LAS unsigned* hist = (LAS unsigned*)(L + 6400);
    LAS float* red = L + 6656;
    LAS unsigned* sw = (LAS unsigned*)(L + 6672);
    const int tid = C.tid;
    for (int m = C.bid; m < NTOK; m += C.G) {
        const int b = m >> 12, t = m & 4095, n = ((t >> 6) + 1) * 64;
        qs[tid] = bf2f(tid < 256 ? QI0[(size_t)m * 256 + tid] : QI1[(size_t)m * 256 + tid - 256]);
        if (tid < 256) q4[tid] = bf2f(CQ[(size_t)m * 256 + tid]);
        if (tid < 8) wq[tid] = MS[(size_t)m * 256 + 64 + tid] * 0.35355339059327373f;
        __syncthreads();
        for (int s = tid; s < n; s += 512) {
            const f32x4* kp = (const f32x4*)(MS + (((size_t)b << 12) + s) * 256);
            float kv[64];
#pragma unroll
            for (int j = 0; j < 16; ++j) { const f32x4 w = kp[j]; kv[4 * j] = w.x; kv[4 * j + 1] = w.y; kv[4 * j + 2] = w.z; kv[4 * j + 3] = w.w; }
            float acc = 0.f;
            for (int hh = 0; hh < 8; ++hh) {
                float d = 0.f;
#pragma unroll
                for (int c = 0; c < 64; ++c) d = fmaf(qs[hh * 64 + c], kv[c], d);
                d = fmaxf(d * 0.125f, 0.f);
                acc = fmaf(d, wq[hh], acc);
            }
            sc[s] = acc;
        }
        __syncthreads();
        int cnt;
        if (n <= 256) { if (tid < n) sel[tid] = tid; cnt = n; }
        else {
            unsigned key[8];
#pragma unroll
            for (int j = 0; j < 8; ++j) { const int idx = tid + 512 * j; unsigned kk = 0u; if (idx < n) { const unsigned u = __float_as_uint(sc[idx]); kk = (u & 0x80000000u) ? ~u : (u | 0x80000000u); } key[j] = kk; }
            if (tid == 0) { sw[0] = 0u; sw[1] = 256u; sw[3] = 0u; }
            unsigned mask = 0u;
            for (int pass = 3; pass >= 0; --pass) {
                const int shift = pass * 8;
                if (tid < 256) hist[tid] = 0u;
                __syncthreads();
                const unsigned prefix = sw[0];
#pragma unroll
                for (int j = 0; j < 8; ++j) { const int idx = tid + 512 * j; if (idx < n && (key[j] & mask) == prefix) atomicAdd((unsigned*)&hist[(key[j] >> shift) & 255u], 1u); }
                __syncthreads();
                if (tid == 0) { const unsigned k = sw[1]; unsigned c = 0u; int bb = 255; for (; bb > 0; --bb) { if (c + hist[bb] >= k) break; c += hist[bb]; }
                    sw[1] = k - c; sw[0] = prefix | ((unsigned)bb << shift); sw[2] = hist[bb]; }
                mask |= (0xFFu << shift);
                __syncthreads();
            }
            const unsigned thr = sw[0], need = sw[1], eqc = sw[2];
            if (tid == 0) { int cut = SEQ;
                if (eqc != need) { unsigned c = 0u; for (int i = 0; i < n; ++i) { const unsigned u = __float_as_uint(sc[i]); const unsigned kk = (u & 0x80000000u) ? ~u : (u | 0x80000000u); if (kk == thr) { ++c; if (c == need) { cut = i; break; } } } }
                sw[4] = (unsigned)cut; }
            __syncthreads();
            const int cut = (int)sw[4];
#pragma unroll
            for (int j = 0; j < 8; ++j) { const int idx = tid + 512 * j; if (idx < n && (key[j] > thr || (key[j] == thr && idx <= cut))) { const unsigned pos = atomicAdd((unsigned*)&sw[3], 1u); if (pos < 256u) sel[pos] = idx; } }
            cnt = 256;
        }
        __syncthreads();
        float s4[4] = {-INFINITY, -INFINITY, -INFINITY, -INFINITY};
        if (tid < cnt) {
            const v4u* kr = (const v4u*)(CK + (((size_t)b << 12) + sel[tid]) * 256);
#pragma unroll
            for (int hh = 0; hh < 4; ++hh) { float d = 0.f;
#pragma unroll
                for (int j = 0; j < 8; ++j) { const v4u w = kr[hh * 8 + j]; const LAS float* qq = q4 + hh * 64 + 8 * j;
                    d = fmaf(qq[0], bflo(w.x), d); d = fmaf(qq[1], bfhi(w.x), d); d = fmaf(qq[2], bflo(w.y), d); d = fmaf(qq[3], bfhi(w.y), d);
                    d = fmaf(qq[4], bflo(w.z), d); d = fmaf(qq[5], bfhi(w.z), d); d = fmaf(qq[6], bflo(w.w), d); d = fmaf(qq[7], bfhi(w.w), d); }
                s4[hh] = d * 0.125f; }
        }
        if (tid < 256) {
#pragma unroll
            for (int hh = 0; hh < 4; ++hh) { const float v = wave_max(s4[hh]); if (C.lane == 0) red[hh * 4 + C.wave] = v; }
        }
        __syncthreads();
        float mx[4];
#pragma unroll
        for (int hh = 0; hh < 4; ++hh) mx[hh] = fmaxf(fmaxf(red[hh * 4], red[hh * 4 + 1]), fmaxf(red[hh * 4 + 2], red[hh * 4 + 3]));
        __syncthreads();
        if (tid < 256) {
#pragma unroll
            for (int hh = 0; hh < 4; ++hh) { const float e = (tid < cnt) ? expf(s4[hh] - mx[hh]) : 0.f; ps[hh * 256 + tid] = e; const float v = wave_sum(e); if (C.lane == 0) red[hh * 4 + C.wave] = v; }
        }
        __syncthreads();
        if (tid < 256) {
            const int hh = tid >> 6;
            const float lsum = red[hh * 4] + red[hh * 4 + 1] + red[hh * 4 + 2] + red[hh * 4 + 3];
            float o = 0.f;
            for (int j = 0; j < cnt; ++j) o = fmaf(ps[hh * 256 + j], bf2f(CV[(((size_t)b << 12) + sel[j]) * 256 + tid]), o);
            const float z = bf2f(CZ[(size_t)m * 256 + tid]);
            CQ[(size_t)m * 256 + tid] = (bf16)f2bf(o / lsum * siluf_(z));
        }
        __syncthreads();
    }
}

typedef short bf16x8_t __attribute__((ext_vector_type(8)));
__device__ __forceinline__ float dpp_f(float x, const int ctrl_sel) {
    const int xi = __builtin_bit_cast(int, x); int r;
    if (ctrl_sel == 0) r = __builtin_amdgcn_update_dpp(xi, xi, 0xB1, 0xF, 0xF, false);
    else if (ctrl_sel == 1) r = __builtin_amdgcn_update_dpp(xi, xi, 0x4E, 0xF, 0xF, false);
    else r = __builtin_amdgcn_update_dpp(xi, xi, 0x141, 0xF, 0xF, false);
    return __builtin_bit_cast(float, r);
}
__device__ __forceinline__ float red8(float x) { x += dpp_f(x, 0); x += dpp_f(x, 1); x += dpp_f(x, 2); return x; }

constexpr int DSTEP_T = 320;
constexpr int D_LDS_STEP = 0, D_LDS_VS = 81920, D_LDS_TWD = 98304, D_LDS_ADS = 106496;
__device__ __forceinline__ void mixD1(Ctx C, const Params& P, int l) {
    OPQ(C);
    unsigned char* ws = P.ws;
    const bf16* DR = PLP(ws, PL_DR); const bf16* DK = PLP(ws, PL_DK); const bf16* DV = PLP(ws, PL_DV); const float* MS = (const float*)(ws + WS_MISC);
    const float* mu = P.in[6] + l * 896; const float* w0 = P.in[7] + l * 256; const float* w_up = P.in[8] + (size_t)l * 64 * 256; const float* a0 = P.in[9] + l * 256;
    const float* a_up = P.in[10] + (size_t)l * 64 * 256; const float* k_k = P.in[11] + l * 256; const float* k_a = P.in[12] + l * 256; const float* r_k = P.in[13] + l * 256;
    bf16* OL = (bf16*)(ws + WS_OL); bf16* CCp = (bf16*)(ws + WS_CC); float* BON = (float*)(ws + WS_DBON); float* AB = (float*)(ws + WS_DAB);
    LAS float* STEP = (LAS float*)(C.lds + D_LDS_STEP); LAS float* VS = (LAS float*)(C.lds + D_LDS_VS);
    LAS bf16* TWD = (LAS bf16*)(C.lds + D_LDS_TWD); LAS bf16* ADS = (LAS bf16*)(C.lds + D_LDS_ADS);
    const int tid = C.tid, lane = C.lane, wave = C.wave;
    const int tt = tid >> 3, c8 = tid & 7;
    for (int u = C.bid; u < 256; u += C.G) {
        const int b = u >> 5, h = (u >> 3) & 3, seg = u & 7, hc0 = h * 64;
        __syncthreads();
        {
            const int i = tid >> 3;
            const f32x4 wa = *(const f32x4*)(w_up + (size_t)i * 256 + hc0 + 8 * c8), wb = *(const f32x4*)(w_up + (size_t)i * 256 + hc0 + 8 * c8 + 4);
            const f32x4 aa = *(const f32x4*)(a_up + (size_t)i * 256 + hc0 + 8 * c8), ab = *(const f32x4*)(a_up + (size_t)i * 256 + hc0 + 8 * c8 + 4);
#pragma unroll
            for (int j = 0; j < 4; ++j) { TWD[(8 * c8 + j) * 64 + i] = (bf16)f2bf(wa[j]); TWD[(8 * c8 + 4 + j) * 64 + i] = (bf16)f2bf(wb[j]);
                                          ADS[(8 * c8 + j) * 64 + i] = (bf16)f2bf(aa[j]); ADS[(8 * c8 + 4 + j) * 64 + i] = (bf16)f2bf(ab[j]); }
        }
        __syncthreads();
        const int mat = wave >> 2, mt = wave & 3, fr = lane & 15, fq = lane >> 4;
        bf16x8_t bfrag[4][2];
#pragma unroll
        for (int nt = 0; nt < 4; ++nt)
#pragma unroll
            for (int k2 = 0; k2 < 2; ++k2) bfrag[nt][k2] = *(const LAS bf16x8_t*)((mat ? ADS : TWD) + (16 * nt + fr) * 64 + 32 * k2 + 8 * fq);
        float bias4[4];
#pragma unroll
        for (int nt = 0; nt < 4; ++nt) bias4[nt] = (mat ? a0 : w0)[hc0 + 16 * nt + fr];
        __syncthreads();
        float S[8], H[8];
#pragma unroll
        for (int j = 0; j < 8; ++j) { S[j] = 0.f; H[j] = (8 * c8 + j == tt) ? 1.f : 0.f; }
        v4u rc, kc, vc, rp, kp, vp; f32x4 wc0, wc1, ac0, ac1, wp0, wp1, ap0, ap1;
#define D1_LOADRAW(BLK) do { const int tl_ = seg * 512 + (BLK) * 64 + tt; const size_t m_ = ((size_t)b << 12) + tl_; const int ch_ = hc0 + 8 * c8; \
            rc = *(const v4u*)(DR + m_ * 256 + ch_); kc = *(const v4u*)(DK + m_ * 256 + ch_); vc = *(const v4u*)(DV + m_ * 256 + ch_); \
            wc0 = *(const f32x4*)(MS + m_ * 256 + 72 + 8 * c8); wc1 = *(const f32x4*)(MS + m_ * 256 + 76 + 8 * c8); ac0 = *(const f32x4*)(MS + m_ * 256 + 136 + 8 * c8); ac1 = *(const f32x4*)(MS + m_ * 256 + 140 + 8 * c8); \
            rp = (v4u){0u, 0u, 0u, 0u}; kp = rp; vp = rp; wp0 = (f32x4){0.f, 0.f, 0.f, 0.f}; wp1 = wp0; ap0 = wp0; ap1 = wp0; \
            if (tl_ > 0) { rp = *(const v4u*)(DR + (m_ - 1) * 256 + ch_); kp = *(const v4u*)(DK + (m_ - 1) * 256 + ch_); vp = *(const v4u*)(DV + (m_ - 1) * 256 + ch_); \
                wp0 = *(const f32x4*)(MS + (m_ - 1) * 256 + 72 + 8 * c8); wp1 = *(const f32x4*)(MS + (m_ - 1) * 256 + 76 + 8 * c8); ap0 = *(const f32x4*)(MS + (m_ - 1) * 256 + 136 + 8 * c8); ap1 = *(const f32x4*)(MS + (m_ - 1) * 256 + 140 + 8 * c8); } } while (0)
        D1_LOADRAW(0);
        for (int blk = 0; blk < 8; ++blk) {
            const int tloc0 = seg * 512 + blk * 64;
            const size_t m = ((size_t)b << 12) + tloc0 + tt;
            {
                const int ch = hc0 + 8 * c8;
                LAS float* st = STEP + tt * DSTEP_T + c8 * 40;
#pragma unroll
                for (int q = 0; q < 4; ++q) {
                    const unsigned rcw = rc[q], rpw = rp[q], kcw = kc[q], kpw = kp[q], vcw = vc[q], vpw = vp[q];
                    const float mr0 = mu[ch + 2 * q], mr1 = mu[ch + 2 * q + 1], mk0 = mu[256 + ch + 2 * q], mk1 = mu[256 + ch + 2 * q + 1], mv0 = mu[512 + ch + 2 * q], mv1 = mu[512 + ch + 2 * q + 1];
                    float c0 = bflo(rcw), c1 = bfhi(rcw);
                    st[32 + 2 * q] = c0 + mr0 * (bflo(rpw) - c0); st[32 + 2 * q + 1] = c1 + mr1 * (bfhi(rpw) - c1);
                    c0 = bflo(kcw); c1 = bfhi(kcw);
                    st[24 + 2 * q] = c0 + mk0 * (bflo(kpw) - c0); st[24 + 2 * q + 1] = c1 + mk1 * (bfhi(kpw) - c1);
                    c0 = bflo(vcw); c1 = bfhi(vcw);
                    VS[tt * 64 + 8 * c8 + 2 * q] = c0 + mv0 * (bflo(vpw) - c0); VS[tt * 64 + 8 * c8 + 2 * q + 1] = c1 + mv1 * (bfhi(vpw) - c1);
                }
                float tw[8], ad[8];
#pragma unroll
                for (int j = 0; j < 4; ++j) {
                    const float m0 = mu[768 + 8 * c8 + j], m1 = mu[768 + 8 * c8 + 4 + j], n0 = mu[832 + 8 * c8 + j], n1 = mu[832 + 8 * c8 + 4 + j];
                    tw[j] = tanhf(wc0[j] + m0 * (wp0[j] - wc0[j])); tw[4 + j] = tanhf(wc1[j] + m1 * (wp1[j] - wc1[j]));
                    ad[j] = ac0[j] + n0 * (ap0[j] - ac0[j]); ad[4 + j] = ac1[j] + n1 * (ap1[j] - ac1[j]);
                }
                v4u tv, av; tv.x = pk2(tw[0], tw[1]); tv.y = pk2(tw[2], tw[3]); tv.z = pk2(tw[4], tw[5]); tv.w = pk2(tw[6], tw[7]);
                av.x = pk2(ad[0], ad[1]); av.y = pk2(ad[2], ad[3]); av.z = pk2(ad[4], ad[5]); av.w = pk2(ad[6], ad[7]);
                *(LAS v4u*)(TWD + tt * 64 + 8 * c8) = tv; *(LAS v4u*)(ADS + tt * 64 + 8 * c8) = av;
            }
            __syncthreads();
            {
                const LAS bf16* Asrc = mat ? ADS : TWD;
                const bf16x8_t a0f = *(const LAS bf16x8_t*)(Asrc + (16 * mt + fr) * 64 + 8 * fq), a1f = *(const LAS bf16x8_t*)(Asrc + (16 * mt + fr) * 64 + 32 + 8 * fq);
#pragma unroll
                for (int nt = 0; nt < 4; ++nt) {
                    f32x4 acc = (f32x4){0.f, 0.f, 0.f, 0.f};
                    acc = __builtin_amdgcn_mfma_f32_16x16x32_bf16(a0f, bfrag[nt][0], acc, 0, 0, 0);
                    acc = __builtin_amdgcn_mfma_f32_16x16x32_bf16(a1f, bfrag[nt][1], acc, 0, 0, 0);
                    const int c = 16 * nt + fr;
#pragma unroll
                    for (int j = 0; j < 4; ++j) {
                        const int t = 16 * mt + 4 * fq + j; const float x = acc[j] + bias4[nt]; float val;
                        if (mat == 0) { const float nx = -x; const float sp = fmaxf(nx, 0.f) + log1pf(expf(-fabsf(nx))); val = expf(-expf(-sp - 0.5f)); }
                        else val = 1.f / (1.f + expf(-x));
                        STEP[t * DSTEP_T + (c >> 3) * 40 + (mat ? 16 : 8) + (c & 7)] = val;
                    }
                }
            }
            __syncthreads();
            {
                const int ch = hc0 + 8 * c8; LAS float* st = STEP + tt * DSTEP_T + c8 * 40;
                float kkr[8], ssq = 0.f, bon = 0.f;
#pragma unroll
                for (int j = 0; j < 8; ++j) { const float kx = st[24 + j], a = st[16 + j];
                    kkr[j] = kx * k_k[ch + j]; ssq = fmaf(kkr[j], kkr[j], ssq);
                    const float kf = kx * (1.f + (a - 1.f) * k_a[ch + j]); st[24 + j] = kf; bon = fmaf(st[32 + j] * kf, r_k[ch + j], bon); }
                ssq = red8(ssq); bon = red8(bon);
                const float inv = 1.f / fmaxf(sqrtf(ssq), 1e-12f);
#pragma unroll
                for (int j = 0; j < 8; ++j) { const float kk = kkr[j] * inv; st[j] = kk; st[16 + j] = kk * st[16 + j]; }
                if (c8 == 0) BON[m * 4 + h] = bon;
            }
            __syncthreads();
            if (blk + 1 < 8) D1_LOADRAW(blk + 1);
            for (int t = 0; t < 64; ++t) {
                const LAS f32x4* sp = (const LAS f32x4*)(STEP + t * DSTEP_T + c8 * 40);
                const f32x4 k0 = sp[0], k1 = sp[1], w0v = sp[2], w1v = sp[3], b0 = sp[4], b1 = sp[5], f0 = sp[6], f1 = sp[7], r0 = sp[8], r1 = sp[9];
                const float vv = VS[t * 64 + tt];
                float dS = 0.f, dH = 0.f;
#pragma unroll
                for (int j = 0; j < 4; ++j) { dS = fmaf(S[j], k0[j], dS); dH = fmaf(H[j], k0[j], dH); }
#pragma unroll
                for (int j = 0; j < 4; ++j) { dS = fmaf(S[4 + j], k1[j], dS); dH = fmaf(H[4 + j], k1[j], dH); }
                dS = -red8(dS); dH = -red8(dH);
                float oS = 0.f, oH = 0.f;
#pragma unroll
                for (int j = 0; j < 4; ++j) {
                    S[j] = fmaf(S[j], w0v[j], fmaf(dS, b0[j], vv * f0[j])); H[j] = fmaf(H[j], w0v[j], dH * b0[j]);
                    oS = fmaf(S[j], r0[j], oS); oH = fmaf(H[j], r0[j], oH);
                }
#pragma unroll
                for (int j = 0; j < 4; ++j) {
                    S[4 + j] = fmaf(S[4 + j], w1v[j], fmaf(dS, b1[j], vv * f1[j])); H[4 + j] = fmaf(H[4 + j], w1v[j], dH * b1[j]);
                    oS = fmaf(S[4 + j], r1[j], oS); oH = fmaf(H[4 + j], r1[j], oH);
                }
                oS = red8(oS); oH = red8(oH);
                if (c8 == 0) { const size_t mo = (((size_t)b << 12) + tloc0 + t) * 256 + hc0 + tt; OL[mo] = (bf16)f2bf(oS); CCp[mo] = (bf16)f2bf(oH); }
            }
            __syncthreads();
        }
#undef D1_LOADRAW
        {
            float* ab = AB + (size_t)u * 8192;
            *(f32x4*)(ab + tt * 64 + 8 * c8) = (f32x4){H[0], H[1], H[2], H[3]}; *(f32x4*)(ab + tt * 64 + 8 * c8 + 4) = (f32x4){H[4], H[5], H[6], H[7]};
            *(f32x4*)(ab + 4096 + tt * 64 + 8 * c8) = (f32x4){S[0], S[1], S[2], S[3]}; *(f32x4*)(ab + 4096 + tt * 64 + 8 * c8 + 4) = (f32x4){S[4], S[5], S[6], S[7]};
        }
    }
}
__device__ __forceinline__ void mixD1_ut(Ctx C, const Params& P, int l) {
    OPQ(C);
    unsigned char* ws = P.ws;
    const bf16* DR = PLP(ws, PL_DR); const bf16* DK = PLP(ws, PL_DK); const bf16* DV = PLP(ws, PL_DV); const float* MS = (const float*)(ws + WS_MISC);
    const float* mu = P.in[6] + l * 896; const float* w0 = P.in[7] + l * 256; const float* w_up = P.in[8] + (size_t)l * 64 * 256; const float* a0 = P.in[9] + l * 256;
    const float* a_up = P.in[10] + (size_t)l * 64 * 256; const float* k_k = P.in[11] + l * 256; const float* k_a = P.in[12] + l * 256; const float* r_k = P.in[13] + l * 256;
    bf16* OL = (bf16*)(ws + WS_OL); bf16* CCp = (bf16*)(ws + WS_CC); float* BON = (float*)(ws + WS_DBON); float* AB = (float*)(ws + WS_DAB);
    LAS float* STEP = (LAS float*)(C.lds + D_LDS_STEP); LAS bf16* VS16 = (LAS bf16*)(C.lds + D_LDS_VS);
    LAS bf16* BKR = (LAS bf16*)(C.lds + 90112); LAS bf16* BKT = (LAS bf16*)(C.lds + 94208); LAS bf16* XB = (LAS bf16*)(C.lds + 98304);
    LAS bf16* VA = (LAS bf16*)(C.lds + 114688); LAS float* RH = (LAS float*)(C.lds + 122880);
    LAS float* GAM = (LAS float*)(C.lds + 131584); LAS float* MN = (LAS float*)(C.lds + 135936); LAS bf16* KR = (LAS bf16*)(C.lds + 140032); LAS bf16* QP = (LAS bf16*)(C.lds + 144128);
    LAS bf16* TWD = (LAS bf16*)(C.lds + D_LDS_TWD); LAS bf16* ADS = (LAS bf16*)(C.lds + D_LDS_ADS);
    const int wave = C.wave;
    for (int u = C.bid; u < 256; u += C.G) {
        const int lane = lane_id_fresh(), tid = wave * 64 + lane;
        const int tt = tid >> 3, c8 = tid & 7;
        const int b = u >> 5, h = (u >> 3) & 3, seg = u & 7, hc0 = h * 64;
        __syncthreads();
        {
            const int i = tid >> 3;
            const f32x4 wa = *(const f32x4*)(w_up + (size_t)i * 256 + hc0 + 8 * c8), wb = *(const f32x4*)(w_up + (size_t)i * 256 + hc0 + 8 * c8 + 4);
            const f32x4 aa = *(const f32x4*)(a_up + (size_t)i * 256 + hc0 + 8 * c8), ab = *(const f32x4*)(a_up + (size_t)i * 256 + hc0 + 8 * c8 + 4);
#pragma unroll
            for (int j = 0; j < 4; ++j) { TWD[(8 * c8 + j) * 64 + i] = (bf16)f2bf(wa[j]); TWD[(8 * c8 + 4 + j) * 64 + i] = (bf16)f2bf(wb[j]);
                                          ADS[(8 * c8 + j) * 64 + i] = (bf16)f2bf(aa[j]); ADS[(8 * c8 + 4 + j) * 64 + i] = (bf16)f2bf(ab[j]); }
        }
        __syncthreads();
        const int mat = wave >> 2, mt = wave & 3, fr = lane & 15, fq = lane >> 4;
        bf16x8_t bfrag[4][2];
#pragma unroll
        for (int nt = 0; nt < 4; ++nt)
#pragma unroll
            for (int k2 = 0; k2 < 2; ++k2) bfrag[nt][k2] = *(const LAS bf16x8_t*)((mat ? ADS : TWD) + (16 * nt + fr) * 64 + 32 * k2 + 8 * fq);
        float bias4[4];
#pragma unroll
        for (int nt = 0; nt < 4; ++nt) bias4[nt] = (mat ? a0 : w0)[hc0 + 16 * nt + fr];
        __syncthreads();
        const int xc = lane & 15, xq = lane >> 4;
        f32x4 X[4];
#pragma unroll
        for (int kt = 0; kt < 4; ++kt)
#pragma unroll
            for (int j = 0; j < 4; ++j) X[kt][j] = (wave >= 4 && (16 * (wave - 4) + 4 * xq + j) == (16 * kt + xc)) ? 1.f : 0.f;
        for (int i = tid; i < 64 * 16; i += 512) VA[(64 + (i >> 4)) * 32 + (i & 15)] = (bf16)0;
        v4u rc, kc, vc, rp, kp, vp; f32x4 wc0, wc1, ac0, ac1, wp0, wp1, ap0, ap1;
#define D1_LOADRAW(BLK) do { const int tl_ = seg * 512 + (BLK) * 64 + tt; const size_t m_ = ((size_t)b << 12) + tl_; const int ch_ = hc0 + 8 * c8; \
            rc = *(const v4u*)(DR + m_ * 256 + ch_); kc = *(const v4u*)(DK + m_ * 256 + ch_); vc = *(const v4u*)(DV + m_ * 256 + ch_); \
            wc0 = *(const f32x4*)(MS + m_ * 256 + 72 + 8 * c8); wc1 = *(const f32x4*)(MS + m_ * 256 + 76 + 8 * c8); ac0 = *(const f32x4*)(MS + m_ * 256 + 136 + 8 * c8); ac1 = *(const f32x4*)(MS + m_ * 256 + 140 + 8 * c8); \
            rp = (v4u){0u, 0u, 0u, 0u}; kp = rp; vp = rp; wp0 = (f32x4){0.f, 0.f, 0.f, 0.f}; wp1 = wp0; ap0 = wp0; ap1 = wp0; \
            if (tl_ > 0) { rp = *(const v4u*)(DR + (m_ - 1) * 256 + ch_); kp = *(const v4u*)(DK + (m_ - 1) * 256 + ch_); vp = *(const v4u*)(DV + (m_ - 1) * 256 + ch_); \
                wp0 = *(const f32x4*)(MS + (m_ - 1) * 256 + 72 + 8 * c8); wp1 = *(const f32x4*)(MS + (m_ - 1) * 256 + 76 + 8 * c8); ap0 = *(const f32x4*)(MS + (m_ - 1) * 256 + 136 + 8 * c8); ap1 = *(const f32x4*)(MS + (m_ - 1) * 256 + 140 + 8 * c8); } } while (0)
        for (int blk = 0; blk < 8; ++blk) {
            D1_LOADRAW(blk);
            const int tloc0 = seg * 512 + blk * 64;
            const size_t m = ((size_t)b << 12) + tloc0 + tt;
            {
                const int ch = hc0 + 8 * c8;
                LAS float* st = STEP + tt * DSTEP_T + c8 * 40;
#pragma unroll
                for (int q = 0; q < 4; ++q) {
                    const unsigned rcw = rc[q], rpw = rp[q], kcw = kc[q], kpw = kp[q], vcw = vc[q], vpw = vp[q];
                    const float mr0 = mu[ch + 2 * q], mr1 = mu[ch + 2 * q + 1], mk0 = mu[256 + ch + 2 * q], mk1 = mu[256 + ch + 2 * q + 1], mv0 = mu[512 + ch + 2 * q], mv1 = mu[512 + ch + 2 * q + 1];
                    float c0 = bflo(rcw), c1 = bfhi(rcw);
                    st[32 + 2 * q] = c0 + mr0 * (bflo(rpw) - c0); st[32 + 2 * q + 1] = c1 + mr1 * (bfhi(rpw) - c1);
                    c0 = bflo(kcw); c1 = bfhi(kcw);
                    st[24 + 2 * q] = c0 + mk0 * (bflo(kpw) - c0); st[24 + 2 * q + 1] = c1 + mk1 * (bfhi(kpw) - c1);
                    c0 = bflo(vcw); c1 = bfhi(vcw);
                    VS16[tt * 64 + 8 * c8 + 2 * q] = (bf16)f2bf(c0 + mv0 * (bflo(vpw) - c0)); VS16[tt * 64 + 8 * c8 + 2 * q + 1] = (bf16)f2bf(c1 + mv1 * (bfhi(vpw) - c1));
                }
                float tw[8], ad[8];
#pragma unroll
                for (int j = 0; j < 4; ++j) {
                    const float m0 = mu[768 + 8 * c8 + j], m1 = mu[768 + 8 * c8 + 4 + j], n0 = mu[832 + 8 * c8 + j], n1 = mu[832 + 8 * c8 + 4 + j];
                    tw[j] = tanhf(wc0[j] + m0 * (wp0[j] - wc0[j])); tw[4 + j] = tanhf(wc1[j] + m1 * (wp1[j] - wc1[j]));
                    ad[j] = ac0[j] + n0 * (ap0[j] - ac0[j]); ad[4 + j] = ac1[j] + n1 * (ap1[j] - ac1[j]);
                }
                v4u tv, av; tv.x = pk2(tw[0], tw[1]); tv.y = pk2(tw[2], tw[3]); tv.z = pk2(tw[4], tw[5]); tv.w = pk2(tw[6], tw[7]);
                av.x = pk2(ad[0], ad[1]); av.y = pk2(ad[2], ad[3]); av.z = pk2(ad[4], ad[5]); av.w = pk2(ad[6], ad[7]);
                *(LAS v4u*)(TWD + tt * 64 + 8 * c8) = tv; *(LAS v4u*)(ADS + tt * 64 + 8 * c8) = av;
            }
            __syncthreads();
            {
                const LAS bf16* Asrc = mat ? ADS : TWD;
                const bf16x8_t a0f = *(const LAS bf16x8_t*)(Asrc + (16 * mt + fr) * 64 + 8 * fq), a1f = *(const LAS bf16x8_t*)(Asrc + (16 * mt + fr) * 64 + 32 + 8 * fq);
#pragma unroll
                for (int nt = 0; nt < 4; ++nt) {
                    f32x4 acc = (f32x4){0.f, 0.f, 0.f, 0.f};
                    acc = __builtin_amdgcn_mfma_f32_16x16x32_bf16(a0f, bfrag[nt][0], acc, 0, 0, 0);
                    acc = __builtin_amdgcn_mfma_f32_16x16x32_bf16(a1f, bfrag[nt][1], acc, 0, 0, 0);
                    const int c = 16 * nt + fr;
#pragma unroll
                    for (int j = 0; j < 4; ++j) {
                        const int t = 16 * mt + 4 * fq + j; const float x = acc[j] + bias4[nt]; float val;
                        if (mat == 0) { const float nx = -x; const float sp = fmaxf(nx, 0.f) + log1pf(expf(-fabsf(nx))); val = expf(-expf(-sp - 0.5f)); }
                        else val = 1.f / (1.f + expf(-x));
                        STEP[t * DSTEP_T + (c >> 3) * 40 + (mat ? 16 : 8) + (c & 7)] = val;
                    }
                }
            }
            __syncthreads();
            {
                const int ch = hc0 + 8 * c8; LAS float* st = STEP + tt * DSTEP_T + c8 * 40;
                float kkr[8], ssq = 0.f, bon = 0.f;
#pragma unroll
                for (int j = 0; j < 8; ++j) { const float kx = st[24 + j], a = st[16 + j];
                    kkr[j] = kx * k_k[ch + j]; ssq = fmaf(kkr[j], kkr[j], ssq);
                    const float kf = kx * (1.f + (a - 1.f) * k_a[ch + j]); st[24 + j] = kf; bon = fmaf(st[32 + j] * kf, r_k[ch + j], bon); }
                ssq = red8(ssq); bon = red8(bon);
                const float inv = 1.f / fmaxf(sqrtf(ssq), 1e-12f);
#pragma unroll
                for (int j = 0; j < 8; ++j) { const float kk = kkr[j] * inv; st[j] = kk; st[16 + j] = kk * st[16 + j]; }
                if (c8 == 0) BON[m * 4 + h] = bon;
            }
            __syncthreads();
            for (int sb = 0; sb < 4; ++sb) {
                const int tau = 16 * sb;
                int xcs = xc, xqs = xq, tids = tid; asm volatile("" : "+v"(xcs), "+v"(xqs), "+v"(tids));
#pragma unroll
                for (int kt = 0; kt < 4; ++kt)
#pragma unroll
                    for (int j = 0; j < 4; ++j) XB[(16 * wave + 4 * xqs + j) * 64 + 16 * kt + xcs] = (bf16)f2bf(X[kt][j]);
#pragma unroll
                for (int e = 0; e < 2; ++e) {
                    const int idx = tids + 512 * e, t2 = idx >> 6, k = idx & 63;
                    const LAS float* sw = STEP + tau * DSTEP_T + (k >> 3) * 40 + 8 + (k & 7);
                    float g0 = 1.f;
#pragma unroll
                    for (int u2 = 0; u2 < 15; ++u2) g0 *= (u2 < t2) ? sw[u2 * DSTEP_T] : 1.f;
                    const float g1 = g0 * sw[t2 * DSTEP_T];
                    if (t2 == 15) GAM[k] = g1;
                    const LAS float* st = STEP + (tau + t2) * DSTEP_T + (k >> 3) * 40 + (k & 7);
                    const float ig = __builtin_amdgcn_rcpf(g1);
                    const float kh = st[24] * ig, bh = st[16] * ig;
                    KR[t2 * 64 + k] = (bf16)f2bf(st[0] * g0); KR[(16 + t2) * 64 + k] = (bf16)f2bf(st[32] * g1);
                    BKR[t2 * 64 + k] = (bf16)f2bf(kh); BKR[(16 + t2) * 64 + k] = (bf16)f2bf(bh);
                    BKT[k * 32 + t2] = (bf16)f2bf(kh); BKT[k * 32 + 16 + t2] = (bf16)f2bf(-bh);
                    const int rho = idx & 63, s2 = idx >> 6;
                    VA[rho * 32 + s2] = VS16[(tau + s2) * 64 + rho];
                }
                __syncthreads();
                f32x4 dR;
                {
                    const bf16x8_t a0 = *(const LAS bf16x8_t*)(XB + (16 * wave + xcs) * 64 + 8 * xqs), a1 = *(const LAS bf16x8_t*)(XB + (16 * wave + xcs) * 64 + 32 + 8 * xqs);
                    const bf16x8_t bk0 = *(const LAS bf16x8_t*)(KR + xcs * 64 + 8 * xqs), bk1 = *(const LAS bf16x8_t*)(KR + xcs * 64 + 32 + 8 * xqs);
                    const bf16x8_t br0 = *(const LAS bf16x8_t*)(KR + (16 + xcs) * 64 + 8 * xqs), br1 = *(const LAS bf16x8_t*)(KR + (16 + xcs) * 64 + 32 + 8 * xqs);
                    f32x4 dK = (f32x4){0.f, 0.f, 0.f, 0.f}; dR = dK;
                    dK = __builtin_amdgcn_mfma_f32_16x16x32_bf16(a0, bk0, dK, 0, 0, 0); dK = __builtin_amdgcn_mfma_f32_16x16x32_bf16(a1, bk1, dK, 0, 0, 0);
                    dR = __builtin_amdgcn_mfma_f32_16x16x32_bf16(a0, br0, dR, 0, 0, 0); dR = __builtin_amdgcn_mfma_f32_16x16x32_bf16(a1, br1, dR, 0, 0, 0);
#pragma unroll
                    for (int j = 0; j < 4; ++j) RH[(16 * wave + 4 * xqs + j) * 16 + xcs] = dK[j];
                    if (wave == 7) {
#pragma unroll
                        for (int mt = 0; mt < 2; ++mt)
#pragma unroll
                            for (int nt = 0; nt < 2; ++nt) {
                                f32x4 acc = (f32x4){0.f, 0.f, 0.f, 0.f};
#pragma unroll
                                for (int ks = 0; ks < 2; ++ks)
                                    acc = __builtin_amdgcn_mfma_f32_16x16x32_bf16(*(const LAS bf16x8_t*)(BKR + (16 * mt + xcs) * 64 + 32 * ks + 8 * xqs), *(const LAS bf16x8_t*)(KR + (16 * nt + xcs) * 64 + 32 * ks + 8 * xqs), acc, 0, 0, 0);
#pragma unroll
                                for (int j = 0; j < 4; ++j) MN[(16 * mt + 4 * xqs + j) * 32 + 16 * nt + xcs] = acc[j];
                            }
                    }
                }
                __syncthreads();
                {
                    const int rho = tids >> 2, tq = tids & 3;
                    float rhs[4];
                    { const f32x4 x = *(const LAS f32x4*)(RH + rho * 16 + 4 * tq); rhs[0] = x[0]; rhs[1] = x[1]; rhs[2] = x[2]; rhs[3] = x[3]; }
                    float vv[16];
                    {
                        const v4u w0 = *(const LAS v4u*)(VA + rho * 32), w1 = *(const LAS v4u*)(VA + rho * 32 + 8);
                        vv[0] = bflo(w0.x); vv[1] = bfhi(w0.x); vv[2] = bflo(w0.y); vv[3] = bfhi(w0.y); vv[4] = bflo(w0.z); vv[5] = bfhi(w0.z); vv[6] = bflo(w0.w); vv[7] = bfhi(w0.w);
                        vv[8] = bflo(w1.x); vv[9] = bfhi(w1.x); vv[10] = bflo(w1.y); vv[11] = bfhi(w1.y); vv[12] = bflo(w1.z); vv[13] = bfhi(w1.z); vv[14] = bflo(w1.w); vv[15] = bfhi(w1.w);
                    }
#pragma unroll
                    for (int s2 = 0; s2 < 15; ++s2) {
                        const float mine = rhs[s2 & 3];
                        const float sa = __shfl(mine, (lane_id_fresh() & ~3) | (s2 >> 2));
                        const f32x4 n4 = *(const LAS f32x4*)(MN + s2 * 32 + 4 * tq), m4 = *(const LAS f32x4*)(MN + (16 + s2) * 32 + 4 * tq);
#pragma unroll
                        for (int i = 0; i < 4; ++i) { const float upd = fmaf(vv[s2], n4[i], fmaf(-sa, m4[i], rhs[i])); rhs[i] = (4 * tq + i > s2) ? upd : rhs[i]; }
                    }
                    v2u ow; ow.x = pk2(rhs[0], rhs[1]); ow.y = pk2(rhs[2], rhs[3]);
                    *(LAS v2u*)(VA + rho * 32 + 16 + 4 * tq) = ow;
                    if (wave == 2) {
#pragma unroll
                        for (int e = 0; e < 4; ++e) {
                            const int idx = (tids & 63) + 64 * e, t2 = idx >> 4, s2 = idx & 15;
                            const bool on = s2 <= t2;
                            QP[t2 * 32 + s2] = (bf16)f2bf(on ? MN[s2 * 32 + 16 + t2] : 0.f);
                            QP[t2 * 32 + 16 + s2] = (bf16)f2bf(on ? -MN[(16 + s2) * 32 + 16 + t2] : 0.f);
                        }
                    }
                }
                __syncthreads();
                {
                    const bf16x8_t aV = *(const LAS bf16x8_t*)(VA + (16 * wave + xcs) * 32 + 8 * xqs);
                    const bf16x8_t bQ = *(const LAS bf16x8_t*)(QP + xcs * 32 + 8 * xqs);
                    const f32x4 O = __builtin_amdgcn_mfma_f32_16x16x32_bf16(aV, bQ, dR, 0, 0, 0);
                    v2u ow; ow.x = pk2(O[0], O[1]); ow.y = pk2(O[2], O[3]);
                    const size_t mo = (((size_t)b << 12) + tloc0 + tau + xcs) * 256 + hc0 + 16 * (wave & 3) + 4 * xqs;
                    *(v2u*)((wave < 4 ? OL : CCp) + mo) = ow;
#pragma unroll
                    for (int kt = 0; kt < 4; ++kt) {
                        X[kt] = __builtin_amdgcn_mfma_f32_16x16x32_bf16(aV, *(const LAS bf16x8_t*)(BKT + (16 * kt + xcs) * 32 + 8 * xqs), X[kt], 0, 0, 0);
                        const float g16 = GAM[16 * kt + xcs];
#pragma unroll
                        for (int j = 0; j < 4; ++j) X[kt][j] *= g16;
                    }
                }
                __syncthreads();
            }
        }
#undef D1_LOADRAW
        {
            float* ab = AB + (size_t)u * 8192 + (wave < 4 ? 4096 : 0);
#pragma unroll
            for (int kt = 0; kt < 4; ++kt)
#pragma unroll
                for (int j = 0; j < 4; ++j) ab[(16 * (wave & 3) + 4 * xq + j) * 64 + 16 * kt + xc] = X[kt][j];
        }
    }
}
__device__ __forceinline__ void mixD2(Ctx C, unsigned char* ws) {
    OPQ(C);
    if (C.bid >= 32) return;
    const float* AB = (const float*)(ws + WS_DAB); float* SS = (float*)(ws + WS_DSS);
    LAS float* SL = (LAS float*)C.lds; LAS float* AL = SL + 4096;
    const int tid = C.tid, rr = tid >> 3, ks = tid & 7;
    float S[8];
#pragma unroll
    for (int j = 0; j < 8; ++j) S[j] = 0.f;
    f32x4 na0, na1, nb0, nb1;
#define D2_LOAD(U) do { const float* ab_ = AB + (size_t)(U) * 8192; na0 = *(const f32x4*)(ab_ + tid * 8); na1 = *(const f32x4*)(ab_ + tid * 8 + 4); \
        nb0 = *(const f32x4*)(ab_ + 4096 + rr * 64 + 8 * ks); nb1 = *(const f32x4*)(ab_ + 4096 + rr * 64 + 8 * ks + 4); } while (0)
    D2_LOAD(C.bid * 8);
    for (int seg = 0; seg < 8; ++seg) {
        const int u = C.bid * 8 + seg;
        float* so = SS + (size_t)u * 4096 + rr * 64 + 8 * ks;
        *(f32x4*)so = (f32x4){S[0], S[1], S[2], S[3]}; *(f32x4*)(so + 4) = (f32x4){S[4], S[5], S[6], S[7]};
        if (seg == 7) break;
        __syncthreads();
        *(LAS f32x4*)(SL + rr * 64 + 8 * ks) = (f32x4){S[0], S[1], S[2], S[3]}; *(LAS f32x4*)(SL + rr * 64 + 8 * ks + 4) = (f32x4){S[4], S[5], S[6], S[7]};
        *(LAS f32x4*)(AL + tid * 8) = na0; *(LAS f32x4*)(AL + tid * 8 + 4) = na1;
        const f32x4 bb0 = nb0, bb1 = nb1;
        if (seg + 1 < 7) D2_LOAD(u + 1);
        __syncthreads();
#pragma unroll
        for (int j = 0; j < 4; ++j) { S[j] = bb0[j]; S[4 + j] = bb1[j]; }
#pragma nounroll
        for (int i = 0; i < 64; ++i) {
            const float s = SL[rr * 64 + i];
            const f32x4 a0 = *(const LAS f32x4*)(AL + i * 64 + 8 * ks), a1 = *(const LAS f32x4*)(AL + i * 64 + 8 * ks + 4);
#pragma unroll
            for (int j = 0; j < 4; ++j) { S[j] = fmaf(s, a0[j], S[j]); S[4 + j] = fmaf(s, a1[j], S[4 + j]); }
        }
    }
#undef D2_LOAD
}
__device__ __forceinline__ void mixD3(Ctx C, const Params& P, int l) {
    OPQ(C);
    unsigned char* ws = P.ws;
    bf16* DR = PLP(ws, PL_DR); const bf16* DV = PLP(ws, PL_DV); const bf16* DZ = PLP(ws, PL_DZ);
    const bf16* OL = (const bf16*)(ws + WS_OL); const bf16* CCp = (const bf16*)(ws + WS_CC); const float* BON = (const float*)(ws + WS_DBON); const float* SS = (const float*)(ws + WS_DSS);
    const float* mu = P.in[6] + l * 896; const float* gn_g = P.in[14] + l * 256; const float* gn_b = P.in[15] + l * 256;
    const int lane = C.lane, wave = C.wave;
    for (int u = C.bid; u < 256; u += C.G) {
        const int b = u >> 5, h = (u >> 3) & 3, seg = u & 7, hc = h * 64 + lane;
        float S[64];
        {
            const f32x4* sp = (const f32x4*)(SS + (size_t)u * 4096 + lane * 64);
#pragma unroll
            for (int q = 0; q < 16; ++q) { const f32x4 x = sp[q]; S[4 * q] = x[0]; S[4 * q + 1] = x[1]; S[4 * q + 2] = x[2]; S[4 * q + 3] = x[3]; }
        }
        const float muv = mu[512 + hc], gg = gn_g[hc], gb = gn_b[hc];
        unsigned short ncv[8], nol[8], nvc[9], nzz[8]; float nbon[8];
#define D3_LOAD(T8) do { const int tl0_ = seg * 512 + wave * 64 + (T8); const size_t m0_ = ((size_t)b << 12) + tl0_; \
            nvc[0] = (tl0_ > 0) ? DV[(m0_ - 1) * 256 + hc] : (unsigned short)0; \
            _Pragma("unroll") for (int j = 0; j < 8; ++j) { const size_t m = m0_ + j; ncv[j] = CCp[m * 256 + hc]; nol[j] = OL[m * 256 + hc]; nbon[j] = BON[m * 4 + h]; nvc[j + 1] = DV[m * 256 + hc]; nzz[j] = DZ[m * 256 + hc]; } } while (0)
        D3_LOAD(0);
#pragma nounroll
        for (int t8 = 0; t8 < 64; t8 += 8) {
            const int tl0 = seg * 512 + wave * 64 + t8;
            const size_t m0 = ((size_t)b << 12) + tl0;
            float cv[8], ol[8], bon[8], vc[9], zz[8];
            vc[0] = bf2f(nvc[0]);
#pragma unroll
            for (int j = 0; j < 8; ++j) { cv[j] = bf2f(ncv[j]); ol[j] = bf2f(nol[j]); bon[j] = nbon[j]; vc[j + 1] = bf2f(nvc[j + 1]); zz[j] = bf2f(nzz[j]); }
            if (t8 + 8 < 64) D3_LOAD(t8 + 8);
#pragma unroll
            for (int j = 0; j < 8; ++j) {
                float o = ol[j];
#pragma unroll
                for (int i = 0; i < 64; ++i) o = fmaf(S[i], __builtin_bit_cast(float, __builtin_amdgcn_readlane(__builtin_bit_cast(int, cv[j]), i)), o);
                const float mean = wave_sum(o) * (1.f / 64.f); const float d = o - mean; const float var = wave_sum(d * d) * (1.f / 64.f);
                float y = d * __builtin_amdgcn_rsqf(var + 64e-5f) * gg + gb;
                y += bon[j] * (vc[j + 1] + muv * (vc[j] - vc[j + 1]));
                DR[(m0 + j) * 256 + hc] = (bf16)f2bf(y * zz[j] * fsig(zz[j]));
            }
        }
#undef D3_LOAD
    }
}

template <bool OUT>
__device__ __forceinline__ void mixB_chunks(Ctx C, unsigned char* ws, const float* normg, bf16* OUTP) {
    OPQ(C);
    const bf16* BQ = PLP(ws, PL_BQ); const bf16* BI = PLP(ws, PL_BI); const bf16* BZ = PLP(ws, PL_BZ); const float* BF = (const float*)(ws + WS_BF);
    float* BS = (float*)(ws + WS_BS); float* BG = (float*)(ws + WS_BG);
    LAS float* FT = (LAS float*)(C.lds + C.wave * 16384); LAS float* QT = FT + 1024; LAS float* IT = FT + 2048; LAS float* ZT = FT + 3072;
    const int lane = C.lane;
    const float gnorm = OUT ? normg[lane] : 0.f;
    for (int item = C.bid * 8 + C.wave; item < 2048; item += C.G * 8) {
        const int bh = item >> 6, c = item & 63, b = bh >> 2, h = bh & 3;
        const size_t m0 = ((size_t)b << 12) + c * 64;
        float S[64];
        if (OUT) {
            const float* sp = BS + (size_t)item * 4096 + lane;
#pragma unroll
            for (int d = 0; d < 64; ++d) S[d] = sp[d * 64];
        } else {
#pragma unroll
            for (int d = 0; d < 64; ++d) S[d] = 0.f;
        }
        float g = 1.f;
        float nf[16]; unsigned short ni[16], nq[16], nz[16];
#define B_LOADTILE(T0) do { _Pragma("unroll") for (int s = 0; s < 16; ++s) { const size_t m = m0 + (T0) + s; nf[s] = BF[m * 256 + h * 64 + lane]; ni[s] = BI[m * 256 + h * 64 + lane]; \
            if (OUT) { nq[s] = BQ[m * 256 + h * 64 + lane]; nz[s] = BZ[m * 256 + h * 64 + lane]; } } } while (0)
        B_LOADTILE(0);
        for (int t0 = 0; t0 < 64; t0 += 16) {
#pragma unroll
            for (int s = 0; s < 16; ++s) {
                FT[s * 64 + lane] = nf[s]; IT[s * 64 + lane] = bf2f(ni[s]);
                if (OUT) { QT[s * 64 + lane] = bf2f(nq[s]); ZT[s * 64 + lane] = bf2f(nz[s]); }
            }
            if (t0 + 16 < 64) B_LOADTILE(t0 + 16);
            LDS_WAIT(); asm volatile("" ::: "memory");
            if (!OUT) {
#pragma unroll
                for (int s = 0; s < 16; ++s) g *= FT[s * 64 + lane];
            }
#pragma nounroll
            for (int s = 0; s < 16; ++s) {
                const size_t m = m0 + t0 + s;
                const float iv = IT[s * 64 + lane];
                const LAS f32x4* fp = (const LAS f32x4*)(FT + s * 64); const LAS f32x4* qp = (const LAS f32x4*)(QT + s * 64);
                float o = 0.f;
#pragma unroll
                for (int q4 = 0; q4 < 16; ++q4) {
                    const f32x4 f4 = fp[q4];
#pragma unroll
                    for (int j = 0; j < 4; ++j) S[4 * q4 + j] = fmaf(f4[j], S[4 * q4 + j] - iv, iv);
                    if (OUT) { const f32x4 qv = qp[q4];
#pragma unroll
                        for (int j = 0; j < 4; ++j) o = fmaf(qv[j], S[4 * q4 + j], o); }
                }
                if (OUT) {
                    const float r = __builtin_amdgcn_rsqf(wave_sum(o * o) * (1.f / 64.f) + 1e-6f);
                    const float z = ZT[s * 64 + lane];
                    OUTP[m * 256 + h * 64 + lane] = (bf16)f2bf(o * r * gnorm * z * fsig(z));
                }
            }
            LDS_WAIT(); asm volatile("" ::: "memory");
        }
#undef B_LOADTILE
        if (!OUT) {
            float* sp = BS + (size_t)item * 4096 + lane;
#pragma unroll
            for (int d = 0; d < 64; ++d) sp[d * 64] = S[d];
            BG[item * 64 + lane] = g;
        }
    }
}
__device__ __forceinline__ void mixB_scan(Ctx C, unsigned char* ws) {
    OPQ(C);
    float* BS = (float*)(ws + WS_BS); const float* BG = (const float*)(ws + WS_BG);
    for (int e = C.bid * 512 + C.tid; e < 32 * 4096; e += C.G * 512) {
        const int bh = e >> 12, dv = e & 4095, d = dv >> 6;
        float S = 0.f;
#pragma unroll 8
        for (int c = 0; c < 64; ++c) {
            const size_t idx = ((size_t)(bh * 64 + c) << 12) + dv;
            const float sl = BS[idx], g = BG[(bh * 64 + c) * 64 + d];
            BS[idx] = S;
            S = fmaf(g, S, sl);
        }
    }
}

typedef float f32x16 __attribute__((ext_vector_type(16)));
__device__ __forceinline__ int crow_(int r, int hi) { return (r & 3) + 8 * (r >> 2) + 4 * hi; }
__device__ __forceinline__ void mixA_fast(Ctx C, unsigned char* ws, const float* bias, bf16* OUTP) {
    OPQ(C);
    const bf16* AQ = PLP(ws, PL_AQ); const bf16* AK = PLP(ws, PL_AK); const bf16* AVT = PLP(ws, PL_AV); const bf16* AZ = PLP(ws, PL_AZ);
    LAS float* BL = (LAS float*)C.lds;
    __syncthreads();
    for (int i = C.tid; i < 768; i += 512) BL[i] = bias[i] * 1.4426950408889634f;
    __syncthreads();
    const int lane = C.lane, q = lane & 31, hi = lane >> 5;
    for (int item = C.bid * 8 + C.wave; item < 2048; item += C.G * 8) {
        const int h = item & 3, c = (item >> 2) & 63, b = item >> 8;
        const size_t mq0 = ((size_t)b << 12) + c * 64;
        bf16x8_t qf[2][4];
#pragma unroll
        for (int qb = 0; qb < 2; ++qb)
#pragma unroll
            for (int s = 0; s < 4; ++s) qf[qb][s] = *(const bf16x8_t*)(AQ + (mq0 + 32 * qb + q) * 256 + h * 64 + 16 * s + 8 * hi);
        f32x16 O[2][2];
#pragma unroll
        for (int qb = 0; qb < 2; ++qb)
#pragma unroll
            for (int db = 0; db < 2; ++db)
#pragma unroll
                for (int r = 0; r < 16; ++r) O[qb][db][r] = 0.f;
        float mrun[2] = {-1e30f, -1e30f}, lrun[2] = {0.f, 0.f};
        const int klo = (c >= 8) ? (c - 8) * 64 : 0;
        const int nkb = (c * 64 + 64 - klo) >> 5;
        const LAS float* bh = BL + h * 192;
        bf16x8_t kfn[4], vtn[2][2];
#define A_LOADKV(KB) do { const size_t kb_ = (size_t)(b * 4 + h) * 128 + ((klo >> 5) + (KB)); _Pragma("unroll") for (int s = 0; s < 4; ++s) kfn[s] = *(const bf16x8_t*)(AK + ((kb_ * 4 + s) * 64 + lane) * 8); \
            _Pragma("unroll") for (int db = 0; db < 2; ++db) _Pragma("unroll") for (int s2 = 0; s2 < 2; ++s2) vtn[db][s2] = *(const bf16x8_t*)(AVT + (((kb_ * 2 + db) * 2 + s2) * 64 + lane) * 8); } while (0)
        A_LOADKV(0);
        for (int kb = 0; kb < nkb; ++kb) {
            const int kbase = klo + 32 * kb;
            bf16x8_t kf[4];
#pragma unroll
            for (int s = 0; s < 4; ++s) kf[s] = kfn[s];
            bf16x8_t vt[2][2];
#pragma unroll
            for (int db = 0; db < 2; ++db)
#pragma unroll
                for (int s2 = 0; s2 < 2; ++s2) vt[db][s2] = vtn[db][s2];
            if (kb + 1 < nkb) A_LOADKV(kb + 1);
#pragma unroll
            for (int qb = 0; qb < 2; ++qb) {
                f32x16 st;
#pragma unroll
                for (int r = 0; r < 16; ++r) st[r] = 0.f;
#pragma unroll
                for (int s = 0; s < 4; ++s) st = __builtin_amdgcn_mfma_f32_32x32x16_bf16(kf[s], qf[qb][s], st, 0, 0, 0);
                const int qpos = c * 64 + 32 * qb + q;
                float mx = -1e30f;
                if (qpos - (kbase + 31) >= 128) {
                    const float bc = bh[191];
#pragma unroll
                    for (int r = 0; r < 16; ++r) { st[r] = fmaf(st[r], 0.125f * 1.4426950408889634f, bc); mx = fmaxf(mx, st[r]); }
                } else {
#pragma unroll
                    for (int r = 0; r < 16; ++r) {
                        int rel = qpos - (kbase + crow_(r, hi)); rel = rel < -63 ? -63 : (rel > 128 ? 128 : rel);
                        st[r] = fmaf(st[r], 0.125f * 1.4426950408889634f, bh[rel + 63]);
                        mx = fmaxf(mx, st[r]);
                    }
                }
                mx = xh_max(mx);
                const float mn = fmaxf(mrun[qb], mx);
                float ps = 0.f;
#pragma unroll
                for (int r = 0; r < 16; ++r) { st[r] = __builtin_amdgcn_exp2f(st[r] - mn); ps += st[r]; }
                ps = xh_sum(ps);
                if (__builtin_amdgcn_ballot_w64(mn != mrun[qb]) != 0ull) {
                    const float al = __builtin_amdgcn_exp2f(mrun[qb] - mn);
                    lrun[qb] *= al;
#pragma unroll
                    for (int db = 0; db < 2; ++db)
#pragma unroll
                        for (int r = 0; r < 16; ++r) O[qb][db][r] *= al;
                }
                mrun[qb] = mn;
                lrun[qb] += ps;
                v4u p0, p1;
                p0.x = pk2(st[0], st[1]); p0.y = pk2(st[2], st[3]); p0.z = pk2(st[4], st[5]); p0.w = pk2(st[6], st[7]);
                p1.x = pk2(st[8], st[9]); p1.y = pk2(st[10], st[11]); p1.z = pk2(st[12], st[13]); p1.w = pk2(st[14], st[15]);
                const bf16x8_t pf0 = __builtin_bit_cast(bf16x8_t, p0), pf1 = __builtin_bit_cast(bf16x8_t, p1);
#pragma unroll
                for (int db = 0; db < 2; ++db) {
                    O[qb][db] = __builtin_amdgcn_mfma_f32_32x32x16_bf16(vt[db][0], pf0, O[qb][db], 0, 0, 0);
                    O[qb][db] = __builtin_amdgcn_mfma_f32_32x32x16_bf16(vt[db][1], pf1, O[qb][db], 0, 0, 0);
                }
            }
        }
#undef A_LOADKV
#pragma unroll
        for (int qb = 0; qb < 2; ++qb) {
            const float invl = 1.f / lrun[qb];
            const size_t mrow = (mq0 + 32 * qb + q) * 256 + h * 64;
#pragma unroll
            for (int db = 0; db < 2; ++db)
#pragma unroll
                for (int g = 0; g < 4; ++g) {
                    const int col = 32 * db + 8 * g + 4 * hi;
                    const v2u z = *(const v2u*)(AZ + mrow + col);
                    const float z0 = bflo(z.x), z1 = bfhi(z.x), z2 = bflo(z.y), z3 = bfhi(z.y);
                    v2u w;
                    w.x = pk2(O[qb][db][4 * g] * invl * z0 * fsig(z0), O[qb][db][4 * g + 1] * invl * z1 * fsig(z1));
                    w.y = pk2(O[qb][db][4 * g + 2] * invl * z2 * fsig(z2), O[qb][db][4 * g + 3] * invl * z3 * fsig(z3));
                    *(v2u*)(OUTP + mrow + col) = w;
                }
        }
    }
}

typedef __bf16 bf2_t __attribute__((ext_vector_type(2)));
__device__ __forceinline__ float dot2u(unsigned a, unsigned b, float c) { return __builtin_amdgcn_fdot2_f32_bf16(__builtin_bit_cast(bf2_t, a), __builtin_bit_cast(bf2_t, b), c, false); }
__device__ __forceinline__ float fma_s(float a, float b, float c) { float d; asm("v_fma_f32 %0, %1, %2, %3" : "=v"(d) : "v"(a), "v"(b), "v"(c)); return d; }
__device__ __forceinline__ float add_s(float a, float b) { float d; asm("v_add_f32_e32 %0, %1, %2" : "=v"(d) : "v"(a), "v"(b)); return d; }
__device__ __forceinline__ float mul_s(float a, float b) { float d; asm("v_mul_f32_e32 %0, %1, %2" : "=v"(d) : "v"(a), "v"(b)); return d; }
__device__ __forceinline__ unsigned dpp_row_shl_u32(unsigned x, const int n) {
    int r;
    if (n == 1) r = __builtin_amdgcn_update_dpp(0, (int)x, 0x101, 0xF, 0xF, true);
    else if (n == 2) r = __builtin_amdgcn_update_dpp(0, (int)x, 0x102, 0xF, 0xF, true);
    else if (n == 4) r = __builtin_amdgcn_update_dpp(0, (int)x, 0x104, 0xF, 0xF, true);
    else r = __builtin_amdgcn_update_dpp(0, (int)x, 0x108, 0xF, 0xF, true);
    return (unsigned)r;
}
__device__ __forceinline__ unsigned suffix_sum_u32(unsigned x, int lane) {
    unsigned v = x;
    v += dpp_row_shl_u32(v, 1); v += dpp_row_shl_u32(v, 2); v += dpp_row_shl_u32(v, 4); v += dpp_row_shl_u32(v, 8);
    const unsigned t1 = (unsigned)__builtin_amdgcn_readlane((int)v, 16), t2 = (unsigned)__builtin_amdgcn_readlane((int)v, 32), t3 = (unsigned)__builtin_amdgcn_readlane((int)v, 48);
    const int row = lane >> 4;
    return v + (row == 0 ? t1 + t2 + t3 : (row == 1 ? t2 + t3 : (row == 2 ? t3 : 0u)));
}
constexpr int C_NB = 256, C_CAP = 128;
constexpr float C_WIN = 5.f;
__device__ const float C_ZN[64] = { 0.000f, 0.000f, 0.000f, 0.000f, -0.842f, -0.431f, -0.180f, 0.000f, 0.140f, 0.253f, 0.349f, 0.431f, 0.502f, 0.566f, 0.623f, 0.674f, 0.722f, 0.765f, 0.805f, 0.842f, 0.876f, 0.908f,
    0.939f, 0.967f, 0.994f, 1.020f, 1.044f, 1.068f, 1.090f, 1.111f, 1.131f, 1.150f, 1.169f, 1.187f, 1.204f, 1.221f, 1.237f, 1.252f, 1.267f, 1.282f, 1.296f, 1.309f, 1.322f, 1.335f, 1.348f, 1.360f, 1.372f, 1.383f, 1.394f,
    1.405f, 1.416f, 1.426f, 1.436f, 1.446f, 1.456f, 1.465f, 1.474f, 1.484f, 1.492f, 1.501f, 1.510f, 1.518f, 1.526f, 1.534f };
constexpr int C_LDS_HIST = 0, C_LDS_QIF = 33792, C_LDS_BMP = 66560, C_LDS_QP = 99328, C_LDS_WQ = 101376, C_LDS_SCR = 102400;
enum { QP_LO = 0, QP_SC = 1, QP_CRIT = 2, QP_LO2 = 3, QP_SC2 = 4, QP_CRIT2 = 5, QP_KREM = 6, QP_CNT = 7, QP_LVL = 8, QP_CC = 9, QP_ANYL2 = 15 };
__device__ __forceinline__ int c_bin(float s, float nlosc, float sc) { return (int)__builtin_amdgcn_fmed3f(fma_s(s, sc, nlosc), 0.f, (float)(C_NB - 1)); }
__device__ __forceinline__ float relu_asm(float x) { const int xi = __builtin_bit_cast(int, x); return __builtin_bit_cast(float, xi > 0 ? xi : 0); }
__device__ __forceinline__ void mixC_fast(Ctx C, unsigned char* ws, bf16* OUTP, const int parts = 3) {
    OPQ(C);
    const bf16* CQ = PLP(ws, PL_CQ); const bf16* CK = PLP(ws, PL_CK); const bf16* CVT = PLP(ws, PL_CV); const bf16* CZ = PLP(ws, PL_CZ);
    const bf16* QI0 = PLP(ws, PL_CQI0); const bf16* QI1 = PLP(ws, PL_CQI1); const bf16* KI = (const bf16*)(ws + WS_KI); const float* MS = (const float*)(ws + WS_MISC);
    LAS unsigned* HIST = (LAS unsigned*)(C.lds + C_LDS_HIST); LAS unsigned* BMP = (LAS unsigned*)(C.lds + C_LDS_BMP);
    LAS float* QPf = (LAS float*)(C.lds + C_LDS_QP); LAS int* QPi = (LAS int*)(C.lds + C_LDS_QP); LAS float* WQ = (LAS float*)(C.lds + C_LDS_WQ);
    LAS unsigned long long* LIST = (LAS unsigned long long*)(C.lds + C_LDS_HIST);
    LAS unsigned char* QIFL = C.lds + C_LDS_QIF;
    v4u* BINS = (v4u*)PLP(ws, PL_AK) + (size_t)C.bid * (128 * 64);
    const int wave = C.wave;
    if (wave & 4) __builtin_amdgcn_s_setprio(0); else __builtin_amdgcn_s_setprio(2);
    for (int pass2 = 0; pass2 < 2; ++pass2)
    for (int ui = C.bid; ui < 256; ui += C.G) {
        const int b = ui & 7, c = pass2 == 0 ? 63 - (ui >> 3) : (ui >> 3);
        const int n = 64 * (c + 1), nkb = n >> 5;
        const size_t mq0 = ((size_t)b << 12) + c * 64, mk0 = (size_t)b << 12;
        __syncthreads();
#define TTW ((volatile LAS unsigned*)(C.lds + MISC_OFF) + 32)
        if (EXP >= 200 && wave == 0 && lane_id_fresh() == 0) { const unsigned tn_ = (unsigned)__builtin_amdgcn_s_memrealtime(); TTW[1] = tn_; TTW[2] = tn_; }
#define TACC(slot) do { if (EXP >= 200 && wave == 0 && lane_id_fresh() == 0) { const unsigned tn_ = (unsigned)__builtin_amdgcn_s_memrealtime(); atomicAdd((unsigned*)(ws + WS_CTL) + 8192 + 16 * (slot) + 2, tn_ - TTW[2]); TTW[2] = tn_; } } while (0)
        if (!(parts & 1)) {} else if (c <= 3) {
            const int tid0 = wave * 64 + lane_id_fresh();
            for (int i = tid0; i < 64 * 128; i += 512) BMP[i] = ((i & 127) < nkb) ? 0xFFFFFFFFu : 0u;
        } else {
          for (int qb = 0; qb < 2; ++qb) {
            {
                const int lane = lane_id_fresh();
                const int hh = lane >> 3;
                bf16x8_t stg[4];
                {
                    const int q = lane & 31, hi = lane >> 5;
#pragma unroll
                    for (int s = 0; s < 4; ++s) stg[s] = *(const bf16x8_t*)((wave < 4 ? QI0 : QI1) + (mq0 + 32 * qb + q) * 256 + (wave & 3) * 64 + 16 * s + 8 * hi);
                }
                v4u wq4[4]; float wv4[4];
#pragma unroll
                for (int qq = 0; qq < 4; ++qq) {
                    const size_t m = mq0 + 32 * qb + wave * 4 + qq;
                    wq4[qq] = *(const v4u*)((hh < 4 ? QI0 : QI1) + m * 256 + (hh & 3) * 64 + 8 * (lane & 7));
                    wv4[qq] = MS[m * 256 + 64 + hh];
                }
#pragma unroll
                for (int qq = 0; qq < 4; ++qq) {
                    const int qx = wave * 4 + qq;
                    const v4u w = wq4[qq];
                    float ssq;
                    { const float a0 = bflo(w.x), a1 = bfhi(w.x), a2 = bflo(w.y), a3 = bfhi(w.y), a4 = bflo(w.z), a5 = bfhi(w.z), a6 = bflo(w.w), a7 = bfhi(w.w);
                      ssq = a0 * a0 + a1 * a1 + a2 * a2 + a3 * a3 + a4 * a4 + a5 * a5 + a6 * a6 + a7 * a7; }
                    ssq = red8(ssq);
                    const float wv = wv4[qq] * (0.35355339059327373f * 0.125f);
                    float tm = 0.4f * wv * sqrtf(ssq), tv = 0.34f * wv * wv * ssq;
                    tm += dppf(tm, 4); tm += swz16f(tm); tm = xh_sum(tm);
                    tv += dppf(tv, 4); tv += swz16f(tv); tv = xh_sum(tv);
                    if ((lane & 7) == 0) WQ[qx * 8 + hh] = wv;
                    if (lane == 0) { const float sd = fmaxf(sqrtf(tv), 1e-20f);
                        { const float sc_ = (float)C_NB / (C_WIN * sd); QPf[qx * 16 + QP_SC] = sc_; QPf[qx * 16 + QP_LO] = -(tm + (C_ZN[c] - 0.5f * C_WIN) * sd) * sc_; }
                        QPi[qx * 16 + QP_KREM] = 256; QPi[qx * 16 + QP_CNT] = 0; QPi[qx * 16 + QP_LVL] = 0; QPi[qx * 16 + QP_CRIT] = -1; QPi[qx * 16 + QP_CRIT2] = -1; }
                }
                if (wave == 0 && lane == 0) QPi[QP_ANYL2] = 0;
#pragma unroll
                for (int s = 0; s < 4; ++s) *(LAS bf16x8_t*)(QIFL + (wave * 4 + s) * 1024 + lane * 16) = stg[s];
            }
            TACC(6);
            int mode = 0; bool fastv = false;
            while (true) {
                if (mode == 3) {
                    const int lane = lane_id_fresh(), q = lane & 31, hi = lane >> 5;
                    const int crit1 = QPi[q * 16 + QP_CRIT];
                    v4u wr[16];
#pragma unroll
                    for (int i = 0; i < 16; ++i) { const int kb = wave + 8 * i; wr[i] = BINS[(kb < nkb ? kb : wave) * 64 + lane]; }
#pragma unroll
                    for (int i = 0; i < 16; ++i) {
                        const int kb = wave + 8 * i;
                        if (kb < nkb) {
                            unsigned bits = 0u;
#pragma unroll
                            for (int r = 0; r < 16; ++r) {
                                const int b1 = (int)((wr[i][r >> 2] >> (8 * (r & 3))) & 255u);
                                if (b1 > crit1) bits |= 1u << ((r & 3) + 8 * (r >> 2));
                                if (b1 == crit1) { const unsigned pos = atomicAdd((unsigned*)&QPi[q * 16 + QP_CNT], 1u);
                                    if (pos < (unsigned)C_CAP) LIST[q * C_CAP + pos] = (unsigned long long)(unsigned)(32 * kb + crow_(r, hi)); }
                            }
                            bits <<= 4 * hi;
                            bits = xh_or(bits);
                            if (hi == 0) BMP[(32 * qb + q) * 128 + kb] = bits;
                        }
                    }
                    fastv = true;
                    __syncthreads();
                    TACC(7);
                    break;
                }
                {
                    const int lane = lane_id_fresh(), q = lane & 31, hi = lane >> 5;
                    if (mode < 2) { for (int i = wave * 64 + lane; i < 32 * 257; i += 512) HIST[i] = 0u; }
                    __syncthreads();
                    const float lo1 = QPf[q * 16 + QP_LO], sc1 = QPf[q * 16 + QP_SC]; const int crit1 = QPi[q * 16 + QP_CRIT]; const int lvl = QPi[q * 16 + QP_LVL];
                    bf16x8_t qif[4][4];
#pragma unroll
                    for (int hh = 0; hh < 4; ++hh)
#pragma unroll
                        for (int s = 0; s < 4; ++s) qif[hh][s] = *(const LAS bf16x8_t*)(QIFL + (hh * 4 + s) * 1024 + lane * 16);
                    bf16x8_t kr0[4], kr1[4], kr2[4];
#define C_LOADKI(dst, KB) do { if ((KB) < nkb) { _Pragma("unroll") for (int s = 0; s < 4; ++s) dst[s] = *(const bf16x8_t*)(KI + ((((size_t)b * 128 + (KB)) * 4 + s) * 64 + lane) * 8); } } while (0)
                    C_LOADKI(kr0, wave); C_LOADKI(kr1, wave + 8); C_LOADKI(kr2, wave + 16);
                    for (int kb = wave; kb < nkb; kb += 8) {
                        const int kbase = 32 * kb;
                        bf16x8_t kif[4];
#pragma unroll
                        for (int s = 0; s < 4; ++s) { kif[s] = kr0[s]; kr0[s] = kr1[s]; kr1[s] = kr2[s]; }
                        C_LOADKI(kr2, kb + 24);
                        f32x16 I;
#pragma unroll
                        for (int r = 0; r < 16; ++r) I[r] = 0.f;
#pragma unroll
                        for (int hh = 0; hh < 8; ++hh) {
                            f32x16 D;
#pragma unroll
                            for (int r = 0; r < 16; ++r) D[r] = 0.f;
                            if (hh < 4) {
#pragma unroll
                                for (int s = 0; s < 4; ++s) D = __builtin_amdgcn_mfma_f32_32x32x16_bf16(kif[s], qif[hh][s], D, 0, 0, 0);
                            } else {
#pragma unroll
                                for (int s = 0; s < 4; ++s) D = __builtin_amdgcn_mfma_f32_32x32x16_bf16(kif[s], *(const LAS bf16x8_t*)(QIFL + (hh * 4 + s) * 1024 + lane * 16), D, 0, 0, 0);
                            }
                            const float wqh = WQ[q * 8 + hh];
#pragma unroll
                            for (int r = 0; r < 16; ++r) I[r] = fma_s(relu_asm(D[r]), wqh, I[r]);
                            asm volatile("" : "+v"(kif[0]), "+v"(kif[1]), "+v"(kif[2]), "+v"(kif[3]), "+v"(I));
                        }
                        if (mode == 0) {
                            v4u rec; rec.x = 0u; rec.y = 0u; rec.z = 0u; rec.w = 0u;
#pragma unroll
                            for (int r = 0; r < 16; ++r) { const int bn = c_bin(I[r], lo1, sc1); atomicAdd((unsigned*)&HIST[q * 257 + bn], 1u); rec[r >> 2] |= (unsigned)bn << (8 * (r & 3)); }
                            BINS[kb * 64 + lane] = rec;
                        } else if (mode == 1) {
                            if (lvl == 1) {
                                const float lo2 = QPf[q * 16 + QP_LO2], sc2 = QPf[q * 16 + QP_SC2];
#pragma unroll
                                for (int r = 0; r < 16; ++r) { if (c_bin(I[r], lo1, sc1) == crit1) { const int bn = c_bin(I[r], lo2, sc2); atomicAdd((unsigned*)&HIST[q * 257 + bn], 1u); } }
                            }
                        } else {
                            unsigned bits = 0u;
#pragma unroll
                            for (int r = 0; r < 16; ++r) {
                                const int b1 = c_bin(I[r], lo1, sc1);
                                bool sel = b1 > crit1, cand = (b1 == crit1);
                                if (cand && lvl == 1) { const int b2 = c_bin(I[r], QPf[q * 16 + QP_LO2], QPf[q * 16 + QP_SC2]); const int crit2 = QPi[q * 16 + QP_CRIT2]; sel = b2 > crit2; cand = (b2 == crit2); }
                                if (sel) bits |= 1u << ((r & 3) + 8 * (r >> 2));
                                if (cand) { const unsigned pos = atomicAdd((unsigned*)&QPi[q * 16 + QP_CNT], 1u);
                                    if (pos < (unsigned)C_CAP) LIST[q * C_CAP + pos] = ((unsigned long long)__float_as_uint(I[r]) << 32) | (unsigned)(kbase + crow_(r, hi)); }
                            }
                            bits <<= 4 * hi;
                            bits = xh_or(bits);
                            if (hi == 0) BMP[(32 * qb + q) * 128 + kb] = bits;
                        }
                    }
                }
#undef C_LOADKI
                __syncthreads();
                TACC(7);
                if (mode == 2) break;
                {
                    const int lane = lane_id_fresh();
                    LAS unsigned* SCR = (LAS unsigned*)(C.lds + C_LDS_SCR + wave * 256);
#pragma nounroll
                    for (int qq = 0; qq < 4; ++qq) {
                        const int qx = wave * 4 + qq;
                        const int lv = QPi[qx * 16 + QP_LVL];
                        if (mode == 1 && lv == 0) continue;
                        const int krem = QPi[qx * 16 + QP_KREM];
                        unsigned cnt[4]; unsigned s = 0u;
#pragma unroll
                        for (int j = 0; j < 4; ++j) { cnt[j] = HIST[qx * 257 + lane * 4 + j]; s += cnt[j]; }
                        const unsigned incl = suffix_sum_u32(s, lane);
                        unsigned run = incl - s;
                        int fcrit = -1; unsigned frun = 0u, fcnt = 0u;
#pragma unroll
                        for (int j = 3; j >= 0; --j) {
                            const bool hit = run < (unsigned)krem && run + cnt[j] >= (unsigned)krem;
                            fcrit = hit ? lane * 4 + j : fcrit; frun = hit ? run : frun; fcnt = hit ? cnt[j] : fcnt;
                            run += cnt[j];
                        }
                        if (fcrit >= 0) {
                            QPi[qx * 16 + QP_KREM] = krem - (int)frun; QPi[qx * 16 + QP_CC] = (int)fcnt;
                            if (mode == 0) { QPi[qx * 16 + QP_CRIT] = fcrit;
                                if (fcnt > (unsigned)C_CAP) { const float nlosc = QPf[qx * 16 + QP_LO], sc = QPf[qx * 16 + QP_SC];
                                    QPf[qx * 16 + QP_LO2] = (nlosc - (float)fcrit) * (float)C_NB; QPf[qx * 16 + QP_SC2] = sc * (float)C_NB; QPi[qx * 16 + QP_LVL] = 1; QPi[QP_ANYL2] = 1; } }
                            else QPi[qx * 16 + QP_CRIT2] = fcrit;
                        }
                    }
                }
                __syncthreads();
                TACC(8);
                if (mode == 0) { const bool need_l2 = (QPi[QP_ANYL2] != 0); mode = need_l2 ? 1 : ((EXP == 31 || EXP == 33) ? 2 : 3);
                    if (EXP == 226 && need_l2 && wave == 0 && lane_id_fresh() == 0) atomicAdd((unsigned*)(ws + WS_CTL) + 8192 + 16 * 6 + 3, 10000u);
                    if (EXP == 227 && wave == 0 && lane_id_fresh() == 0) { unsigned tot = 0u; for (int qx = 0; qx < 32; ++qx) tot += (unsigned)QPi[qx * 16 + QP_CC]; atomicAdd((unsigned*)(ws + WS_CTL) + 8192 + 16 * 7 + 3, tot); } }
                else mode = 2;
                __syncthreads();
            }
            if (EXP == 33) fastv = true;
            {
                const int lane = lane_id_fresh();
                if (fastv) {
                    int o1 = QPi[(wave * 4 + 0) * 16 + QP_CNT], o2 = QPi[(wave * 4 + 1) * 16 + QP_CNT], o3 = QPi[(wave * 4 + 2) * 16 + QP_CNT], o4 = QPi[(wave * 4 + 3) * 16 + QP_CNT];
                    o1 = o1 < C_CAP ? o1 : C_CAP; o2 = o1 + (o2 < C_CAP ? o2 : C_CAP); o3 = o2 + (o3 < C_CAP ? o3 : C_CAP); o4 = o3 + (o4 < C_CAP ? o4 : C_CAP);
                    for (int g = lane; g < o4; g += 64) {
                        const int qq = (g >= o1 ? 1 : 0) + (g >= o2 ? 1 : 0) + (g >= o3 ? 1 : 0);
                        const int ci = g - (qq == 0 ? 0 : (qq == 1 ? o1 : (qq == 2 ? o2 : o3)));
                        const int qx = wave * 4 + qq;
                        const unsigned idx = (unsigned)LIST[qx * C_CAP + ci];
                        const bf16* kp = KI + ((size_t)(b * 128 + (int)(idx >> 5)) * 4 * 64 + (idx & 31u)) * 8;
                        v4u kk[8];
#pragma unroll
                        for (int s = 0; s < 4; ++s)
#pragma unroll
                            for (int h2 = 0; h2 < 2; ++h2) kk[s * 2 + h2] = *(const v4u*)(kp + (s * 64 + h2 * 32) * 8);
                        float Iv = 0.f;
#pragma unroll
                        for (int hh = 0; hh < 8; ++hh) {
                            float d = 0.f;
#pragma unroll
                            for (int s = 0; s < 4; ++s)
#pragma unroll
                                for (int h2 = 0; h2 < 2; ++h2) {
                                    const v4u qv = *(const LAS v4u*)(QIFL + (hh * 4 + s) * 1024 + (h2 * 32 + qx) * 16);
                                    const v4u kv = kk[s * 2 + h2];
                                    d = dot2u(kv.x, qv.x, d); d = dot2u(kv.y, qv.y, d); d = dot2u(kv.z, qv.z, d); d = dot2u(kv.w, qv.w, d);
                                }
                            Iv = fmaf(fmaxf(d, 0.f), WQ[qx * 8 + hh], Iv);
                        }
                        LIST[qx * C_CAP + ci] = ((unsigned long long)__float_as_uint(Iv) << 32) | idx;
                    }
                    LDS_WAIT(); asm volatile("" ::: "memory");
                }
#pragma nounroll
                for (int qq = 0; qq < 4; ++qq) {
                    const int qx = wave * 4 + qq;
                    int cn = QPi[qx * 16 + QP_CNT]; cn = cn < C_CAP ? cn : C_CAP;
                    const int need = QPi[qx * 16 + QP_KREM];
                    for (int ci = lane; ci < cn; ci += 64) {
                        const unsigned long long me = LIST[qx * C_CAP + ci];
                        const float mv = __uint_as_float((unsigned)(me >> 32)); const unsigned mi = (unsigned)me;
                        int rank = 0;
                        for (int j = 0; j < cn; ++j) { const unsigned long long o = LIST[qx * C_CAP + j]; const float ov = __uint_as_float((unsigned)(o >> 32)); const unsigned oi = (unsigned)o;
                            rank += (ov > mv || (ov == mv && oi < mi)) ? 1 : 0; }
                        if (rank < need) atomicOr((unsigned*)&BMP[(32 * qb + qx) * 128 + (mi >> 5)], 1u << (mi & 31));
                    }
                }
            }
            __syncthreads();
            TACC(9);
          }
        }
        __syncthreads();
        if (EXP >= 200 && wave == 0 && lane_id_fresh() == 0) { const unsigned tn_ = (unsigned)__builtin_amdgcn_s_memrealtime(); atomicAdd((unsigned*)(ws + WS_CTL) + 8192 + 16 * 4 + 2, tn_ - TTW[1]); TTW[1] = tn_; }
        if (parts & 2) {
            const int lane = lane_id_fresh(), q = lane & 31, hi = lane >> 5;
            const int qb = wave & 1, h = wave >> 1, ql = 32 * qb + q;
            bf16x8_t qf[4];
#pragma unroll
            for (int s = 0; s < 4; ++s) qf[s] = *(const bf16x8_t*)(CQ + (mq0 + ql) * 256 + h * 64 + 16 * s + 8 * hi);
            f32x16 O[2];
#pragma unroll
            for (int db = 0; db < 2; ++db)
#pragma unroll
                for (int r = 0; r < 16; ++r) O[db][r] = 0.f;
            float mrun = -1e30f, lrun = 0.f;
            bf16x8_t kfn[4], vtn[2][2];
#define C_LOADKV(KB) do { const size_t kb_ = (size_t)(b * 4 + h) * 128 + (KB); _Pragma("unroll") for (int s = 0; s < 4; ++s) kfn[s] = *(const bf16x8_t*)(CK + ((kb_ * 4 + s) * 64 + lane) * 8); \
                _Pragma("unroll") for (int db = 0; db < 2; ++db) _Pragma("unroll") for (int s2 = 0; s2 < 2; ++s2) vtn[db][s2] = *(const bf16x8_t*)(CVT + (((kb_ * 2 + db) * 2 + s2) * 64 + lane) * 8); } while (0)
            C_LOADKV(0);
            for (int kb = 0; kb < nkb; ++kb) {
                const unsigned word = BMP[ql * 128 + kb] >> (4 * hi);
                bf16x8_t kf[4];
#pragma unroll
                for (int s = 0; s < 4; ++s) kf[s] = kfn[s];
                bf16x8_t vt[2][2];
#pragma unroll
                for (int db = 0; db < 2; ++db)
#pragma unroll
                    for (int s2 = 0; s2 < 2; ++s2) vt[db][s2] = vtn[db][s2];
                if (kb + 1 < nkb) C_LOADKV(kb + 1);
                f32x16 st;
#pragma unroll
                for (int r = 0; r < 16; ++r) st[r] = 0.f;
#pragma unroll
                for (int s = 0; s < 4; ++s) st = __builtin_amdgcn_mfma_f32_32x32x16_bf16(kf[s], qf[s], st, 0, 0, 0);
                float mx = -INFINITY;
#pragma unroll
                for (int r = 0; r < 16; ++r) {
                    const bool on = (word >> ((r & 3) + 8 * (r >> 2))) & 1u;
                    st[r] = on ? st[r] : -INFINITY;
                    mx = fmaxf(mx, st[r]);
                }
                mx = xh_max(mx) * (0.125f * 1.4426950408889634f);
                const float mn = fmaxf(mrun, mx);
                float ps = 0.f;
#pragma unroll
                for (int r = 0; r < 16; ++r) { st[r] = __builtin_amdgcn_exp2f(fmaf(st[r], 0.125f * 1.4426950408889634f, -mn)); ps += st[r]; }
                ps = xh_sum(ps);
                if (__builtin_amdgcn_ballot_w64(mn != mrun) != 0ull) {
                    const float al = __builtin_amdgcn_exp2f(mrun - mn);
                    lrun *= al;
#pragma unroll
                    for (int db = 0; db < 2; ++db)
#pragma unroll
                        for (int r = 0; r < 16; ++r) O[db][r] *= al;
                }
                mrun = mn;
                lrun += ps;
                v4u p0, p1;
                p0.x = pk2(st[0], st[1]); p0.y = pk2(st[2], st[3]); p0.z = pk2(st[4], st[5]); p0.w = pk2(st[6], st[7]);
                p1.x = pk2(st[8], st[9]); p1.y = pk2(st[10], st[11]); p1.z = pk2(st[12], st[13]); p1.w = pk2(st[14], st[15]);
                const bf16x8_t pf0 = __builtin_bit_cast(bf16x8_t, p0), pf1 = __builtin_bit_cast(bf16x8_t, p1);
#pragma unroll
                for (int db = 0; db < 2; ++db) {
                    O[db] = __builtin_amdgcn_mfma_f32_32x32x16_bf16(vt[db][0], pf0, O[db], 0, 0, 0);
                    O[db] = __builtin_amdgcn_mfma_f32_32x32x16_bf16(vt[db][1], pf1, O[db], 0, 0, 0);
                }
            }
#undef C_LOADKV
            const float invl = 1.f / lrun;
            const size_t mrow = (mq0 + ql) * 256 + h * 64;
#pragma unroll
            for (int db = 0; db < 2; ++db)
#pragma unroll
                for (int g = 0; g < 4; ++g) {
                    const int col = 32 * db + 8 * g + 4 * hi;
                    const v2u z = *(const v2u*)(CZ + mrow + col);
                    const float z0 = bflo(z.x), z1 = bfhi(z.x), z2 = bflo(z.y), z3 = bfhi(z.y);
                    v2u w;
                    w.x = pk2(O[db][4 * g] * invl * z0 * fsig(z0), O[db][4 * g + 1] * invl * z1 * fsig(z1));
                    w.y = pk2(O[db][4 * g + 2] * invl * z2 * fsig(z2), O[db][4 * g + 3] * invl * z3 * fsig(z3));
                    *(v2u*)(OUTP + mrow + col) = w;
                }
        }
        if (EXP >= 200) { __syncthreads(); if (wave == 0 && lane_id_fresh() == 0) { const unsigned tn_ = (unsigned)__builtin_amdgcn_s_memrealtime(); atomicAdd((unsigned*)(ws + WS_CTL) + 8192 + 16 * 5 + 2, tn_ - TTW[1]); } }
    }
    __builtin_amdgcn_s_setprio(0);
}
#define GRID_BAR() do { xcd_barrier(bar, C.wave == 0 && lane_id_fresh() == 0); if (EXP >= 100) { volatile LAS unsigned* TSW = (volatile LAS unsigned*)(C.lds + MISC_OFF) + 12; const unsigned k_ = TSW[0] + 1u; if (C.wave == 0 && lane_id_fresh() == 0) { TSW[0] = k_; TSW[k_] = (unsigned)__builtin_amdgcn_s_memrealtime(); } } } while (0)
#ifndef EXP
#define EXP 0
#endif
#define REP(k) for (int rep_ = 0; rep_ < ((EXP == (k)) ? 2 : 1); ++rep_)
template <int l>
__device__ __forceinline__ void layer_body(Ctx C, const Params& P, const XcdBarrier& bar) {
    unsigned char* ws = P.ws;
    const float* xin = (l == 0) ? P.in[0] : P.out;
    bf16* DRY = (bf16*)P.out;
    REP(1) {
        pg8::Gemm g{(const pg8::bf16_t*)(ws + WS_H), (const pg8::bf16_t*)(ws + WS_W1T), NTOK, NG1, 1024};
        pg8::StaticOrder S; S.init(NTOK, NG1, C.G, C.bid);
        EpiG1 E{ws, (const float*)(ws + WS_LB) + l * 256};
        pg8::gemm_phase<EpiG1, pg8::StaticOrder, true, true>(C.lds, g, S, E, C.wave);
    }
    GRID_BAR();
    REP(2) { mixD1_ut(C, P, l); __syncthreads(); }
    REP(3) { mixB_chunks<false>(C, ws, nullptr, nullptr); __syncthreads(); }
    GRID_BAR();
    REP(16) { mixD2(C, ws); __syncthreads(); }
    mixB_scan(C, ws);
    __syncthreads();
    convert_weights(C, P, 1, l == 0 ? 1 : 2, 32);
    if (l == 0) convert_weights(C, P, 0, 2, 32);
    __syncthreads();
    mixA_fast(C, ws, P.in[3] + l * 4 * 192, PLP(ws, PL_AQ));
    __syncthreads();
    GRID_BAR();
#define SUBT(k) do { if (EXP >= 200) { __syncthreads(); if (C.wave == 0 && lane_id_fresh() == 0) { volatile LAS unsigned* tt_ = (volatile LAS unsigned*)(C.lds + MISC_OFF) + 32; const unsigned tn_ = (unsigned)__builtin_amdgcn_s_memrealtime(); const unsigned d_ = tn_ - tt_[0]; tt_[0] = tn_; \
        unsigned* cw_ = (unsigned*)(ws + WS_CTL) + 8192 + 16 * (k); atomicMax(cw_ + l, d_); atomicAdd(cw_ + 2, d_); } } } while (0)
    if (EXP >= 200 && C.wave == 0 && lane_id_fresh() == 0) { volatile LAS unsigned* tt_ = (volatile LAS unsigned*)(C.lds + MISC_OFF) + 32; tt_[0] = (unsigned)__builtin_amdgcn_s_memrealtime(); }
    REP(4) { mixD3(C, P, l); __syncthreads(); }
    SUBT(0);
    if (EXP == 5 && l == 0) { mixB_chunks<true>(C, ws, P.in[5] + l * 64, DRY); __syncthreads(); }
    mixB_chunks<true>(C, ws, P.in[5] + l * 64, PLP(ws, PL_BQ));
    SUBT(1);
    SUBT(2);
    if (EXP == 7 && l == 0) { mixC_fast(C, ws, DRY); __syncthreads(); }
    if (EXP == 17 && l == 0) { mixC_fast(C, ws, DRY, 1); __syncthreads(); }
    if (EXP == 18 && l == 0) { mixC_fast(C, ws, DRY, 2); __syncthreads(); }
    mixC_fast(C, ws, PLP(ws, PL_CQ));
    SUBT(3);
    GRID_BAR();
    REP(8) {
        pg8::Gemm g{(const pg8::bf16_t*)PLP(ws, 0), (const pg8::bf16_t*)(ws + WS_WBT), NTOK, 1024, 256, (size_t)PLANE, (size_t)1024 * 256 * 2};
        pg8::GroupedOrder S; S.init(NTOK, 1024, 4, C.G, C.bid);
        EpiBf E{(bf16*)(ws + WS_PB), 1024, (size_t)NTOK * 1024};
        pg8::gemm_phase<EpiBf, pg8::GroupedOrder, true, true>(C.lds, g, S, E, C.wave);
    }
    GRID_BAR();
    REP(9) {
        pg8::Gemm g{(const pg8::bf16_t*)(ws + WS_H), (const pg8::bf16_t*)(ws + WS_WGT), NTOK, 4096, 1024};
        pg8::StaticOrder S; S.init(NTOK, 4096, C.G, C.bid);
        EpiGate E{(const bf16*)(ws + WS_PB), (bf16*)(ws + WS_Y)};
        pg8::gemm_phase<EpiGate, pg8::StaticOrder, true, true>(C.lds, g, S, E, C.wave);
    }
    GRID_BAR();
    for (int rep_ = 0; rep_ < ((EXP == 10 && l == 0) ? 3 : 1); ++rep_) {
        pg8::Gemm g{(const pg8::bf16_t*)(ws + WS_Y), (const pg8::bf16_t*)(ws + WS_WOT), NTOK, 1024, 1024};
        pg8::StaticOrder S; S.init(NTOK, 1024, C.G, C.bid);
        EpiRes E{xin, P.out};
        pg8::gemm_phase<EpiRes, pg8::StaticOrder, true, true>(C.lds, g, S, E, C.wave);
    }
    GRID_BAR();
    if (l == 0) { REP(11) { norm_rows_bf16(C, P.out, P.in[1] + 1024, (bf16*)(ws + WS_H)); } GRID_BAR(); }
    else {
        OPQ(C); const int gw = C.bid * 8 + C.wave, NGW = C.G * 8;
        for (int m = gw; m < NTOK; m += NGW) rms_row(P.out + (size_t)m * 1024, P.in[18], nullptr, P.out + (size_t)m * 1024, C.lane);
    }
    if (EXP == 12) { for (int i = 0; i < 20; ++i) GRID_BAR(); }
}
__global__ void __launch_bounds__(512, 2) mega_fwd(Params P) {
    extern __shared__ __attribute__((aligned(16))) unsigned char lds_raw[];
    Ctx C; C.lds = (LAS unsigned char*)lds_raw; C.wave = __builtin_amdgcn_readfirstlane((int)threadIdx.x >> 6); C.G = gridDim.x; C.bid = blockIdx.x; OPQ(C);
    unsigned char* ws = P.ws;
    for (int u = C.tid; u < (LDS_BYTES - LDSCTL_OFF) / 4; u += 512) ((LAS unsigned*)(C.lds + LDSCTL_OFF))[u] = 0u;
    __syncthreads();
    volatile LAS unsigned* MISCW = (volatile LAS unsigned*)(C.lds + MISC_OFF);
    XcdBarrier bar = xcd_barrier_post((unsigned*)(ws + WS_CTL) + CW_BAR, MISCW + 8);
    if (EXP >= 100 && C.wave == 0 && lane_id_fresh() == 0) { volatile LAS unsigned* TSW = (volatile LAS unsigned*)(C.lds + MISC_OFF) + 12; TSW[0] = 1u; TSW[1] = (unsigned)__builtin_amdgcn_s_memrealtime(); }
    __syncthreads();
    for (int rep_ = 0; rep_ < ((EXP == 13) ? 2 : 1); ++rep_) { setup_tables(C, P); }
    for (int rep_ = 0; rep_ < ((EXP == 14) ? 2 : 1); ++rep_) { convert_weights(C, P, 0, 1); }
    for (int rep_ = 0; rep_ < ((EXP == 15) ? 2 : 1); ++rep_) { norm_rows_bf16(C, P.in[0], P.in[1], (bf16*)(ws + WS_H)); }
    GRID_BAR();
    layer_body<0>(C, P, bar);
    layer_body<1>(C, P, bar);
    if (EXP >= 100) {
        GRID_BAR();
        if (C.bid == 0 && C.wave == 0 && lane_id_fresh() == 0) {
            volatile LAS unsigned* TSW = (volatile LAS unsigned*)(C.lds + MISC_OFF) + 12;
            const int j = EXP - 100; unsigned dt;
            if (j >= 100) { const unsigned* cw_ = (const unsigned*)(P.ws + WS_CTL) + 8192 + 16 * ((j - 100) % 10);
                dt = (j < 110) ? (__hip_atomic_load(cw_, __ATOMIC_RELAXED, __HIP_MEMORY_SCOPE_AGENT) + __hip_atomic_load(cw_ + 1, __ATOMIC_RELAXED, __HIP_MEMORY_SCOPE_AGENT)) : (__hip_atomic_load(cw_ + ((j >= 120) ? 3 : 2), __ATOMIC_RELAXED, __HIP_MEMORY_SCOPE_AGENT) / 256u); }
            else if (j == 0) dt = TSW[2] - TSW[1];
            else if (j <= 7) dt = (TSW[2 + j] - TSW[1 + j]) + (TSW[10 + j] - TSW[9 + j]);
            else if (j == 8) dt = (TSW[10] - TSW[9]);
            else dt = (TSW[18] - TSW[17]);
            const unsigned long long t0 = __builtin_amdgcn_s_memrealtime();
            while (__builtin_amdgcn_s_memrealtime() - t0 < 10ull * dt) __builtin_amdgcn_s_sleep(8);
        }
    }
}

extern "C" void kernel_launch(void* const* d_in, const int* in_sizes, int n_in, void* d_out, int out_size, void* d_ws, size_t ws_size, hipStream_t stream) {
    static int grid = 0;
    if (grid == 0) {
        if (n_in != 19 || ws_size < WS_END) { fprintf(stderr, "kernel_launch: need 19 inputs and %zu bytes of workspace (got %d, %zu)\n", (size_t)WS_END, n_in, ws_size); grid = -1; return; }
        int dev = 0, cus = 0, per_cu = 0;
        if (hipGetDevice(&dev) != hipSuccess || hipDeviceGetAttribute(&cus, hipDeviceAttributeMultiprocessorCount, dev) != hipSuccess) { grid = -1; return; }
        if (hipFuncSetAttribute((const void*)mega_fwd, hipFuncAttributeMaxDynamicSharedMemorySize, LDS_BYTES) != hipSuccess) { grid = -1; return; }
        (void)hipOccupancyMaxActiveBlocksPerMultiprocessor(&per_cu, (const void*)mega_fwd, 512, LDS_BYTES);
        (void)hipGetLastError();
        grid = cus;
    }
    if (grid < 0) return;
    if (hipMemsetAsync((char*)d_ws + WS_CTL, 0, CTL_ZERO_BYTES, stream) != hipSuccess) return;
    Params p{};
    for (int i = 0; i < 19; ++i) p.in[i] = (const float*)d_in[i];
    p.out = (float*)d_out; p.ws = (unsigned char*)d_ws;
    hipLaunchKernelGGL(mega_fwd, dim3(grid), dim3(512), LDS_BYTES, stream, p);
}
```

```cpp
#define EXP 0
#include <hip/hip_runtime.h>
#include <cstdio>
#include <cstdint>
#include <math.h>

#define DM 1024
#define SEQ 4096
#define NBATCH 8
#define NTOK (NBATCH * SEQ)
#define INC 8904
#define C_AQ 0
#define C_AK 256
#define C_AV 512
#define C_AZ 768
#define C_BQ 1024
#define C_BF 1280
#define C_BI 1536
#define C_BZ 1792
#define C_CQ 2048
#define C_CK 2304
#define C_CV 2560
#define C_CZ 2816
#define C_CQI 3072
#define C_CKI 3584
#define C_CWI 3648
#define C_PD 3656
#define C_DR 3656
#define C_DK 3912
#define C_DV 4168
#define C_DWD 4424
#define C_DAD 4488
#define C_DZ 4552
#define C_PG 4808
#define NG1 4864

namespace pg8 {
#define PG8_LAS __attribute__((address_space(3)))
typedef unsigned short bf16_t;
typedef short bf16x8 __attribute__((ext_vector_type(8)));
typedef float f32x4 __attribute__((ext_vector_type(4)));
typedef unsigned u32x4 __attribute__((ext_vector_type(4)));
constexpr int BM = 256, BK = 64, HALF = 128, HTB = HALF * BK * 2  , STAGE_BYTES = 8 * HTB, NXCD = 8, WGM = 8;

__host__ __device__ __forceinline__ int lds_byte(int r, int c) { const int st = (r >> 4) * 2 + (c >> 5), rr = r & 15, cc = c & 31, ob = rr * 64 + cc * 2; return st * 1024 + (ob ^ (((ob >> 9) & 1) << 5)); }
__host__ __device__ __forceinline__ void stage_rc(int b, int& R, int& C) { const int st = b / 1024, sb = b % 1024, swz = sb ^ (((sb >> 9) & 1) << 5); R = (st >> 1) * 16 + swz / 64; C = (st & 1) * 32 + (swz % 64) / 2; }
__host__ __device__ __forceinline__ int perm32(int rho) { const int n = rho >> 4, i = rho & 15; return 8 * (i >> 2) + 4 * n + (i & 3); }

struct Unit { int pm, pn; int grp; };
struct Gemm { const bf16_t* A; const bf16_t* Bt; int M, N, K; size_t a_grp = 0, b_grp = 0; };

struct StaticOrder {
    int nM, nN, nwg, G, c;
    __host__ __device__ void init(int M, int N, int G_, int c_) { nM = M / BM; nN = N / BM; nwg = nM * nN; G = G_; c = c_; }
    __host__ __device__ bool next(int i, Unit& u) const {
        const long L = (long)i * G + c; if (L >= nwg) return false;
        int wgid = (int)L; { const int q = nwg / NXCD, r = nwg % NXCD, xcd = wgid % NXCD, off = wgid / NXCD; wgid = (xcd < r ? xcd * (q + 1) : r * (q + 1) + (xcd - r) * q) + off; }
        const int nig = WGM * nN, gid = wgid / nig, fm = gid * WGM, gsz = (nM - fm) < WGM ? (nM - fm) : WGM;
        u.pm = fm + ((wgid % nig) % gsz); u.pn = (wgid % nig) / gsz; u.grp = 0; return true;
    }
    __device__ __forceinline__ void a_ready(const Unit&) const {}
    __device__ __forceinline__ void done(const Unit&) const {}
};
struct GroupedOrder {
    StaticOrder so; int ngrp;
    __host__ __device__ void init(int M, int N, int ngrp_, int G_, int c_) { so.init(M, N, G_, c_); ngrp = ngrp_; }
    __host__ __device__ bool next(int i, Unit& u) const {
        const long L = (long)i * so.G + so.c; if (L >= (long)ngrp * so.nwg) return false;
        const int grp = (int)(L / so.nwg), loc = (int)(L % so.nwg);
        StaticOrder t = so; t.c = loc; t.G = so.nwg;
        t.next(0, u); u.grp = grp; return true;
    }
    __device__ __forceinline__ void a_ready(const Unit&) const {}
    __device__ __forceinline__ void done(const Unit&) const {}
};

__device__ __forceinline__ unsigned cvt_pk_bf16(float lo, float hi) { unsigned r; asm volatile("v_cvt_pk_bf16_f32 %0, %1, %2" : "=v"(r) : "v"(lo), "v"(hi)); return r; }
template <class Epi, class Sched, bool ALIGN_EPI = false, bool SP2 = false>
__device__ __forceinline__ void gemm_phase(PG8_LAS unsigned char* lds, const Gemm g, const Sched& S, const Epi& E, const int wave_in) {
    int lane_; asm volatile("v_mbcnt_lo_u32_b32 %0, -1, 0\n\tv_mbcnt_hi_u32_b32 %0, -1, %0" : "=v"(lane_));
    const int wid = wave_in, lane = lane_, tid = wid * 64 + lane, wr = wid >> 2, wc = wid & 3, fr = lane & 15, fq = lane >> 4;
    const int K = g.K, nt = K / BK;
    unsigned voffA[2], voffB[2];
#pragma unroll
    for (int i = 0; i < 2; ++i) { int R, C; stage_rc(tid * 16 + i * 8192, R, C); const int Rb = Epi::PERM ? ((R & ~31) + perm32(R & 31)) : R;
        voffA[i] = (unsigned)(R * K + C) * 2u; voffB[i] = (unsigned)(Rb * K + C) * 2u; }
    const size_t kstep = (size_t)(BK * 2);
    const size_t hstep = (size_t)HALF * K * 2;
    const size_t tstep = 2 * hstep;
    const unsigned ldsw = (unsigned)wid * 1024u;
    const int aoff = lds_byte(wr * 64 + fr, fq * 8), boff = lds_byte(wc * 32 + fr, fq * 8);
#define PG8_SA(b, h) (((b) * 2 + (h)) * HTB)
#define PG8_SB(b, h) ((4 + (b) * 2 + (h)) * HTB)
#define PG8_STAGE(bufoff, gbase, voff) do { _Pragma("unroll") for (int _i = 0; _i < 2; ++_i) \
        __builtin_amdgcn_global_load_lds((const unsigned*)((const char*)(gbase) + (voff)[_i]), (PG8_LAS unsigned*)(lds + (bufoff) + ldsw + _i * 8192), 16, 0, 0); } while (0)
#define PG8_LDA(dst, b, h) do { _Pragma("unroll") for (int m = 0; m < 4; ++m) _Pragma("unroll") for (int k = 0; k < 2; ++k) dst[m][k] = *(const PG8_LAS bf16x8*)(lds + PG8_SA(b, h) + aoff + m * 2048 + k * 1024); } while (0)
#define PG8_LDB(dst, b, h) do { _Pragma("unroll") for (int n = 0; n < 2; ++n) _Pragma("unroll") for (int k = 0; k < 2; ++k) dst[n][k] = *(const PG8_LAS bf16x8*)(lds + PG8_SB(b, h) + boff + n * 2048 + k * 1024); } while (0)
#define PG8_MMA(ai, bj, At, Bt) do { __builtin_amdgcn_s_setprio(1); _Pragma("unroll") for (int m = 0; m < 4; ++m) _Pragma("unroll") for (int n = 0; n < 2; ++n) _Pragma("unroll") for (int k = 0; k < 2; ++k) \
        acc[ai][bj][m][n] = __builtin_amdgcn_mfma_f32_16x16x32_bf16(Bt[n][k], At[m][k], acc[ai][bj][m][n], 0, 0, 0); __builtin_amdgcn_s_setprio(0); } while (0)
#define PG8_WAIT_V(n) asm volatile("s_waitcnt vmcnt(" #n ")" ::: "memory")
#define PG8_WAIT_L(n) asm volatile("s_waitcnt lgkmcnt(" #n ")" ::: "memory")
#define PG8_BAR __builtin_amdgcn_s_barrier()
#define PG8_SCHED __builtin_amdgcn_sched_barrier(0)
    Unit cur, nxt; int ui = 0;
    if (!S.next(0, cur)) return;
    f32x4 acc[2][2][4][2];
#pragma unroll
    for (int a = 0; a < 2; ++a)
#pragma unroll
        for (int b = 0; b < 2; ++b)
#pragma unroll
            for (int m = 0; m < 4; ++m)
#pragma unroll
                for (int n = 0; n < 2; ++n) acc[a][b][m][n] = (f32x4){0.f, 0.f, 0.f, 0.f};
    bf16x8 At[4][2], B0[2][2], B1[2][2];
    const char* cA = (const char*)g.A + (size_t)cur.grp * g.a_grp + (size_t)cur.pm * tstep; const char* cB = (const char*)g.Bt + (size_t)cur.grp * g.b_grp + (size_t)cur.pn * tstep;
    S.a_ready(cur);
    if constexpr (SP2) {
        PG8_STAGE(PG8_SB(0, 0), cB, voffB); PG8_STAGE(PG8_SB(0, 1), cB + hstep, voffB); PG8_STAGE(PG8_SA(0, 0), cA, voffA); PG8_STAGE(PG8_SA(0, 1), cA + hstep, voffA);
        if (wr == 1) PG8_BAR;
        PG8_WAIT_V(2); PG8_BAR;
        PG8_STAGE(PG8_SB(1, 0), cB + kstep, voffB); PG8_STAGE(PG8_SA(1, 0), cA + kstep, voffA); PG8_STAGE(PG8_SB(1, 1), cB + hstep + kstep, voffB);
        PG8_WAIT_V(6); PG8_BAR;
    } else {
        PG8_STAGE(PG8_SB(0, 0), cB, voffB); PG8_STAGE(PG8_SA(0, 0), cA, voffA); PG8_STAGE(PG8_SB(0, 1), cB + hstep, voffB); PG8_STAGE(PG8_SA(0, 1), cA + hstep, voffA);
        if (wr == 1) PG8_BAR;
        PG8_WAIT_V(4); PG8_BAR;
        PG8_STAGE(PG8_SB(1, 0), cB + kstep, voffB); PG8_STAGE(PG8_SA(1, 0), cA + kstep, voffA); PG8_STAGE(PG8_SB(1, 1), cB + hstep + kstep, voffB);
        PG8_WAIT_V(6); PG8_BAR;
    }
    for (;;) {
        const bool has_next = S.next(ui + 1, nxt);
        const char* nA = has_next ? (const char*)g.A + (size_t)nxt.grp * g.a_grp + (size_t)nxt.pm * tstep : cA; const char* nB = has_next ? (const char*)g.Bt + (size_t)nxt.grp * g.b_grp + (size_t)nxt.pn * tstep : cB;
        for (int t = 0; t < nt; t += 2) {
            const bool last = (t == nt - 2);
            const char* a1 = cA + (size_t)(t + 1) * kstep;
            const char* a2 = last ? nA : cA + (size_t)(t + 2) * kstep; const char* b2 = last ? nB : cB + (size_t)(t + 2) * kstep;
            const char* a3 = a2 + kstep; const char* b3 = b2 + kstep;
            if (last && has_next) S.a_ready(nxt);
            if constexpr (SP2) {
            PG8_LDB(B0, 0, 0); PG8_LDB(B1, 0, 1); PG8_SCHED; PG8_LDA(At, 0, 0); PG8_STAGE(PG8_SA(1, 1), a1 + hstep, voffA);
            PG8_WAIT_V(8); PG8_WAIT_L(0); PG8_BAR; PG8_MMA(0, 0, At, B0); PG8_MMA(0, 1, At, B1); PG8_BAR; PG8_SCHED;
            PG8_LDA(At, 0, 1); PG8_STAGE(PG8_SB(0, 0), b2, voffB); PG8_STAGE(PG8_SB(0, 1), b2 + hstep, voffB); PG8_STAGE(PG8_SA(0, 0), a2, voffA);
            PG8_WAIT_V(8); PG8_WAIT_L(0); PG8_BAR; PG8_MMA(1, 0, At, B0); PG8_MMA(1, 1, At, B1); PG8_BAR; PG8_SCHED;
            PG8_LDB(B0, 1, 0); PG8_LDB(B1, 1, 1); PG8_SCHED; PG8_LDA(At, 1, 0); PG8_STAGE(PG8_SA(0, 1), a2 + hstep, voffA);
            PG8_WAIT_V(8); PG8_WAIT_L(0); PG8_BAR; PG8_MMA(0, 0, At, B0); PG8_MMA(0, 1, At, B1); PG8_BAR; PG8_SCHED;
            PG8_LDA(At, 1, 1); PG8_STAGE(PG8_SB(1, 0), b3, voffB); PG8_STAGE(PG8_SB(1, 1), b3 + hstep, voffB); PG8_STAGE(PG8_SA(1, 0), a3, voffA);
            PG8_WAIT_V(8); PG8_WAIT_L(0); PG8_BAR; PG8_MMA(1, 0, At, B0); PG8_MMA(1, 1, At, B1); PG8_BAR; PG8_SCHED;
            } else {
            PG8_LDB(B0, 0, 0); PG8_SCHED; PG8_LDA(At, 0, 0); PG8_STAGE(PG8_SA(1, 1), a1 + hstep, voffA);
            PG8_WAIT_L(8); PG8_BAR; PG8_WAIT_L(0); PG8_MMA(0, 0, At, B0); PG8_BAR; PG8_SCHED;
            PG8_LDB(B1, 0, 1); PG8_STAGE(PG8_SB(0, 0), b2, voffB);
            PG8_BAR; PG8_WAIT_L(0); PG8_MMA(0, 1, At, B1); PG8_BAR;
            PG8_LDA(At, 0, 1); PG8_STAGE(PG8_SA(0, 0), a2, voffA);
            PG8_BAR; PG8_WAIT_L(0); PG8_MMA(1, 0, At, B0); PG8_BAR; PG8_SCHED;
            PG8_STAGE(PG8_SB(0, 1), b2 + hstep, voffB);
            PG8_WAIT_V(6); PG8_BAR; PG8_MMA(1, 1, At, B1); PG8_BAR;
            PG8_LDB(B0, 1, 0); PG8_SCHED; PG8_LDA(At, 1, 0); PG8_STAGE(PG8_SA(0, 1), a2 + hstep, voffA);
            PG8_WAIT_L(8); PG8_BAR; PG8_WAIT_L(0); PG8_MMA(0, 0, At, B0); PG8_BAR; PG8_SCHED;
            PG8_LDB(B1, 1, 1); PG8_STAGE(PG8_SB(1, 0), b3, voffB);
            PG8_BAR; PG8_WAIT_L(0); PG8_MMA(0, 1, At, B1); PG8_BAR;
            PG8_LDA(At, 1, 1); PG8_STAGE(PG8_SA(1, 0), a3, voffA);
            PG8_BAR; PG8_WAIT_L(0); PG8_MMA(1, 0, At, B0); PG8_BAR; PG8_SCHED;
            PG8_STAGE(PG8_SB(1, 1), b3 + hstep, voffB);
            PG8_WAIT_V(6); PG8_BAR; PG8_MMA(1, 1, At, B1); PG8_BAR;
            }
        }
        if constexpr (ALIGN_EPI) { if (wr == 0) PG8_BAR; }
        if constexpr (!Epi::AFTER_DRAIN) { E(acc, cur, wr, wc, fr, fq); S.done(cur); }
        if (!has_next) break;
#pragma unroll
        for (int a = 0; a < 2; ++a)
#pragma unroll
            for (int b = 0; b < 2; ++b)
#pragma unroll
                for (int m = 0; m < 4; ++m)
#pragma unroll
                    for (int n = 0; n < 2; ++n) acc[a][b][m][n] = (f32x4){0.f, 0.f, 0.f, 0.f};
        cur = nxt; cA = nA; cB = nB; ++ui;
        if constexpr (ALIGN_EPI) { if (wr == 1) PG8_BAR; }
    }
    PG8_WAIT_V(0);
    if constexpr (!ALIGN_EPI) { if (wr == 0) PG8_BAR; }
    PG8_BAR;
    if constexpr (Epi::AFTER_DRAIN) { E.fused(acc, cur, wr, wc, fr, fq, lds, wid, lane); S.done(cur); }
#undef PG8_SA
#undef PG8_SB
#undef PG8_STAGE
#undef PG8_LDA
#undef PG8_LDB
#undef PG8_MMA
#undef PG8_WAIT_V
#undef PG8_WAIT_L
#undef PG8_BAR
#undef PG8_SCHED
}
}

#define GAS __attribute__((address_space(1)))
#define LAS __attribute__((address_space(3)))
typedef unsigned short bf16;
typedef unsigned v4u __attribute__((ext_vector_type(4)));
typedef unsigned v2u __attribute__((ext_vector_type(2)));
typedef float f32x4 __attribute__((ext_vector_type(4)));
typedef GAS unsigned gu32;
#define RLX_AGENT __ATOMIC_RELAXED, __HIP_MEMORY_SCOPE_AGENT
#define LDS_WAIT() asm volatile("s_waitcnt lgkmcnt(0)" ::: "memory")
#define VM_WAIT() asm volatile("s_waitcnt vmcnt(0)" ::: "memory")
__device__ __forceinline__ unsigned f2bf(float f) { unsigned u = __builtin_bit_cast(unsigned, f); return (u + 0x7fffu + ((u >> 16) & 1u)) >> 16; }
typedef float f32x2_t_ __attribute__((ext_vector_type(2))); typedef __bf16 bf16x2_t_ __attribute__((ext_vector_type(2)));
__device__ __forceinline__ unsigned pk2(float lo, float hi) { const f32x2_t_ v = {lo, hi}; const bf16x2_t_ b = __builtin_convertvector(v, bf16x2_t_); return __builtin_bit_cast(unsigned, b); }
__device__ __forceinline__ float bf2f(unsigned short b) { return __builtin_bit_cast(float, (unsigned)b << 16); }
__device__ __forceinline__ float bflo(unsigned w) { return __builtin_bit_cast(float, w << 16); }
__device__ __forceinline__ float bfhi(unsigned w) { return __builtin_bit_cast(float, w & 0xffff0000u); }
__device__ __forceinline__ float sigmoidf_(float x) { return 1.f / (1.f + expf(-x)); }
__device__ __forceinline__ float fsig(float x) { return __builtin_amdgcn_rcpf(1.f + __builtin_amdgcn_exp2f(-1.4426950408889634f * x)); }
__device__ __forceinline__ float siluf_(float x) { return x / (1.f + expf(-x)); }
__device__ __forceinline__ float dppf(float x, const int sel) {
    const int xi = __builtin_bit_cast(int, x); int r;
    if (sel == 0) r = __builtin_amdgcn_update_dpp(xi, xi, 0xB1, 0xF, 0xF, false);
    else if (sel == 1) r = __builtin_amdgcn_update_dpp(xi, xi, 0x4E, 0xF, 0xF, false);
    else if (sel == 2) r = __builtin_amdgcn_update_dpp(xi, xi, 0x141, 0xF, 0xF, false);
    else if (sel == 3) r = __builtin_amdgcn_update_dpp(xi, xi, 0x140, 0xF, 0xF, false);
    else r = __builtin_amdgcn_update_dpp(xi, xi, 0x128, 0xF, 0xF, false);
    return __builtin_bit_cast(float, r);
}
__device__ __forceinline__ float swz16f(float x) { return __builtin_bit_cast(float, __builtin_amdgcn_ds_swizzle(__builtin_bit_cast(int, x), 0x401F)); }
__device__ __forceinline__ float xh_sum(float x) { auto rr = __builtin_amdgcn_permlane32_swap(__float_as_uint(x), __float_as_uint(x), false, false); return __uint_as_float(rr[0]) + __uint_as_float(rr[1]); }
__device__ __forceinline__ float xh_max(float x) { auto rr = __builtin_amdgcn_permlane32_swap(__float_as_uint(x), __float_as_uint(x), false, false); return fmaxf(__uint_as_float(rr[0]), __uint_as_float(rr[1])); }
__device__ __forceinline__ unsigned xh_or(unsigned x) { auto rr = __builtin_amdgcn_permlane32_swap(x, x, false, false); return rr[0] | rr[1]; }
__device__ __forceinline__ float wave_sum(float v) {
    v += dppf(v, 0); v += dppf(v, 1); v += dppf(v, 2); v += dppf(v, 3); v += swz16f(v); return xh_sum(v);
}
__device__ __forceinline__ float wave_max(float v) {
    v = fmaxf(v, dppf(v, 0)); v = fmaxf(v, dppf(v, 1)); v = fmaxf(v, dppf(v, 2)); v = fmaxf(v, dppf(v, 3)); v = fmaxf(v, swz16f(v)); return xh_max(v);
}

constexpr size_t MiB = 1u << 20;
constexpr size_t WS_CTL = 0, CTL_ZERO_BYTES = 1 * MiB;
constexpr size_t WS_COS = 1 * MiB, WS_SIN = 1 * MiB + 512 * 1024;
constexpr size_t WS_LB = 2 * MiB;
constexpr size_t WS_DBON = 3 * MiB;
constexpr size_t WS_DAB = 4 * MiB;
constexpr size_t WS_DSS = 12 * MiB;
constexpr size_t WS_W1T = 16 * MiB;
constexpr size_t WS_WGT = 26 * MiB;
constexpr size_t WS_WBT = 34 * MiB;
constexpr size_t WS_WOT = 36 * MiB;
constexpr size_t WS_KI = 38 * MiB;
constexpr size_t WS_H = 42 * MiB;
constexpr size_t WS_PL = 106 * MiB;
constexpr size_t PLANE = 16 * MiB;
constexpr size_t WS_BF = WS_PL + 17 * PLANE;
constexpr size_t WS_MISC = WS_BF + 32 * MiB;
constexpr size_t WS_OL = WS_MISC + 32 * MiB;
constexpr size_t WS_CC = WS_OL + 16 * MiB;
constexpr size_t WS_BS = WS_CC + 16 * MiB;
constexpr size_t WS_BG = WS_BS + 32 * MiB;
constexpr size_t WS_END = WS_BG + 1 * MiB;
constexpr size_t WS_Y = WS_PL;
constexpr size_t WS_PB = WS_PL + 4 * PLANE;
static_assert(WS_PB + (size_t)4 * NTOK * 1024 * 2 <= WS_OL, "P_b overlay");
enum { PL_AQ = 0, PL_BQ = 1, PL_CQ = 2, PL_DR = 3, PL_AK = 4, PL_AV = 5, PL_AZ = 6, PL_BI = 7, PL_BZ = 8, PL_CK = 9, PL_CV = 10, PL_CZ = 11, PL_CQI0 = 12, PL_CQI1 = 13, PL_DK = 14, PL_DV = 15, PL_DZ = 16 };
#define PLP(ws, i) ((bf16*)((ws) + WS_PL + (size_t)(i) * PLANE))
constexpr int CW_BAR = 4096;

constexpr int RING_BYTES = 131072;
constexpr int LDSCTL_OFF = RING_BYTES, MISC_OFF = LDSCTL_OFF + 320;
constexpr int LDS_BYTES = 155648;

__device__ __forceinline__ int rope_j(int head, int dim) {
    const int bj = head >> 1, wc = ((head & 1) << 1) | ((dim >> 4) & 1), n = dim >> 5, fq = (dim >> 2) & 3, i = dim & 3;
    return 128 * bj + 32 * wc + 16 * n + 4 * fq + i;
}
__device__ __forceinline__ int win_dst_row(int c, int& which) {
    which = 0;
    if (c < 2048) return c;
    if (c < 2304) { const int l = c - 2048; return 8 * 256 + rope_j(l >> 6, l & 63); }
    if (c < 2560) { const int l = c - 2304; return 9 * 256 + rope_j(l >> 6, l & 63); }
    if (c < 3072) return c;
    if (c < 3584) { const int l = c - 3072; return (12 + (l >> 8)) * 256 + rope_j((l >> 6) & 3, l & 63); }
    if (c < 3648) return 14 * 256 + rope_j(0, c - 3584);
    if (c < 3656) return 14 * 256 + 64 + (c - 3648);
    if (c < 3912) return 15 * 256 + (c - 3656);
    if (c < 4168) return 16 * 256 + (c - 3912);
    if (c < 4424) return 17 * 256 + (c - 4168);
    if (c < 4488) return 14 * 256 + 72 + (c - 4424);
    if (c < 4552) return 14 * 256 + 136 + (c - 4488);
    if (c < 4808) return 18 * 256 + (c - 4552);
    which = 1;
    { const int g = c - 4808, br = g >> 10, y = g & 1023, pn = y >> 6, wc = (y >> 4) & 3, fq = (y >> 2) & 3, i = y & 3;
      return 256 * pn + 128 * (br >> 1) + 32 * wc + 16 * (br & 1) + 4 * fq + i; }
}

__device__ __forceinline__ size_t kfrag_off(int bh, int t, int d) { return ((((size_t)bh * 128 + (t >> 5)) * 4 + (d >> 4)) * 64 + ((t & 31) + 32 * ((d >> 3) & 1))) * 8 + (d & 7); }
__device__ __forceinline__ size_t vfrag_off(int bh, int t, int d) { const int kk = t & 31, r16 = kk & 15;
    return (((((size_t)bh * 128 + (t >> 5)) * 2 + (d >> 5)) * 2 + (kk >> 4)) * 64 + ((d & 31) + 32 * ((r16 >> 2) & 1))) * 8 + 4 * (r16 >> 3) + (r16 & 3); }

struct EpiG1 {
    static constexpr bool PERM = false, AFTER_DRAIN = false;
    unsigned char* ws; const float* lbl;
    __device__ __forceinline__ void operator()(const f32x4 (&acc)[2][2][4][2], const pg8::Unit& u, int wr, int wc, int fr, int fq) const {
        asm volatile("" : "+v"(fr), "+v"(fq));
        const int pn = u.pn;
        const int rbase = u.pm * 256 + wr * 64 + fr;
        const int cq = wc * 32 + 4 * fq;
        if (pn == 5) {
            float* BF = (float*)(ws + WS_BF);
#pragma unroll
            for (int bj = 0; bj < 2; ++bj)
#pragma unroll
                for (int n = 0; n < 2; ++n) {
                    const int col = cq + bj * 128 + n * 16;
                    const f32x4 l4 = *(const f32x4*)(lbl + col);
#pragma unroll
                    for (int ai = 0; ai < 2; ++ai)
#pragma unroll
                        for (int m = 0; m < 4; ++m) {
                            const f32x4 x = acc[ai][bj][m][n]; f32x4 o;
#pragma unroll
                            for (int i = 0; i < 4; ++i) o[i] = 1.f - (1.f - l4[i]) * fsig(-x[i]);
                            *(f32x4*)(BF + (size_t)(rbase + ai * 128 + m * 16) * 256 + col) = o;
                            asm volatile("" ::: "memory");
                        }
                }
        } else if (pn == 14) {
            float* MS = (float*)(ws + WS_MISC);
            const float* tcos = (const float*)(ws + WS_COS); const float* tsin = (const float*)(ws + WS_SIN);
#pragma unroll
            for (int bj = 0; bj < 2; ++bj) {
                if (bj == 0 && wc < 2) {
                    const int d0 = 16 * (wc & 1) + 4 * fq;
#pragma unroll
                    for (int ai = 0; ai < 2; ++ai)
#pragma unroll
                        for (int m = 0; m < 4; ++m) {
                            const int row = rbase + ai * 128 + m * 16, pos = row & (SEQ - 1);
                            const f32x4 c4 = *(const f32x4*)(tcos + pos * 32 + d0), s4 = *(const f32x4*)(tsin + pos * 32 + d0);
                            const f32x4 x1 = acc[ai][0][m][0], x2 = acc[ai][0][m][1];
                            const f32x4 y1 = x1 * c4 - x2 * s4, y2 = x2 * c4 + x1 * s4;
                            *(f32x4*)(MS + (size_t)row * 256 + d0) = y1;
                            *(f32x4*)(MS + (size_t)row * 256 + 32 + d0) = y2;
                            bf16* KIp = (bf16*)(ws + WS_KI);
                            v2u w1, w2; w1.x = pk2(y1[0], y1[1]); w1.y = pk2(y1[2], y1[3]); w2.x = pk2(y2[0], y2[1]); w2.y = pk2(y2[2], y2[3]);
                            *(v2u*)(KIp + kfrag_off(row >> 12, pos, d0)) = w1; *(v2u*)(KIp + kfrag_off(row >> 12, pos, 32 + d0)) = w2;
                            asm volatile("" ::: "memory");
                        }
                } else {
#pragma unroll
                    for (int n = 0; n < 2; ++n)
#pragma unroll
                        for (int ai = 0; ai < 2; ++ai)
#pragma unroll
                            for (int m = 0; m < 4; ++m)
                                *(f32x4*)(MS + (size_t)(rbase + ai * 128 + m * 16) * 256 + cq + bj * 128 + n * 16) = acc[ai][bj][m][n];
                }
            }
        } else {
            const unsigned long long lo = 0ull | (0ull << 0) | (4ull << 5) | (5ull << 10) | (6ull << 15) | (1ull << 20) | (0ull << 25) | (7ull << 30) | (8ull << 35) | (2ull << 40) | (9ull << 45) | (10ull << 50) | (11ull << 55);
            const unsigned long long hi = (12ull << 0) | (13ull << 5) | (0ull << 10) | (3ull << 15) | (14ull << 20) | (15ull << 25) | (16ull << 30);
            const int plane = (int)((pn < 12 ? (lo >> (5 * pn)) : (hi >> (5 * (pn - 12)))) & 31ull);
            bf16* PLN = PLP(ws, plane);
            if (pn == 8 || pn == 9 || pn == 12 || pn == 13) {
                const float* tcos = (const float*)(ws + WS_COS); const float* tsin = (const float*)(ws + WS_SIN);
                const int d0 = 16 * (wc & 1) + 4 * fq;
#pragma unroll
                for (int ai = 0; ai < 2; ++ai)
#pragma unroll
                    for (int m = 0; m < 4; ++m) {
                        const int row = rbase + ai * 128 + m * 16, pos = row & (SEQ - 1);
                        const f32x4 c4 = *(const f32x4*)(tcos + pos * 32 + d0), s4 = *(const f32x4*)(tsin + pos * 32 + d0);
#pragma unroll
                        for (int bj = 0; bj < 2; ++bj) {
                            const int head = 2 * bj + (wc >> 1);
                            const f32x4 x1 = acc[ai][bj][m][0], x2 = acc[ai][bj][m][1];
                            const f32x4 y1 = x1 * c4 - x2 * s4, y2 = x2 * c4 + x1 * s4;
                            v2u w1, w2; w1.x = pk2(y1[0], y1[1]); w1.y = pk2(y1[2], y1[3]); w2.x = pk2(y2[0], y2[1]); w2.y = pk2(y2[2], y2[3]);
                            if (pn == 9) {
                                const int bh = (row >> 12) * 4 + head;
                                *(v2u*)(PLN + kfrag_off(bh, pos, d0)) = w1; *(v2u*)(PLN + kfrag_off(bh, pos, 32 + d0)) = w2;
                            } else {
                                *(v2u*)(PLN + (size_t)row * 256 + head * 64 + d0) = w1;
                                *(v2u*)(PLN + (size_t)row * 256 + head * 64 + 32 + d0) = w2;
                            }
                        }
                        asm volatile("" ::: "memory");
                    }
            } else if (pn == 2 || pn == 10) {
#pragma unroll
                for (int ai = 0; ai < 2; ++ai)
#pragma unroll
                    for (int m = 0; m < 4; ++m) {
                        const int row = rbase + ai * 128 + m * 16, bb = row >> 12, tq = row & (SEQ - 1);
#pragma unroll
                        for (int bj = 0; bj < 2; ++bj)
#pragma unroll
                            for (int n = 0; n < 2; ++n) {
                                const f32x4 x = acc[ai][bj][m][n]; const int col = cq + bj * 128 + n * 16;
                                bf16* p = PLN + vfrag_off(bb * 4 + (col >> 6), tq, col & 63);
#pragma unroll
                                for (int i = 0; i < 4; ++i) p[8 * i] = (bf16)f2bf(x[i]);
                            }
                        asm volatile("" ::: "memory");
                    }
            } else if (pn == 1) {
#pragma unroll
                for (int ai = 0; ai < 2; ++ai)
#pragma unroll
                    for (int m = 0; m < 4; ++m) {
                        const int row = rbase + ai * 128 + m * 16, bb = row >> 12, tq = row & (SEQ - 1);
#pragma unroll
                        for (int bj = 0; bj < 2; ++bj)
#pragma unroll
                            for (int n = 0; n < 2; ++n) {
                                const f32x4 x = acc[ai][bj][m][n]; const int col = cq + bj * 128 + n * 16;
                                v2u w; w.x = pk2(x[0], x[1]); w.y = pk2(x[2], x[3]);
                                *(v2u*)(PLN + kfrag_off(bb * 4 + (col >> 6), tq, col & 63)) = w;
                            }
                        asm volatile("" ::: "memory");
                    }
            } else if (pn == 4) {
#pragma unroll
                for (int ai = 0; ai < 2; ++ai)
#pragma unroll
                    for (int m = 0; m < 4; ++m) {
                        bf16* rowp = PLN + (size_t)(rbase + ai * 128 + m * 16) * 256 + cq;
#pragma unroll
                        for (int bj = 0; bj < 2; ++bj)
#pragma unroll
                            for (int n = 0; n < 2; ++n) {
                                f32x4 x = acc[ai][bj][m][n];
#pragma unroll
                                for (int i = 0; i < 4; ++i) x[i] = x[i] * fsig(x[i]);
                                v2u w; w.x = pk2(x[0], x[1]); w.y = pk2(x[2], x[3]);
                                *(v2u*)(rowp + bj * 128 + n * 16) = w;
                            }
                        asm volatile("" ::: "memory");
                    }
            } else {
#pragma unroll
                for (int ai = 0; ai < 2; ++ai)
#pragma unroll
                    for (int m = 0; m < 4; ++m) {
                        bf16* rowp = PLN + (size_t)(rbase + ai * 128 + m * 16) * 256 + cq;
#pragma unroll
                        for (int bj = 0; bj < 2; ++bj)
#pragma unroll
                            for (int n = 0; n < 2; ++n) {
                                const f32x4 x = acc[ai][bj][m][n];
                                v2u w; w.x = pk2(x[0], x[1]); w.y = pk2(x[2], x[3]);
                                *(v2u*)(rowp + bj * 128 + n * 16) = w;
                            }
                        asm volatile("" ::: "memory");
                    }
            }
        }
    }
};
struct EpiBf {
    static constexpr bool PERM = true, AFTER_DRAIN = false;
    bf16* O; int ldc; size_t o_grp;
    __device__ __forceinline__ void operator()(const f32x4 (&acc)[2][2][4][2], const pg8::Unit& u, int wr, int wc, int fr, int fq) const {
        asm volatile("" : "+v"(fr), "+v"(fq));
        const int rbase = u.pm * 256 + wr * 64 + fr, cb = u.pn * 256 + wc * 32 + 8 * fq;
#pragma unroll
        for (int ai = 0; ai < 2; ++ai)
#pragma unroll
            for (int m = 0; m < 4; ++m) {
                bf16* rowp = O + (size_t)u.grp * o_grp + (size_t)(rbase + ai * 128 + m * 16) * ldc + cb;
#pragma unroll
                for (int bj = 0; bj < 2; ++bj) { const f32x4 x = acc[ai][bj][m][0], y = acc[ai][bj][m][1]; v4u w; w.x = pk2(x[0], x[1]); w.y = pk2(x[2], x[3]); w.z = pk2(y[0], y[1]); w.w = pk2(y[2], y[3]); *(v4u*)(rowp + bj * 128) = w; }
            }
    }
};
struct EpiGate {
    static constexpr bool PERM = false, AFTER_DRAIN = false;
    const bf16* PB; bf16* Y;
    __device__ __forceinline__ void operator()(const f32x4 (&acc)[2][2][4][2], const pg8::Unit& u, int wr, int wc, int fr, int fq) const {
        asm volatile("" : "+v"(fr), "+v"(fq));
        const int rbase = u.pm * 256 + wr * 64 + fr, yc = u.pn * 64 + wc * 16 + 4 * fq;
#pragma unroll
        for (int ai = 0; ai < 2; ++ai)
#pragma unroll
            for (int m = 0; m < 4; ++m) {
                const size_t row = (size_t)(rbase + ai * 128 + m * 16);
                f32x4 y = (f32x4){0.f, 0.f, 0.f, 0.f};
#pragma unroll
                for (int br = 0; br < 4; ++br) {
                    const v2u pw = *(const v2u*)(PB + ((size_t)br * NTOK + row) * 1024 + yc);
                    const f32x4 g = acc[ai][br >> 1][m][br & 1];
                    y[0] += bflo(pw.x) * fsig(g[0]); y[1] += bfhi(pw.x) * fsig(g[1]);
                    y[2] += bflo(pw.y) * fsig(g[2]); y[3] += bfhi(pw.y) * fsig(g[3]);
                }
                v2u w; w.x = pk2(y[0], y[1]); w.y = pk2(y[2], y[3]);
                *(v2u*)(Y + row * 1024 + yc) = w;
                asm volatile("" ::: "memory");
            }
    }
};
struct EpiRes {
    static constexpr bool PERM = true, AFTER_DRAIN = false;
    const float* R; float* O;
    __device__ __forceinline__ void operator()(const f32x4 (&acc)[2][2][4][2], const pg8::Unit& u, int wr, int wc, int fr, int fq) const {
        asm volatile("" : "+v"(fr), "+v"(fq));
        const int rbase = u.pm * 256 + wr * 64 + fr, cb = u.pn * 256 + wc * 32 + 8 * fq;
#pragma unroll
        for (int ai = 0; ai < 2; ++ai)
#pragma unroll
            for (int m = 0; m < 4; ++m) {
                const size_t off = (size_t)(rbase + ai * 128 + m * 16) * 1024 + cb;
#pragma unroll
                for (int bj = 0; bj < 2; ++bj)
#pragma unroll
                    for (int n = 0; n < 2; ++n) { const f32x4 r = *(const f32x4*)(R + off + bj * 128 + n * 4); *(f32x4*)(O + off + bj * 128 + n * 4) = r + acc[ai][bj][m][n]; }
            }
    }
};
#define XB_TMO      128
#define XB_XCNT(j)  (256  + 64 * (j))
#define XB_XSUB(j)  (1280 + 64 * (j))
#define XB_XGEN(j)  (2304 + 64 * (j))
#define XB_TOP      3328
#define XB_TOPGEN   3392
#define XCD_BAR_WORDS 3456
#define XB_SPIN_CAP (1u << 18)

__device__ __forceinline__ unsigned xb_ld(unsigned* p)              { return __hip_atomic_load(p, __ATOMIC_RELAXED, __HIP_MEMORY_SCOPE_AGENT); }
__device__ __forceinline__ unsigned xb_add(unsigned* p, unsigned v) { return __hip_atomic_fetch_add(p, v, __ATOMIC_RELAXED, __HIP_MEMORY_SCOPE_AGENT); }
__device__ __forceinline__ unsigned xb_xcc_id() { return (unsigned)__builtin_amdgcn_s_getreg((3 << 11) | 20) & 0xFu; }
#define XB_SPIN(cond, bar) do { unsigned _sp = 0; while (cond) { __builtin_amdgcn_s_sleep(1); \
    if ((++_sp & 255u) == 0u) { if (xb_ld(&(bar)[XB_TMO])) break; if (_sp > XB_SPIN_CAP) { atomicAdd(&(bar)[XB_TMO], 1u); break; } } } } while (0)

struct XcdBarrier {
    unsigned* bar; unsigned x;
    volatile LAS unsigned* st;
};

__device__ __forceinline__ XcdBarrier xcd_barrier_post(unsigned* bar, volatile LAS unsigned* st) {
    XcdBarrier b; b.bar = bar; b.x = xb_xcc_id(); b.st = st;
    if (threadIdx.x == 0) (void)xb_add(&bar[XB_XCNT(b.x)], 1u);
    return b;
}
__device__ __forceinline__ void xcd_barrier_complete(unsigned* bar, unsigned x, unsigned& nloc, unsigned& nx) {
    const unsigned G = gridDim.x * gridDim.y * gridDim.z;
    unsigned sum, cnt, mine, sp = 0u;
    for (;;) {
        sum = 0u; cnt = 0u; mine = 0u;
#pragma unroll
        for (unsigned j = 0; j < 16; ++j) { const unsigned c = xb_ld(&bar[XB_XCNT(j)]); sum += c; cnt += (c > 0u) ? 1u : 0u; mine = (j == x) ? c : mine; }
        if (sum == G) break;
        __builtin_amdgcn_s_sleep(1);
        if ((++sp & 255u) == 0u) { if (xb_ld(&bar[XB_TMO])) break; if (sp > XB_SPIN_CAP) { atomicAdd(&bar[XB_TMO], 1u); break; } }
    }
    nloc = mine > 0u ? mine : 1u; nx = cnt > 0u ? cnt : 1u;
}

__device__ __forceinline__ void xcd_barrier(const XcdBarrier& b_in, const bool t0) {
    XcdBarrier b = b_in; asm volatile("" : "+s"(b.bar), "+s"(b.x));
    asm volatile("s_waitcnt vmcnt(0)" ::: "memory");
    __syncthreads();
    if (t0) {
        unsigned* bar = b.bar;
        __builtin_amdgcn_s_waitcnt(0);
        unsigned nloc = b.st[0], nx = b.st[1];
        if (nloc == 0u) { xcd_barrier_complete(bar, b.x, nloc, nx); b.st[0] = nloc; b.st[1] = nx; }
        const unsigned old = xb_add(&bar[XB_XSUB(b.x)], 1u);
        const unsigned gen = old / nloc;
        if (old + 1u == (gen + 1u) * nloc) {
            __builtin_amdgcn_fence(__ATOMIC_RELEASE, "agent");
            asm volatile("s_waitcnt vmcnt(0)" ::: "memory");
            const unsigned og = xb_add(&bar[XB_TOP], 1u);
            const unsigned tg = og / nx;
            if (og + 1u == (tg + 1u) * nx) xb_add(&bar[XB_TOPGEN], 1u);
            else XB_SPIN(xb_ld(&bar[XB_TOPGEN]) == tg, bar);
            __builtin_amdgcn_fence(__ATOMIC_ACQUIRE, "agent");
            xb_add(&bar[XB_XGEN(b.x)], 1u);
            asm volatile("s_waitcnt vmcnt(0)" ::: "memory");
        } else {
            XB_SPIN(xb_ld(&bar[XB_XGEN(b.x)]) == gen, bar);
            __builtin_amdgcn_fence(__ATOMIC_ACQUIRE, "agent");
            asm volatile("s_waitcnt vmcnt(0)" ::: "memory");
        }
    }
    __syncthreads();
}

struct Params { const float* in[19]; float* out; unsigned char* ws; };
struct Ctx {
    LAS unsigned char* lds; int tid, lane, wave, G, bid;
};
__device__ __forceinline__ int lane_id_fresh() { int l; asm volatile("v_mbcnt_lo_u32_b32 %0, -1, 0\n\tv_mbcnt_hi_u32_b32 %0, -1, %0" : "=v"(l)); return l; }
#define OPQ(C) do { (C).lane = lane_id_fresh(); (C).tid = (C).wave * 64 + (C).lane; } while (0)

template <class MapFn>
__device__ __forceinline__ void transpose_item(const float* W, int K, int N, LAS float* scr, int item, int lane, MapFn map) {
    const int nblk = (N + 31) / 32, kb = item / nblk, nb = item % nblk, k0 = 64 * kb, n0 = 32 * nb;
    const int ncol = n0 + (lane & 31);
    float wv[32];
#pragma unroll
    for (int i = 0; i < 32; ++i) { const int kk = 2 * i + (lane >> 5); wv[i] = (ncol < N) ? W[(size_t)(k0 + kk) * N + ncol] : 0.f; }
#pragma unroll
    for (int i = 0; i < 32; ++i) { const int kk = 2 * i + (lane >> 5); scr[kk * 33 + (lane & 31)] = wv[i]; }
    LDS_WAIT(); asm volatile("" ::: "memory");
    const int c = lane & 7;
#pragma unroll
    for (int j = 0; j < 4; ++j) {
        const int n = (lane >> 3) + 8 * j; const LAS float* s = scr + (8 * c) * 33 + n;
        v4u o; o.x = pk2(s[0 * 33], s[1 * 33]); o.y = pk2(s[2 * 33], s[3 * 33]); o.z = pk2(s[4 * 33], s[5 * 33]); o.w = pk2(s[6 * 33], s[7 * 33]);
        if (n0 + n < N) { bf16* dst = map(n0 + n); if (dst) *(v4u*)(dst + k0 + 8 * c) = o; }
    }
    LDS_WAIT(); asm volatile("" ::: "memory");
}
__device__ __forceinline__ void convert_weights(Ctx C, const Params& P, int l, const int parts, const int bid0 = 0) {
    OPQ(C);
    if (C.bid < bid0) return;
    LAS float* scr = (LAS float*)(C.lds + C.wave * 16384);
    const int gw = (C.bid - bid0) * 8 + C.wave, NGW = (C.G - bid0) * 8;
    unsigned char* ws = P.ws;
    bf16* W1t = (bf16*)(ws + WS_W1T); bf16* Wgt = (bf16*)(ws + WS_WGT);
    bf16* Wbt = (bf16*)(ws + WS_WBT); bf16* Wot = (bf16*)(ws + WS_WOT);
    const float* w_in = P.in[2] + (size_t)l * 1024 * INC; const float* w_br = P.in[16] + (size_t)l * 4 * 256 * 1024; const float* w_out = P.in[17] + (size_t)l * 1024 * 1024;
    constexpr int NBLK = (INC + 31) / 32, NB1 = 151;
    if (parts & 1) {
        for (int it = gw; it < 16 * NB1; it += NGW) {
            const int item = (it / NB1) * NBLK + (it % NB1);
            transpose_item(w_in, 1024, INC, scr, item, C.lane, [&](int c) -> bf16* { int which; const int row = win_dst_row(c, which); return which ? (bf16*)nullptr : W1t + (size_t)row * 1024; });
        }
        for (int i = (C.bid - bid0) * 512 + C.tid; i < 56 * 1024 / 8; i += (C.G - bid0) * 512) *(v4u*)(W1t + (size_t)(14 * 256 + 200) * 1024 + (size_t)i * 8) = (v4u){0u, 0u, 0u, 0u};
    }
    if (parts & 2) {
        constexpr int NB2 = NBLK - 150, I_G = 16 * NB2, I_BR = 4 * 32, I_OUT = 16 * 32;
        for (int it = gw; it < I_G + 4 * I_BR + I_OUT; it += NGW) {
            int r = it;
            if (r < I_G) { const int item = (r / NB2) * NBLK + 150 + (r % NB2);
                transpose_item(w_in, 1024, INC, scr, item, C.lane, [&](int c) -> bf16* { int which; const int row = win_dst_row(c, which); return which ? Wgt + (size_t)row * 1024 : (bf16*)nullptr; }); continue; }
            r -= I_G;
            if (r < 4 * I_BR) { const int br = r / I_BR, ri = r % I_BR; transpose_item(w_br + (size_t)br * 256 * 1024, 256, 1024, scr, ri, C.lane, [&](int c) -> bf16* { return Wbt + ((size_t)br * 1024 + c) * 256; }); continue; }
            r -= 4 * I_BR;
            transpose_item(w_out, 1024, 1024, scr, r, C.lane, [&](int c) -> bf16* { return Wot + (size_t)c * 1024; });
        }
    }
}
__device__ __forceinline__ void rms_row(const float* xrow, const float* g, bf16* obf, float* of32, int lane) {
    const f32x4* xr = (const f32x4*)xrow + lane;
    f32x4 v[4]; float s = 0.f;
#pragma unroll
    for (int j = 0; j < 4; ++j) { v[j] = xr[64 * j]; s += (v[j].x * v[j].x + v[j].y * v[j].y) + (v[j].z * v[j].z + v[j].w * v[j].w); }
    const float inv = rsqrtf(wave_sum(s) * (1.f / 1024.f) + 1e-6f);
#pragma unroll
    for (int j = 0; j < 4; ++j) {
        const f32x4 gg = ((const f32x4*)g)[lane + 64 * j];
        const f32x4 o = v[j] * inv * gg;
        if (obf) { v2u w; w.x = pk2(o.x, o.y); w.y = pk2(o.z, o.w); ((v2u*)obf)[lane + 64 * j] = w; }
        else ((f32x4*)of32)[lane + 64 * j] = o;
    }
}
template <int N>
__device__ __forceinline__ void rms_rows(const float* x, size_t rs, const float* g, bf16* ob, float* of, int lane) {
    f32x4 v[N][4]; float s[N];
#pragma unroll
    for (int r = 0; r < N; ++r)
#pragma unroll
        for (int j = 0; j < 4; ++j) v[r][j] = ((const f32x4*)(x + r * rs))[lane + 64 * j];
#pragma unroll
    for (int r = 0; r < N; ++r) { s[r] = 0.f;
#pragma unroll
        for (int j = 0; j < 4; ++j) s[r] += (v[r][j].x * v[r][j].x + v[r][j].y * v[r][j].y) + (v[r][j].z * v[r][j].z + v[r][j].w * v[r][j].w); }
#pragma unroll
    for (int r = 0; r < N; ++r) s[r] = rsqrtf(wave_sum(s[r]) * (1.f / 1024.f) + 1e-6f);
#pragma unroll
    for (int j = 0; j < 4; ++j) {
        const f32x4 gg = ((const f32x4*)g)[lane + 64 * j];
#pragma unroll
        for (int r = 0; r < N; ++r) {
            const f32x4 o = v[r][j] * s[r] * gg;
            if (ob) { v2u w; w.x = pk2(o.x, o.y); w.y = pk2(o.z, o.w); ((v2u*)(ob + r * rs))[lane + 64 * j] = w; }
            else ((f32x4*)(of + r * rs))[lane + 64 * j] = o;
        }
    }
}
__device__ __forceinline__ void norm_rows_bf16(Ctx C, const float* x, const float* g, bf16* h) {
    OPQ(C);
    const int gw = C.bid * 8 + C.wave, NGW = C.G * 8;
    int m = gw;
    for (; m + 3 * NGW < NTOK; m += 4 * NGW) rms_rows<4>(x + (size_t)m * 1024, (size_t)NGW * 1024, g, h + (size_t)m * 1024, nullptr, C.lane);
    for (; m < NTOK; m += NGW) rms_row(x + (size_t)m * 1024, g, h + (size_t)m * 1024, nullptr, C.lane);
}
__device__ __forceinline__ void setup_tables(Ctx C, const Params& P) {
    OPQ(C);
    float* tcos = (float*)(P.ws + WS_COS); float* tsin = (float*)(P.ws + WS_SIN); float* lb = (float*)(P.ws + WS_LB);
    for (int i = C.bid * 512 + C.tid; i < SEQ * 32; i += C.G * 512) {
        const int pos = i >> 5, j = i & 31;
        const float freq = (float)pow(10000.0, -(double)j / 32.0);
        const float ang = (float)pos * freq;
        tcos[i] = (float)cos((double)ang); tsin[i] = (float)sin((double)ang);
    }
    if (C.bid == 0 && C.tid < 256) {
        const float l0 = P.in[4][C.tid], l1 = P.in[4][256 + C.tid];
        lb[C.tid] = 0.f; lb[256 + C.tid] = 1.f / (1.f + expf(l0 - l1));
    }
}

__device__ __forceinline__ void mixA_simple(Ctx C, unsigned char* ws, const float* bias) {
    OPQ(C);
    bf16* AQ = PLP(ws, PL_AQ); const bf16* AK = PLP(ws, PL_AK); const bf16* AV = PLP(ws, PL_AV); const bf16* AZ = PLP(ws, PL_AZ);
    for (int it = C.bid * 512 + C.tid; it < 4 * NTOK; it += C.G * 512) {
        const int h = it / NTOK, m = it % NTOK, b = m >> 12, t = m & 4095, c = t >> 6, qi = t & 63;
        float q[64], o[64];
        {
            const v4u* qp = (const v4u*)(AQ + (size_t)m * 256 + h * 64);
#pragma unroll
            for (int j = 0; j < 8; ++j) { const v4u w = qp[j]; q[8 * j] = bflo(w.x); q[8 * j + 1] = bfhi(w.x); q[8 * j + 2] = bflo(w.y); q[8 * j + 3] = bfhi(w.y); q[8 * j + 4] = bflo(w.z); q[8 * j + 5] = bfhi(w.z); q[8 * j + 6] = bflo(w.w); q[8 * j + 7] = bfhi(w.w); }
        }
#pragma unroll
        for (int d = 0; d < 64; ++d) o[d] = 0.f;
        float mx = -INFINITY, l = 0.f;
        const float* bh = bias + h * 192;
        for (int kj = 0; kj < 576; ++kj) {
            const int kp = c * 64 - 512 + kj;
            if (kp < 0) continue;
            const size_t mk = ((size_t)b << 12) + kp;
            const v4u* kr = (const v4u*)(AK + mk * 256 + h * 64); const v4u* vr = (const v4u*)(AV + mk * 256 + h * 64);
            float s = 0.f;
#pragma unroll
            for (int j = 0; j < 8; ++j) { const v4u w = kr[j];
                s = fmaf(q[8 * j], bflo(w.x), s); s = fmaf(q[8 * j + 1], bfhi(w.x), s); s = fmaf(q[8 * j + 2], bflo(w.y), s); s = fmaf(q[8 * j + 3], bfhi(w.y), s);
                s = fmaf(q[8 * j + 4], bflo(w.z), s); s = fmaf(q[8 * j + 5], bfhi(w.z), s); s = fmaf(q[8 * j + 6], bflo(w.w), s); s = fmaf(q[8 * j + 7], bfhi(w.w), s); }
            int rel = qi + 512 - kj; rel = rel < -63 ? -63 : (rel > 128 ? 128 : rel);
            s = s * 0.125f + bh[rel + 63];
            const float mn = fmaxf(mx, s), al = expf(mx - mn), pe = expf(s - mn);
            l = l * al + pe; mx = mn;
#pragma unroll
            for (int j = 0; j < 8; ++j) { const v4u w = vr[j];
                o[8 * j] = fmaf(pe, bflo(w.x), o[8 * j] * al); o[8 * j + 1] = fmaf(pe, bfhi(w.x), o[8 * j + 1] * al); o[8 * j + 2] = fmaf(pe, bflo(w.y), o[8 * j + 2] * al); o[8 * j + 3] = fmaf(pe, bfhi(w.y), o[8 * j + 3] * al);
                o[8 * j + 4] = fmaf(pe, bflo(w.z), o[8 * j + 4] * al); o[8 * j + 5] = fmaf(pe, bfhi(w.z), o[8 * j + 5] * al); o[8 * j + 6] = fmaf(pe, bflo(w.w), o[8 * j + 6] * al); o[8 * j + 7] = fmaf(pe, bfhi(w.w), o[8 * j + 7] * al); }
        }
        const float invl = 1.f / l;
        const v4u* zp = (const v4u*)(AZ + (size_t)m * 256 + h * 64); v4u* op = (v4u*)(AQ + (size_t)m * 256 + h * 64);
#pragma unroll
        for (int j = 0; j < 8; ++j) { const v4u z = zp[j]; v4u w;
            w.x = pk2(o[8 * j] * invl * siluf_(bflo(z.x)), o[8 * j + 1] * invl * siluf_(bfhi(z.x))); w.y = pk2(o[8 * j + 2] * invl * siluf_(bflo(z.y)), o[8 * j + 3] * invl * siluf_(bfhi(z.y)));
            w.z = pk2(o[8 * j + 4] * invl * siluf_(bflo(z.z)), o[8 * j + 5] * invl * siluf_(bfhi(z.z))); w.w = pk2(o[8 * j + 6] * invl * siluf_(bflo(z.w)), o[8 * j + 7] * invl * siluf_(bfhi(z.w)));
            op[j] = w; }
    }
}
__device__ __forceinline__ void mixB_simple(Ctx C, unsigned char* ws, const float* normg) {
    OPQ(C);
    if (C.bid < 32 || C.bid >= 36) return;
    const int gw = (C.bid - 32) * 8 + C.wave;
    const int b = gw >> 2, h = gw & 3, v = C.lane;
    bf16* BQ = PLP(ws, PL_BQ); const bf16* BI = PLP(ws, PL_BI); const bf16* BZ = PLP(ws, PL_BZ); const float* BF = (const float*)(ws + WS_BF);
    float S[64];
#pragma unroll
    for (int d = 0; d < 64; ++d) S[d] = 0.f;
    const float g = normg[v];
    for (int t = 0; t < SEQ; ++t) {
        const size_t m = ((size_t)b << 12) + t;
        const float* fr = BF + m * 256 + h * 64; const bf16* qr = BQ + m * 256 + h * 64;
        const float iv = bf2f(BI[m * 256 + h * 64 + v]); const float z = bf2f(BZ[m * 256 + h * 64 + v]);
        float o = 0.f;
#pragma unroll
        for (int d = 0; d < 64; ++d) { S[d] = fmaf(fr[d], S[d] - iv, iv); o = fmaf(bf2f(qr[d]), S[d], o); }
        const float r = rsqrtf(wave_sum(o * o) * (1.f / 64.f) + 1e-6f);
        asm volatile("" ::: "memory");
        BQ[m * 256 + h * 64 + v] = (bf16)f2bf(o * r * g * siluf_(z));
    }
}
__device__ __forceinline__ void mixD_simple(Ctx C, unsigned char* ws, const Params& P, int l) {
    OPQ(C);
    if (C.bid >= 32) return;
    const int b = C.bid >> 2, h = C.bid & 3, tid = C.tid;
    bf16* DR = PLP(ws, PL_DR); const bf16* DK = PLP(ws, PL_DK); const bf16* DV = PLP(ws, PL_DV); const bf16* DZ = PLP(ws, PL_DZ); const float* MS = (const float*)(ws + WS_MISC);
    const float* mu = P.in[6] + l * 896; const float* w0 = P.in[7] + l * 256; const float* w_up = P.in[8] + (size_t)l * 64 * 256; const float* a0 = P.in[9] + l * 256;
    const float* a_up = P.in[10] + (size_t)l * 64 * 256; const float* k_k = P.in[11] + l * 256; const float* k_a = P.in[12] + l * 256; const float* r_k = P.in[13] + l * 256;
    const float* gn_g = P.in[14] + l * 256; const float* gn_b = P.in[15] + l * 256;
    LAS float* L = (LAS float*)C.lds;
    LAS float* twd = L; LAS float* ads = L + 64; LAS float* rs = L + 128; LAS float* kr = L + 192; LAS float* vs = L + 256;
    LAS float* wv = L + 320; LAS float* av = L + 384; LAS float* kkv = L + 448; LAS float* kfv = L + 512; LAS float* bv = L + 576; LAS float* ob = L + 640; LAS float* bon = L + 704;
    const int v = tid >> 3, ks = tid & 7;
    float S[8];
#pragma unroll
    for (int i = 0; i < 8; ++i) S[i] = 0.f;
    const int grp = tid >> 6, cc = tid & 63;
    float prev = 0.f, mucol = 0.f;
    if (grp == 0) mucol = mu[768 + cc]; else if (grp == 1) mucol = mu[832 + cc]; else if (grp == 2) mucol = mu[h * 64 + cc]; else if (grp == 3) mucol = mu[256 + h * 64 + cc]; else if (grp == 4) mucol = mu[512 + h * 64 + cc];
    for (int t = 0; t < SEQ; ++t) {
        const size_t m = ((size_t)b << 12) + t;
        if (grp < 5) {
            float cur;
            if (grp == 0) cur = MS[m * 256 + 72 + cc]; else if (grp == 1) cur = MS[m * 256 + 136 + cc];
            else if (grp == 2) cur = bf2f(DR[m * 256 + h * 64 + cc]); else if (grp == 3) cur = bf2f(DK[m * 256 + h * 64 + cc]); else cur = bf2f(DV[m * 256 + h * 64 + cc]);
            const float sh = cur + mucol * (prev - cur); prev = cur;
            if (grp == 0) twd[cc] = tanhf(sh); else if (grp == 1) ads[cc] = sh; else if (grp == 2) rs[cc] = sh; else if (grp == 3) kr[cc] = sh; else vs[cc] = sh;
        }
        __syncthreads();
        if (tid < 128) {
            const int c = tid & 63, hc = h * 64 + c;
            if (tid < 64) { float wl = w0[hc];
_Pragma("nounroll")
                for (int i = 0; i < 64; ++i) wl = fmaf(twd[i], w_up[i * 256 + hc], wl);
                const float x = -wl; const float sp = fmaxf(x, 0.f) + log1pf(expf(-fabsf(x))); wv[c] = expf(-expf(-sp - 0.5f)); }
            else { float al = a0[hc];
_Pragma("nounroll")
                for (int i = 0; i < 64; ++i) al = fmaf(ads[i], a_up[i * 256 + hc], al); av[c] = sigmoidf_(al); }
        }
        __syncthreads();
        if (tid < 64) {
            const int hc = h * 64 + tid; const float kx = kr[tid], a = av[tid];
            const float kkr = kx * k_k[hc]; const float nrm = sqrtf(wave_sum(kkr * kkr)); const float kk = kkr / fmaxf(nrm, 1e-12f);
            const float kf = kx * (1.f + (a - 1.f) * k_a[hc]);
            kkv[tid] = kk; kfv[tid] = kf; bv[tid] = kk * a;
            const float bsum = wave_sum(rs[tid] * kf * r_k[hc]); if (tid == 0) bon[0] = bsum;
        }
        __syncthreads();
        {
            float sa = 0.f;
#pragma unroll
            for (int i = 0; i < 8; ++i) sa = fmaf(S[i], kkv[8 * ks + i], sa);
            sa += __shfl_xor(sa, 1); sa += __shfl_xor(sa, 2); sa += __shfl_xor(sa, 4); sa = -sa;
            const float vv = vs[v]; float o = 0.f;
#pragma unroll
            for (int i = 0; i < 8; ++i) { S[i] = fmaf(S[i], wv[8 * ks + i], fmaf(sa, bv[8 * ks + i], vv * kfv[8 * ks + i])); o = fmaf(S[i], rs[8 * ks + i], o); }
            o += __shfl_xor(o, 1); o += __shfl_xor(o, 2); o += __shfl_xor(o, 4);
            if (ks == 0) ob[v] = o;
        }
        __syncthreads();
        if (tid < 64) {
            const int hc = h * 64 + tid; const float o = ob[tid];
            const float mean = wave_sum(o) * (1.f / 64.f); const float d = o - mean; const float var = wave_sum(d * d) * (1.f / 64.f);
            float y = d * rsqrtf(var + 64e-5f) * gn_g[hc] + gn_b[hc];
            y += bon[0] * vs[tid];
            const float z = bf2f(DZ[m * 256 + hc]);
            DR[m * 256 + hc] = (bf16)f2bf(y * siluf_(z));
        }
        __syncthreads();
    }
}
__device__ __forceinline__ void mixC_simple(Ctx C, unsigned char* ws) {
    OPQ(C);
    bf16* CQ = PLP(ws, PL_CQ); const bf16* CK = PLP(ws, PL_CK); const bf16* CV = PLP(ws, PL_CV); const bf16* CZ = PLP(ws, PL_CZ);
    const bf16* QI0 = PLP(ws, PL_CQI0); const bf16* QI1 = PLP(ws, PL_CQI1); const float* MS = (const float*)(ws + WS_MISC);
    LAS float* L = (LAS float*)C.lds;
    LAS float* qs = L;
    LAS float* q4 = L + 512;
    LAS float* wq = L + 768;
    LAS float* sc = L + 1024;
    LAS float* ps = L + 5120;
    LAS int* sel = (LAS int*)(L + 6144);
    LAS unsigned* hist = (LAS unsigned*)(L + 6400);
    LAS float* red = L + 6656;
    LAS unsigned* sw = (LAS unsigned*)(L + 6672);
    const int tid = C.tid;
    for (int m = C.bid; m < NTOK; m += C.G) {
        const int b = m >> 12, t = m & 4095, n = ((t >> 6) + 1) * 64;
        qs[tid] = bf2f(tid < 256 ? QI0[(size_t)m * 256 + tid] : QI1[(size_t)m * 256 + tid - 256]);
        if (tid < 256) q4[tid] = bf2f(CQ[(size_t)m * 256 + tid]);
        if (tid < 8) wq[tid] = MS[(size_t)m * 256 + 64 + tid] * 0.35355339059327373f;
        __syncthreads();
        for (int s = tid; s < n; s += 512) {
            const f32x4* kp = (const f32x4*)(MS + (((size_t)b << 12) + s) * 256);
            float kv[64];
#pragma unroll
            for (int j = 0; j < 16; ++j) { const f32x4 w = kp[j]; kv[4 * j] = w.x; kv[4 * j + 1] = w.y; kv[4 * j + 2] = w.z; kv[4 * j + 3] = w.w; }
            float acc = 0.f;
            for (int hh = 0; hh < 8; ++hh) {
                float d = 0.f;
#pragma unroll
                for (int c = 0; c < 64; ++c) d = fmaf(qs[hh * 64 + c], kv[c], d);
                d = fmaxf(d * 0.125f, 0.f);
                acc = fmaf(d, wq[hh], acc);
            }
            sc[s] = acc;
        }
        __syncthreads();
        int cnt;
        if (n <= 256) { if (tid < n) sel[tid] = tid; cnt = n; }
        else {
            unsigned key[8];
#pragma unroll
            for (int j = 0; j < 8; ++j) { const int idx = tid + 512 * j; unsigned kk = 0u; if (idx < n) { const unsigned u = __float_as_uint(sc[idx]); kk = (u & 0x80000000u) ? ~u : (u | 0x80000000u); } key[j] = kk; }
            if (tid == 0) { sw[0] = 0u; sw[1] = 256u; sw[3] = 0u; }
            unsigned mask = 0u;
            for (int pass = 3; pass >= 0; --pass) {
                const int shift = pass * 8;
                if (tid < 256) hist[tid] = 0u;
                __syncthreads();
                const unsigned prefix = sw[0];
#pragma unroll
                for (int j = 0; j < 8; ++j) { const int idx = tid + 512 * j; if (idx < n && (key[j] & mask) == prefix) atomicAdd((unsigned*)&hist[(key[j] >> shift) & 255u], 1u); }
                __syncthreads();
                if (tid == 0) { const unsigned k = sw[1]; unsigned c = 0u; int bb = 255; for (; bb > 0; --bb) { if (c + hist[bb] >= k) break; c += hist[bb]; }
                    sw[1] = k - c; sw[0] = prefix | ((unsigned)bb << shift); sw[2] = hist[bb]; }
                mask |= (0xFFu << shift);
                __syncthreads();
            }
            const unsigned thr = sw[0], need = sw[1], eqc = sw[2];
            if (tid == 0) { int cut = SEQ;
                if (eqc != need) { unsigned c = 0u; for (int i = 0; i < n; ++i) { const unsigned u = __float_as_uint(sc[i]); const unsigned kk = (u & 0x80000000u) ? ~u : (u | 0x80000000u); if (kk == thr) { ++c; if (c == need) { cut = i; break; } } } }
                sw[4] = (unsigned)cut; }
            __syncthreads();
            const int cut = (int)sw[4];
#pragma unroll
            for (int j = 0; j < 8; ++j) { const int idx = tid + 512 * j; if (idx < n && (key[j] > thr || (key[j] == thr && idx <= cut))) { const unsigned pos = atomicAdd((unsigned*)&sw[3], 1u); if (pos < 256u) sel[pos] = idx; } }
            cnt = 256;
        }
        __syncthreads();
        float s4[4] = {-INFINITY, -INFINITY, -INFINITY, -INFINITY};
        if (tid < cnt) {
            const v4u* kr = (const v4u*)(CK + (((size_t)b << 12) + sel[tid]) * 256);
#pragma unroll
            for (int hh = 0; hh < 4; ++hh) { float d = 0.f;
#pragma unroll
                for (int j = 0; j < 8; ++j) { const v4u w = kr[hh * 8 + j]; const LAS float* qq = q4 + hh * 64 + 8 * j;
                    d = fmaf(qq[0], bflo(w.x), d); d = fmaf(qq[1], bfhi(w.x), d); d = fmaf(qq[2], bflo(w.y), d); d = fmaf(qq[3], bfhi(w.y), d);
                    d = fmaf(qq[4], bflo(w.z), d); d = fmaf(qq[5], bfhi(w.z), d); d = fmaf(qq[6], bflo(w.w), d); d = fmaf(qq[7], bfhi(w.w), d); }
                s4[hh] = d * 0.125f; }
        }
        if (tid < 256) {
#pragma unroll
            for (int hh = 0; hh < 4; ++hh) { const float v = wave_max(s4[hh]); if (C.lane == 0) red[hh * 4 + C.wave] = v; }
        }
        __syncthreads();
        float mx[4];
#pragma unroll
        for (int hh = 0; hh < 4; ++hh) mx[hh] = fmaxf(fmaxf(red[hh * 4], red[hh * 4 + 1]), fmaxf(red[hh * 4 + 2], red[hh * 4 + 3]));
        __syncthreads();
        if (tid < 256) {
#pragma unroll
            for (int hh = 0; hh < 4; ++hh) { const float e = (tid < cnt) ? expf(s4[hh] - mx[hh]) : 0.f; ps[hh * 256 + tid] = e; const float v = wave_sum(e); if (C.lane == 0) red[hh * 4 + C.wave] = v; }
        }
        __syncthreads();
        if (tid < 256) {
            const int hh = tid >> 6;
            const float lsum = red[hh * 4] + red[hh * 4 + 1] + red[hh * 4 + 2] + red[hh * 4 + 3];
            float o = 0.f;
            for (int j = 0; j < cnt; ++j) o = fmaf(ps[hh * 256 + j], bf2f(CV[(((size_t)b << 12) + sel[j]) * 256 + tid]), o);
            const float z = bf2f(CZ[(size_t)m * 256 + tid]);
            CQ[(size_t)m * 256 + tid] = (bf16)f2bf(o / lsum * siluf_(z));
        }
        __syncthreads();
    }
}

typedef float f32x16 __attribute__((ext_vector_type(16)));
__device__ __forceinline__ float ftanh(float x) { return 1.f - 2.f * __builtin_amdgcn_rcpf(1.f + __builtin_amdgcn_exp2f(2.8853900817779268f * x)); }
__device__ __forceinline__ float quad_bcast(float x, const int k) {
    const int xi = __builtin_bit_cast(int, x); int r;
    if (k == 0) r = __builtin_amdgcn_update_dpp(xi, xi, 0x00, 0xF, 0xF, false);
    else if (k == 1) r = __builtin_amdgcn_update_dpp(xi, xi, 0x55, 0xF, 0xF, false);
    else if (k == 2) r = __builtin_amdgcn_update_dpp(xi, xi, 0xAA, 0xF, 0xF, false);
    else r = __builtin_amdgcn_update_dpp(xi, xi, 0xFF, 0xF, 0xF, false);
    return __builtin_bit_cast(float, r);
}
typedef short bf16x8_t __attribute__((ext_vector_type(8)));
__device__ __forceinline__ float dpp_f(float x, const int ctrl_sel) {
    const int xi = __builtin_bit_cast(int, x); int r;
    if (ctrl_sel == 0) r = __builtin_amdgcn_update_dpp(xi, xi, 0xB1, 0xF, 0xF, false);
    else if (ctrl_sel == 1) r = __builtin_amdgcn_update_dpp(xi, xi, 0x4E, 0xF, 0xF, false);
    else r = __builtin_amdgcn_update_dpp(xi, xi, 0x141, 0xF, 0xF, false);
    return __builtin_bit_cast(float, r);
}
__device__ __forceinline__ float red8(float x) { x += dpp_f(x, 0); x += dpp_f(x, 1); x += dpp_f(x, 2); return x; }

constexpr int DSTEP_T = 320;
constexpr int D_LDS_STEP = 0, D_LDS_VS = 81920, D_LDS_TWD = 98304, D_LDS_ADS = 106496;
__device__ __forceinline__ void mixD1(Ctx C, const Params& P, int l) {
    OPQ(C);
    unsigned char* ws = P.ws;
    const bf16* DR = PLP(ws, PL_DR); const bf16* DK = PLP(ws, PL_DK); const bf16* DV = PLP(ws, PL_DV); const float* MS = (const float*)(ws + WS_MISC);
    const float* mu = P.in[6] + l * 896; const float* w0 = P.in[7] + l * 256; const float* w_up = P.in[8] + (size_t)l * 64 * 256; const float* a0 = P.in[9] + l * 256;
    const float* a_up = P.in[10] + (size_t)l * 64 * 256; const float* k_k = P.in[11] + l * 256; const float* k_a = P.in[12] + l * 256; const float* r_k = P.in[13] + l * 256;
    bf16* OL = (bf16*)(ws + WS_OL); bf16* CCp = (bf16*)(ws + WS_CC); float* BON = (float*)(ws + WS_DBON); float* AB = (float*)(ws + WS_DAB);
    LAS float* STEP = (LAS float*)(C.lds + D_LDS_STEP); LAS float* VS = (LAS float*)(C.lds + D_LDS_VS);
    LAS bf16* TWD = (LAS bf16*)(C.lds + D_LDS_TWD); LAS bf16* ADS = (LAS bf16*)(C.lds + D_LDS_ADS);
    const int tid = C.tid, lane = C.lane, wave = C.wave;
    const int tt = tid >> 3, c8 = tid & 7;
    for (int u = C.bid; u < 256; u += C.G) {
        const int b = u >> 5, h = (u >> 3) & 3, seg = u & 7, hc0 = h * 64;
        __syncthreads();
        {
            const int i = tid >> 3;
            const f32x4 wa = *(const f32x4*)(w_up + (size_t)i * 256 + hc0 + 8 * c8), wb = *(const f32x4*)(w_up + (size_t)i * 256 + hc0 + 8 * c8 + 4);
            const f32x4 aa = *(const f32x4*)(a_up + (size_t)i * 256 + hc0 + 8 * c8), ab = *(const f32x4*)(a_up + (size_t)i * 256 + hc0 + 8 * c8 + 4);
#pragma unroll
            for (int j = 0; j < 4; ++j) { TWD[(8 * c8 + j) * 64 + i] = (bf16)f2bf(wa[j]); TWD[(8 * c8 + 4 + j) * 64 + i] = (bf16)f2bf(wb[j]);
                                          ADS[(8 * c8 + j) * 64 + i] = (bf16)f2bf(aa[j]); ADS[(8 * c8 + 4 + j) * 64 + i] = (bf16)f2bf(ab[j]); }
        }
        __syncthreads();
        const int mat = wave >> 2, mt = wave & 3, fr = lane & 15, fq = lane >> 4;
        bf16x8_t bfrag[4][2];
#pragma unroll
        for (int nt = 0; nt < 4; ++nt)
#pragma unroll
            for (int k2 = 0; k2 < 2; ++k2) bfrag[nt][k2] = *(const LAS bf16x8_t*)((mat ? ADS : TWD) + (16 * nt + fr) * 64 + 32 * k2 + 8 * fq);
        float bias4[4];
#pragma unroll
        for (int nt = 0; nt < 4; ++nt) bias4[nt] = (mat ? a0 : w0)[hc0 + 16 * nt + fr];
        __syncthreads();
        float S[8], H[8];
#pragma unroll
        for (int j = 0; j < 8; ++j) { S[j] = 0.f; H[j] = (8 * c8 + j == tt) ? 1.f : 0.f; }
        v4u rc, kc, vc, rp, kp, vp; f32x4 wc0, wc1, ac0, ac1, wp0, wp1, ap0, ap1;
#define D1_LOADRAW(BLK) do { const int tl_ = seg * 512 + (BLK) * 64 + tt; const size_t m_ = ((size_t)b << 12) + tl_; const int ch_ = hc0 + 8 * c8; \
            rc = *(const v4u*)(DR + m_ * 256 + ch_); kc = *(const v4u*)(DK + m_ * 256 + ch_); vc = *(const v4u*)(DV + m_ * 256 + ch_); \
            wc0 = *(const f32x4*)(MS + m_ * 256 + 72 + 8 * c8); wc1 = *(const f32x4*)(MS + m_ * 256 + 76 + 8 * c8); ac0 = *(const f32x4*)(MS + m_ * 256 + 136 + 8 * c8); ac1 = *(const f32x4*)(MS + m_ * 256 + 140 + 8 * c8); \
            rp = (v4u){0u, 0u, 0u, 0u}; kp = rp; vp = rp; wp0 = (f32x4){0.f, 0.f, 0.f, 0.f}; wp1 = wp0; ap0 = wp0; ap1 = wp0; \
            if (tl_ > 0) { rp = *(const v4u*)(DR + (m_ - 1) * 256 + ch_); kp = *(const v4u*)(DK + (m_ - 1) * 256 + ch_); vp = *(const v4u*)(DV + (m_ - 1) * 256 + ch_); \
                wp0 = *(const f32x4*)(MS + (m_ - 1) * 256 + 72 + 8 * c8); wp1 = *(const f32x4*)(MS + (m_ - 1) * 256 + 76 + 8 * c8); ap0 = *(const f32x4*)(MS + (m_ - 1) * 256 + 136 + 8 * c8); ap1 = *(const f32x4*)(MS + (m_ - 1) * 256 + 140 + 8 * c8); } } while (0)
        D1_LOADRAW(0);
        for (int blk = 0; blk < 8; ++blk) {
            const int tloc0 = seg * 512 + blk * 64;
            const size_t m = ((size_t)b << 12) + tloc0 + tt;
            {
                const int ch = hc0 + 8 * c8;
                LAS float* st = STEP + tt * DSTEP_T + c8 * 40;
#pragma unroll
                for (int q = 0; q < 4; ++q) {
                    const unsigned rcw = rc[q], rpw = rp[q], kcw = kc[q], kpw = kp[q], vcw = vc[q], vpw = vp[q];
                    const float mr0 = mu[ch + 2 * q], mr1 = mu[ch + 2 * q + 1], mk0 = mu[256 + ch + 2 * q], mk1 = mu[256 + ch + 2 * q + 1], mv0 = mu[512 + ch + 2 * q], mv1 = mu[512 + ch + 2 * q + 1];
                    float c0 = bflo(rcw), c1 = bfhi(rcw);
                    st[32 + 2 * q] = c0 + mr0 * (bflo(rpw) - c0); st[32 + 2 * q + 1] = c1 + mr1 * (bfhi(rpw) - c1);
                    c0 = bflo(kcw); c1 = bfhi(kcw);
                    st[24 + 2 * q] = c0 + mk0 * (bflo(kpw) - c0); st[24 + 2 * q + 1] = c1 + mk1 * (bfhi(kpw) - c1);
                    c0 = bflo(vcw); c1 = bfhi(vcw);
                    VS[tt * 64 + 8 * c8 + 2 * q] = c0 + mv0 * (bflo(vpw) - c0); VS[tt * 64 + 8 * c8 + 2 * q + 1] = c1 + mv1 * (bfhi(vpw) - c1);
                }
                float tw[8], ad[8];
#pragma unroll
                for (int j = 0; j < 4; ++j) {
                    const float m0 = mu[768 + 8 * c8 + j], m1 = mu[768 + 8 * c8 + 4 + j], n0 = mu[832 + 8 * c8 + j], n1 = mu[832 + 8 * c8 + 4 + j];
                    tw[j] = tanhf(wc0[j] + m0 * (wp0[j] - wc0[j])); tw[4 + j] = tanhf(wc1[j] + m1 * (wp1[j] - wc1[j]));
                    ad[j] = ac0[j] + n0 * (ap0[j] - ac0[j]); ad[4 + j] = ac1[j] + n1 * (ap1[j] - ac1[j]);
                }
                v4u tv, av; tv.x = pk2(tw[0], tw[1]); tv.y = pk2(tw[2], tw[3]); tv.z = pk2(tw[4], tw[5]); tv.w = pk2(tw[6], tw[7]);
                av.x = pk2(ad[0], ad[1]); av.y = pk2(ad[2], ad[3]); av.z = pk2(ad[4], ad[5]); av.w = pk2(ad[6], ad[7]);
                *(LAS v4u*)(TWD + tt * 64 + 8 * c8) = tv; *(LAS v4u*)(ADS + tt * 64 + 8 * c8) = av;
            }
            __syncthreads();
            {
                const LAS bf16* Asrc = mat ? ADS : TWD;
                const bf16x8_t a0f = *(const LAS bf16x8_t*)(Asrc + (16 * mt + fr) * 64 + 8 * fq), a1f = *(const LAS bf16x8_t*)(Asrc + (16 * mt + fr) * 64 + 32 + 8 * fq);
#pragma unroll
                for (int nt = 0; nt < 4; ++nt) {
                    f32x4 acc = (f32x4){0.f, 0.f, 0.f, 0.f};
                    acc = __builtin_amdgcn_mfma_f32_16x16x32_bf16(a0f, bfrag[nt][0], acc, 0, 0, 0);
                    acc = __builtin_amdgcn_mfma_f32_16x16x32_bf16(a1f, bfrag[nt][1], acc, 0, 0, 0);
                    const int c = 16 * nt + fr;
#pragma unroll
                    for (int j = 0; j < 4; ++j) {
                        const int t = 16 * mt + 4 * fq + j; const float x = acc[j] + bias4[nt]; float val;
                        if (mat == 0) { const float nx = -x; const float sp = fmaxf(nx, 0.f) + log1pf(expf(-fabsf(nx))); val = expf(-expf(-sp - 0.5f)); }
                        else val = 1.f / (1.f + expf(-x));
                        STEP[t * DSTEP_T + (c >> 3) * 40 + (mat ? 16 : 8) + (c & 7)] = val;
                    }
                }
            }
            __syncthreads();
            {
                const int ch = hc0 + 8 * c8; LAS float* st = STEP + tt * DSTEP_T + c8 * 40;
                float kkr[8], ssq = 0.f, bon = 0.f;
#pragma unroll
                for (int j = 0; j < 8; ++j) { const float kx = st[24 + j], a = st[16 + j];
                    kkr[j] = kx * k_k[ch + j]; ssq = fmaf(kkr[j], kkr[j], ssq);
                    const float kf = kx * (1.f + (a - 1.f) * k_a[ch + j]); st[24 + j] = kf; bon = fmaf(st[32 + j] * kf, r_k[ch + j], bon); }
                ssq = red8(ssq); bon = red8(bon);
                const float inv = 1.f / fmaxf(sqrtf(ssq), 1e-12f);
#pragma unroll
                for (int j = 0; j < 8; ++j) { const float kk = kkr[j] * inv; st[j] = kk; st[16 + j] = kk * st[16 + j]; }
                if (c8 == 0) BON[m * 4 + h] = bon;
            }
            __syncthreads();
            if (blk + 1 < 8) D1_LOADRAW(blk + 1);
            for (int t = 0; t < 64; ++t) {
                const LAS f32x4* sp = (const LAS f32x4*)(STEP + t * DSTEP_T + c8 * 40);
                const f32x4 k0 = sp[0], k1 = sp[1], w0v = sp[2], w1v = sp[3], b0 = sp[4], b1 = sp[5], f0 = sp[6], f1 = sp[7], r0 = sp[8], r1 = sp[9];
                const float vv = VS[t * 64 + tt];
                float dS = 0.f, dH = 0.f;
#pragma unroll
                for (int j = 0; j < 4; ++j) { dS = fmaf(S[j], k0[j], dS); dH = fmaf(H[j], k0[j], dH); }
#pragma unroll
                for (int j = 0; j < 4; ++j) { dS = fmaf(S[4 + j], k1[j], dS); dH = fmaf(H[4 + j], k1[j], dH); }
                dS = -red8(dS); dH = -red8(dH);
                float oS = 0.f, oH = 0.f;
#pragma unroll
                for (int j = 0; j < 4; ++j) {
                    S[j] = fmaf(S[j], w0v[j], fmaf(dS, b0[j], vv * f0[j])); H[j] = fmaf(H[j], w0v[j], dH * b0[j]);
                    oS = fmaf(S[j], r0[j], oS); oH = fmaf(H[j], r0[j], oH);
                }
#pragma unroll
                for (int j = 0; j < 4; ++j) {
                    S[4 + j] = fmaf(S[4 + j], w1v[j], fmaf(dS, b1[j], vv * f1[j])); H[4 + j] = fmaf(H[4 + j], w1v[j], dH * b1[j]);
                    oS = fmaf(S[4 + j], r1[j], oS); oH = fmaf(H[4 + j], r1[j], oH);
                }
                oS = red8(oS); oH = red8(oH);
                if (c8 == 0) { const size_t mo = (((size_t)b << 12) + tloc0 + t) * 256 + hc0 + tt; OL[mo] = (bf16)f2bf(oS); CCp[mo] = (bf16)f2bf(oH); }
            }
            __syncthreads();
        }
#undef D1_LOADRAW
        {
            float* ab = AB + (size_t)u * 8192;
            *(f32x4*)(ab + tt * 64 + 8 * c8) = (f32x4){H[0], H[1], H[2], H[3]}; *(f32x4*)(ab + tt * 64 + 8 * c8 + 4) = (f32x4){H[4], H[5], H[6], H[7]};
            *(f32x4*)(ab + 4096 + tt * 64 + 8 * c8) = (f32x4){S[0], S[1], S[2], S[3]}; *(f32x4*)(ab + 4096 + tt * 64 + 8 * c8 + 4) = (f32x4){S[4], S[5], S[6], S[7]};
        }
    }
}
__device__ __forceinline__ void mixD1_ut(Ctx C, const Params& P, int l) {
    OPQ(C);
    unsigned char* ws = P.ws;
    const bf16* DR = PLP(ws, PL_DR); const bf16* DK = PLP(ws, PL_DK); const bf16* DV = PLP(ws, PL_DV); const float* MS = (const float*)(ws + WS_MISC);
    const float* mu = P.in[6] + l * 896; const float* w0 = P.in[7] + l * 256; const float* w_up = P.in[8] + (size_t)l * 64 * 256; const float* a0 = P.in[9] + l * 256;
    const float* a_up = P.in[10] + (size_t)l * 64 * 256; const float* k_k = P.in[11] + l * 256; const float* k_a = P.in[12] + l * 256; const float* r_k = P.in[13] + l * 256;
    bf16* OL = (bf16*)(ws + WS_OL); bf16* CCp = (bf16*)(ws + WS_CC); float* BON = (float*)(ws + WS_DBON); float* AB = (float*)(ws + WS_DAB);
    LAS float* STEP = (LAS float*)(C.lds + D_LDS_STEP); LAS bf16* VS16 = (LAS bf16*)(C.lds + D_LDS_VS);
    constexpr int XS = 72, TS = 40, RS = 20, MS_ = 36;
    LAS bf16* BKR = (LAS bf16*)(C.lds + 90112); LAS bf16* BKT = (LAS bf16*)(C.lds + 94720); LAS bf16* XB = (LAS bf16*)(C.lds + 99840);
    LAS bf16* VA = (LAS bf16*)(C.lds + 118272); LAS float* RH = (LAS float*)(C.lds + 131840);
    LAS float* GAM = (LAS float*)(C.lds + 131584); LAS float* MN = (LAS float*)(C.lds + 142080); LAS bf16* KR = (LAS bf16*)(C.lds + 146688); LAS bf16* QP = (LAS bf16*)(C.lds + 151296);
    LAS bf16* TWD = (LAS bf16*)(C.lds + D_LDS_TWD); LAS bf16* ADS = (LAS bf16*)(C.lds + D_LDS_ADS);
    LAS float* PAR = (LAS float*)(C.lds + 152576);
    const int wave = C.wave;
    for (int u = C.bid; u < 256; u += C.G) {
        const int lane = lane_id_fresh(), tid = wave * 64 + lane;
        const int tt = tid >> 3, c8 = tid & 7;
        const int b = u >> 5, h = (u >> 3) & 3, seg = u & 7, hc0 = h * 64;
        __syncthreads();
        {
            const int arr = tid >> 6, j = tid & 63;
            PAR[tid] = arr < 3 ? mu[256 * arr + hc0 + j] : (arr == 3 ? mu[768 + j] : (arr == 4 ? mu[832 + j] : (arr == 5 ? k_k[hc0 + j] : (arr == 6 ? k_a[hc0 + j] : r_k[hc0 + j]))));
        }
        {
            const int i = tid >> 3;
            const f32x4 wa = *(const f32x4*)(w_up + (size_t)i * 256 + hc0 + 8 * c8), wb = *(const f32x4*)(w_up + (size_t)i * 256 + hc0 + 8 * c8 + 4);
            const f32x4 aa = *(const f32x4*)(a_up + (size_t)i * 256 + hc0 + 8 * c8), ab = *(const f32x4*)(a_up + (size_t)i * 256 + hc0 + 8 * c8 + 4);
#pragma unroll
            for (int j = 0; j < 4; ++j) { TWD[(8 * c8 + j) * 64 + i] = (bf16)f2bf(wa[j]); TWD[(8 * c8 + 4 + j) * 64 + i] = (bf16)f2bf(wb[j]);
                                          ADS[(8 * c8 + j) * 64 + i] = (bf16)f2bf(aa[j]); ADS[(8 * c8 + 4 + j) * 64 + i] = (bf16)f2bf(ab[j]); }
        }
        __syncthreads();
        const int mat = wave >> 2, mt = wave & 3, fr = lane & 15, fq = lane >> 4;
        bf16x8_t bfrag[4][2];
#pragma unroll
        for (int nt = 0; nt < 4; ++nt)
#pragma unroll
            for (int k2 = 0; k2 < 2; ++k2) bfrag[nt][k2] = *(const LAS bf16x8_t*)((mat ? ADS : TWD) + (16 * nt + fr) * 64 + 32 * k2 + 8 * fq);
        float bias4[4];
#pragma unroll
        for (int nt = 0; nt < 4; ++nt) bias4[nt] = (mat ? a0 : w0)[hc0 + 16 * nt + fr];
        __syncthreads();
        const int xc = lane & 15, xq = lane >> 4;
        f32x4 X[4];
#pragma unroll
        for (int kt = 0; kt < 4; ++kt)
#pragma unroll
            for (int j = 0; j < 4; ++j) X[kt][j] = (wave >= 4 && (16 * (wave - 4) + 4 * xq + j) == (16 * kt + xc)) ? 1.f : 0.f;
        for (int i = tid; i < 64 * 16; i += 512) VA[(64 + (i >> 4)) * TS + (i & 15)] = (bf16)0;
        v4u rc, kc, vc, rp, kp, vp; f32x4 wc0, wc1, ac0, ac1, wp0, wp1, ap0, ap1;
#define D1_LOADRAW(BLK) do { const int tl_ = seg * 512 + (BLK) * 64 + tt; const size_t m_ = ((size_t)b << 12) + tl_; const int ch_ = hc0 + 8 * c8; \
            rc = *(const v4u*)(DR + m_ * 256 + ch_); kc = *(const v4u*)(DK + m_ * 256 + ch_); vc = *(const v4u*)(DV + m_ * 256 + ch_); \
            wc0 = *(const f32x4*)(MS + m_ * 256 + 72 + 8 * c8); wc1 = *(const f32x4*)(MS + m_ * 256 + 76 + 8 * c8); ac0 = *(const f32x4*)(MS + m_ * 256 + 136 + 8 * c8); ac1 = *(const f32x4*)(MS + m_ * 256 + 140 + 8 * c8); \
            rp = (v4u){0u, 0u, 0u, 0u}; kp = rp; vp = rp; wp0 = (f32x4){0.f, 0.f, 0.f, 0.f}; wp1 = wp0; ap0 = wp0; ap1 = wp0; \
            if (tl_ > 0) { rp = *(const v4u*)(DR + (m_ - 1) * 256 + ch_); kp = *(const v4u*)(DK + (m_ - 1) * 256 + ch_); vp = *(const v4u*)(DV + (m_ - 1) * 256 + ch_); \
                wp0 = *(const f32x4*)(MS + (m_ - 1) * 256 + 72 + 8 * c8); wp1 = *(const f32x4*)(MS + (m_ - 1) * 256 + 76 + 8 * c8); ap0 = *(const f32x4*)(MS + (m_ - 1) * 256 + 136 + 8 * c8); ap1 = *(const f32x4*)(MS + (m_ - 1) * 256 + 140 + 8 * c8); } } while (0)
        for (int blk = 0; blk < 8; ++blk) {
            D1_LOADRAW(blk);
            unsigned pf0 = 0u, pf1 = 0u, pf2 = 0u; float pf3 = 0.f, pf4 = 0.f;
            if (blk + 1 < 8) { const size_t mn_ = ((size_t)b << 12) + seg * 512 + (blk + 1) * 64 + tt; const int ch_ = hc0 + 8 * c8;
                pf0 = *(const unsigned*)(DR + mn_ * 256 + ch_); pf1 = *(const unsigned*)(DK + mn_ * 256 + ch_); pf2 = *(const unsigned*)(DV + mn_ * 256 + ch_);
                pf3 = MS[mn_ * 256 + 72 + 8 * c8]; pf4 = MS[mn_ * 256 + 136 + 8 * c8]; }
            const int tloc0 = seg * 512 + blk * 64;
            const size_t m = ((size_t)b << 12) + tloc0 + tt;
            for (int rep41_ = 0; rep41_ < ((EXP == 41) ? 2 : 1); ++rep41_) {
            {
                const int ch = hc0 + 8 * c8;
                LAS float* st = STEP + tt * DSTEP_T + c8 * 40;
#pragma unroll
                for (int q = 0; q < 4; ++q) {
                    const unsigned rcw = rc[q], rpw = rp[q], kcw = kc[q], kpw = kp[q], vcw = vc[q], vpw = vp[q];
                    const float mr0 = PAR[8 * c8 + 2 * q], mr1 = PAR[8 * c8 + 2 * q + 1], mk0 = PAR[64 + 8 * c8 + 2 * q], mk1 = PAR[64 + 8 * c8 + 2 * q + 1], mv0 = PAR[128 + 8 * c8 + 2 * q], mv1 = PAR[128 + 8 * c8 + 2 * q + 1];
                    float c0 = bflo(rcw), c1 = bfhi(rcw);
                    st[32 + 2 * q] = c0 + mr0 * (bflo(rpw) - c0); st[32 + 2 * q + 1] = c1 + mr1 * (bfhi(rpw) - c1);
                    c0 = bflo(kcw); c1 = bfhi(kcw);
                    st[24 + 2 * q] = c0 + mk0 * (bflo(kpw) - c0); st[24 + 2 * q + 1] = c1 + mk1 * (bfhi(kpw) - c1);
                    c0 = bflo(vcw); c1 = bfhi(vcw);
                    VS16[tt * 64 + 8 * c8 + 2 * q] = (bf16)f2bf(c0 + mv0 * (bflo(vpw) - c0)); VS16[tt * 64 + 8 * c8 + 2 * q + 1] = (bf16)f2bf(c1 + mv1 * (bfhi(vpw) - c1));
                }
                float tw[8], ad[8];
#pragma unroll
                for (int j = 0; j < 4; ++j) {
                    const float m0 = PAR[192 + 8 * c8 + j], m1 = PAR[192 + 8 * c8 + 4 + j], n0 = PAR[256 + 8 * c8 + j], n1 = PAR[256 + 8 * c8 + 4 + j];
                    tw[j] = ftanh(wc0[j] + m0 * (wp0[j] - wc0[j])); tw[4 + j] = ftanh(wc1[j] + m1 * (wp1[j] - wc1[j]));
                    ad[j] = ac0[j] + n0 * (ap0[j] - ac0[j]); ad[4 + j] = ac1[j] + n1 * (ap1[j] - ac1[j]);
                }
                v4u tv, av; tv.x = pk2(tw[0], tw[1]); tv.y = pk2(tw[2], tw[3]); tv.z = pk2(tw[4], tw[5]); tv.w = pk2(tw[6], tw[7]);
                av.x = pk2(ad[0], ad[1]); av.y = pk2(ad[2], ad[3]); av.z = pk2(ad[4], ad[5]); av.w = pk2(ad[6], ad[7]);
                *(LAS v4u*)(TWD + tt * 64 + 8 * c8) = tv; *(LAS v4u*)(ADS + tt * 64 + 8 * c8) = av;
            }
            __syncthreads();
            {
                const LAS bf16* Asrc = mat ? ADS : TWD;
                const bf16x8_t a0f = *(const LAS bf16x8_t*)(Asrc + (16 * mt + fr) * 64 + 8 * fq), a1f = *(const LAS bf16x8_t*)(Asrc + (16 * mt + fr) * 64 + 32 + 8 * fq);
#pragma unroll
                for (int nt = 0; nt < 4; ++nt) {
                    f32x4 acc = (f32x4){0.f, 0.f, 0.f, 0.f};
                    acc = __builtin_amdgcn_mfma_f32_16x16x32_bf16(a0f, bfrag[nt][0], acc, 0, 0, 0);
                    acc = __builtin_amdgcn_mfma_f32_16x16x32_bf16(a1f, bfrag[nt][1], acc, 0, 0, 0);
                    const int c = 16 * nt + fr;
#pragma unroll
                    for (int j = 0; j < 4; ++j) {
                        const int t = 16 * mt + 4 * fq + j; const float x = acc[j] + bias4[nt]; float val;
                        if (mat == 0) { const float nx = -x;
                            const float sp = fmaxf(nx, 0.f) + __builtin_amdgcn_logf(1.f + __builtin_amdgcn_exp2f(-1.4426950408889634f * fabsf(nx))) * 0.6931471805599453f;
                            val = __builtin_amdgcn_exp2f(-1.4426950408889634f * __builtin_amdgcn_exp2f(-1.4426950408889634f * (sp + 0.5f))); }
                        else val = fsig(x);
                        STEP[t * DSTEP_T + (c >> 3) * 40 + (mat ? 16 : 8) + (c & 7)] = val;
                    }
                }
            }
            __syncthreads();
            {
                const int ch = hc0 + 8 * c8; LAS float* st = STEP + tt * DSTEP_T + c8 * 40;
                float kkr[8], ssq = 0.f, bon = 0.f;
#pragma unroll
                for (int j = 0; j < 8; ++j) { const float kx = st[24 + j], a = st[16 + j];
                    kkr[j] = kx * PAR[320 + 8 * c8 + j]; ssq = fmaf(kkr[j], kkr[j], ssq);
                    const float kf = kx * (1.f + (a - 1.f) * PAR[384 + 8 * c8 + j]); st[24 + j] = kf; bon = fmaf(st[32 + j] * kf, PAR[448 + 8 * c8 + j], bon); }
                ssq = red8(ssq); bon = red8(bon);
                const float inv = 1.f / fmaxf(sqrtf(ssq), 1e-12f);
#pragma unroll
                for (int j = 0; j < 8; ++j) { const float kk = kkr[j] * inv; st[j] = kk; st[16 + j] = kk * st[16 + j]; }
                if (c8 == 0) BON[m * 4 + h] = bon;
            }
            __syncthreads();
            }
            for (int sb = 0; sb < 4; ++sb) {
                const int tau = 16 * sb;
                int xcs = xc, xqs = xq, tids = tid; asm volatile("" : "+v"(xcs), "+v"(xqs), "+v"(tids));
                f32x4 dR;
                for (int rep44_ = 0; rep44_ < ((EXP == 44) ? 2 : 1); ++rep44_) {
#pragma unroll
                for (int kt = 0; kt < 4; ++kt)
#pragma unroll
                    for (int j = 0; j < 4; ++j) XB[(16 * wave + 4 * xqs + j) * XS + 16 * kt + xcs] = (bf16)f2bf(X[kt][j]);
#pragma unroll
                for (int e = 0; e < 2; ++e) {
                    const int idx = tids + 512 * e, t2 = idx >> 6, k = idx & 63;
                    const LAS float* sw = STEP + tau * DSTEP_T + (k >> 3) * 40 + 8 + (k & 7);
                    float g0 = 1.f;
#pragma unroll
                    for (int u2 = 0; u2 < 15; ++u2) g0 *= (u2 < t2) ? sw[u2 * DSTEP_T] : 1.f;
                    const float g1 = g0 * sw[t2 * DSTEP_T];
                    if (t2 == 15) GAM[k] = g1;
                    const LAS float* st = STEP + (tau + t2) * DSTEP_T + (k >> 3) * 40 + (k & 7);
                    const float ig = __builtin_amdgcn_rcpf(g1);
                    const float kh = st[24] * ig, bh = st[16] * ig;
                    KR[t2 * XS + k] = (bf16)f2bf(st[0] * g0); KR[(16 + t2) * XS + k] = (bf16)f2bf(st[32] * g1);
                    BKR[t2 * XS + k] = (bf16)f2bf(kh); BKR[(16 + t2) * XS + k] = (bf16)f2bf(bh);
                    BKT[k * TS + t2] = (bf16)f2bf(kh); BKT[k * TS + 16 + t2] = (bf16)f2bf(-bh);
                    const int rho = idx & 63, s2 = idx >> 6;
                    VA[rho * TS + s2] = VS16[(tau + s2) * 64 + rho];
                }
                __syncthreads();
                {
                    const bf16x8_t a0 = *(const LAS bf16x8_t*)(XB + (16 * wave + xcs) * XS + 8 * xqs), a1 = *(const LAS bf16x8_t*)(XB + (16 * wave + xcs) * XS + 32 + 8 * xqs);
                    const bf16x8_t bk0 = *(const LAS bf16x8_t*)(KR + xcs * XS + 8 * xqs), bk1 = *(const LAS bf16x8_t*)(KR + xcs * XS + 32 + 8 * xqs);
                    const bf16x8_t br0 = *(const LAS bf16x8_t*)(KR + (16 + xcs) * XS + 8 * xqs), br1 = *(const LAS bf16x8_t*)(KR + (16 + xcs) * XS + 32 + 8 * xqs);
                    f32x4 dK = (f32x4){0.f, 0.f, 0.f, 0.f}; dR = dK;
                    dK = __builtin_amdgcn_mfma_f32_16x16x32_bf16(a0, bk0, dK, 0, 0, 0); dK = __builtin_amdgcn_mfma_f32_16x16x32_bf16(a1, bk1, dK, 0, 0, 0);
                    dR = __builtin_amdgcn_mfma_f32_16x16x32_bf16(a0, br0, dR, 0, 0, 0); dR = __builtin_amdgcn_mfma_f32_16x16x32_bf16(a1, br1, dR, 0, 0, 0);
#pragma unroll
                    for (int j = 0; j < 4; ++j) RH[(16 * wave + 4 * xqs + j) * RS + xcs] = dK[j];
                    if (wave >= 4) {
                        const int mt = (wave - 4) >> 1, nt = (wave - 4) & 1;
                        f32x4 acc = (f32x4){0.f, 0.f, 0.f, 0.f};
#pragma unroll
                        for (int ks = 0; ks < 2; ++ks)
                            acc = __builtin_amdgcn_mfma_f32_16x16x32_bf16(*(const LAS bf16x8_t*)(BKR + (16 * mt + xcs) * XS + 32 * ks + 8 * xqs), *(const LAS bf16x8_t*)(KR + (16 * nt + xcs) * XS + 32 * ks + 8 * xqs), acc, 0, 0, 0);
#pragma unroll
                        for (int j = 0; j < 4; ++j) MN[(16 * mt + 4 * xqs + j) * MS_ + 16 * nt + xcs] = acc[j];
                    }
                }
                __syncthreads();
                }
                for (int rep43_ = 0; rep43_ < ((EXP == 43) ? 2 : 1); ++rep43_) {
                {
                    const int rho = tids >> 2, tq = tids & 3;
                    float rhs[4];
                    { const f32x4 x = *(const LAS f32x4*)(RH + rho * RS + 4 * tq); rhs[0] = x[0]; rhs[1] = x[1]; rhs[2] = x[2]; rhs[3] = x[3]; }
                    float vv[16];
                    {
                        const v4u w0 = *(const LAS v4u*)(VA + rho * TS), w1 = *(const LAS v4u*)(VA + rho * TS + 8);
                        vv[0] = bflo(w0.x); vv[1] = bfhi(w0.x); vv[2] = bflo(w0.y); vv[3] = bfhi(w0.y); vv[4] = bflo(w0.z); vv[5] = bfhi(w0.z); vv[6] = bflo(w0.w); vv[7] = bfhi(w0.w);
                        vv[8] = bflo(w1.x); vv[9] = bfhi(w1.x); vv[10] = bflo(w1.y); vv[11] = bfhi(w1.y); vv[12] = bflo(w1.z); vv[13] = bfhi(w1.z); vv[14] = bflo(w1.w); vv[15] = bfhi(w1.w);
                    }
#pragma unroll
                    for (int s2 = 0; s2 < 15; ++s2) {
                        const float mine = rhs[s2 & 3];
                        const float sa = quad_bcast(mine, s2 >> 2);
                        const f32x4 n4 = *(const LAS f32x4*)(MN + s2 * MS_ + 4 * tq), m4 = *(const LAS f32x4*)(MN + (16 + s2) * MS_ + 4 * tq);
#pragma unroll
                        for (int i = 0; i < 4; ++i) { const float upd = fmaf(vv[s2], n4[i], fmaf(-sa, m4[i], rhs[i])); rhs[i] = (4 * tq + i > s2) ? upd : rhs[i]; }
                    }
                    v2u ow; ow.x = pk2(rhs[0], rhs[1]); ow.y = pk2(rhs[2], rhs[3]);
                    *(LAS v2u*)(VA + rho * TS + 16 + 4 * tq) = ow;
                    if (wave < 4) {
                        {
                            const int e = wave;
                            const int idx = (tids & 63) + 64 * e, t2 = idx >> 4, s2 = idx & 15;
                            const bool on = s2 <= t2;
                            QP[t2 * TS + s2] = (bf16)f2bf(on ? MN[s2 * MS_ + 16 + t2] : 0.f);
                            QP[t2 * TS + 16 + s2] = (bf16)f2bf(on ? -MN[(16 + s2) * MS_ + 16 + t2] : 0.f);
                        }
                    }
                }
                __syncthreads();
                }
                {
                    const bf16x8_t aV = *(const LAS bf16x8_t*)(VA + (16 * wave + xcs) * TS + 8 * xqs);
                    const bf16x8_t bQ = *(const LAS bf16x8_t*)(QP + xcs * TS + 8 * xqs);
                    const f32x4 O = __builtin_amdgcn_mfma_f32_16x16x32_bf16(aV, bQ, dR, 0, 0, 0);
                    v2u ow; ow.x = pk2(O[0], O[1]); ow.y = pk2(O[2], O[3]);
                    const size_t mo = (((size_t)b << 12) + tloc0 + tau + xcs) * 256 + hc0 + 16 * (wave & 3) + 4 * xqs;
                    *(v2u*)((wave < 4 ? OL : CCp) + mo) = ow;
#pragma unroll
                    for (int kt = 0; kt < 4; ++kt) {
                        X[kt] = __builtin_amdgcn_mfma_f32_16x16x32_bf16(aV, *(const LAS bf16x8_t*)(BKT + (16 * kt + xcs) * TS + 8 * xqs), X[kt], 0, 0, 0);
                        const float g16 = GAM[16 * kt + xcs];
#pragma unroll
                        for (int j = 0; j < 4; ++j) X[kt][j] *= g16;
                    }
                }
                __syncthreads();
            }
            asm volatile("" :: "v"(pf0), "v"(pf1), "v"(pf2), "v"(pf3), "v"(pf4));
        }
#undef D1_LOADRAW
        {
            float* ab = AB + (size_t)u * 8192 + (wave < 4 ? 4096 : 0);
#pragma unroll
            for (int kt = 0; kt < 4; ++kt)
#pragma unroll
                for (int j = 0; j < 4; ++j) ab[(16 * (wave & 3) + 4 * xq + j) * 64 + 16 * kt + xc] = X[kt][j];
        }
    }
}
__device__ __forceinline__ void mixD2(Ctx C, unsigned char* ws) {
    OPQ(C);
    if (C.bid >= 32) return;
    const float* AB = (const float*)(ws + WS_DAB); float* SS = (float*)(ws + WS_DSS);
    constexpr int SLS = 68;
    LAS float* SL = (LAS float*)C.lds; LAS float* AL = SL + 64 * SLS;
    const int tid = C.tid, rr = tid >> 3, ks = tid & 7;
    float S[8];
#pragma unroll
    for (int j = 0; j < 8; ++j) S[j] = 0.f;
    f32x4 na0, na1, nb0, nb1;
#define D2_LOAD(U) do { const float* ab_ = AB + (size_t)(U) * 8192; na0 = *(const f32x4*)(ab_ + tid * 8); na1 = *(const f32x4*)(ab_ + tid * 8 + 4); \
        nb0 = *(const f32x4*)(ab_ + 4096 + rr * 64 + 8 * ks); nb1 = *(const f32x4*)(ab_ + 4096 + rr * 64 + 8 * ks + 4); } while (0)
    D2_LOAD(C.bid * 8);
    for (int seg = 0; seg < 8; ++seg) {
        const int u = C.bid * 8 + seg;
        float* so = SS + (size_t)u * 4096 + rr * 64 + 8 * ks;
        *(f32x4*)so = (f32x4){S[0], S[1], S[2], S[3]}; *(f32x4*)(so + 4) = (f32x4){S[4], S[5], S[6], S[7]};
        if (seg == 7) break;
        __syncthreads();
        *(LAS f32x4*)(SL + rr * SLS + 8 * ks) = (f32x4){S[0], S[1], S[2], S[3]}; *(LAS f32x4*)(SL + rr * SLS + 8 * ks + 4) = (f32x4){S[4], S[5], S[6], S[7]};
        *(LAS f32x4*)(AL + tid * 8) = na0; *(LAS f32x4*)(AL + tid * 8 + 4) = na1;
        const f32x4 bb0 = nb0, bb1 = nb1;
        if (seg + 1 < 7) D2_LOAD(u + 1);
        __syncthreads();
#pragma unroll
        for (int j = 0; j < 4; ++j) { S[j] = bb0[j]; S[4 + j] = bb1[j]; }
#pragma unroll 8
        for (int i = 0; i < 64; ++i) {
            const float s = SL[rr * SLS + i];
            const f32x4 a0 = *(const LAS f32x4*)(AL + i * 64 + 8 * ks), a1 = *(const LAS f32x4*)(AL + i * 64 + 8 * ks + 4);
#pragma unroll
            for (int j = 0; j < 4; ++j) { S[j] = fmaf(s, a0[j], S[j]); S[4 + j] = fmaf(s, a1[j], S[4 + j]); }
        }
    }
#undef D2_LOAD
}
__device__ __forceinline__ void mixD3(Ctx C, const Params& P, int l) {
    OPQ(C);
    unsigned char* ws = P.ws;
    bf16* DR = PLP(ws, PL_DR); const bf16* DV = PLP(ws, PL_DV); const bf16* DZ = PLP(ws, PL_DZ);
    const bf16* OL = (const bf16*)(ws + WS_OL); const bf16* CCp = (const bf16*)(ws + WS_CC); const float* BON = (const float*)(ws + WS_DBON); const float* SS = (const float*)(ws + WS_DSS);
    const float* mu = P.in[6] + l * 896; const float* gn_g = P.in[14] + l * 256; const float* gn_b = P.in[15] + l * 256;
    const int wave = C.wave;
    for (int u = C.bid; u < 256; u += C.G) {
        const int lane = lane_id_fresh(), tn = lane & 31, h2 = lane >> 5;
        const int b = u >> 5, h = (u >> 3) & 3, seg = u & 7, hc0 = h * 64;
        const int tl0 = seg * 512 + wave * 64; const size_t m0 = ((size_t)b << 12) + tl0;
        LAS float* PT = (LAS float*)C.lds;
        __syncthreads();
        { const int tid_ = wave * 64 + lane; if (tid_ < 192) PT[tid_] = tid_ < 64 ? gn_g[hc0 + tid_] : (tid_ < 128 ? gn_b[hc0 + tid_ - 64] : mu[512 + hc0 + tid_ - 128]); }
        __syncthreads();
        bf16x8_t cf[2][4];
#pragma unroll
        for (int tt = 0; tt < 2; ++tt)
#pragma unroll
            for (int s = 0; s < 4; ++s) cf[tt][s] = *(const bf16x8_t*)(CCp + (m0 + 32 * tt + tn) * 256 + hc0 + 16 * s + 8 * h2);
        f32x16 acc[2][2];
#pragma unroll
        for (int vt = 0; vt < 2; ++vt)
#pragma unroll
            for (int tt = 0; tt < 2; ++tt)
#pragma unroll
                for (int r = 0; r < 16; ++r) acc[vt][tt][r] = 0.f;
#pragma unroll
        for (int vt = 0; vt < 2; ++vt)
#pragma unroll
            for (int s = 0; s < 4; ++s) {
                const float* sp = SS + (size_t)u * 4096 + (32 * vt + tn) * 64 + 16 * s + 8 * h2;
                const f32x4 x0 = *(const f32x4*)sp, x1 = *(const f32x4*)(sp + 4);
                v4u hi, lo;
                hi.x = pk2(x0[0], x0[1]); hi.y = pk2(x0[2], x0[3]); hi.z = pk2(x1[0], x1[1]); hi.w = pk2(x1[2], x1[3]);
                lo.x = pk2(x0[0] - bflo(hi.x), x0[1] - bfhi(hi.x)); lo.y = pk2(x0[2] - bflo(hi.y), x0[3] - bfhi(hi.y));
                lo.z = pk2(x1[0] - bflo(hi.z), x1[1] - bfhi(hi.z)); lo.w = pk2(x1[2] - bflo(hi.w), x1[3] - bfhi(hi.w));
                const bf16x8_t ah = __builtin_bit_cast(bf16x8_t, hi), al = __builtin_bit_cast(bf16x8_t, lo);
#pragma unroll
                for (int tt = 0; tt < 2; ++tt) {
                    acc[vt][tt] = __builtin_amdgcn_mfma_f32_32x32x16_bf16(ah, cf[tt][s], acc[vt][tt], 0, 0, 0);
                    acc[vt][tt] = __builtin_amdgcn_mfma_f32_32x32x16_bf16(al, cf[tt][s], acc[vt][tt], 0, 0, 0);
                }
            }
#pragma unroll
        for (int tt = 0; tt < 2; ++tt) {
            const int tl = tl0 + 32 * tt + tn; const size_t m = m0 + 32 * tt + tn;
            asm volatile("" ::: "memory");
            v2u wo[8], w1[8], w0[8], wz[8];
#pragma unroll
            for (int e = 0; e < 8; ++e) {
                const int vb = 32 * (e >> 2) + 8 * (e & 3) + 4 * h2;
                wo[e] = *(const v2u*)(OL + m * 256 + hc0 + vb); w1[e] = *(const v2u*)(DV + m * 256 + hc0 + vb); wz[e] = *(const v2u*)(DZ + m * 256 + hc0 + vb);
                w0[e] = (v2u){0u, 0u};
                if (tl > 0) w0[e] = *(const v2u*)(DV + (m - 1) * 256 + hc0 + vb);
            }
            const float bon = BON[m * 4 + h];
            float o[32]; float sum = 0.f;
#pragma unroll
            for (int vt = 0; vt < 2; ++vt)
#pragma unroll
                for (int g = 0; g < 4; ++g) {
                    const v2u w = wo[4 * vt + g];
                    o[16 * vt + 4 * g] = acc[vt][tt][4 * g] + bflo(w.x); o[16 * vt + 4 * g + 1] = acc[vt][tt][4 * g + 1] + bfhi(w.x);
                    o[16 * vt + 4 * g + 2] = acc[vt][tt][4 * g + 2] + bflo(w.y); o[16 * vt + 4 * g + 3] = acc[vt][tt][4 * g + 3] + bfhi(w.y);
                }
#pragma unroll
            for (int i = 0; i < 32; ++i) sum += o[i];
            const float mean = xh_sum(sum) * (1.f / 64.f);
            float vs = 0.f;
#pragma unroll
            for (int i = 0; i < 32; ++i) { o[i] -= mean; vs = fmaf(o[i], o[i], vs); }
            const float rs = __builtin_amdgcn_rsqf(xh_sum(vs) * (1.f / 64.f) + 64e-5f);
#pragma unroll
            for (int vt = 0; vt < 2; ++vt)
#pragma unroll
                for (int g = 0; g < 4; ++g) {
                    const int vb = 32 * vt + 8 * g + 4 * h2;
                    const f32x4 gg = *(const LAS f32x4*)(PT + vb), gb = *(const LAS f32x4*)(PT + 64 + vb), mv = *(const LAS f32x4*)(PT + 128 + vb);
                    const v2u a1 = w1[4 * vt + g], a0 = w0[4 * vt + g], az = wz[4 * vt + g];
                    const float c1[4] = {bflo(a1.x), bfhi(a1.x), bflo(a1.y), bfhi(a1.y)}, c0[4] = {bflo(a0.x), bfhi(a0.x), bflo(a0.y), bfhi(a0.y)}, zz[4] = {bflo(az.x), bfhi(az.x), bflo(az.y), bfhi(az.y)};
                    float y[4];
#pragma unroll
                    for (int i = 0; i < 4; ++i) {
                        float yy = o[16 * vt + 4 * g + i] * rs * gg[i] + gb[i];
                        yy += bon * (c1[i] + mv[i] * (c0[i] - c1[i]));
                        y[i] = yy * zz[i] * fsig(zz[i]);
                    }
                    v2u ow; ow.x = pk2(y[0], y[1]); ow.y = pk2(y[2], y[3]);
                    *(v2u*)(DR + m * 256 + hc0 + vb) = ow;
                }
        }
    }
}

template <bool OUT>
__device__ __forceinline__ void mixB_chunks(Ctx C, unsigned char* ws, const float* normg, bf16* OUTP) {
    OPQ(C);
    const bf16* BQ = PLP(ws, PL_BQ); const bf16* BI = PLP(ws, PL_BI); const bf16* BZ = PLP(ws, PL_BZ); const float* BF = (const float*)(ws + WS_BF);
    float* BS = (float*)(ws + WS_BS); float* BG = (float*)(ws + WS_BG);
    LAS float* FT = (LAS float*)(C.lds + C.wave * 16384); LAS float* QT = FT + 1024; LAS float* IT = FT + 2048; LAS float* ZT = FT + 3072;
    const int lane = C.lane;
    const float gnorm = OUT ? normg[lane] : 0.f;
    for (int item = C.bid * 8 + C.wave; item < 2048; item += C.G * 8) {
        const int bh = item >> 6, c = item & 63, b = bh >> 2, h = bh & 3;
        const size_t m0 = ((size_t)b << 12) + c * 64;
        float S[64];
        if (OUT) {
            const float* sp = BS + (size_t)item * 4096 + lane;
#pragma unroll
            for (int d = 0; d < 64; ++d) S[d] = sp[d * 64];
        } else {
#pragma unroll
            for (int d = 0; d < 64; ++d) S[d] = 0.f;
        }
        float g = 1.f;
        float nf[16]; unsigned short ni[16], nq[16], nz[16];
#define B_LOADTILE(T0) do { _Pragma("unroll") for (int s = 0; s < 16; ++s) { const size_t m = m0 + (T0) + s; nf[s] = BF[m * 256 + h * 64 + lane]; ni[s] = BI[m * 256 + h * 64 + lane]; \
            if (OUT) { nq[s] = BQ[m * 256 + h * 64 + lane]; nz[s] = BZ[m * 256 + h * 64 + lane]; } } } while (0)
        B_LOADTILE(0);
        for (int t0 = 0; t0 < 64; t0 += 16) {
#pragma unroll
            for (int s = 0; s < 16; ++s) {
                FT[s * 64 + lane] = nf[s]; IT[s * 64 + lane] = bf2f(ni[s]);
                if (OUT) { QT[s * 64 + lane] = bf2f(nq[s]); ZT[s * 64 + lane] = bf2f(nz[s]); }
            }
            if (t0 + 16 < 64) B_LOADTILE(t0 + 16);
            LDS_WAIT(); asm volatile("" ::: "memory");
            if (!OUT) {
#pragma unroll
                for (int s = 0; s < 16; ++s) g *= FT[s * 64 + lane];
            }
#pragma unroll 2
            for (int s = 0; s < 16; ++s) {
                const size_t m = m0 + t0 + s;
                const float iv = IT[s * 64 + lane];
                const LAS f32x4* fp = (const LAS f32x4*)(FT + s * 64); const LAS f32x4* qp = (const LAS f32x4*)(QT + s * 64);
                float o = 0.f;
#pragma unroll
                for (int q4 = 0; q4 < 16; ++q4) {
                    const f32x4 f4 = fp[q4];
#pragma unroll
                    for (int j = 0; j < 4; ++j) S[4 * q4 + j] = fmaf(f4[j], S[4 * q4 + j] - iv, iv);
                    if (OUT) { const f32x4 qv = qp[q4];
#pragma unroll
                        for (int j = 0; j < 4; ++j) o = fmaf(qv[j], S[4 * q4 + j], o); }
                }
                if (OUT) {
                    const float r = __builtin_amdgcn_rsqf(wave_sum(o * o) * (1.f / 64.f) + 1e-6f);
                    const float z = ZT[s * 64 + lane];
                    OUTP[m * 256 + h * 64 + lane] = (bf16)f2bf(o * r * gnorm * z * fsig(z));
                }
            }
            LDS_WAIT(); asm volatile("" ::: "memory");
        }
#undef B_LOADTILE
        if (!OUT) {
            float* sp = BS + (size_t)item * 4096 + lane;
#pragma unroll
            for (int d = 0; d < 64; ++d) sp[d * 64] = S[d];
            BG[item * 64 + lane] = g;
        }
    }
}
__device__ __forceinline__ void mixB_scan(Ctx C, unsigned char* ws) {
    OPQ(C);
    float* BS = (float*)(ws + WS_BS); const float* BG = (const float*)(ws + WS_BG);
    if (C.bid < 32) return;
    for (int e = (C.bid - 32) * 512 + C.tid; e < 32 * 4096; e += (C.G - 32) * 512) {
        const int bh = e >> 12, dv = e & 4095, d = dv >> 6;
        float S = 0.f;
#pragma nounroll
        for (int c0 = 0; c0 < 64; c0 += 32) {
            float sl[32], g[32];
#pragma unroll
            for (int c = 0; c < 32; ++c) { sl[c] = BS[((size_t)(bh * 64 + c0 + c) << 12) + dv]; g[c] = BG[(bh * 64 + c0 + c) * 64 + d]; }
#pragma unroll
            for (int c = 0; c < 32; ++c) { BS[((size_t)(bh * 64 + c0 + c) << 12) + dv] = S; S = fmaf(g[c], S, sl[c]); }
        }
    }
}

typedef float f32x16 __attribute__((ext_vector_type(16)));
__device__ __forceinline__ int crow_(int r, int hi) { return (r & 3) + 8 * (r >> 2) + 4 * hi; }
__device__ __forceinline__ void mixA_fast(Ctx C, unsigned char* ws, const float* bias, bf16* OUTP) {
    OPQ(C);
    const bf16* AQ = PLP(ws, PL_AQ); const bf16* AK = PLP(ws, PL_AK); const bf16* AVT = PLP(ws, PL_AV); const bf16* AZ = PLP(ws, PL_AZ);
    LAS float* BL = (LAS float*)C.lds;
    __syncthreads();
    for (int i = C.tid; i < 768; i += 512) BL[i] = bias[i] * 1.4426950408889634f;
    __syncthreads();
    const int lane = C.lane, q = lane & 31, hi = lane >> 5;
    for (int item = C.bid * 8 + C.wave; item < 2048; item += C.G * 8) {
        const int h = item & 3, c = (item >> 2) & 63, b = item >> 8;
        const size_t mq0 = ((size_t)b << 12) + c * 64;
        bf16x8_t qf[2][4];
#pragma unroll
        for (int qb = 0; qb < 2; ++qb)
#pragma unroll
            for (int s = 0; s < 4; ++s) qf[qb][s] = *(const bf16x8_t*)(AQ + (mq0 + 32 * qb + q) * 256 + h * 64 + 16 * s + 8 * hi);
        f32x16 O[2][2];
#pragma unroll
        for (int qb = 0; qb < 2; ++qb)
#pragma unroll
            for (int db = 0; db < 2; ++db)
#pragma unroll
                for (int r = 0; r < 16; ++r) O[qb][db][r] = 0.f;
        float mrun[2] = {-1e30f, -1e30f}, lrun[2] = {0.f, 0.f};
        const int klo = (c >= 8) ? (c - 8) * 64 : 0;
        const int nkb = (c * 64 + 64 - klo) >> 5;
        const LAS float* bh = BL + h * 192;
        bf16x8_t kfn[4], vtn[2][2];
#define A_LOADKV(KB) do { const size_t kb_ = (size_t)(b * 4 + h) * 128 + ((klo >> 5) + (KB)); _Pragma("unroll") for (int s = 0; s < 4; ++s) kfn[s] = *(const bf16x8_t*)(AK + ((kb_ * 4 + s) * 64 + lane) * 8); \
            _Pragma("unroll") for (int db = 0; db < 2; ++db) _Pragma("unroll") for (int s2 = 0; s2 < 2; ++s2) vtn[db][s2] = *(const bf16x8_t*)(AVT + (((kb_ * 2 + db) * 2 + s2) * 64 + lane) * 8); } while (0)
        A_LOADKV(0);
        for (int kb = 0; kb < nkb; ++kb) {
            const int kbase = klo + 32 * kb;
            bf16x8_t kf[4];
#pragma unroll
            for (int s = 0; s < 4; ++s) kf[s] = kfn[s];
            bf16x8_t vt[2][2];
#pragma unroll
            for (int db = 0; db < 2; ++db)
#pragma unroll
                for (int s2 = 0; s2 < 2; ++s2) vt[db][s2] = vtn[db][s2];
            if (kb + 1 < nkb) A_LOADKV(kb + 1);
#pragma unroll
            for (int qb = 0; qb < 2; ++qb) {
                f32x16 st;
#pragma unroll
                for (int r = 0; r < 16; ++r) st[r] = 0.f;
#pragma unroll
                for (int s = 0; s < 4; ++s) st = __builtin_amdgcn_mfma_f32_32x32x16_bf16(kf[s], qf[qb][s], st, 0, 0, 0);
                const int qpos = c * 64 + 32 * qb + q;
                float mx = -1e30f;
                if (qpos - (kbase + 31) >= 128) {
                    const float bc = bh[191];
#pragma unroll
                    for (int r = 0; r < 16; ++r) { st[r] = fmaf(st[r], 0.125f * 1.4426950408889634f, bc); mx = fmaxf(mx, st[r]); }
                } else {
#pragma unroll
                    for (int r = 0; r < 16; ++r) {
                        int rel = qpos - (kbase + crow_(r, hi)); rel = rel < -63 ? -63 : (rel > 128 ? 128 : rel);
                        st[r] = fmaf(st[r], 0.125f * 1.4426950408889634f, bh[rel + 63]);
                        mx = fmaxf(mx, st[r]);
                    }
                }
                mx = xh_max(mx);
                const float mn = fmaxf(mrun[qb], mx);
                float ps = 0.f;
#pragma unroll
                for (int r = 0; r < 16; ++r) { st[r] = __builtin_amdgcn_exp2f(st[r] - mn); ps += st[r]; }
                ps = xh_sum(ps);
                if (__builtin_amdgcn_ballot_w64(mn != mrun[qb]) != 0ull) {
                    const float al = __builtin_amdgcn_exp2f(mrun[qb] - mn);
                    lrun[qb] *= al;
#pragma unroll
                    for (int db = 0; db < 2; ++db)
#pragma unroll
                        for (int r = 0; r < 16; ++r) O[qb][db][r] *= al;
                }
                mrun[qb] = mn;
                lrun[qb] += ps;
                v4u p0, p1;
                p0.x = pk2(st[0], st[1]); p0.y = pk2(st[2], st[3]); p0.z = pk2(st[4], st[5]); p0.w = pk2(st[6], st[7]);
                p1.x = pk2(st[8], st[9]); p1.y = pk2(st[10], st[11]); p1.z = pk2(st[12], st[13]); p1.w = pk2(st[14], st[15]);
                const bf16x8_t pf0 = __builtin_bit_cast(bf16x8_t, p0), pf1 = __builtin_bit_cast(bf16x8_t, p1);
#pragma unroll
                for (int db = 0; db < 2; ++db) {
                    O[qb][db] = __builtin_amdgcn_mfma_f32_32x32x16_bf16(vt[db][0], pf0, O[qb][db], 0, 0, 0);
                    O[qb][db] = __builtin_amdgcn_mfma_f32_32x32x16_bf16(vt[db][1], pf1, O[qb][db], 0, 0, 0);
                }
            }
        }
#undef A_LOADKV
#pragma unroll
        for (int qb = 0; qb < 2; ++qb) {
            const float invl = 1.f / lrun[qb];
            const size_t mrow = (mq0 + 32 * qb + q) * 256 + h * 64;
#pragma unroll
            for (int db = 0; db < 2; ++db)
#pragma unroll
                for (int g = 0; g < 4; ++g) {
                    const int col = 32 * db + 8 * g + 4 * hi;
                    const v2u z = *(const v2u*)(AZ + mrow + col);
                    const float z0 = bflo(z.x), z1 = bfhi(z.x), z2 = bflo(z.y), z3 = bfhi(z.y);
                    v2u w;
                    w.x = pk2(O[qb][db][4 * g] * invl * z0 * fsig(z0), O[qb][db][4 * g + 1] * invl * z1 * fsig(z1));
                    w.y = pk2(O[qb][db][4 * g + 2] * invl * z2 * fsig(z2), O[qb][db][4 * g + 3] * invl * z3 * fsig(z3));
                    *(v2u*)(OUTP + mrow + col) = w;
                }
        }
    }
}

typedef __bf16 bf2_t __attribute__((ext_vector_type(2)));
__device__ __forceinline__ float dot2u(unsigned a, unsigned b, float c) { return __builtin_amdgcn_fdot2_f32_bf16(__builtin_bit_cast(bf2_t, a), __builtin_bit_cast(bf2_t, b), c, false); }
__device__ __forceinline__ float fma_s(float a, float b, float c) { float d; asm("v_fma_f32 %0, %1, %2, %3" : "=v"(d) : "v"(a), "v"(b), "v"(c)); return d; }
__device__ __forceinline__ float add_s(float a, float b) { float d; asm("v_add_f32_e32 %0, %1, %2" : "=v"(d) : "v"(a), "v"(b)); return d; }
__device__ __forceinline__ float mul_s(float a, float b) { float d; asm("v_mul_f32_e32 %0, %1, %2" : "=v"(d) : "v"(a), "v"(b)); return d; }
__device__ __forceinline__ unsigned dpp_row_shl_u32(unsigned x, const int n) {
    int r;
    if (n == 1) r = __builtin_amdgcn_update_dpp(0, (int)x, 0x101, 0xF, 0xF, true);
    else if (n == 2) r = __builtin_amdgcn_update_dpp(0, (int)x, 0x102, 0xF, 0xF, true);
    else if (n == 4) r = __builtin_amdgcn_update_dpp(0, (int)x, 0x104, 0xF, 0xF, true);
    else r = __builtin_amdgcn_update_dpp(0, (int)x, 0x108, 0xF, 0xF, true);
    return (unsigned)r;
}
__device__ __forceinline__ unsigned suffix_sum_u32(unsigned x, int lane) {
    unsigned v = x;
    v += dpp_row_shl_u32(v, 1); v += dpp_row_shl_u32(v, 2); v += dpp_row_shl_u32(v, 4); v += dpp_row_shl_u32(v, 8);
    const unsigned t1 = (unsigned)__builtin_amdgcn_readlane((int)v, 16), t2 = (unsigned)__builtin_amdgcn_readlane((int)v, 32), t3 = (unsigned)__builtin_amdgcn_readlane((int)v, 48);
    const int row = lane >> 4;
    return v + (row == 0 ? t1 + t2 + t3 : (row == 1 ? t2 + t3 : (row == 2 ? t3 : 0u)));
}
__device__ __forceinline__ int mask_sel(float x, int m) { const int xi = __builtin_bit_cast(int, x); return (xi & m) | ((int)0xFF800000 & ~m); }
constexpr int C_NB = 256, C_CAP = 128;
constexpr float C_WIN = 5.f;
__device__ const float C_ZN[64] = { 0.000f, 0.000f, 0.000f, 0.000f, -0.842f, -0.431f, -0.180f, 0.000f, 0.140f, 0.253f, 0.349f, 0.431f, 0.502f, 0.566f, 0.623f, 0.674f, 0.722f, 0.765f, 0.805f, 0.842f, 0.876f, 0.908f,
    0.939f, 0.967f, 0.994f, 1.020f, 1.044f, 1.068f, 1.090f, 1.111f, 1.131f, 1.150f, 1.169f, 1.187f, 1.204f, 1.221f, 1.237f, 1.252f, 1.267f, 1.282f, 1.296f, 1.309f, 1.322f, 1.335f, 1.348f, 1.360f, 1.372f, 1.383f, 1.394f,
    1.405f, 1.416f, 1.426f, 1.436f, 1.446f, 1.456f, 1.465f, 1.474f, 1.484f, 1.492f, 1.501f, 1.510f, 1.518f, 1.526f, 1.534f };
constexpr int C_BMS = 129;
constexpr int C_LDS_HIST = 0, C_LDS_QIF = 33792, C_LDS_BMP = 66560, C_LDS_QP = 99584, C_LDS_WQ = 101632, C_LDS_SCR = 102656, C_LDS_QBAR = 104704;
enum { QP_LO = 0, QP_SC = 1, QP_CRIT = 2, QP_LO2 = 3, QP_SC2 = 4, QP_CRIT2 = 5, QP_KREM = 6, QP_CNT = 7, QP_LVL = 8, QP_CC = 9, QP_ANYL2 = 15 };
__device__ __forceinline__ int c_bin(float s, float nlosc, float sc) { return (int)__builtin_amdgcn_fmed3f(fma_s(s, sc, nlosc), 0.f, (float)(C_NB - 1)); }
__device__ __forceinline__ float relu_asm(float x) { const int xi = __builtin_bit_cast(int, x); return __builtin_bit_cast(float, xi > 0 ? xi : 0); }
__device__ __forceinline__ void mixC_fast(Ctx C, unsigned char* ws, bf16* OUTP, const int parts = 3) {
    OPQ(C);
    const bf16* CQ = PLP(ws, PL_CQ); const bf16* CK = PLP(ws, PL_CK); const bf16* CVT = PLP(ws, PL_CV); const bf16* CZ = PLP(ws, PL_CZ);
    const bf16* QI0 = PLP(ws, PL_CQI0); const bf16* QI1 = PLP(ws, PL_CQI1); const bf16* KI = (const bf16*)(ws + WS_KI); const float* MS = (const float*)(ws + WS_MISC);
    LAS unsigned* HIST = (LAS unsigned*)(C.lds + C_LDS_HIST); LAS unsigned* BMP = (LAS unsigned*)(C.lds + C_LDS_BMP);
    LAS float* QPf = (LAS float*)(C.lds + C_LDS_QP); LAS int* QPi = (LAS int*)(C.lds + C_LDS_QP); LAS float* WQ = (LAS float*)(C.lds + C_LDS_WQ);
    LAS unsigned long long* LIST = (LAS unsigned long long*)(C.lds + C_LDS_HIST);
    LAS unsigned char* QIFL = C.lds + C_LDS_QIF;
    v4u* BINS = (v4u*)PLP(ws, PL_AK) + (size_t)C.bid * (128 * 64);
    const int wave = C.wave;
    if (wave & 4) __builtin_amdgcn_s_setprio(0); else __builtin_amdgcn_s_setprio(2);
    for (int pass2 = 0; pass2 < 2; ++pass2)
    for (int ui = C.bid; ui < 256; ui += C.G) {
        const int b = ui & 7, c = pass2 == 0 ? 63 - (ui >> 3) : (ui >> 3);
        const int n = 64 * (c + 1), nkb = n >> 5;
        const size_t mq0 = ((size_t)b << 12) + c * 64, mk0 = (size_t)b << 12;
        __syncthreads();
#define TTW ((volatile LAS unsigned*)(C.lds + MISC_OFF) + 32)
        if (EXP >= 200 && wave == 0 && lane_id_fresh() == 0) { const unsigned tn_ = (unsigned)__builtin_amdgcn_s_memrealtime(); TTW[1] = tn_; TTW[2] = tn_; }
#define TACC(slot) do { if (EXP >= 200 && wave == 0 && lane_id_fresh() == 0) { const unsigned tn_ = (unsigned)__builtin_amdgcn_s_memrealtime(); atomicAdd((unsigned*)(ws + WS_CTL) + 8192 + 16 * (slot) + 2, tn_ - TTW[2]); TTW[2] = tn_; } } while (0)
        if (!(parts & 1)) {} else if (c <= 3) {
            const int tid0 = wave * 64 + lane_id_fresh();
            for (int i = tid0; i < 64 * 128; i += 512) BMP[(i >> 7) * C_BMS + (i & 127)] = ((i & 127) < nkb) ? 0xFFFFFFFFu : 0u;
        } else {
          for (int qb = 0; qb < 2; ++qb) {
            {
                const int lane = lane_id_fresh();
                const int hh = lane >> 3;
                bf16x8_t stg[4];
                {
                    const int q = lane & 31, hi = lane >> 5;
#pragma unroll
                    for (int s = 0; s < 4; ++s) stg[s] = *(const bf16x8_t*)((wave < 4 ? QI0 : QI1) + (mq0 + 32 * qb + q) * 256 + (wave & 3) * 64 + 16 * s + 8 * hi);
                }
                v4u wq4[4]; float wv4[4];
#pragma unroll
                for (int qq = 0; qq < 4; ++qq) {
                    const size_t m = mq0 + 32 * qb + wave * 4 + qq;
                    wq4[qq] = *(const v4u*)((hh < 4 ? QI0 : QI1) + m * 256 + (hh & 3) * 64 + 8 * (lane & 7));
                    wv4[qq] = MS[m * 256 + 64 + hh];
                }
#pragma unroll
                for (int qq = 0; qq < 4; ++qq) {
                    const int qx = wave * 4 + qq;
                    const v4u w = wq4[qq];
                    float ssq;
                    { const float a0 = bflo(w.x), a1 = bfhi(w.x), a2 = bflo(w.y), a3 = bfhi(w.y), a4 = bflo(w.z), a5 = bfhi(w.z), a6 = bflo(w.w), a7 = bfhi(w.w);
                      ssq = a0 * a0 + a1 * a1 + a2 * a2 + a3 * a3 + a4 * a4 + a5 * a5 + a6 * a6 + a7 * a7; }
                    ssq = red8(ssq);
                    const float wv = wv4[qq] * (0.35355339059327373f * 0.125f);
                    float tm = 0.4f * wv * sqrtf(ssq), tv = 0.34f * wv * wv * ssq;
                    tm += dppf(tm, 4); tm += swz16f(tm); tm = xh_sum(tm);
                    tv += dppf(tv, 4); tv += swz16f(tv); tv = xh_sum(tv);
                    if ((lane & 7) == 0) WQ[qx * 8 + hh] = wv;
                    {
                        float cq[8];
                        cq[0] = bflo(w.x); cq[1] = bfhi(w.x); cq[2] = bflo(w.y); cq[3] = bfhi(w.y); cq[4] = bflo(w.z); cq[5] = bfhi(w.z); cq[6] = bflo(w.w); cq[7] = bfhi(w.w);
#pragma unroll
                        for (int j = 0; j < 8; ++j) { float v = cq[j] * (0.5f * wv); v += dppf(v, 4); v += swz16f(v); v = xh_sum(v); cq[j] = v; }
                        v4u hi4, lo4;
                        hi4.x = pk2(cq[0], cq[1]); hi4.y = pk2(cq[2], cq[3]); hi4.z = pk2(cq[4], cq[5]); hi4.w = pk2(cq[6], cq[7]);
                        lo4.x = pk2(cq[0] - bflo(hi4.x), cq[1] - bfhi(hi4.x)); lo4.y = pk2(cq[2] - bflo(hi4.y), cq[3] - bfhi(hi4.y));
                        lo4.z = pk2(cq[4] - bflo(hi4.z), cq[5] - bfhi(hi4.z)); lo4.w = pk2(cq[6] - bflo(hi4.w), cq[7] - bfhi(hi4.w));
                        if (lane < 8) { const int s_ = lane >> 1, h2_ = lane & 1;
                            *(LAS v4u*)(C.lds + C_LDS_QBAR + (0 * 4 + s_) * 1024 + (h2_ * 32 + qx) * 16) = hi4;
                            *(LAS v4u*)(C.lds + C_LDS_QBAR + (1 * 4 + s_) * 1024 + (h2_ * 32 + qx) * 16) = lo4; }
                    }
                    if (lane == 0) { const float sd = fmaxf(sqrtf(tv), 1e-20f);
                        { const float sc_ = (float)C_NB / (C_WIN * sd); QPf[qx * 16 + QP_SC] = sc_; QPf[qx * 16 + QP_LO] = -(tm + (C_ZN[c] - 0.5f * C_WIN) * sd) * sc_; }
                        QPi[qx * 16 + QP_KREM] = 256; QPi[qx * 16 + QP_CNT] = 0; QPi[qx * 16 + QP_LVL] = 0; QPi[qx * 16 + QP_CRIT] = -1; QPi[qx * 16 + QP_CRIT2] = -1; }
                }
                if (wave == 0 && lane == 0) QPi[QP_ANYL2] = 0;
#pragma unroll
                for (int s = 0; s < 4; ++s) *(LAS bf16x8_t*)(QIFL + (wave * 4 + s) * 1024 + lane * 16) = stg[s];
            }
            TACC(6);
            int mode = 0; bool fastv = false;
            while (true) {
                if (mode == 3) {
                    const int lane = lane_id_fresh(), q = lane & 31, hi = lane >> 5;
                    const int crit1 = QPi[q * 16 + QP_CRIT];
                    v4u wr[16];
#pragma unroll
                    for (int i = 0; i < 16; ++i) { const int kb = wave + 8 * i; wr[i] = BINS[(kb < nkb ? kb : wave) * 64 + lane]; }
#pragma unroll
                    for (int i = 0; i < 16; ++i) {
                        const int kb = wave + 8 * i;
                        if (kb < nkb) {
                            unsigned bits = 0u;
#pragma unroll
                            for (int r = 0; r < 16; ++r) {
                                const int b1 = (int)((wr[i][r >> 2] >> (8 * (r & 3))) & 255u);
                                if (b1 > crit1) bits |= 1u << ((r & 3) + 8 * (r >> 2));
                                if (b1 == crit1) { const unsigned pos = atomicAdd((unsigned*)&QPi[q * 16 + QP_CNT], 1u);
                                    if (pos < (unsigned)C_CAP) LIST[q * C_CAP + pos] = (unsigned long long)(unsigned)(32 * kb + crow_(r, hi)); }
                            }
                            bits <<= 4 * hi;
                            bits = xh_or(bits);
                            if (hi == 0) BMP[(32 * qb + q) * C_BMS + kb] = bits;
                        }
                    }
                    fastv = true;
                    __syncthreads();
                    TACC(7);
                    break;
                }
                {
                    const int lane = lane_id_fresh(), q = lane & 31, hi = lane >> 5;
                    if (mode < 2) { for (int i = wave * 64 + lane; i < 32 * 257; i += 512) HIST[i] = 0u; }
                    __syncthreads();
                    const float lo1 = QPf[q * 16 + QP_LO], sc1 = QPf[q * 16 + QP_SC]; const int crit1 = QPi[q * 16 + QP_CRIT]; const int lvl = QPi[q * 16 + QP_LVL];
                    bf16x8_t qif[4][4];
#pragma unroll
                    for (int hh = 0; hh < 4; ++hh)
#pragma unroll
                        for (int s = 0; s < 4; ++s) qif[hh][s] = *(const LAS bf16x8_t*)(QIFL + (hh * 4 + s) * 1024 + lane * 16);
                    bf16x8_t kn[4];
#define C_LOADKI(dst, KB) do { if ((KB) < nkb) { _Pragma("unroll") for (int s = 0; s < 4; ++s) dst[s] = *(const bf16x8_t*)(KI + ((((size_t)b * 128 + (KB)) * 4 + s) * 64 + lane) * 8); } } while (0)
#define C_QL(H, S) (*(const LAS bf16x8_t*)(QIFL + ((H) * 4 + (S)) * 1024 + lane * 16))
                    C_LOADKI(kn, wave);
                    float wq8[8];
#pragma unroll
                    for (int hh = 0; hh < 8; ++hh) wq8[hh] = 0.5f * WQ[q * 8 + hh];
                    for (int kb = wave; kb < nkb; kb += 8) {
                        const int kbase = 32 * kb;
                        bf16x8_t kif[4];
#pragma unroll
                        for (int s = 0; s < 4; ++s) kif[s] = kn[s];
                        C_LOADKI(kn, kb + 8);
                        f32x16 I;
                        for (int rep52_ = 0; rep52_ < ((EXP == 52) ? 2 : 1); ++rep52_) {
#pragma unroll
                        for (int r = 0; r < 16; ++r) I[r] = 0.f;
                        f32x16 D0, D1, DL;
                        bf16x8_t qfa[4], qfb[4];
#pragma unroll
                        for (int s = 0; s < 4; ++s) { qfa[s] = *(const LAS bf16x8_t*)(C.lds + C_LDS_QBAR + (0 * 4 + s) * 1024 + lane * 16); qfb[s] = *(const LAS bf16x8_t*)(C.lds + C_LDS_QBAR + (1 * 4 + s) * 1024 + lane * 16); }
#pragma unroll
                        for (int r = 0; r < 16; ++r) { D0[r] = 0.f; D1[r] = 0.f; DL[r] = 0.f; }
#pragma unroll
                        for (int s = 0; s < 4; ++s) D0 = __builtin_amdgcn_mfma_f32_32x32x16_bf16(kif[s], qif[0][s], D0, 0, 0, 0);
#pragma unroll
                        for (int s = 0; s < 4; ++s) DL = __builtin_amdgcn_mfma_f32_32x32x16_bf16(kif[s], qfa[s], DL, 0, 0, 0);
#pragma unroll
                        for (int s = 0; s < 4; ++s) DL = __builtin_amdgcn_mfma_f32_32x32x16_bf16(kif[s], qfb[s], DL, 0, 0, 0);
                        __builtin_amdgcn_sched_barrier(0);
#define C_STAGE(HH, DC, DN, QN_EXPR, PRE, ISRC) do { const float wqh = wq8[HH]; \
                            _Pragma("unroll") for (int s = 0; s < 4; ++s) { \
                                if (s == 0) { _Pragma("unroll") for (int r = 0; r < 16; ++r) DN[r] = 0.f; } \
                                DN = __builtin_amdgcn_mfma_f32_32x32x16_bf16(kif[s], QN_EXPR, DN, 0, 0, 0); \
                                PRE; \
                                float i0 = ISRC[4 * s], i1 = ISRC[4 * s + 1], i2 = ISRC[4 * s + 2], i3 = ISRC[4 * s + 3]; \
                                i0 = __builtin_fmaf(__builtin_fabsf(DC[4 * s]), wqh, i0); i1 = __builtin_fmaf(__builtin_fabsf(DC[4 * s + 1]), wqh, i1); \
                                i2 = __builtin_fmaf(__builtin_fabsf(DC[4 * s + 2]), wqh, i2); i3 = __builtin_fmaf(__builtin_fabsf(DC[4 * s + 3]), wqh, i3); \
                                asm volatile("" : "+v"(i0), "+v"(i1), "+v"(i2), "+v"(i3)); \
                                I[4 * s] = i0; I[4 * s + 1] = i1; I[4 * s + 2] = i2; I[4 * s + 3] = i3; \
                                __builtin_amdgcn_sched_barrier(0); } } while (0)
                        C_STAGE(0, D0, D1, qif[1][s], (void)0, DL);
                        C_STAGE(1, D1, D0, qif[2][s], (void)0, I);
                        C_STAGE(2, D0, D1, qif[3][s], qfa[s] = C_QL(4, s), I);
                        C_STAGE(3, D1, D0, qfa[s], qfb[s] = C_QL(5, s), I);
                        C_STAGE(4, D0, D1, qfb[s], qfa[s] = C_QL(6, s), I);
                        C_STAGE(5, D1, D0, qfa[s], qfb[s] = C_QL(7, s), I);
                        C_STAGE(6, D0, D1, qfb[s], (void)0, I);
                        { const float wqh = wq8[7];
#pragma unroll
                          for (int s = 0; s < 4; ++s) {
                              float i0 = I[4 * s], i1 = I[4 * s + 1], i2 = I[4 * s + 2], i3 = I[4 * s + 3];
                              i0 = __builtin_fmaf(__builtin_fabsf(D1[4 * s]), wqh, i0); i1 = __builtin_fmaf(__builtin_fabsf(D1[4 * s + 1]), wqh, i1);
                              i2 = __builtin_fmaf(__builtin_fabsf(D1[4 * s + 2]), wqh, i2); i3 = __builtin_fmaf(__builtin_fabsf(D1[4 * s + 3]), wqh, i3);
                              asm volatile("" : "+v"(i0), "+v"(i1), "+v"(i2), "+v"(i3));
                              I[4 * s] = i0; I[4 * s + 1] = i1; I[4 * s + 2] = i2; I[4 * s + 3] = i3; } }
                        asm volatile("" : "+v"(I));
                        }
#undef C_STAGE
                        if (mode == 0) {
                            v4u rec; rec.x = 0u; rec.y = 0u; rec.z = 0u; rec.w = 0u;
#pragma unroll
                            for (int r = 0; r < 16; ++r) { const int bn = c_bin(I[r], lo1, sc1); atomicAdd((unsigned*)&HIST[q * 257 + bn], 1u); rec[r >> 2] |= (unsigned)bn << (8 * (r & 3));
                                if (EXP == 51) { unsigned z0 = 0u; asm volatile("" : "+v"(z0)); atomicAdd((unsigned*)&HIST[q * 257 + bn], z0); } }
                            BINS[kb * 64 + lane] = rec;
                        } else if (mode == 1) {
                            if (lvl == 1) {
                                const float lo2 = QPf[q * 16 + QP_LO2], sc2 = QPf[q * 16 + QP_SC2];
#pragma unroll
                                for (int r = 0; r < 16; ++r) { if (c_bin(I[r], lo1, sc1) == crit1) { const int bn = c_bin(I[r], lo2, sc2); atomicAdd((unsigned*)&HIST[q * 257 + bn], 1u); } }
                            }
                        } else {
                            unsigned bits = 0u;
#pragma unroll
                            for (int r = 0; r < 16; ++r) {
                                const int b1 = c_bin(I[r], lo1, sc1);
                                bool sel = b1 > crit1, cand = (b1 == crit1);
                                if (cand && lvl == 1) { const int b2 = c_bin(I[r], QPf[q * 16 + QP_LO2], QPf[q * 16 + QP_SC2]); const int crit2 = QPi[q * 16 + QP_CRIT2]; sel = b2 > crit2; cand = (b2 == crit2); }
                                if (sel) bits |= 1u << ((r & 3) + 8 * (r >> 2));
                                if (cand) { const unsigned pos = atomicAdd((unsigned*)&QPi[q * 16 + QP_CNT], 1u);
                                    if (pos < (unsigned)C_CAP) LIST[q * C_CAP + pos] = ((unsigned long long)__float_as_uint(I[r]) << 32) | (unsigned)(kbase + crow_(r, hi)); }
                            }
                            bits <<= 4 * hi;
                            bits = xh_or(bits);
                            if (hi == 0) BMP[(32 * qb + q) * C_BMS + kb] = bits;
                        }
                    }
                }
#undef C_LOADKI
#undef C_QL
                __syncthreads();
                TACC(7);
                if (mode == 2) break;
                {
                    const int lane = lane_id_fresh();
                    LAS unsigned* SCR = (LAS unsigned*)(C.lds + C_LDS_SCR + wave * 256);
#pragma nounroll
                    for (int qq = 0; qq < 4; ++qq) {
                        const int qx = wave * 4 + qq;
                        const int lv = QPi[qx * 16 + QP_LVL];
                        if (mode == 1 && lv == 0) continue;
                        const int krem = QPi[qx * 16 + QP_KREM];
                        unsigned cnt[4]; unsigned s = 0u;
#pragma unroll
                        for (int j = 0; j < 4; ++j) { cnt[j] = HIST[qx * 257 + lane * 4 + j]; s += cnt[j]; }
                        const unsigned incl = suffix_sum_u32(s, lane);
                        unsigned run = incl - s;
                        int fcrit = -1; unsigned frun = 0u, fcnt = 0u;
#pragma unroll
                        for (int j = 3; j >= 0; --j) {
                            const bool hit = run < (unsigned)krem && run + cnt[j] >= (unsigned)krem;
                            fcrit = hit ? lane * 4 + j : fcrit; frun = hit ? run : frun; fcnt = hit ? cnt[j] : fcnt;
                            run += cnt[j];
                        }
                        if (fcrit >= 0) {
                            QPi[qx * 16 + QP_KREM] = krem - (int)frun; QPi[qx * 16 + QP_CC] = (int)fcnt;
                            if (mode == 0) { QPi[qx * 16 + QP_CRIT] = fcrit;
                                if (fcnt > (unsigned)C_CAP) { const float nlosc = QPf[qx * 16 + QP_LO], sc = QPf[qx * 16 + QP_SC];
                                    QPf[qx * 16 + QP_LO2] = (nlosc - (float)fcrit) * (float)C_NB; QPf[qx * 16 + QP_SC2] = sc * (float)C_NB; QPi[qx * 16 + QP_LVL] = 1; QPi[QP_ANYL2] = 1; } }
                            else QPi[qx * 16 + QP_CRIT2] = fcrit;
                        }
                    }
                }
                __syncthreads();
                TACC(8);
                if (mode == 0) { const bool need_l2 = (QPi[QP_ANYL2] != 0); mode = need_l2 ? 1 : ((EXP == 31 || EXP == 33) ? 2 : 3);
                    if (EXP == 226 && need_l2 && wave == 0 && lane_id_fresh() == 0) atomicAdd((unsigned*)(ws + WS_CTL) + 8192 + 16 * 6 + 3, 10000u);
                    if (EXP == 227 && wave == 0 && lane_id_fresh() == 0) { unsigned tot = 0u; for (int qx = 0; qx < 32; ++qx) tot += (unsigned)QPi[qx * 16 + QP_CC]; atomicAdd((unsigned*)(ws + WS_CTL) + 8192 + 16 * 7 + 3, tot); } }
                else mode = 2;
                __syncthreads();
            }
            if (EXP == 33) fastv = true;
            {
                const int lane = lane_id_fresh();
                if (fastv) {
                    int o1 = QPi[(wave * 4 + 0) * 16 + QP_CNT], o2 = QPi[(wave * 4 + 1) * 16 + QP_CNT], o3 = QPi[(wave * 4 + 2) * 16 + QP_CNT], o4 = QPi[(wave * 4 + 3) * 16 + QP_CNT];
                    o1 = o1 < C_CAP ? o1 : C_CAP; o2 = o1 + (o2 < C_CAP ? o2 : C_CAP); o3 = o2 + (o3 < C_CAP ? o3 : C_CAP); o4 = o3 + (o4 < C_CAP ? o4 : C_CAP);
                    for (int g = lane; g < o4; g += 64) {
                        const int qq = (g >= o1 ? 1 : 0) + (g >= o2 ? 1 : 0) + (g >= o3 ? 1 : 0);
                        const int ci = g - (qq == 0 ? 0 : (qq == 1 ? o1 : (qq == 2 ? o2 : o3)));
                        const int qx = wave * 4 + qq;
                        const unsigned idx = (unsigned)LIST[qx * C_CAP + ci];
                        const bf16* kp = KI + ((size_t)(b * 128 + (int)(idx >> 5)) * 4 * 64 + (idx & 31u)) * 8;
                        v4u kk[8];
#pragma unroll
                        for (int s = 0; s < 4; ++s)
#pragma unroll
                            for (int h2 = 0; h2 < 2; ++h2) kk[s * 2 + h2] = *(const v4u*)(kp + (s * 64 + h2 * 32) * 8);
                        float Iv = 0.f;
#pragma unroll
                        for (int hh = 0; hh < 8; ++hh) {
                            float d = 0.f;
#pragma unroll
                            for (int s = 0; s < 4; ++s)
#pragma unroll
                                for (int h2 = 0; h2 < 2; ++h2) {
                                    const v4u qv = *(const LAS v4u*)(QIFL + (hh * 4 + s) * 1024 + (h2 * 32 + qx) * 16);
                                    const v4u kv = kk[s * 2 + h2];
                                    d = dot2u(kv.x, qv.x, d); d = dot2u(kv.y, qv.y, d); d = dot2u(kv.z, qv.z, d); d = dot2u(kv.w, qv.w, d);
                                }
                            Iv = fmaf(fmaxf(d, 0.f), WQ[qx * 8 + hh], Iv);
                        }
                        LIST[qx * C_CAP + ci] = ((unsigned long long)__float_as_uint(Iv) << 32) | idx;
                    }
                    LDS_WAIT(); asm volatile("" ::: "memory");
                }
#pragma nounroll
                for (int qq = 0; qq < 4; ++qq) {
                    const int qx = wave * 4 + qq;
                    int cn = QPi[qx * 16 + QP_CNT]; cn = cn < C_CAP ? cn : C_CAP;
                    const int need = QPi[qx * 16 + QP_KREM];
                    for (int ci = lane; ci < cn; ci += 64) {
                        const unsigned long long me = LIST[qx * C_CAP + ci];
                        const float mv = __uint_as_float((unsigned)(me >> 32)); const unsigned mi = (unsigned)me;
                        int rank = 0;
                        for (int j = 0; j < cn; ++j) { const unsigned long long o = LIST[qx * C_CAP + j]; const float ov = __uint_as_float((unsigned)(o >> 32)); const unsigned oi = (unsigned)o;
                            rank += (ov > mv || (ov == mv && oi < mi)) ? 1 : 0; }
                        if (rank < need) atomicOr((unsigned*)&BMP[(32 * qb + qx) * C_BMS + (mi >> 5)], 1u << (mi & 31));
                    }
                }
            }
            __syncthreads();
            TACC(9);
          }
        }
        __syncthreads();
        if (EXP >= 200 && wave == 0 && lane_id_fresh() == 0) { const unsigned tn_ = (unsigned)__builtin_amdgcn_s_memrealtime(); atomicAdd((unsigned*)(ws + WS_CTL) + 8192 + 16 * 4 + 2, tn_ - TTW[1]); TTW[1] = tn_; }
        if (parts & 2) {
            const int lane = lane_id_fresh(), q = lane & 31, hi = lane >> 5;
            const int qb = wave & 1, h = wave >> 1, ql = 32 * qb + q;
            bf16x8_t qf[4];
#pragma unroll
            for (int s = 0; s < 4; ++s) qf[s] = *(const bf16x8_t*)(CQ + (mq0 + ql) * 256 + h * 64 + 16 * s + 8 * hi);
            f32x16 O[2];
#pragma unroll
            for (int db = 0; db < 2; ++db)
#pragma unroll
                for (int r = 0; r < 16; ++r) O[db][r] = 0.f;
            float mrun = -1e30f, lrun = 0.f;
            bf16x8_t kA[4], vA[2][2], kB[4], vB[2][2];
#define C_LOADK(KF, KB) do { const int kbc_ = (KB) < nkb ? (KB) : nkb - 1; const size_t kb_ = (size_t)(b * 4 + h) * 128 + kbc_; _Pragma("unroll") for (int s = 0; s < 4; ++s) KF[s] = *(const bf16x8_t*)(CK + ((kb_ * 4 + s) * 64 + lane) * 8); } while (0)
#define C_LOADV(VT, KB) do { const int kbc_ = (KB) < nkb ? (KB) : nkb - 1; const size_t kb_ = (size_t)(b * 4 + h) * 128 + kbc_; _Pragma("unroll") for (int db = 0; db < 2; ++db) _Pragma("unroll") for (int s2 = 0; s2 < 2; ++s2) VT[db][s2] = *(const bf16x8_t*)(CVT + (((kb_ * 2 + db) * 2 + s2) * 64 + lane) * 8); } while (0)
#define C_ATT_BLOCK(kf, vt, kb) do { \
                const unsigned word = BMP[ql * C_BMS + kb] >> (4 * hi); \
                f32x16 st; \
_Pragma("unroll") \
                for (int r = 0; r < 16; ++r) st[r] = 0.f; \
_Pragma("unroll") \
                for (int s = 0; s < 4; ++s) st = __builtin_amdgcn_mfma_f32_32x32x16_bf16(kf[s], qf[s], st, 0, 0, 0); \
                C_LOADK(kf, (kb) + 2); \
                float mx = -INFINITY; \
_Pragma("unroll") \
                for (int r = 0; r < 16; ++r) { \
                    const int msk_ = __builtin_amdgcn_sbfe((int)word, (r & 3) + 8 * (r >> 2), 1); \
                    st[r] = __builtin_bit_cast(float, (mask_sel(st[r], msk_))); \
                    mx = fmaxf(mx, st[r]); \
                } \
                mx = xh_max(mx) * (0.125f * 1.4426950408889634f); \
                const float mn = fmaxf(mrun, mx); \
                float ps = 0.f; \
_Pragma("unroll") \
                for (int r = 0; r < 16; ++r) { st[r] = __builtin_amdgcn_exp2f(fmaf(st[r], 0.125f * 1.4426950408889634f, -mn)); ps += st[r]; } \
                ps = xh_sum(ps); \
                if (__builtin_amdgcn_ballot_w64(mn != mrun) != 0ull) { \
                    const float al = __builtin_amdgcn_exp2f(mrun - mn); \
                    lrun *= al; \
_Pragma("unroll") \
                    for (int db = 0; db < 2; ++db) \
_Pragma("unroll") \
                        for (int r = 0; r < 16; ++r) O[db][r] *= al; \
                } \
                mrun = mn; \
                lrun += ps; \
                v4u p0, p1; \
                p0.x = pk2(st[0], st[1]); p0.y = pk2(st[2], st[3]); p0.z = pk2(st[4], st[5]); p0.w = pk2(st[6], st[7]); \
                p1.x = pk2(st[8], st[9]); p1.y = pk2(st[10], st[11]); p1.z = pk2(st[12], st[13]); p1.w = pk2(st[14], st[15]); \
                const bf16x8_t pf0 = __builtin_bit_cast(bf16x8_t, p0), pf1 = __builtin_bit_cast(bf16x8_t, p1); \
_Pragma("unroll") \
                for (int db = 0; db < 2; ++db) { \
                    O[db] = __builtin_amdgcn_mfma_f32_32x32x16_bf16(vt[db][0], pf0, O[db], 0, 0, 0); \
                    O[db] = __builtin_amdgcn_mfma_f32_32x32x16_bf16(vt[db][1], pf1, O[db], 0, 0, 0); \
                } \
                C_LOADV(vt, (kb) + 2); \
            } while (0)
            C_LOADK(kA, 0); C_LOADV(vA, 0); C_LOADK(kB, 1); C_LOADV(vB, 1);
            for (int kb = 0; kb < nkb; kb += 2) {
                C_ATT_BLOCK(kA, vA, kb);
                C_ATT_BLOCK(kB, vB, (kb + 1));
            }
#undef C_LOADK
#undef C_LOADV
#undef C_ATT_BLOCK
            const float invl = 1.f / lrun;
            const size_t mrow = (mq0 + ql) * 256 + h * 64;
#pragma unroll
            for (int db = 0; db < 2; ++db)
#pragma unroll
                for (int g = 0; g < 4; ++g) {
                    const int col = 32 * db + 8 * g + 4 * hi;
                    const v2u z = *(const v2u*)(CZ + mrow + col);
                    const float z0 = bflo(z.x), z1 = bfhi(z.x), z2 = bflo(z.y), z3 = bfhi(z.y);
                    v2u w;
                    w.x = pk2(O[db][4 * g] * invl * z0 * fsig(z0), O[db][4 * g + 1] * invl * z1 * fsig(z1));
                    w.y = pk2(O[db][4 * g + 2] * invl * z2 * fsig(z2), O[db][4 * g + 3] * invl * z3 * fsig(z3));
                    *(v2u*)(OUTP + mrow + col) = w;
                }
        }
        if (EXP >= 200) { __syncthreads(); if (wave == 0 && lane_id_fresh() == 0) { const unsigned tn_ = (unsigned)__builtin_amdgcn_s_memrealtime(); atomicAdd((unsigned*)(ws + WS_CTL) + 8192 + 16 * 5 + 2, tn_ - TTW[1]); } }
    }
    __builtin_amdgcn_s_setprio(0);
}
#define GRID_BAR() do { xcd_barrier(bar, C.wave == 0 && lane_id_fresh() == 0); if (EXP >= 100) { volatile LAS unsigned* TSW = (volatile LAS unsigned*)(C.lds + MISC_OFF) + 12; const unsigned k_ = TSW[0] + 1u; if (C.wave == 0 && lane_id_fresh() == 0) { TSW[0] = k_; TSW[k_] = (unsigned)__builtin_amdgcn_s_memrealtime(); } } } while (0)
#ifndef EXP
#define EXP 0
#endif
#define REP(k) for (int rep_ = 0; rep_ < ((EXP == (k)) ? 2 : 1); ++rep_)
template <int l>
__device__ __forceinline__ void layer_body(Ctx C, const Params& P, const XcdBarrier& bar) {
    unsigned char* ws = P.ws;
    const float* xin = (l == 0) ? P.in[0] : P.out;
    bf16* DRY = (bf16*)P.out;
    REP(1) {
        pg8::Gemm g{(const pg8::bf16_t*)(ws + WS_H), (const pg8::bf16_t*)(ws + WS_W1T), NTOK, NG1, 1024};
        pg8::StaticOrder S; S.init(NTOK, NG1, C.G, C.bid);
        EpiG1 E{ws, (const float*)(ws + WS_LB) + l * 256};
        pg8::gemm_phase<EpiG1, pg8::StaticOrder, true, true>(C.lds, g, S, E, C.wave);
    }
    __syncthreads();
    convert_weights(C, P, l, 2, 128);
    GRID_BAR();
    REP(2) { mixD1_ut(C, P, l); __syncthreads(); }
    REP(3) { mixB_chunks<false>(C, ws, nullptr, nullptr); __syncthreads(); }
    GRID_BAR();
    REP(16) { mixD2(C, ws); __syncthreads(); }
    mixB_scan(C, ws);
    __syncthreads();
    if (l == 0) convert_weights(C, P, 1, 1, 32);
    __syncthreads();
    mixA_fast(C, ws, P.in[3] + l * 4 * 192, PLP(ws, PL_AQ));
    __syncthreads();
    GRID_BAR();
#define SUBT(k) do { if (EXP >= 200) { __syncthreads(); if (C.wave == 0 && lane_id_fresh() == 0) { volatile LAS unsigned* tt_ = (volatile LAS unsigned*)(C.lds + MISC_OFF) + 32; const unsigned tn_ = (unsigned)__builtin_amdgcn_s_memrealtime(); const unsigned d_ = tn_ - tt_[0]; tt_[0] = tn_; \
        unsigned* cw_ = (unsigned*)(ws + WS_CTL) + 8192 + 16 * (k); atomicMax(cw_ + l, d_); atomicAdd(cw_ + 2, d_); } } } while (0)
    if (EXP >= 200 && C.wave == 0 && lane_id_fresh() == 0) { volatile LAS unsigned* tt_ = (volatile LAS unsigned*)(C.lds + MISC_OFF) + 32; tt_[0] = (unsigned)__builtin_amdgcn_s_memrealtime(); }
    REP(4) { mixD3(C, P, l); __syncthreads(); }
    SUBT(0);
    if (EXP == 5 && l == 0) { mixB_chunks<true>(C, ws, P.in[5] + l * 64, DRY); __syncthreads(); }
    mixB_chunks<true>(C, ws, P.in[5] + l * 64, PLP(ws, PL_BQ));
    SUBT(1);
    SUBT(2);
    if (EXP == 7 && l == 0) { mixC_fast(C, ws, DRY); __syncthreads(); }
    if (EXP == 17 && l == 0) { mixC_fast(C, ws, DRY, 1); __syncthreads(); }
    if (EXP == 18 && l == 0) { mixC_fast(C, ws, DRY, 2); __syncthreads(); }
    mixC_fast(C, ws, PLP(ws, PL_CQ));
    SUBT(3);
    GRID_BAR();
    REP(8) {
        pg8::Gemm g{(const pg8::bf16_t*)PLP(ws, 0), (const pg8::bf16_t*)(ws + WS_WBT), NTOK, 1024, 256, (size_t)PLANE, (size_t)1024 * 256 * 2};
        pg8::GroupedOrder S; S.init(NTOK, 1024, 4, C.G, C.bid);
        EpiBf E{(bf16*)(ws + WS_PB), 1024, (size_t)NTOK * 1024};
        pg8::gemm_phase<EpiBf, pg8::GroupedOrder, true, true>(C.lds, g, S, E, C.wave);
    }
    GRID_BAR();
    REP(9) {
        pg8::Gemm g{(const pg8::bf16_t*)(ws + WS_H), (const pg8::bf16_t*)(ws + WS_WGT), NTOK, 4096, 1024};
        pg8::StaticOrder S; S.init(NTOK, 4096, C.G, C.bid);
        EpiGate E{(const bf16*)(ws + WS_PB), (bf16*)(ws + WS_Y)};
        pg8::gemm_phase<EpiGate, pg8::StaticOrder, true, true>(C.lds, g, S, E, C.wave);
    }
    GRID_BAR();
    for (int rep_ = 0; rep_ < ((EXP == 10 && l == 0) ? 3 : 1); ++rep_) {
        pg8::Gemm g{(const pg8::bf16_t*)(ws + WS_Y), (const pg8::bf16_t*)(ws + WS_WOT), NTOK, 1024, 1024};
        pg8::StaticOrder S; S.init(NTOK, 1024, C.G, C.bid);
        EpiRes E{xin, P.out};
        pg8::gemm_phase<EpiRes, pg8::StaticOrder, true, true>(C.lds, g, S, E, C.wave);
    }
    GRID_BAR();
    if (l == 0) { REP(11) { norm_rows_bf16(C, P.out, P.in[1] + 1024, (bf16*)(ws + WS_H)); } GRID_BAR(); }
    else {
        OPQ(C); const int gw = C.bid * 8 + C.wave, NGW = C.G * 8;
        int m = gw;
        for (; m + 3 * NGW < NTOK; m += 4 * NGW) rms_rows<4>(P.out + (size_t)m * 1024, (size_t)NGW * 1024, P.in[18], nullptr, P.out + (size_t)m * 1024, C.lane);
        for (; m < NTOK; m += NGW) rms_row(P.out + (size_t)m * 1024, P.in[18], nullptr, P.out + (size_t)m * 1024, C.lane);
    }
    if (EXP == 12) { for (int i = 0; i < 20; ++i) GRID_BAR(); }
}
__global__ void __launch_bounds__(512, 2) mega_fwd(Params P) {
    extern __shared__ __attribute__((aligned(16))) unsigned char lds_raw[];
    Ctx C; C.lds = (LAS unsigned char*)lds_raw; C.wave = __builtin_amdgcn_readfirstlane((int)threadIdx.x >> 6); C.G = gridDim.x; C.bid = blockIdx.x; OPQ(C);
    unsigned char* ws = P.ws;
    for (int u = C.tid; u < (LDS_BYTES - LDSCTL_OFF) / 4; u += 512) ((LAS unsigned*)(C.lds + LDSCTL_OFF))[u] = 0u;
    __syncthreads();
    volatile LAS unsigned* MISCW = (volatile LAS unsigned*)(C.lds + MISC_OFF);
    XcdBarrier bar = xcd_barrier_post((unsigned*)(ws + WS_CTL) + CW_BAR, MISCW + 8);
    if (EXP >= 100 && C.wave == 0 && lane_id_fresh() == 0) { volatile LAS unsigned* TSW = (volatile LAS unsigned*)(C.lds + MISC_OFF) + 12; TSW[0] = 1u; TSW[1] = (unsigned)__builtin_amdgcn_s_memrealtime(); }
    __syncthreads();
    for (int rep_ = 0; rep_ < ((EXP == 13) ? 2 : 1); ++rep_) { setup_tables(C, P); }
    for (int rep_ = 0; rep_ < ((EXP == 14) ? 2 : 1); ++rep_) { convert_weights(C, P, 0, 1); }
    for (int rep_ = 0; rep_ < ((EXP == 15) ? 2 : 1); ++rep_) { norm_rows_bf16(C, P.in[0], P.in[1], (bf16*)(ws + WS_H)); }
    GRID_BAR();
    layer_body<0>(C, P, bar);
    layer_body<1>(C, P, bar);
    if (EXP >= 100) {
        GRID_BAR();
        if (C.bid == 0 && C.wave == 0 && lane_id_fresh() == 0) {
            volatile LAS unsigned* TSW = (volatile LAS unsigned*)(C.lds + MISC_OFF) + 12;
            const int j = EXP - 100; unsigned dt;
            if (j >= 100) { const unsigned* cw_ = (const unsigned*)(P.ws + WS_CTL) + 8192 + 16 * ((j - 100) % 10);
                dt = (j < 110) ? (__hip_atomic_load(cw_, __ATOMIC_RELAXED, __HIP_MEMORY_SCOPE_AGENT) + __hip_atomic_load(cw_ + 1, __ATOMIC_RELAXED, __HIP_MEMORY_SCOPE_AGENT)) : (__hip_atomic_load(cw_ + ((j >= 120) ? 3 : 2), __ATOMIC_RELAXED, __HIP_MEMORY_SCOPE_AGENT) / 256u); }
            else if (j == 0) dt = TSW[2] - TSW[1];
            else if (j <= 7) dt = (TSW[2 + j] - TSW[1 + j]) + (TSW[10 + j] - TSW[9 + j]);
            else if (j == 8) dt = (TSW[10] - TSW[9]);
            else dt = (TSW[18] - TSW[17]);
            const unsigned long long t0 = __builtin_amdgcn_s_memrealtime();
            while (__builtin_amdgcn_s_memrealtime() - t0 < 10ull * dt) __builtin_amdgcn_s_sleep(8);
        }
    }
}

extern "C" void kernel_launch(void* const* d_in, const int* in_sizes, int n_in, void* d_out, int out_size, void* d_ws, size_t ws_size, hipStream_t stream) {
    static int grid = 0;
    if (grid == 0) {
        if (n_in != 19 || ws_size < WS_END) { fprintf(stderr, "kernel_launch: need 19 inputs and %zu bytes of workspace (got %d, %zu)\n", (size_t)WS_END, n_in, ws_size); grid = -1; return; }
        int dev = 0, cus = 0, per_cu = 0;
        if (hipGetDevice(&dev) != hipSuccess || hipDeviceGetAttribute(&cus, hipDeviceAttributeMultiprocessorCount, dev) != hipSuccess) { grid = -1; return; }
        if (hipFuncSetAttribute((const void*)mega_fwd, hipFuncAttributeMaxDynamicSharedMemorySize, LDS_BYTES) != hipSuccess) { grid = -1; return; }
        (void)hipOccupancyMaxActiveBlocksPerMultiprocessor(&per_cu, (const void*)mega_fwd, 512, LDS_BYTES);
        (void)hipGetLastError();
        grid = cus;
    }
    if (grid < 0) return;
    if (hipMemsetAsync((char*)d_ws + WS_CTL, 0, CTL_ZERO_BYTES, stream) != hipSuccess) return;
    Params p{};
    for (int i = 0; i < 19; ++i) p.in[i] = (const float*)d_in[i];
    p.out = (float*)d_out; p.ws = (unsigned char*)d_ws;
    hipLaunchKernelGGL(mega_fwd, dim3(grid), dim3(512), LDS_BYTES, stream, p);
}
```
